# Optimizing an MI355X kernel written in HIP

```python
import jax
import jax.numpy as jnp
from jax import lax
import numpy as np

D_MODEL = 1024
BATCH = 4
SEQ = 8192
DEPTH = 2

GRID_W = 64
CTX_LEN = 256
N_MIXERS = 2
N_ATTN_LAYERS = (DEPTH + N_MIXERS - 1) // N_MIXERS
N_RWKV_LAYERS = DEPTH // N_MIXERS
N_MOD = 6
NORM_EPS = 1e-6

N_HEADS = 16
N_KV_HEADS = 4
HEAD_DIM = D_MODEL // N_HEADS
Q_DIM = N_HEADS * HEAD_DIM
KV_DIM = N_KV_HEADS * HEAD_DIM
ROPE_THETA = 10000.0
Q_BLOCK = 128

RWKV_HEAD = 64
RWKV_HEADS = D_MODEL // RWKV_HEAD
DECAY_LORA = 64
AAA_LORA = 64
GATE_LORA = 160
GN_EPS = 64e-5
N_DIRS = 2

D_FF = 2816
CONV_W = 3

kernel_name = 'hybrid_attn_rwkv7_convffn_dit'


def rms_norm(x):
    xf = x.astype(jnp.float32)
    return (xf * lax.rsqrt(jnp.mean(xf * xf, axis=-1, keepdims=True) + NORM_EPS)).astype(x.dtype)


def modulate(x, shift, scale):
    return rms_norm(x) * (1.0 + scale) + shift


def centred_shift(x):
    xp = jnp.pad(x, ((0, 0), (1, 1), (0, 0)))
    return 0.5 * (xp[:, :-2] + xp[:, 2:])


def centred_dwconv(x, w, b):
    t = x.shape[1]
    p = CONV_W // 2
    xp = jnp.pad(x, ((0, 0), (p, p), (0, 0)))
    return sum(w[j] * xp[:, j:j + t] for j in range(CONV_W)) + b


def axial_rope_tables(n_tokens):
    rows = n_tokens // GRID_W
    row = jnp.repeat(jnp.arange(rows, dtype=jnp.float32), GRID_W)
    col = jnp.tile(jnp.arange(GRID_W, dtype=jnp.float32), rows)
    n_freq = HEAD_DIM // 4
    inv_freq = ROPE_THETA ** (-jnp.arange(n_freq, dtype=jnp.float32) / n_freq)
    ang = jnp.concatenate([row[:, None] * inv_freq, col[:, None] * inv_freq], axis=-1)
    return jnp.cos(ang), jnp.sin(ang)


def apply_rope(x, cos, sin):
    xp = x.reshape(*x.shape[:-1], HEAD_DIM // 2, 2)
    x0, x1 = xp[..., 0], xp[..., 1]
    c = cos[None, :, None, :].astype(x.dtype)
    s = sin[None, :, None, :].astype(x.dtype)
    return jnp.stack([x0 * c - x1 * s, x0 * s + x1 * c], axis=-1).reshape(x.shape)


def gqa_attend(q, k, v):
    s = jnp.einsum('bqhgd,bkhd->bhgqk', q, k).astype(jnp.float32) * (HEAD_DIM ** -0.5)
    p = jax.nn.softmax(s, axis=-1).astype(v.dtype)
    return jnp.einsum('bhgqk,bkhd->bqhgd', p, v)


def attention_mixer(h_lat, h_ctx, w_qkv, q_gain, k_gain, w_o, cos, sin, need_ctx_out):
    n_group = N_HEADS // N_KV_HEADS

    def project(h):
        b, t, _ = h.shape
        q, k, v = jnp.split(h @ w_qkv, [Q_DIM, Q_DIM + KV_DIM], axis=-1)
        q = rms_norm(q.reshape(b, t, N_HEADS, HEAD_DIM)) * q_gain
        k = rms_norm(k.reshape(b, t, N_KV_HEADS, HEAD_DIM)) * k_gain
        return q, k, v.reshape(b, t, N_KV_HEADS, HEAD_DIM)

    q_l, k_l, v_l = project(h_lat)
    q_c, k_c, v_c = project(h_ctx)
    q_l = apply_rope(q_l, cos, sin)
    k_l = apply_rope(k_l, cos, sin)
    k_all = jnp.concatenate([k_c, k_l], axis=1)
    v_all = jnp.concatenate([v_c, v_l], axis=1)

    b, s, _ = h_lat.shape
    n_blk = s // Q_BLOCK
    q_blk = jnp.moveaxis(q_l.reshape(b, n_blk, Q_BLOCK, N_KV_HEADS, n_group, HEAD_DIM), 1, 0)
    o_l = lax.map(lambda qb: gqa_attend(qb, k_all, v_all), q_blk)
    o_l = jnp.moveaxis(o_l, 0, 1).reshape(b, s, Q_DIM) @ w_o

    o_c = None
    if need_ctx_out:
        c_len = h_ctx.shape[1]
        o_c = gqa_attend(q_c.reshape(b, c_len, N_KV_HEADS, n_group, HEAD_DIM), k_c, v_c)
        o_c = o_c.reshape(b, c_len, Q_DIM) @ w_o
    return o_l, o_c


def rwkv_heads(t):
    return t.reshape(t.shape[0], t.shape[1], RWKV_HEADS, RWKV_HEAD)


def l2_normalize(x):
    xf = x.astype(jnp.float32)
    return (xf / jnp.maximum(jnp.sqrt(jnp.sum(xf * xf, axis=-1, keepdims=True)), 1e-12)).astype(x.dtype)


def wkv7_scan(state0, decay, k, v, a, b, r, reverse):
    emit = r is not None
    seq = (decay, k, v, a, b) + ((r,) if emit else ())
    xs = tuple(jnp.moveaxis(t, 1, 0) for t in seq)

    def step(S, inp):
        d_t, k_t, v_t, a_t, b_t = inp[:5]
        sa = jnp.einsum('bhvk,bhk->bhv', S, a_t)
        S = S * d_t[:, :, None, :] + sa[..., None] * b_t[:, :, None, :] + v_t[..., None] * k_t[:, :, None, :]
        y = jnp.einsum('bhvk,bhk->bhv', S, inp[5]) if emit else None
        return S, y

    S, ys = lax.scan(step, state0, xs, reverse=reverse)
    return S, (jnp.moveaxis(ys, 0, 1) if emit else None)


def rwkv7_mixer(h_lat, h_ctx, mu, w_r, w_k, w_v, w_o, decay_w0, decay_w1, decay_w2,
                aaa_a0, aaa_a1, aaa_a2, gate_g1, gate_g2, k_k, k_a, r_k, gn_w, gn_b, need_ctx_out):
    def scan_inputs(h):
        xx = centred_shift(h) - h
        xw, xk, xv, xa = (h + xx * mu[i] for i in (1, 2, 3, 4))
        k = xk @ w_k
        v = rwkv_heads(xv @ w_v)
        kk = l2_normalize(rwkv_heads(k * k_k))
        dirs = []
        for d in range(N_DIRS):
            w_log = -jax.nn.softplus(-(decay_w0[d] + jnp.tanh(xw @ decay_w1[d]) @ decay_w2[d])) - 0.5
            a = jax.nn.sigmoid(aaa_a0[d] + (xa @ aaa_a1[d]) @ aaa_a2[d])
            decay = rwkv_heads(jnp.exp(-jnp.exp(w_log)))
            k_d = rwkv_heads(k * (1.0 + (a - 1.0) * k_a))
            dirs.append((decay, k_d, -kk, kk * rwkv_heads(a)))
        return xx, v, dirs

    def receptance(h, xx):
        return rwkv_heads((h + xx * mu[0]) @ w_r)

    def readout(h, xx, r, v, dirs, y):
        b, t, _ = h.shape
        mean = jnp.mean(y, axis=-1, keepdims=True)
        var = jnp.mean(jnp.square(y - mean), axis=-1, keepdims=True)
        y_n = ((y - mean) * lax.rsqrt(var + GN_EPS)).reshape(b, t, D_MODEL).astype(h.dtype) * gn_w + gn_b
        bonus = sum(jnp.sum(r * k_d * r_k, axis=-1, keepdims=True) for (_, k_d, _, _) in dirs) * v
        g = jax.nn.sigmoid((h + xx * mu[5]) @ gate_g1) @ gate_g2
        return ((y_n + bonus.reshape(b, t, D_MODEL)) * g) @ w_o

    b = h_lat.shape[0]
    xx_c, v_c, dirs_c = scan_inputs(h_ctx)
    xx_l, v_l, dirs_l = scan_inputs(h_lat)
    r_c = receptance(h_ctx, xx_c) if need_ctx_out else None
    r_l = receptance(h_lat, xx_l)
    state0 = jnp.zeros((b, RWKV_HEADS, RWKV_HEAD, RWKV_HEAD), jnp.float32)
    ys_l, ys_c = [], []
    for d in range(N_DIRS):
        reverse = d == 1
        dec_c, kd_c, a_c, b_c = dirs_c[d]
        s_ctx, y_c = wkv7_scan(state0, dec_c, kd_c, v_c, a_c, b_c, r_c, reverse)
        dec_l, kd_l, a_l, b_l = dirs_l[d]
        _, y_l = wkv7_scan(s_ctx, dec_l, kd_l, v_l, a_l, b_l, r_l, reverse)
        ys_l.append(y_l)
        ys_c.append(y_c)
    o_l = readout(h_lat, xx_l, r_l, v_l, dirs_l, sum(ys_l))
    o_c = readout(h_ctx, xx_c, r_c, v_c, dirs_c, sum(ys_c)) if need_ctx_out else None
    return o_l, o_c


def conv_ffn(h, w_up, conv_w, conv_b, w_down):
    u = centred_dwconv(h @ w_up, conv_w, conv_b)
    gate, val = jnp.split(u, 2, axis=-1)
    return (jax.nn.silu(gate) * val) @ w_down


def setup_inputs(seed: int = 0) -> dict:
    key = jax.random.key(seed)
    ks = iter(jax.random.split(key, 40))
    D = D_MODEL

    def nrm(shape, scale):
        return jax.random.normal(next(ks), shape, jnp.float32) * scale

    def gain(shape):
        return 1.0 + nrm(shape, 0.05)

    return {
        'x': nrm((BATCH, SEQ, D), 1.0),
        'c': nrm((BATCH, D), 1.0),
        'ctx': nrm((BATCH, CTX_LEN, D), 1.0),
        'c_ctx': nrm((D,), 1.0),
        'ada_w': nrm((DEPTH, D, N_MOD * D), 0.5 * D ** -0.5),
        'ada_b': nrm((DEPTH, N_MOD * D), 0.02),
        'attn_w_qkv': nrm((N_ATTN_LAYERS, D, Q_DIM + 2 * KV_DIM), D ** -0.5),
        'attn_q_gain': gain((N_ATTN_LAYERS, HEAD_DIM)),
        'attn_k_gain': gain((N_ATTN_LAYERS, HEAD_DIM)),
        'attn_w_o': nrm((N_ATTN_LAYERS, Q_DIM, D), Q_DIM ** -0.5),
        'rwkv_mu': jax.random.uniform(next(ks), (N_RWKV_LAYERS, 6, D), jnp.float32),
        'rwkv_w_r': nrm((N_RWKV_LAYERS, D, D), D ** -0.5),
        'rwkv_w_k': nrm((N_RWKV_LAYERS, D, D), D ** -0.5),
        'rwkv_w_v': nrm((N_RWKV_LAYERS, D, D), D ** -0.5),
        'rwkv_w_o': nrm((N_RWKV_LAYERS, D, D), D ** -0.5),
        'rwkv_decay_w0': jax.random.uniform(next(ks), (N_RWKV_LAYERS, N_DIRS, D), jnp.float32, minval=-7.0, maxval=-2.0),
        'rwkv_decay_w1': nrm((N_RWKV_LAYERS, N_DIRS, D, DECAY_LORA), D ** -0.5),
        'rwkv_decay_w2': nrm((N_RWKV_LAYERS, N_DIRS, DECAY_LORA, D), 0.1 * DECAY_LORA ** -0.5),
        'rwkv_aaa_a0': nrm((N_RWKV_LAYERS, N_DIRS, D), 0.1),
        'rwkv_aaa_a1': nrm((N_RWKV_LAYERS, N_DIRS, D, AAA_LORA), D ** -0.5),
        'rwkv_aaa_a2': nrm((N_RWKV_LAYERS, N_DIRS, AAA_LORA, D), 0.1 * AAA_LORA ** -0.5),
        'rwkv_gate_g1': nrm((N_RWKV_LAYERS, D, GATE_LORA), D ** -0.5),
        'rwkv_gate_g2': nrm((N_RWKV_LAYERS, GATE_LORA, D), GATE_LORA ** -0.5),
        'rwkv_k_k': 0.85 + nrm((N_RWKV_LAYERS, D), 0.05),
        'rwkv_k_a': gain((N_RWKV_LAYERS, D)),
        'rwkv_r_k': nrm((N_RWKV_LAYERS, RWKV_HEADS, RWKV_HEAD), 0.1),
        'rwkv_gn_w': gain((N_RWKV_LAYERS, D)),
        'rwkv_gn_b': nrm((N_RWKV_LAYERS, D), 0.02),
        'ffn_w_up': nrm((DEPTH, D, 2 * D_FF), D ** -0.5),
        'ffn_conv_w': nrm((DEPTH, CONV_W, 2 * D_FF), CONV_W ** -0.5),
        'ffn_conv_b': nrm((DEPTH, 2 * D_FF), 0.02),
        'ffn_w_down': nrm((DEPTH, D_FF, D), D_FF ** -0.5),
        'final_gain': gain((D,)),
    }


def reference(x, c, ctx, c_ctx, ada_w, ada_b, attn_w_qkv, attn_q_gain, attn_k_gain, attn_w_o,
              rwkv_mu, rwkv_w_r, rwkv_w_k, rwkv_w_v, rwkv_w_o, rwkv_decay_w0, rwkv_decay_w1, rwkv_decay_w2,
              rwkv_aaa_a0, rwkv_aaa_a1, rwkv_aaa_a2, rwkv_gate_g1, rwkv_gate_g2, rwkv_k_k, rwkv_k_a, rwkv_r_k,
              rwkv_gn_w, rwkv_gn_b, ffn_w_up, ffn_conv_w, ffn_conv_b, ffn_w_down, final_gain):
    cos, sin = axial_rope_tables(x.shape[1])
    x_lat, x_ctx = x, ctx
    for i in range(DEPTH):
        ctx_out = i < DEPTH - 1
        j = i // N_MIXERS
        mod_l = (jax.nn.silu(c) @ ada_w[i] + ada_b[i])[:, None, :]
        mod_c = (jax.nn.silu(c_ctx) @ ada_w[i] + ada_b[i])[None, None, :]
        sh1_l, sc1_l, g1_l, sh2_l, sc2_l, g2_l = jnp.split(mod_l, N_MOD, axis=-1)
        sh1_c, sc1_c, g1_c, sh2_c, sc2_c, g2_c = jnp.split(mod_c, N_MOD, axis=-1)
        h_l = modulate(x_lat, sh1_l, sc1_l)
        h_c = modulate(x_ctx, sh1_c, sc1_c)
        if i % N_MIXERS == 0:
            y_l, y_c = attention_mixer(h_l, h_c, attn_w_qkv[j], attn_q_gain[j], attn_k_gain[j], attn_w_o[j],
                                       cos, sin, ctx_out)
        else:
            y_l, y_c = rwkv7_mixer(h_l, h_c, rwkv_mu[j], rwkv_w_r[j], rwkv_w_k[j], rwkv_w_v[j], rwkv_w_o[j],
                                   rwkv_decay_w0[j], rwkv_decay_w1[j], rwkv_decay_w2[j],
                                   rwkv_aaa_a0[j], rwkv_aaa_a1[j], rwkv_aaa_a2[j],
                                   rwkv_gate_g1[j], rwkv_gate_g2[j], rwkv_k_k[j], rwkv_k_a[j], rwkv_r_k[j],
                                   rwkv_gn_w[j], rwkv_gn_b[j], ctx_out)
        x_lat = x_lat + g1_l * y_l
        x_lat = x_lat + g2_l * conv_ffn(modulate(x_lat, sh2_l, sc2_l),
                                        ffn_w_up[i], ffn_conv_w[i], ffn_conv_b[i], ffn_w_down[i])
        if ctx_out:
            x_ctx = x_ctx + g1_c * y_c
            x_ctx = x_ctx + g2_c * conv_ffn(modulate(x_ctx, sh2_c, sc2_c),
                                            ffn_w_up[i], ffn_conv_w[i], ffn_conv_b[i], ffn_w_down[i])
    return rms_norm(x_lat) * final_gain
```

```cpp
#include <hip/hip_runtime.h>
#include <hip/hip_cooperative_groups.h>
#include <cstdio>
#include <cstdint>
namespace cg = cooperative_groups;

typedef unsigned short u16;
typedef _Float16 f16;
using bf16x8 = __attribute__((ext_vector_type(8))) short;
using f32x16 = __attribute__((ext_vector_type(16))) float;
using f32x4 = __attribute__((ext_vector_type(4))) float;
using u32x4 = __attribute__((ext_vector_type(4))) unsigned;
#define DI __device__ __forceinline__
DI u32x4 mk4(unsigned a, unsigned b, unsigned c, unsigned d) { u32x4 r; r[0] = a; r[1] = b; r[2] = c; r[3] = d; return r; }

constexpr int TL = 32768;
constexpr int TCX = 1024;
constexpr int MR = 33792;
constexpr int DM = 1024;
constexpr int DFF = 2816;
constexpr int NKEY = 8448;
constexpr int NPHASE = 18;

struct Params {
  const float *x, *c, *ctx, *c_ctx, *ada_w, *ada_b, *w_qkv, *q_gain, *k_gain, *w_o;
  const float *mu, *rw_r, *rw_k, *rw_v, *rw_o, *dw0, *dw1, *dw2, *a0, *a1, *a2, *g1, *g2, *k_k, *k_a, *r_k, *gn_w, *gn_b;
  const float *f_up, *f_cw, *f_cb, *f_down, *final_gain;
  float* out;
  u16 *qkv_t, *wo_t, *up_t, *down_t, *rr_t, *rk_t, *rv_t, *ro_t, *w1_t, *a1_t, *g1_t, *w2_t, *a2_t, *g2_t;
  float *modpart, *modv, *rope, *XC, *bonus;
  u16* zero;
  u16 *H, *XX, *Q, *QC, *Kb, *Vt, *ACT0, *ACT1;
  f16 *R16, *K16, *V16, *KK16, *Y0, *Y1;
  u16 *LW, *LA, *LG, *Z;
  int phase_lo, phase_hi;
};

DI u16 f2bf(float x) { unsigned u = __float_as_uint(x); u += 0x7fffu + ((u >> 16) & 1u); return (u16)(u >> 16); }
DI float bf2f(u16 h) { return __uint_as_float(((unsigned)h) << 16); }
DI unsigned pack2(float a, float b) { return (unsigned)f2bf(a) | (((unsigned)f2bf(b)) << 16); }
DI float wave_sum(float v) {
#pragma unroll
  for (int o = 32; o > 0; o >>= 1) v += __shfl_xor(v, o, 64);
  return v;
}
DI float sigmoidf_(float x) { return 1.f / (1.f + __expf(-x)); }
DI int midx_of(int row) { return row < TL ? (row >> 13) : 4; }
DI float* resid_ptr(const Params& p, int row) { return row < TL ? p.out + (size_t)row * DM : p.XC + (size_t)(row - TL) * DM; }
DI const float* xin_ptr(const Params& p, int row) { return row < TL ? p.x + (size_t)row * DM : p.ctx + (size_t)(row - TL) * DM; }

template <class AF, class BF>
DI void gemm_mainloop(char* smem, int nparts, int kpart, AF arow, BF brow, f32x16 (&acc)[2][2]) {
  u16* As = (u16*)smem;
  u16* Bs = As + 128 * 64;
  const int tid = threadIdx.x, lane = tid & 63, wave = tid >> 6;
  const int wm = wave >> 1, wn = wave & 1;
  const int lr = tid >> 3, lc = tid & 7;
#pragma unroll
  for (int i = 0; i < 2; ++i)
#pragma unroll
    for (int j = 0; j < 2; ++j)
#pragma unroll
      for (int e = 0; e < 16; ++e) acc[i][j][e] = 0.f;
  const u16* bp[4];
#pragma unroll
  for (int q = 0; q < 4; ++q) bp[q] = brow(lr + 32 * q) + lc * 8;
  const int nk = kpart >> 6;
  const int total = nparts * nk;
  u32x4 ra[4], rb[4];
  const u16* ap[4];
#pragma unroll
  for (int q = 0; q < 4; ++q) ap[q] = arow(lr + 32 * q, 0) + lc * 8;
#pragma unroll
  for (int q = 0; q < 4; ++q) {
    ra[q] = *(const u32x4*)(ap[q]);
    rb[q] = *(const u32x4*)(bp[q]);
  }
  const int sw = (lane >> 1) & 7;
  const int hsel = lane >> 5;
  int part = 0, kk = 0;
#pragma unroll 1
  for (int it = 0; it < total; ++it) {
    __syncthreads();
#pragma unroll
    for (int q = 0; q < 4; ++q) {
      const int row = lr + 32 * q;
      const int pc = lc ^ ((row >> 1) & 7);
      *(u32x4*)(As + row * 64 + pc * 8) = ra[q];
      *(u32x4*)(Bs + row * 64 + pc * 8) = rb[q];
    }
    __syncthreads();
    kk += 64;
    if (kk == kpart) {
      kk = 0; ++part;
      if (part < nparts) {
#pragma unroll
        for (int q = 0; q < 4; ++q) ap[q] = arow(lr + 32 * q, part) + lc * 8;
      }
    }
    if (it + 1 < total) {
      const int boff = part * kpart + kk;
#pragma unroll
      for (int q = 0; q < 4; ++q) {
        ra[q] = *(const u32x4*)(ap[q] + kk);
        rb[q] = *(const u32x4*)(bp[q] + boff);
      }
    }
#pragma unroll
    for (int ks = 0; ks < 4; ++ks) {
      const int pc = ((ks * 2 + hsel) ^ sw) * 8;
      bf16x8 af[2], bf[2];
#pragma unroll
      for (int i = 0; i < 2; ++i) {
        af[i] = *(const bf16x8*)(As + (wm * 64 + i * 32 + (lane & 31)) * 64 + pc);
        bf[i] = *(const bf16x8*)(Bs + (wn * 64 + i * 32 + (lane & 31)) * 64 + pc);
      }
#pragma unroll
      for (int i = 0; i < 2; ++i)
#pragma unroll
        for (int j = 0; j < 2; ++j) acc[i][j] = __builtin_amdgcn_mfma_f32_32x32x16_bf16(af[i], bf[j], acc[i][j], 0, 0, 0);
    }
  }
}

template <class F>
DI void epi_direct(const f32x16 (&acc)[2][2], F f) {
  const int lane = threadIdx.x & 63, wave = threadIdx.x >> 6;
  const int wm = wave >> 1, wn = wave & 1, h = lane >> 5;
#pragma unroll
  for (int i = 0; i < 2; ++i)
#pragma unroll
    for (int j = 0; j < 2; ++j)
#pragma unroll
      for (int e = 0; e < 16; ++e) {
        const int row = wm * 64 + i * 32 + (e & 3) + 8 * (e >> 2) + 4 * h;
        const int col = wn * 64 + j * 32 + (lane & 31);
        f(row, col, acc[i][j][e]);
      }
}
#define CS(r, c) Cs[(r) * 128 + (c)]
DI void acc_to_lds(float* Cs, const f32x16 (&acc)[2][2]) {
  __syncthreads();
  epi_direct(acc, [&](int r, int c, float v) { CS(r, c) = v; });
  __syncthreads();
}

struct TJob { const float* src; int srcK, srcN; u16* dst; int ld, koff; const float* mu; int Kpad, Npad; };
DI TJob get_job(const Params& p, int j) {
  TJob t; t.mu = nullptr; t.koff = 0;
  auto set = [&](const float* s, int K, int N, u16* d, int ld) { t.src = s; t.srcK = K; t.srcN = N; t.dst = d; t.ld = ld; t.Kpad = K; t.Npad = N; };
  switch (j) {
    case 0: set(p.w_qkv, 1024, 1536, p.qkv_t, 1024); break;
    case 1: set(p.w_o, 1024, 1024, p.wo_t, 1024); break;
    case 2: set(p.f_up, 1024, 5632, p.up_t, 1024); break;
    case 3: set(p.f_up + (size_t)1024 * 5632, 1024, 5632, p.up_t + (size_t)5632 * 1024, 1024); break;
    case 4: set(p.f_down, 2816, 1024, p.down_t, 2816); break;
    case 5: set(p.f_down + (size_t)2816 * 1024, 2816, 1024, p.down_t + (size_t)1024 * 2816, 2816); break;
    case 6: set(p.rw_r, 1024, 1024, p.rr_t, 2048); break;
    case 7: set(p.rw_r, 1024, 1024, p.rr_t, 2048); t.mu = p.mu + 0 * 1024; t.koff = 1024; break;
    case 8: set(p.rw_k, 1024, 1024, p.rk_t, 2048); break;
    case 9: set(p.rw_k, 1024, 1024, p.rk_t, 2048); t.mu = p.mu + 2 * 1024; t.koff = 1024; break;
    case 10: set(p.rw_v, 1024, 1024, p.rv_t, 2048); break;
    case 11: set(p.rw_v, 1024, 1024, p.rv_t, 2048); t.mu = p.mu + 3 * 1024; t.koff = 1024; break;
    case 12: set(p.rw_o, 1024, 1024, p.ro_t, 1024); break;
    case 13: set(p.dw1, 1024, 64, p.w1_t, 2048); break;
    case 14: set(p.dw1, 1024, 64, p.w1_t, 2048); t.mu = p.mu + 1 * 1024; t.koff = 1024; break;
    case 15: set(p.dw1 + 1024 * 64, 1024, 64, p.w1_t + 64 * 2048, 2048); break;
    case 16: set(p.dw1 + 1024 * 64, 1024, 64, p.w1_t + 64 * 2048, 2048); t.mu = p.mu + 1 * 1024; t.koff = 1024; break;
    case 17: set(p.a1, 1024, 64, p.a1_t, 2048); break;
    case 18: set(p.a1, 1024, 64, p.a1_t, 2048); t.mu = p.mu + 4 * 1024; t.koff = 1024; break;
    case 19: set(p.a1 + 1024 * 64, 1024, 64, p.a1_t + 64 * 2048, 2048); break;
    case 20: set(p.a1 + 1024 * 64, 1024, 64, p.a1_t + 64 * 2048, 2048); t.mu = p.mu + 4 * 1024; t.koff = 1024; break;
    case 21: set(p.g1, 1024, 160, p.g1_t, 2048); t.Npad = 256; break;
    case 22: set(p.g1, 1024, 160, p.g1_t, 2048); t.Npad = 256; t.mu = p.mu + 5 * 1024; t.koff = 1024; break;
    case 23: set(p.dw2, 64, 1024, p.w2_t, 64); break;
    case 24: set(p.dw2 + 64 * 1024, 64, 1024, p.w2_t + 1024 * 64, 64); break;
    case 25: set(p.a2, 64, 1024, p.a2_t, 64); break;
    case 26: set(p.a2 + 64 * 1024, 64, 1024, p.a2_t + 1024 * 64, 64); break;
    default: set(p.g2, 160, 1024, p.g2_t, 192); t.Kpad = 192; break;
  }
  return t;
}
constexpr int NJOBS = 28;
DI int job_tiles(const TJob& t) { return ((t.Kpad + 63) >> 6) * ((t.Npad + 63) >> 6); }

__device__ void phase_prep(const Params& p, char* smem) {
  const int tid = threadIdx.x;
  int ttiles = 0;
  for (int j = 0; j < NJOBS; ++j) ttiles += job_tiles(get_job(p, j));
  const int n_mod = 2 * 24 * 8;
  const int n_rope = 1024;
  const int total = ttiles + n_mod + n_rope;
  float* tile = (float*)smem;
  if (blockIdx.x == 0) for (int e = tid; e < 4096; e += 256) p.zero[e] = 0;
  for (int item = blockIdx.x; item < total; item += gridDim.x) {
    if (item < ttiles) {
      int rem = item, j = 0;
      TJob t = get_job(p, 0);
      while (true) { int n = job_tiles(t); if (rem < n) break; rem -= n; ++j; t = get_job(p, j); }
      const int ntn = (t.Npad + 63) >> 6;
      const int kt = rem / ntn, nt = rem % ntn;
      __syncthreads();
#pragma unroll
      for (int i = 0; i < 16; ++i) {
        const int kl = i * 4 + (tid >> 6), nl = tid & 63;
        const int k = kt * 64 + kl, n = nt * 64 + nl;
        float v = 0.f;
        if (k < t.srcK && n < t.srcN) { v = t.src[(size_t)k * t.srcN + n]; if (t.mu) v *= t.mu[k]; }
        tile[kl * 65 + nl] = v;
      }
      __syncthreads();
#pragma unroll
      for (int i = 0; i < 16; ++i) {
        const int nl = i * 4 + (tid >> 6), kl = tid & 63;
        const int k = kt * 64 + kl, n = nt * 64 + nl;
        if (k < t.Kpad && n < t.Npad) t.dst[(size_t)n * t.ld + t.koff + k] = f2bf(tile[kl * 65 + nl]);
      }
    } else if (item < ttiles + n_mod) {
      const int it = item - ttiles;
      const int layer = it / 192, cc = (it % 192) / 8, kc = it % 8;
      float* sil = (float*)smem;
      __syncthreads();
      for (int e = tid; e < 640; e += 256) {
        const int j = e >> 7, k = kc * 128 + (e & 127);
        const float v = j < 4 ? p.c[j * 1024 + k] : p.c_ctx[k];
        sil[e] = v / (1.f + __expf(-v));
      }
      __syncthreads();
      const int col = cc * 256 + tid;
      float a0 = 0, a1 = 0, a2 = 0, a3 = 0, a4 = 0;
      const float* w = p.ada_w + ((size_t)layer * 1024 + kc * 128) * 6144 + col;
#pragma unroll 16
      for (int k = 0; k < 128; ++k) {
        const float wv = w[(size_t)k * 6144];
        a0 += sil[k] * wv; a1 += sil[128 + k] * wv; a2 += sil[256 + k] * wv; a3 += sil[384 + k] * wv; a4 += sil[512 + k] * wv;
      }
      float* mp = p.modpart + ((size_t)(layer * 8 + kc) * 5) * 6144 + col;
      mp[0] = a0; mp[6144] = a1; mp[2 * 6144] = a2; mp[3 * 6144] = a3; mp[4 * 6144] = a4;
    } else {
      const int e = (item - ttiles - n_mod) * 256 + tid;
      const int s = e >> 5, pr = e & 31;
      const int f = pr & 15;
      const float inv_freq = powf(10000.f, -(float)f / 16.f);
      const float pos = (pr < 16) ? (float)(s >> 6) : (float)(s & 63);
      const float ang = pos * inv_freq;
      float sn, cs;
      sincosf(ang, &sn, &cs);
      p.rope[e * 2] = cs; p.rope[e * 2 + 1] = sn;
    }
  }
}

__device__ void phase_modreduce(const Params& p) {
  const int n = 2 * 5 * 6144;
  for (int e = blockIdx.x * 256 + threadIdx.x; e < n; e += gridDim.x * 256) {
    const int layer = e / (5 * 6144), r = e % (5 * 6144), col = r % 6144;
    float s = p.ada_b[layer * 6144 + col];
    for (int kc = 0; kc < 8; ++kc) s += p.modpart[(size_t)(layer * 8 + kc) * 5 * 6144 + r];
    p.modv[e] = s;
  }
}

template <bool FROM_INPUT>
__device__ void phase_modulate(const Params& p, int layer, int which, int nrows) {
  const int lane = threadIdx.x & 63;
  const int gw = blockIdx.x * 4 + (threadIdx.x >> 6), nw = gridDim.x * 4;
  for (int row = gw; row < nrows; row += nw) {
    const float* src = FROM_INPUT ? xin_ptr(p, row) : resid_ptr(p, row);
    const float* mv = p.modv + ((size_t)layer * 5 + midx_of(row)) * 6144 + which * 3072;
    float4 v[4];
    float ss = 0.f;
#pragma unroll
    for (int i = 0; i < 4; ++i) {
      v[i] = *(const float4*)(src + i * 256 + lane * 4);
      ss += v[i].x * v[i].x + v[i].y * v[i].y + v[i].z * v[i].z + v[i].w * v[i].w;
    }
    ss = wave_sum(ss);
    const float rinv = rsqrtf(ss * (1.f / 1024.f) + 1e-6f);
#pragma unroll
    for (int i = 0; i < 4; ++i) {
      const int col = i * 256 + lane * 4;
      const float4 sh = *(const float4*)(mv + col);
      const float4 sc = *(const float4*)(mv + 1024 + col);
      uint2 o;
      o.x = pack2(v[i].x * rinv * (1.f + sc.x) + sh.x, v[i].y * rinv * (1.f + sc.y) + sh.y);
      o.y = pack2(v[i].z * rinv * (1.f + sc.z) + sh.z, v[i].w * rinv * (1.f + sc.w) + sh.w);
      *(uint2*)(p.H + (size_t)row * DM + col) = o;
    }
  }
}

DI void modrow(const Params& p, int row, bool valid, int lane, float (&h)[16]) {
  if (!valid) {
#pragma unroll
    for (int i = 0; i < 16; ++i) h[i] = 0.f;
    return;
  }
  const float* src = resid_ptr(p, row);
  const float* mv = p.modv + ((size_t)1 * 5 + midx_of(row)) * 6144;
  float ss = 0.f;
#pragma unroll
  for (int i = 0; i < 4; ++i) {
    const float4 v = *(const float4*)(src + i * 256 + lane * 4);
    h[i * 4 + 0] = v.x; h[i * 4 + 1] = v.y; h[i * 4 + 2] = v.z; h[i * 4 + 3] = v.w;
    ss += v.x * v.x + v.y * v.y + v.z * v.z + v.w * v.w;
  }
  ss = wave_sum(ss);
  const float rinv = rsqrtf(ss * (1.f / 1024.f) + 1e-6f);
#pragma unroll
  for (int i = 0; i < 4; ++i) {
    const int col = i * 256 + lane * 4;
    const float4 sh = *(const float4*)(mv + col);
    const float4 sc = *(const float4*)(mv + 1024 + col);
    h[i * 4 + 0] = h[i * 4 + 0] * rinv * (1.f + sc.x) + sh.x;
    h[i * 4 + 1] = h[i * 4 + 1] * rinv * (1.f + sc.y) + sh.y;
    h[i * 4 + 2] = h[i * 4 + 2] * rinv * (1.f + sc.z) + sh.z;
    h[i * 4 + 3] = h[i * 4 + 3] * rinv * (1.f + sc.w) + sh.w;
  }
}
__device__ void phase_rwkv_shift(const Params& p) {
  const int lane = threadIdx.x & 63;
  const int gw = blockIdx.x * 4 + (threadIdx.x >> 6), nw = gridDim.x * 4;
  const int nitems = MR / 8;
  for (int item = gw; item < nitems; item += nw) {
    const int r0 = item * 8;
    int sb, T;
    if (r0 < TL) { sb = r0 & ~8191; T = 8192; } else { sb = TL + ((r0 - TL) & ~255); T = 256; }
    float hm[16], hc[16], hn[16];
    modrow(p, r0 - 1, r0 - 1 >= sb, lane, hm);
    modrow(p, r0, true, lane, hc);
    for (int j = 0; j < 8; ++j) {
      const int row = r0 + j;
      modrow(p, row + 1, row + 1 < sb + T, lane, hn);
#pragma unroll
      for (int i = 0; i < 4; ++i) {
        const int col = i * 256 + lane * 4;
        float xx[4];
#pragma unroll
        for (int e = 0; e < 4; ++e) xx[e] = 0.5f * (hm[i * 4 + e] + hn[i * 4 + e]) - hc[i * 4 + e];
        uint2 o, o2;
        o.x = pack2(hc[i * 4 + 0], hc[i * 4 + 1]); o.y = pack2(hc[i * 4 + 2], hc[i * 4 + 3]);
        o2.x = pack2(xx[0], xx[1]); o2.y = pack2(xx[2], xx[3]);
        *(uint2*)(p.H + (size_t)row * DM + col) = o;
        *(uint2*)(p.XX + (size_t)row * DM + col) = o2;
      }
#pragma unroll
      for (int i = 0; i < 16; ++i) { hm[i] = hc[i]; hc[i] = hn[i]; }
    }
  }
}

__device__ void phase_qkv(const Params& p, char* smem) {
  float* Cs = (float*)smem;
  const int tid = threadIdx.x;
  const int ntiles = 264 * 12;
  for (int tile = blockIdx.x; tile < ntiles; tile += gridDim.x) {
    const int mt = tile / 12, nt = tile % 12;
    const int m0 = mt * 128;
    f32x16 acc[2][2];
    gemm_mainloop(smem, 1, 1024,
                  [&](int r, int) { return (const u16*)(p.H + (size_t)(m0 + r) * DM); },
                  [&](int c) { return (const u16*)(p.qkv_t + (size_t)(nt * 128 + c) * 1024); }, acc);
    acc_to_lds(Cs, acc);
    const bool isctx = m0 >= TL;
    const int b = isctx ? (m0 - TL) >> 8 : m0 >> 13;
    const int t0 = isctx ? (m0 - TL) & 255 : m0 & 8191;
    if (nt < 10) {
      const int lane = tid & 63, wave = tid >> 6;
      const int hh = lane >> 5, pr = lane & 31;
      const bool isq = nt < 8;
      const float* gain = isq ? p.q_gain : p.k_gain;
      const float qs = isq ? 0.125f * 1.4426950408889634f : 1.f;
      const float g0 = gain[2 * pr] * qs, g1 = gain[2 * pr + 1] * qs;
      u16* dstb;
      size_t tstride = 64;
      if (isq) {
        const int head = nt * 2 + hh;
        dstb = isctx ? p.QC + ((size_t)(b * 16 + head) * 256 + t0) * 64 : p.Q + ((size_t)(b * 16 + head) * 8192 + t0) * 64;
      } else {
        const int kh = (nt - 8) * 2 + hh;
        dstb = p.Kb + ((size_t)(b * 4 + kh) * NKEY + (isctx ? t0 : 256 + t0)) * 64;
      }
#pragma unroll 4
      for (int rr = 0; rr < 32; ++rr) {
        const int r = wave * 32 + rr;
        const float2 v = *(const float2*)&CS(r, 2 * lane);
        float ss = v.x * v.x + v.y * v.y;
        ss += __shfl_xor(ss, 1, 64); ss += __shfl_xor(ss, 2, 64); ss += __shfl_xor(ss, 4, 64); ss += __shfl_xor(ss, 8, 64); ss += __shfl_xor(ss, 16, 64);
        const float rinv = rsqrtf(ss * (1.f / 64.f) + 1e-6f);
        float x0 = v.x * rinv * g0, x1 = v.y * rinv * g1;
        if (!isctx) {
          const float2 cssn = *(const float2*)(p.rope + ((size_t)(t0 + r) * 32 + pr) * 2);
          const float y0 = x0 * cssn.x - x1 * cssn.y, y1 = x0 * cssn.y + x1 * cssn.x;
          x0 = y0; x1 = y1;
        }
        *(unsigned*)(dstb + (size_t)r * tstride + 2 * pr) = pack2(x0, x1);
      }
    } else {
      const int keybase = (isctx ? t0 : 256 + t0);
      for (int j = 0; j < 4; ++j) {
        const int item = tid + 256 * j;
        const int d = item & 63, hh = (item >> 6) & 1, rg = item >> 7;
        const int kh = (nt - 10) * 2 + hh;
        float v[16];
#pragma unroll
        for (int i = 0; i < 16; ++i) v[i] = CS(rg * 16 + i, hh * 64 + d);
        u16* dst = p.Vt + ((size_t)(b * 4 + kh) * 64 + d) * NKEY + keybase + rg * 16;
        *(u32x4*)(dst) = mk4(pack2(v[0], v[1]), pack2(v[2], v[3]), pack2(v[8], v[9]), pack2(v[10], v[11]));
        *(u32x4*)(dst + 8) = mk4(pack2(v[4], v[5]), pack2(v[6], v[7]), pack2(v[12], v[13]), pack2(v[14], v[15]));
      }
    }
  }
}

__device__ void phase_attn(const Params& p, char* smem) {
  u16* Ks = (u16*)smem;
  u16* Vs = Ks + 64 * 64;
  const int tid = threadIdx.x, lane = tid & 63, wave = tid >> 6;
  const int nitems = 4096 + 128;
  const int sw = (lane >> 1) & 7, hsel = lane >> 5;
  for (int item = blockIdx.x; item < nitems; item += gridDim.x) {
    int b, kvh, qb, nkt;
    const u16* qbase;
    size_t orow;
    const int head_g = wave;
    if (item < 4096) {
      b = item >> 10; kvh = (item >> 8) & 3; qb = item & 255; nkt = NKEY / 64;
      qbase = p.Q + ((size_t)(b * 16 + kvh * 4 + head_g) * 8192 + qb * 32) * 64;
      orow = (size_t)b * 8192 + qb * 32;
    } else {
      const int j = item - 4096;
      b = j >> 5; kvh = (j >> 3) & 3; qb = j & 7; nkt = 4;
      qbase = p.QC + ((size_t)(b * 16 + kvh * 4 + head_g) * 256 + qb * 32) * 64;
      orow = (size_t)TL + b * 256 + qb * 32;
    }
    const int head = kvh * 4 + head_g;
    bf16x8 qf[4];
#pragma unroll
    for (int ks = 0; ks < 4; ++ks) qf[ks] = *(const bf16x8*)(qbase + (lane & 31) * 64 + ks * 16 + hsel * 8);
    const u16* kg = p.Kb + (size_t)(b * 4 + kvh) * NKEY * 64;
    const u16* vg = p.Vt + (size_t)(b * 4 + kvh) * 64 * NKEY;
    f32x16 oacc[2];
#pragma unroll
    for (int i = 0; i < 16; ++i) { oacc[0][i] = 0.f; oacc[1][i] = 0.f; }
    float m = -INFINITY, lsum = 0.f;
    u32x4 rk[2], rv[2];
#pragma unroll
    for (int q = 0; q < 2; ++q) {
      const int ch = tid + 256 * q;
      rk[q] = *(const u32x4*)(kg + (size_t)ch * 8);
      rv[q] = *(const u32x4*)(vg + (size_t)(ch >> 3) * NKEY + (ch & 7) * 8);
    }
    for (int kt = 0; kt < nkt; ++kt) {
      __syncthreads();
#pragma unroll
      for (int q = 0; q < 2; ++q) {
        const int ch = tid + 256 * q;
        const int row = ch >> 3, cc = ch & 7;
        const int pc = cc ^ ((row >> 1) & 7);
        *(u32x4*)(Ks + row * 64 + pc * 8) = rk[q];
        *(u32x4*)(Vs + row * 64 + pc * 8) = rv[q];
      }
      __syncthreads();
      if (kt + 1 < nkt) {
#pragma unroll
        for (int q = 0; q < 2; ++q) {
          const int ch = tid + 256 * q;
          rk[q] = *(const u32x4*)(kg + (size_t)(kt + 1) * 4096 + (size_t)ch * 8);
          rv[q] = *(const u32x4*)(vg + (size_t)(ch >> 3) * NKEY + (kt + 1) * 64 + (ch & 7) * 8);
        }
      }
      f32x16 sacc[2];
#pragma unroll
      for (int i = 0; i < 16; ++i) { sacc[0][i] = 0.f; sacc[1][i] = 0.f; }
#pragma unroll
      for (int kb = 0; kb < 2; ++kb)
#pragma unroll
        for (int ks = 0; ks < 4; ++ks) {
          const bf16x8 a = *(const bf16x8*)(Ks + (kb * 32 + (lane & 31)) * 64 + (((ks * 2 + hsel) ^ sw) * 8));
          sacc[kb] = __builtin_amdgcn_mfma_f32_32x32x16_bf16(a, qf[ks], sacc[kb], 0, 0, 0);
        }
      float mx = sacc[0][0];
#pragma unroll
      for (int i = 1; i < 16; ++i) mx = fmaxf(mx, sacc[0][i]);
#pragma unroll
      for (int i = 0; i < 16; ++i) mx = fmaxf(mx, sacc[1][i]);
      mx = fmaxf(mx, __shfl_xor(mx, 32, 64));
      const float mn = fmaxf(m, mx);
      const float alpha = __builtin_amdgcn_exp2f(m - mn);
      m = mn;
      float ps = 0.f;
#pragma unroll
      for (int kb = 0; kb < 2; ++kb)
#pragma unroll
        for (int i = 0; i < 16; ++i) { const float e = __builtin_amdgcn_exp2f(sacc[kb][i] - mn); sacc[kb][i] = e; ps += e; }
      lsum = lsum * alpha + ps;
#pragma unroll
      for (int i = 0; i < 16; ++i) { oacc[0][i] *= alpha; oacc[1][i] *= alpha; }
#pragma unroll
      for (int kb = 0; kb < 2; ++kb)
#pragma unroll
        for (int s2 = 0; s2 < 2; ++s2) {
          unsigned w[4];
#pragma unroll
          for (int e = 0; e < 4; ++e) w[e] = pack2(sacc[kb][8 * s2 + 2 * e], sacc[kb][8 * s2 + 2 * e + 1]);
          u32x4 pw = mk4(w[0], w[1], w[2], w[3]);
          const bf16x8 pf = __builtin_bit_cast(bf16x8, pw);
          const int chunk = 4 * kb + 2 * s2 + hsel;
#pragma unroll
          for (int db = 0; db < 2; ++db) {
            const bf16x8 a = *(const bf16x8*)(Vs + (db * 32 + (lane & 31)) * 64 + ((chunk ^ sw) * 8));
            oacc[db] = __builtin_amdgcn_mfma_f32_32x32x16_bf16(a, pf, oacc[db], 0, 0, 0);
          }
        }
    }
    const float l = lsum + __shfl_xor(lsum, 32, 64);
    const float inv = 1.f / l;
    u16* od = p.H + (orow + (lane & 31)) * DM + head * 64;
#pragma unroll
    for (int db = 0; db < 2; ++db)
#pragma unroll
      for (int g = 0; g < 4; ++g) {
        uint2 o;
        o.x = pack2(oacc[db][g * 4 + 0] * inv, oacc[db][g * 4 + 1] * inv);
        o.y = pack2(oacc[db][g * 4 + 2] * inv, oacc[db][g * 4 + 3] * inv);
        *(uint2*)(od + db * 32 + 8 * g + 4 * hsel) = o;
      }
  }
}

template <bool FROM_INPUT>
__device__ void phase_proj_res(const Params& p, char* smem, const u16* A, int lda, int K, const u16* Bt, int layer, int gate_idx, int mtiles) {
  const int ntiles = mtiles * 8;
  for (int tile = blockIdx.x; tile < ntiles; tile += gridDim.x) {
    const int mt = tile >> 3, nt = tile & 7;
    const int m0 = mt * 128;
    f32x16 acc[2][2];
    gemm_mainloop(smem, 1, K,
                  [&](int r, int) { return A + (size_t)(m0 + r) * lda; },
                  [&](int c) { return Bt + (size_t)(nt * 128 + c) * K; }, acc);
    const float* gate = p.modv + ((size_t)layer * 5 + midx_of(m0)) * 6144 + gate_idx * 1024 + nt * 128;
    const float* sb = (FROM_INPUT ? xin_ptr(p, m0) : (const float*)resid_ptr(p, m0)) + nt * 128;
    float* db = resid_ptr(p, m0) + nt * 128;
    epi_direct(acc, [&](int r, int c, float v) { db[r * DM + c] = sb[r * DM + c] + gate[c] * v; });
  }
}

__device__ void phase_ffn_up(const Params& p, char* smem, int layer, bool with_ctx, u16* ACT) {
  float* Cs = (float*)smem;
  const int tid = threadIdx.x;
  const int mtiles = with_ctx ? 276 : 264;
  const int ntiles = mtiles * 44;
  const u16* up = p.up_t + (size_t)layer * 5632 * 1024;
  const float* cw = p.f_cw + (size_t)layer * 3 * 5632;
  const float* cb = p.f_cb + (size_t)layer * 5632;
  for (int tile = blockIdx.x; tile < ntiles; tile += gridDim.x) {
    const int mt = tile / 44, nt = tile % 44;
    int rowbase, T, j;
    if (mt < 264) { rowbase = (mt / 66) * 8192; T = 8192; j = mt % 66; }
    else { const int m2 = mt - 264; rowbase = TL + (m2 / 3) * 256; T = 256; j = m2 % 3; }
    const int tb = j * 126 - 1;
    f32x16 acc[2][2];
    gemm_mainloop(smem, 1, 1024,
                  [&](int r, int) { const int t = tb + r; return (t >= 0 && t < T) ? (const u16*)(p.H + (size_t)(rowbase + t) * DM) : (const u16*)p.zero; },
                  [&](int c) { return up + (size_t)(c < 64 ? nt * 64 + c : 2816 + nt * 64 + (c - 64)) * 1024; }, acc);
    acc_to_lds(Cs, acc);
    const int c = tid & 63, rq = tid >> 6;
    const int n = nt * 64 + c;
    const float g0 = cw[n], g1 = cw[5632 + n], g2 = cw[2 * 5632 + n], gb = cb[n];
    const float v0 = cw[2816 + n], v1 = cw[5632 + 2816 + n], v2 = cw[2 * 5632 + 2816 + n], vb = cb[2816 + n];
    const int rs = 1 + rq * 32;
    int re = rs + 32; if (re > 127) re = 127;
    float gp = CS(rs - 1, c), gc = CS(rs, c), vp = CS(rs - 1, c + 64), vc = CS(rs, c + 64);
    for (int r = rs; r < re; ++r) {
      const float gn = CS(r + 1, c), vn = CS(r + 1, c + 64);
      const int t = tb + r;
      if (t < T) {
        const float g = g0 * gp + g1 * gc + g2 * gn + gb;
        const float v = v0 * vp + v1 * vc + v2 * vn + vb;
        const float a = g / (1.f + __expf(-g)) * v;
        ACT[(size_t)(rowbase + t) * DFF + n] = f2bf(a);
      }
      gp = gc; gc = gn; vp = vc; vc = vn;
    }
  }
}

__device__ void phase_rwkv_gemms(const Params& p, char* smem) {
  float* Cs = (float*)smem;
  const int tid = threadIdx.x;
  const int ntiles = 7312;
  for (int tile = blockIdx.x; tile < ntiles; tile += gridDim.x) {
    int job, mt, nt;
    const u16* Bt;
    if (tile < 2048) { job = 0; mt = tile >> 3; nt = tile & 7; Bt = p.rr_t; }
    else if (tile < 4160) { job = 1; mt = (tile - 2048) >> 3; nt = tile & 7; Bt = p.rk_t; }
    else if (tile < 6272) { job = 2; mt = (tile - 4160) >> 3; nt = tile & 7; Bt = p.rv_t; }
    else if (tile < 6536) { job = 3; mt = tile - 6272; nt = 0; Bt = p.w1_t; }
    else if (tile < 6800) { job = 4; mt = tile - 6536; nt = 0; Bt = p.a1_t; }
    else { job = 5; mt = (tile - 6800) >> 1; nt = tile & 1; Bt = p.g1_t; }
    const int m0 = mt * 128;
    f32x16 acc[2][2];
    gemm_mainloop(smem, 2, 1024,
                  [&](int r, int part) { return (const u16*)((part ? p.XX : p.H) + (size_t)(m0 + r) * DM); },
                  [&](int c) { return Bt + (size_t)(nt * 128 + c) * 2048; }, acc);
    if (job == 0) {
      epi_direct(acc, [&](int r, int c, float v) { p.R16[(size_t)(m0 + r) * DM + nt * 128 + c] = (f16)v; });
    } else if (job == 2) {
      epi_direct(acc, [&](int r, int c, float v) { p.V16[(size_t)(m0 + r) * DM + nt * 128 + c] = (f16)v; });
    } else if (job == 3) {
      epi_direct(acc, [&](int r, int c, float v) { p.LW[(size_t)(m0 + r) * 128 + c] = f2bf(tanhf(v)); });
    } else if (job == 4) {
      epi_direct(acc, [&](int r, int c, float v) { p.LA[(size_t)(m0 + r) * 128 + c] = f2bf(v); });
    } else if (job == 5) {
      epi_direct(acc, [&](int r, int c, float v) {
        const int col = nt * 128 + c;
        if (col < 192) p.LG[(size_t)(m0 + r) * 192 + col] = col < 160 ? f2bf(sigmoidf_(v)) : (u16)0;
      });
    } else {
      acc_to_lds(Cs, acc);
      const int lane = tid & 63, wave = tid >> 6;
      const int col = nt * 128 + 2 * lane;
      const float kk0 = p.k_k[col], kk1 = p.k_k[col + 1];
#pragma unroll 4
      for (int rr = 0; rr < 32; ++rr) {
        const int r = wave * 32 + rr;
        const float2 v = *(const float2*)&CS(r, 2 * lane);
        const float a0 = v.x * kk0, a1 = v.y * kk1;
        float ss = a0 * a0 + a1 * a1;
        ss += __shfl_xor(ss, 1, 64); ss += __shfl_xor(ss, 2, 64); ss += __shfl_xor(ss, 4, 64); ss += __shfl_xor(ss, 8, 64); ss += __shfl_xor(ss, 16, 64);
        const float inv = 1.f / fmaxf(sqrtf(ss), 1e-12f);
        f16 k2[2], n2[2];
        k2[0] = (f16)v.x; k2[1] = (f16)v.y; n2[0] = (f16)(a0 * inv); n2[1] = (f16)(a1 * inv);
        *(unsigned*)(p.K16 + (size_t)(m0 + r) * DM + col) = *(const unsigned*)k2;
        *(unsigned*)(p.KK16 + (size_t)(m0 + r) * DM + col) = *(const unsigned*)n2;
      }
    }
  }
}

struct ScanLds {
  float dec[2][16][64], kd[2][16][64], nk[2][16][64], bb[2][16][64], rr[2][16][64];
  float vv[2][16][16];
  float yy[2][16][16];
  float bp[2][4][16];
};
DI float dpp_sum16(float v) {
  v += __shfl_xor(v, 1, 64);
  v += __shfl_xor(v, 2, 64);
  v += __shfl_xor(v, 4, 64);
  v += __shfl_xor(v, 8, 64);
  return v;
}
__device__ void phase_scan(const Params& p, char* smem) {
  ScanLds& L = *(ScanLds*)smem;
  const int tid = threadIdx.x, lane = tid & 63, wave = tid >> 6;
  const int l15 = lane & 15, l4 = lane >> 4;
  for (int item = blockIdx.x; item < 512; item += gridDim.x) {
    int sc, q;
    if (gridDim.x == 512) { const int xcd = item & 7, slot = item >> 3; sc = xcd * 16 + (slot >> 2); q = slot & 3; }
    else { sc = item >> 2; q = item & 3; }
    const int dir = sc & 1, bh = sc >> 1, b = bh >> 4, h = bh & 15;
    const int colw = h * 64 + wave * 16 + l15;
    const int chd = wave * 16 + l15;
    bf16x8 w2f[2], a2f[2];
#pragma unroll
    for (int ks = 0; ks < 2; ++ks) {
      w2f[ks] = *(const bf16x8*)(p.w2_t + ((size_t)(dir * 1024 + colw) * 64 + ks * 32 + l4 * 8));
      a2f[ks] = *(const bf16x8*)(p.a2_t + ((size_t)(dir * 1024 + colw) * 64 + ks * 32 + l4 * 8));
    }
    const float w0c = p.dw0[dir * 1024 + colw], a0c = p.a0[dir * 1024 + colw], kac = p.k_a[colw], rkc = p.r_k[colw];
    float S0 = 0.f, S1 = 0.f, S2 = 0.f, S3 = 0.f;
    const int myrow = wave * 4 + l4;
    const int c0 = l15 * 4;
    bf16x8 lwf[2], laf[2];
    f16 kv[4], kkv[4], rv[4];
    f16 vvr;
    auto chunk_rowbase = [&](int c, bool& isctx) -> int {
      if (c < 16) { isctx = true; const int cc = dir ? 15 - c : c; return TL + b * 256 + cc * 16; }
      isctx = false; const int cc = dir ? 511 - (c - 16) : (c - 16); return b * 8192 + cc * 16;
    };
    auto stage_load = [&](int c) {
      bool isctx; const int rb = chunk_rowbase(c, isctx);
#pragma unroll
      for (int ks = 0; ks < 2; ++ks) {
        lwf[ks] = *(const bf16x8*)(p.LW + ((size_t)(rb + l15) * 128 + dir * 64 + ks * 32 + l4 * 8));
        laf[ks] = *(const bf16x8*)(p.LA + ((size_t)(rb + l15) * 128 + dir * 64 + ks * 32 + l4 * 8));
      }
#pragma unroll
      for (int i = 0; i < 4; ++i) {
        const size_t off = (size_t)(rb + l4 * 4 + i) * DM + colw;
        kv[i] = p.K16[off]; kkv[i] = p.KK16[off];
        rv[i] = isctx ? (f16)0.f : p.R16[off];
      }
      vvr = p.V16[(size_t)(rb + (tid >> 4)) * DM + h * 64 + q * 16 + (tid & 15)];
    };
    auto stage_compute = [&](int c) {
      const int bsel = c & 1;
      f32x4 wacc = {0.f, 0.f, 0.f, 0.f}, aacc = {0.f, 0.f, 0.f, 0.f};
      wacc = __builtin_amdgcn_mfma_f32_16x16x32_bf16(lwf[0], w2f[0], wacc, 0, 0, 0);
      wacc = __builtin_amdgcn_mfma_f32_16x16x32_bf16(lwf[1], w2f[1], wacc, 0, 0, 0);
      aacc = __builtin_amdgcn_mfma_f32_16x16x32_bf16(laf[0], a2f[0], aacc, 0, 0, 0);
      aacc = __builtin_amdgcn_mfma_f32_16x16x32_bf16(laf[1], a2f[1], aacc, 0, 0, 0);
      float bpart[4];
#pragma unroll
      for (int i = 0; i < 4; ++i) {
        const int s = l4 * 4 + i;
        const float sg = sigmoidf_(w0c + wacc[i]);
        const float dec = __expf(-0.6065306597126334f * sg);
        const float a = sigmoidf_(a0c + aacc[i]);
        const float k = (float)kv[i], kk = (float)kkv[i], r = (float)rv[i];
        const float kd = k * (1.f + (a - 1.f) * kac);
        L.dec[bsel][s][chd] = dec;
        L.kd[bsel][s][chd] = kd;
        L.nk[bsel][s][chd] = -kk;
        L.bb[bsel][s][chd] = kk * a;
        L.rr[bsel][s][chd] = r;
        bpart[i] = dpp_sum16(r * kd * rkc);
      }
      if (l15 == 0) {
#pragma unroll
        for (int i = 0; i < 4; ++i) L.bp[bsel][wave][l4 * 4 + i] = bpart[i];
      }
      L.vv[bsel][tid >> 4][tid & 15] = (float)vvr;
    };
    __syncthreads();
    stage_load(0);
    stage_compute(0);
    __syncthreads();
    {
      bool isctx; const int rb = chunk_rowbase(0, isctx);
      if (q == 0 && tid < 16) p.bonus[((size_t)dir * MR + rb + tid) * 16 + h] = L.bp[0][0][tid] + L.bp[0][1][tid] + L.bp[0][2][tid] + L.bp[0][3][tid];
    }
    const int NCH = 528;
    for (int c = 0; c < NCH; ++c) {
      const int bsel = c & 1;
      if (c + 1 < NCH) stage_load(c + 1);
      const bool emit = c >= 16;
#pragma unroll 4
      for (int ss = 0; ss < 16; ++ss) {
        const int s = dir ? 15 - ss : ss;
        const float4 d4 = *(const float4*)&L.dec[bsel][s][c0];
        const float4 k4 = *(const float4*)&L.kd[bsel][s][c0];
        const float4 n4 = *(const float4*)&L.nk[bsel][s][c0];
        const float4 b4 = *(const float4*)&L.bb[bsel][s][c0];
        const float4 r4 = *(const float4*)&L.rr[bsel][s][c0];
        const float vv = L.vv[bsel][s][myrow];
        float sa = S0 * n4.x + S1 * n4.y + S2 * n4.z + S3 * n4.w;
        sa = dpp_sum16(sa);
        S0 = S0 * d4.x + (sa * b4.x + vv * k4.x);
        S1 = S1 * d4.y + (sa * b4.y + vv * k4.y);
        S2 = S2 * d4.z + (sa * b4.z + vv * k4.z);
        S3 = S3 * d4.w + (sa * b4.w + vv * k4.w);
        if (emit) {
          float y = S0 * r4.x + S1 * r4.y + S2 * r4.z + S3 * r4.w;
          y = dpp_sum16(y);
          if (l15 == 0) L.yy[bsel][s][myrow] = y;
        }
      }
      if (c + 1 < NCH) stage_compute(c + 1);
      __syncthreads();
      if (emit) {
        bool isctx; const int rb = chunk_rowbase(c, isctx);
        f16* Y = dir ? p.Y1 : p.Y0;
        Y[(size_t)(rb + (tid >> 4)) * DM + h * 64 + q * 16 + (tid & 15)] = (f16)(L.yy[bsel][tid >> 4][tid & 15] * 0.0625f);
      }
      if (c + 1 < NCH && q == 0 && tid < 16) {
        bool isctx; const int rb = chunk_rowbase(c + 1, isctx);
        const int b2 = (c + 1) & 1;
        p.bonus[((size_t)dir * MR + rb + tid) * 16 + h] = L.bp[b2][0][tid] + L.bp[b2][1][tid] + L.bp[b2][2][tid] + L.bp[b2][3][tid];
      }
    }
  }
}

__device__ void phase_readout(const Params& p, char* smem) {
  float* Cs = (float*)smem;
  const int tid = threadIdx.x;
  const int ntiles = 256 * 8;
  for (int tile = blockIdx.x; tile < ntiles; tile += gridDim.x) {
    const int mt = tile >> 3, nt = tile & 7;
    const int m0 = mt * 128;
    f32x16 acc[2][2];
    gemm_mainloop(smem, 1, 192,
                  [&](int r, int) { return (const u16*)(p.LG + (size_t)(m0 + r) * 192); },
                  [&](int c) { return (const u16*)(p.g2_t + (size_t)(nt * 128 + c) * 192); }, acc);
    acc_to_lds(Cs, acc);
    const int lane = tid & 63, wave = tid >> 6;
    const int head = nt * 2 + (lane >> 5);
    const int col = nt * 128 + 2 * lane;
    const float gw0 = p.gn_w[col], gw1 = p.gn_w[col + 1], gb0 = p.gn_b[col], gb1 = p.gn_b[col + 1];
#pragma unroll 2
    for (int rr = 0; rr < 32; ++rr) {
      const int r = wave * 32 + rr;
      const int row = m0 + r;
      const unsigned ua = *(const unsigned*)(p.Y0 + (size_t)row * DM + col), ub = *(const unsigned*)(p.Y1 + (size_t)row * DM + col);
      const unsigned uv = *(const unsigned*)(p.V16 + (size_t)row * DM + col);
      const f16* fa = (const f16*)&ua; const f16* fb = (const f16*)&ub; const f16* fv = (const f16*)&uv;
      const float y0 = ((float)fa[0] + (float)fb[0]) * 16.f, y1 = ((float)fa[1] + (float)fb[1]) * 16.f;
      float sm = y0 + y1;
      sm += __shfl_xor(sm, 1, 64); sm += __shfl_xor(sm, 2, 64); sm += __shfl_xor(sm, 4, 64); sm += __shfl_xor(sm, 8, 64); sm += __shfl_xor(sm, 16, 64);
      const float mean = sm * (1.f / 64.f);
      const float d0 = y0 - mean, d1 = y1 - mean;
      float vs = d0 * d0 + d1 * d1;
      vs += __shfl_xor(vs, 1, 64); vs += __shfl_xor(vs, 2, 64); vs += __shfl_xor(vs, 4, 64); vs += __shfl_xor(vs, 8, 64); vs += __shfl_xor(vs, 16, 64);
      const float rstd = rsqrtf(vs * (1.f / 64.f) + 64e-5f);
      const float bon = p.bonus[((size_t)0 * MR + row) * 16 + head] + p.bonus[((size_t)1 * MR + row) * 16 + head];
      const float2 g = *(const float2*)&CS(r, 2 * lane);
      const float z0 = (d0 * rstd * gw0 + gb0 + bon * (float)fv[0]) * g.x;
      const float z1 = (d1 * rstd * gw1 + gb1 + bon * (float)fv[1]) * g.y;
      *(unsigned*)(p.Z + (size_t)row * DM + col) = pack2(z0, z1);
    }
  }
}

__device__ void phase_final(const Params& p) {
  const int lane = threadIdx.x & 63;
  const int gw = blockIdx.x * 4 + (threadIdx.x >> 6), nw = gridDim.x * 4;
  for (int row = gw; row < TL; row += nw) {
    float* src = p.out + (size_t)row * DM;
    float4 v[4];
    float ss = 0.f;
#pragma unroll
    for (int i = 0; i < 4; ++i) {
      v[i] = *(const float4*)(src + i * 256 + lane * 4);
      ss += v[i].x * v[i].x + v[i].y * v[i].y + v[i].z * v[i].z + v[i].w * v[i].w;
    }
    ss = wave_sum(ss);
    const float rinv = rsqrtf(ss * (1.f / 1024.f) + 1e-6f);
#pragma unroll
    for (int i = 0; i < 4; ++i) {
      const float4 g = *(const float4*)(p.final_gain + i * 256 + lane * 4);
      float4 o;
      o.x = v[i].x * rinv * g.x; o.y = v[i].y * rinv * g.y; o.z = v[i].z * rinv * g.z; o.w = v[i].w * rinv * g.w;
      *(float4*)(src + i * 256 + lane * 4) = o;
    }
  }
}

__global__ void __launch_bounds__(256, 2) mega(Params p) {
  __shared__ __attribute__((aligned(16))) char smem[65536];
  cg::grid_group grid = cg::this_grid();
  phase_prep(p, smem); grid.sync();
  phase_modreduce(p); grid.sync();
  phase_modulate<true>(p, 0, 0, MR); grid.sync();
  phase_qkv(p, smem); grid.sync();
  phase_attn(p, smem); grid.sync();
  phase_proj_res<true>(p, smem, p.H, 1024, 1024, p.wo_t, 0, 2, 264); grid.sync();
  phase_modulate<false>(p, 0, 1, MR); grid.sync();
  phase_ffn_up(p, smem, 0, true, p.ACT0); grid.sync();
  phase_proj_res<false>(p, smem, p.ACT0, DFF, DFF, p.down_t, 0, 5, 264); grid.sync();
  phase_rwkv_shift(p); grid.sync();
  phase_rwkv_gemms(p, smem); grid.sync();
  phase_scan(p, smem); grid.sync();
  phase_readout(p, smem); grid.sync();
  phase_proj_res<false>(p, smem, p.Z, 1024, 1024, p.ro_t, 1, 2, 256); grid.sync();
  phase_modulate<false>(p, 1, 1, TL); grid.sync();
  phase_ffn_up(p, smem, 1, false, p.ACT1); grid.sync();
  phase_proj_res<false>(p, smem, p.ACT1, DFF, DFF, p.down_t + (size_t)1024 * 2816, 1, 5, 256); grid.sync();
  phase_final(p);
}

extern "C" void kernel_launch(void* const* d_in, const int* in_sizes, int n_in, void* d_out, int out_size, void* d_ws, size_t ws_size,
                              hipStream_t stream) {
  static int grid_blocks = 0;
  if (!grid_blocks) {
    int dev = 0, cus = 0, per_cu = 0;
    hipGetDevice(&dev);
    hipDeviceGetAttribute(&cus, hipDeviceAttributeMultiprocessorCount, dev);
    hipOccupancyMaxActiveBlocksPerMultiprocessor(&per_cu, mega, 256, 0);
    if (per_cu > 2) per_cu = 2;
    if (per_cu < 1) per_cu = 1;
    grid_blocks = cus * per_cu;
  }
  Params p{};
  const float* const* in = (const float* const*)d_in;
  p.x = in[0]; p.c = in[1]; p.ctx = in[2]; p.c_ctx = in[3]; p.ada_w = in[4]; p.ada_b = in[5]; p.w_qkv = in[6]; p.q_gain = in[7];
  p.k_gain = in[8]; p.w_o = in[9]; p.mu = in[10]; p.rw_r = in[11]; p.rw_k = in[12]; p.rw_v = in[13]; p.rw_o = in[14]; p.dw0 = in[15];
  p.dw1 = in[16]; p.dw2 = in[17]; p.a0 = in[18]; p.a1 = in[19]; p.a2 = in[20]; p.g1 = in[21]; p.g2 = in[22]; p.k_k = in[23];
  p.k_a = in[24]; p.r_k = in[25]; p.gn_w = in[26]; p.gn_b = in[27]; p.f_up = in[28]; p.f_cw = in[29]; p.f_cb = in[30];
  p.f_down = in[31]; p.final_gain = in[32];
  p.out = (float*)d_out;
  char* w = (char*)d_ws;
  size_t off = 0;
  auto take = [&](size_t bytes) { char* r = w + off; off += (bytes + 255) & ~(size_t)255; return r; };
  p.qkv_t = (u16*)take((size_t)1536 * 1024 * 2);
  p.wo_t = (u16*)take((size_t)1024 * 1024 * 2);
  p.up_t = (u16*)take((size_t)2 * 5632 * 1024 * 2);
  p.down_t = (u16*)take((size_t)2 * 1024 * 2816 * 2);
  p.rr_t = (u16*)take((size_t)1024 * 2048 * 2);
  p.rk_t = (u16*)take((size_t)1024 * 2048 * 2);
  p.rv_t = (u16*)take((size_t)1024 * 2048 * 2);
  p.ro_t = (u16*)take((size_t)1024 * 1024 * 2);
  p.w1_t = (u16*)take((size_t)128 * 2048 * 2);
  p.a1_t = (u16*)take((size_t)128 * 2048 * 2);
  p.g1_t = (u16*)take((size_t)256 * 2048 * 2);
  p.w2_t = (u16*)take((size_t)2 * 1024 * 64 * 2);
  p.a2_t = (u16*)take((size_t)2 * 1024 * 64 * 2);
  p.g2_t = (u16*)take((size_t)1024 * 192 * 2);
  p.modpart = (float*)take((size_t)2 * 8 * 5 * 6144 * 4);
  p.modv = (float*)take((size_t)2 * 5 * 6144 * 4);
  p.rope = (float*)take((size_t)8192 * 32 * 2 * 4);
  p.XC = (float*)take((size_t)TCX * DM * 4);
  p.bonus = (float*)take((size_t)2 * MR * 16 * 4);
  p.zero = (u16*)take(8192);
  const size_t pb = off;
  p.H = (u16*)take((size_t)MR * DM * 2);
  const size_t after_h = off;
  p.Q = (u16*)take((size_t)TL * DM * 2);
  p.QC = (u16*)take((size_t)TCX * DM * 2);
  p.Kb = (u16*)take((size_t)16 * NKEY * 64 * 2);
  p.Vt = (u16*)take((size_t)16 * NKEY * 64 * 2);
  p.ACT0 = (u16*)take((size_t)MR * DFF * 2);
  const size_t end0 = off;
  off = after_h;
  p.XX = (u16*)take((size_t)MR * DM * 2);
  p.R16 = (f16*)take((size_t)TL * DM * 2);
  p.K16 = (f16*)take((size_t)MR * DM * 2);
  p.V16 = (f16*)take((size_t)MR * DM * 2);
  p.KK16 = (f16*)take((size_t)MR * DM * 2);
  p.LW = (u16*)take((size_t)MR * 128 * 2);
  p.LA = (u16*)take((size_t)MR * 128 * 2);
  p.LG = (u16*)take((size_t)TL * 192 * 2);
  const size_t end1 = off;
  p.Y0 = (f16*)p.H;
  p.Y1 = (f16*)p.XX;
  p.Z = (u16*)p.R16;
  p.ACT1 = (u16*)p.K16;
  (void)pb;
  const size_t need = end0 > end1 ? end0 : end1;
  if (need > ws_size) { fprintf(stderr, "workspace too small: need %zu have %zu\n", need, ws_size); return; }
  void* args[] = {&p};
  hipError_t e = hipLaunchCooperativeKernel((void*)mega, dim3(grid_blocks), dim3(256), args, 0, stream);
  if (e != hipSuccess) fprintf(stderr, "cooperative launch failed: %s (grid %d)\n", hipGetErrorString(e), grid_blocks);
}
```

```cpp
#include <hip/hip_runtime.h>
#include <hip/hip_cooperative_groups.h>
#include <cstdio>
#include <cstdint>
namespace cg = cooperative_groups;

typedef unsigned short u16;
typedef _Float16 f16;
using bf16x8 = __attribute__((ext_vector_type(8))) short;
using f32x16 = __attribute__((ext_vector_type(16))) float;
using f32x4 = __attribute__((ext_vector_type(4))) float;
using u32x4 = __attribute__((ext_vector_type(4))) unsigned;
#define DI __device__ __forceinline__
DI u32x4 mk4(unsigned a, unsigned b, unsigned c, unsigned d) { u32x4 r; r[0] = a; r[1] = b; r[2] = c; r[3] = d; return r; }

constexpr int TL = 32768;
constexpr int TCX = 1024;
constexpr int MR = 33792;
constexpr int DM = 1024;
constexpr int DFF = 2816;
constexpr int NKEY = 8448;
constexpr int NPHASE = 18;

struct Params {
  const float *x, *c, *ctx, *c_ctx, *ada_w, *ada_b, *w_qkv, *q_gain, *k_gain, *w_o;
  const float *mu, *rw_r, *rw_k, *rw_v, *rw_o, *dw0, *dw1, *dw2, *a0, *a1, *a2, *g1, *g2, *k_k, *k_a, *r_k, *gn_w, *gn_b;
  const float *f_up, *f_cw, *f_cb, *f_down, *final_gain;
  float* out;
  u16 *qkv_t, *wo_t, *up_t, *down_t, *rr_t, *rk_t, *rv_t, *ro_t, *w1_t, *a1_t, *g1_t, *w2_t, *a2_t, *g2_t;
  float *modpart, *modv, *rope, *XC, *bonus;
  u16* zero;
  u16 *H, *XX, *Q, *QC, *Kb, *Vt, *ACT0, *ACT1;
  f16 *R16, *K16, *V16, *KK16, *Y0, *Y1;
  u16 *LW, *LA, *LG, *Z;
  int phase_lo, phase_hi;
};

DI u16 f2bf(float x) { unsigned u = __float_as_uint(x); u += 0x7fffu + ((u >> 16) & 1u); return (u16)(u >> 16); }
DI float bf2f(u16 h) { return __uint_as_float(((unsigned)h) << 16); }
DI unsigned pack2(float a, float b) { return (unsigned)f2bf(a) | (((unsigned)f2bf(b)) << 16); }
DI float wave_sum(float v) {
#pragma unroll
  for (int o = 32; o > 0; o >>= 1) v += __shfl_xor(v, o, 64);
  return v;
}
template <int CTRL> DI float dpp_mov(float v) { return __builtin_bit_cast(float, __builtin_amdgcn_update_dpp(0, __builtin_bit_cast(int, v), CTRL, 0xF, 0xF, false)); }
DI float dpp_sum16(float v) {
  v += dpp_mov<0x128>(v);
  v += dpp_mov<0x124>(v);
  v += dpp_mov<0x122>(v);
  v += dpp_mov<0x121>(v);
  return v;
}
DI float sum32(float v) { v = dpp_sum16(v); v += __shfl_xor(v, 16, 64); return v; }
DI float sigmoidf_(float x) { return 1.f / (1.f + __expf(-x)); }
DI int midx_of(int row) { return row < TL ? (row >> 13) : 4; }
DI float* resid_ptr(const Params& p, int row) { return row < TL ? p.out + (size_t)row * DM : p.XC + (size_t)(row - TL) * DM; }
DI const float* xin_ptr(const Params& p, int row) { return row < TL ? p.x + (size_t)row * DM : p.ctx + (size_t)(row - TL) * DM; }

template <class AF, class BF>
DI void gemm_mainloop(char* smem, int nparts, int kpart, AF arow, BF brow, f32x16 (&acc)[2][2]) {
  const int tid = threadIdx.x, lane = tid & 63, wave = tid >> 6;
  const int wm = wave >> 1, wn = wave & 1;
  const int lr = tid >> 3, lc = tid & 7;
#pragma unroll
  for (int i = 0; i < 2; ++i)
#pragma unroll
    for (int j = 0; j < 2; ++j)
#pragma unroll
      for (int e = 0; e < 16; ++e) acc[i][j][e] = 0.f;
  const int csrc = (lc ^ ((lr >> 1) & 7)) * 8;
  const u16* bp[4];
  const u16* ap[4];
#pragma unroll
  for (int q = 0; q < 4; ++q) { bp[q] = brow(lr + 32 * q) + csrc; ap[q] = arow(lr + 32 * q, 0) + csrc; }
  const int nk = kpart >> 6;
  const int total = nparts * nk;
  const int sw = (lane >> 1) & 7;
  const int hsel = lane >> 5;
  char* const wbase = smem + wave * 1024;
  auto stage = [&](int buf, int kk, int boff) {
#pragma unroll
    for (int q = 0; q < 4; ++q) {
      __builtin_amdgcn_global_load_lds((const unsigned*)(ap[q] + kk), (unsigned*)(wbase + buf * 32768 + q * 4096), 16, 0, 0);
      __builtin_amdgcn_global_load_lds((const unsigned*)(bp[q] + boff), (unsigned*)(wbase + buf * 32768 + 16384 + q * 4096), 16, 0, 0);
    }
  };
  __syncthreads();
  stage(0, 0, 0);
  asm volatile("s_waitcnt vmcnt(0)" ::: "memory");
  __syncthreads();
  int part = 0, kk = 0, buf = 0;
#pragma unroll 1
  for (int it = 0; it < total; ++it) {
    kk += 64;
    if (kk == kpart) {
      kk = 0; ++part;
      if (part < nparts) {
#pragma unroll
        for (int q = 0; q < 4; ++q) ap[q] = arow(lr + 32 * q, part) + csrc;
      }
    }
    if (it + 1 < total) stage(buf ^ 1, kk, part * kpart + kk);
    const u16* As = (const u16*)(smem + buf * 32768);
    const u16* Bs = As + 128 * 64;
#pragma unroll
    for (int ks = 0; ks < 4; ++ks) {
      const int pc = ((ks * 2 + hsel) ^ sw) * 8;
      bf16x8 af[2], bf[2];
#pragma unroll
      for (int i = 0; i < 2; ++i) {
        af[i] = *(const bf16x8*)(As + (wm * 64 + i * 32 + (lane & 31)) * 64 + pc);
        bf[i] = *(const bf16x8*)(Bs + (wn * 64 + i * 32 + (lane & 31)) * 64 + pc);
      }
#pragma unroll
      for (int i = 0; i < 2; ++i)
#pragma unroll
        for (int j = 0; j < 2; ++j) acc[i][j] = __builtin_amdgcn_mfma_f32_32x32x16_bf16(af[i], bf[j], acc[i][j], 0, 0, 0);
    }
    asm volatile("s_waitcnt vmcnt(0)" ::: "memory");
    __syncthreads();
    buf ^= 1;
  }
}

template <class F>
DI void epi_direct(const f32x16 (&acc)[2][2], F f) {
  const int lane = threadIdx.x & 63, wave = threadIdx.x >> 6;
  const int wm = wave >> 1, wn = wave & 1, h = lane >> 5;
#pragma unroll
  for (int i = 0; i < 2; ++i)
#pragma unroll
    for (int j = 0; j < 2; ++j)
#pragma unroll
      for (int e = 0; e < 16; ++e) {
        const int row = wm * 64 + i * 32 + (e & 3) + 8 * (e >> 2) + 4 * h;
        const int col = wn * 64 + j * 32 + (lane & 31);
        f(row, col, acc[i][j][e]);
      }
}
#define CS(r, c) Cs[(r) * 128 + (c)]
DI void acc_to_lds(float* Cs, const f32x16 (&acc)[2][2]) {
  __syncthreads();
  epi_direct(acc, [&](int r, int c, float v) { CS(r, c) = v; });
  __syncthreads();
}

struct TJob { const float* src; int srcK, srcN; u16* dst; int ld, koff; const float* mu; int Kpad, Npad; };
DI TJob get_job(const Params& p, int j) {
  TJob t; t.mu = nullptr; t.koff = 0;
  auto set = [&](const float* s, int K, int N, u16* d, int ld) { t.src = s; t.srcK = K; t.srcN = N; t.dst = d; t.ld = ld; t.Kpad = K; t.Npad = N; };
  switch (j) {
    case 0: set(p.w_qkv, 1024, 1536, p.qkv_t, 1024); break;
    case 1: set(p.w_o, 1024, 1024, p.wo_t, 1024); break;
    case 2: set(p.f_up, 1024, 5632, p.up_t, 1024); break;
    case 3: set(p.f_up + (size_t)1024 * 5632, 1024, 5632, p.up_t + (size_t)5632 * 1024, 1024); break;
    case 4: set(p.f_down, 2816, 1024, p.down_t, 2816); break;
    case 5: set(p.f_down + (size_t)2816 * 1024, 2816, 1024, p.down_t + (size_t)1024 * 2816, 2816); break;
    case 6: set(p.rw_r, 1024, 1024, p.rr_t, 2048); break;
    case 7: set(p.rw_r, 1024, 1024, p.rr_t, 2048); t.mu = p.mu + 0 * 1024; t.koff = 1024; break;
    case 8: set(p.rw_k, 1024, 1024, p.rk_t, 2048); break;
    case 9: set(p.rw_k, 1024, 1024, p.rk_t, 2048); t.mu = p.mu + 2 * 1024; t.koff = 1024; break;
    case 10: set(p.rw_v, 1024, 1024, p.rv_t, 2048); break;
    case 11: set(p.rw_v, 1024, 1024, p.rv_t, 2048); t.mu = p.mu + 3 * 1024; t.koff = 1024; break;
    case 12: set(p.rw_o, 1024, 1024, p.ro_t, 1024); break;
    case 13: set(p.dw1, 1024, 64, p.w1_t, 2048); break;
    case 14: set(p.dw1, 1024, 64, p.w1_t, 2048); t.mu = p.mu + 1 * 1024; t.koff = 1024; break;
    case 15: set(p.dw1 + 1024 * 64, 1024, 64, p.w1_t + 64 * 2048, 2048); break;
    case 16: set(p.dw1 + 1024 * 64, 1024, 64, p.w1_t + 64 * 2048, 2048); t.mu = p.mu + 1 * 1024; t.koff = 1024; break;
    case 17: set(p.a1, 1024, 64, p.a1_t, 2048); break;
    case 18: set(p.a1, 1024, 64, p.a1_t, 2048); t.mu = p.mu + 4 * 1024; t.koff = 1024; break;
    case 19: set(p.a1 + 1024 * 64, 1024, 64, p.a1_t + 64 * 2048, 2048); break;
    case 20: set(p.a1 + 1024 * 64, 1024, 64, p.a1_t + 64 * 2048, 2048); t.mu = p.mu + 4 * 1024; t.koff = 1024; break;
    case 21: set(p.g1, 1024, 160, p.g1_t, 2048); t.Npad = 256; break;
    case 22: set(p.g1, 1024, 160, p.g1_t, 2048); t.Npad = 256; t.mu = p.mu + 5 * 1024; t.koff = 1024; break;
    case 23: set(p.dw2, 64, 1024, p.w2_t, 64); break;
    case 24: set(p.dw2 + 64 * 1024, 64, 1024, p.w2_t + 1024 * 64, 64); break;
    case 25: set(p.a2, 64, 1024, p.a2_t, 64); break;
    case 26: set(p.a2 + 64 * 1024, 64, 1024, p.a2_t + 1024 * 64, 64); break;
    default: set(p.g2, 160, 1024, p.g2_t, 192); t.Kpad = 192; break;
  }
  return t;
}
constexpr int NJOBS = 28;
DI int job_tiles(const TJob& t) { return ((t.Kpad + 63) >> 6) * ((t.Npad + 63) >> 6); }

__device__ void phase_prep(const Params& p, char* smem) {
  const int tid = threadIdx.x;
  int ttiles = 0;
  for (int j = 0; j < NJOBS; ++j) ttiles += job_tiles(get_job(p, j));
  const int n_mod = 2 * 24 * 8;
  const int n_rope = 1024;
  const int total = ttiles + n_mod + n_rope;
  float* tile = (float*)smem;
  if (blockIdx.x == 0) for (int e = tid; e < 4096; e += 256) p.zero[e] = 0;
  for (int item = blockIdx.x; item < total; item += gridDim.x) {
    if (item < ttiles) {
      int rem = item, j = 0;
      TJob t = get_job(p, 0);
      while (true) { int n = job_tiles(t); if (rem < n) break; rem -= n; ++j; t = get_job(p, j); }
      const int ntn = (t.Npad + 63) >> 6;
      const int kt = rem / ntn, nt = rem % ntn;
      __syncthreads();
#pragma unroll
      for (int i = 0; i < 16; ++i) {
        const int kl = i * 4 + (tid >> 6), nl = tid & 63;
        const int k = kt * 64 + kl, n = nt * 64 + nl;
        float v = 0.f;
        if (k < t.srcK && n < t.srcN) { v = t.src[(size_t)k * t.srcN + n]; if (t.mu) v *= t.mu[k]; }
        tile[kl * 65 + nl] = v;
      }
      __syncthreads();
#pragma unroll
      for (int i = 0; i < 16; ++i) {
        const int nl = i * 4 + (tid >> 6), kl = tid & 63;
        const int k = kt * 64 + kl, n = nt * 64 + nl;
        if (k < t.Kpad && n < t.Npad) t.dst[(size_t)n * t.ld + t.koff + k] = f2bf(tile[kl * 65 + nl]);
      }
    } else if (item < ttiles + n_mod) {
      const int it = item - ttiles;
      const int layer = it / 192, cc = (it % 192) / 8, kc = it % 8;
      float* sil = (float*)smem;
      __syncthreads();
      for (int e = tid; e < 640; e += 256) {
        const int j = e >> 7, k = kc * 128 + (e & 127);
        const float v = j < 4 ? p.c[j * 1024 + k] : p.c_ctx[k];
        sil[e] = v / (1.f + __expf(-v));
      }
      __syncthreads();
      const int col = cc * 256 + tid;
      float a0 = 0, a1 = 0, a2 = 0, a3 = 0, a4 = 0;
      const float* w = p.ada_w + ((size_t)layer * 1024 + kc * 128) * 6144 + col;
#pragma unroll 16
      for (int k = 0; k < 128; ++k) {
        const float wv = w[(size_t)k * 6144];
        a0 += sil[k] * wv; a1 += sil[128 + k] * wv; a2 += sil[256 + k] * wv; a3 += sil[384 + k] * wv; a4 += sil[512 + k] * wv;
      }
      float* mp = p.modpart + ((size_t)(layer * 8 + kc) * 5) * 6144 + col;
      mp[0] = a0; mp[6144] = a1; mp[2 * 6144] = a2; mp[3 * 6144] = a3; mp[4 * 6144] = a4;
    } else {
      const int e = (item - ttiles - n_mod) * 256 + tid;
      const int s = e >> 5, pr = e & 31;
      const int f = pr & 15;
      const float inv_freq = powf(10000.f, -(float)f / 16.f);
      const float pos = (pr < 16) ? (float)(s >> 6) : (float)(s & 63);
      const float ang = pos * inv_freq;
      float sn, cs;
      sincosf(ang, &sn, &cs);
      p.rope[e * 2] = cs; p.rope[e * 2 + 1] = sn;
    }
  }
}

__device__ void phase_modreduce(const Params& p) {
  const int n = 2 * 5 * 6144;
  for (int e = blockIdx.x * 256 + threadIdx.x; e < n; e += gridDim.x * 256) {
    const int layer = e / (5 * 6144), r = e % (5 * 6144), col = r % 6144;
    float s = p.ada_b[layer * 6144 + col];
    for (int kc = 0; kc < 8; ++kc) s += p.modpart[(size_t)(layer * 8 + kc) * 5 * 6144 + r];
    p.modv[e] = s;
  }
}

template <bool FROM_INPUT>
__device__ void phase_modulate(const Params& p, int layer, int which, int nrows) {
  const int lane = threadIdx.x & 63;
  const int gw = blockIdx.x * 4 + (threadIdx.x >> 6), nw = gridDim.x * 4;
  for (int row = gw; row < nrows; row += nw) {
    const float* src = FROM_INPUT ? xin_ptr(p, row) : resid_ptr(p, row);
    const float* mv = p.modv + ((size_t)layer * 5 + midx_of(row)) * 6144 + which * 3072;
    float4 v[4];
    float ss = 0.f;
#pragma unroll
    for (int i = 0; i < 4; ++i) {
      v[i] = *(const float4*)(src + i * 256 + lane * 4);
      ss += v[i].x * v[i].x + v[i].y * v[i].y + v[i].z * v[i].z + v[i].w * v[i].w;
    }
    ss = wave_sum(ss);
    const float rinv = rsqrtf(ss * (1.f / 1024.f) + 1e-6f);
#pragma unroll
    for (int i = 0; i < 4; ++i) {
      const int col = i * 256 + lane * 4;
      const float4 sh = *(const float4*)(mv + col);
      const float4 sc = *(const float4*)(mv + 1024 + col);
      uint2 o;
      o.x = pack2(v[i].x * rinv * (1.f + sc.x) + sh.x, v[i].y * rinv * (1.f + sc.y) + sh.y);
      o.y = pack2(v[i].z * rinv * (1.f + sc.z) + sh.z, v[i].w * rinv * (1.f + sc.w) + sh.w);
      *(uint2*)(p.H + (size_t)row * DM + col) = o;
    }
  }
}

DI void modrow(const Params& p, int row, bool valid, int lane, float (&h)[16]) {
  if (!valid) {
#pragma unroll
    for (int i = 0; i < 16; ++i) h[i] = 0.f;
    return;
  }
  const float* src = resid_ptr(p, row);
  const float* mv = p.modv + ((size_t)1 * 5 + midx_of(row)) * 6144;
  float ss = 0.f;
#pragma unroll
  for (int i = 0; i < 4; ++i) {
    const float4 v = *(const float4*)(src + i * 256 + lane * 4);
    h[i * 4 + 0] = v.x; h[i * 4 + 1] = v.y; h[i * 4 + 2] = v.z; h[i * 4 + 3] = v.w;
    ss += v.x * v.x + v.y * v.y + v.z * v.z + v.w * v.w;
  }
  ss = wave_sum(ss);
  const float rinv = rsqrtf(ss * (1.f / 1024.f) + 1e-6f);
#pragma unroll
  for (int i = 0; i < 4; ++i) {
    const int col = i * 256 + lane * 4;
    const float4 sh = *(const float4*)(mv + col);
    const float4 sc = *(const float4*)(mv + 1024 + col);
    h[i * 4 + 0] = h[i * 4 + 0] * rinv * (1.f + sc.x) + sh.x;
    h[i * 4 + 1] = h[i * 4 + 1] * rinv * (1.f + sc.y) + sh.y;
    h[i * 4 + 2] = h[i * 4 + 2] * rinv * (1.f + sc.z) + sh.z;
    h[i * 4 + 3] = h[i * 4 + 3] * rinv * (1.f + sc.w) + sh.w;
  }
}
__device__ void phase_rwkv_shift(const Params& p) {
  const int lane = threadIdx.x & 63;
  const int gw = blockIdx.x * 4 + (threadIdx.x >> 6), nw = gridDim.x * 4;
  const int nitems = MR / 8;
  for (int item = gw; item < nitems; item += nw) {
    const int r0 = item * 8;
    int sb, T;
    if (r0 < TL) { sb = r0 & ~8191; T = 8192; } else { sb = TL + ((r0 - TL) & ~255); T = 256; }
    float hm[16], hc[16], hn[16];
    modrow(p, r0 - 1, r0 - 1 >= sb, lane, hm);
    modrow(p, r0, true, lane, hc);
    for (int j = 0; j < 8; ++j) {
      const int row = r0 + j;
      modrow(p, row + 1, row + 1 < sb + T, lane, hn);
#pragma unroll
      for (int i = 0; i < 4; ++i) {
        const int col = i * 256 + lane * 4;
        float xx[4];
#pragma unroll
        for (int e = 0; e < 4; ++e) xx[e] = 0.5f * (hm[i * 4 + e] + hn[i * 4 + e]) - hc[i * 4 + e];
        uint2 o, o2;
        o.x = pack2(hc[i * 4 + 0], hc[i * 4 + 1]); o.y = pack2(hc[i * 4 + 2], hc[i * 4 + 3]);
        o2.x = pack2(xx[0], xx[1]); o2.y = pack2(xx[2], xx[3]);
        *(uint2*)(p.H + (size_t)row * DM + col) = o;
        *(uint2*)(p.XX + (size_t)row * DM + col) = o2;
      }
#pragma unroll
      for (int i = 0; i < 16; ++i) { hm[i] = hc[i]; hc[i] = hn[i]; }
    }
  }
}

__device__ void phase_qkv(const Params& p, char* smem) {
  float* Cs = (float*)smem;
  const int tid = threadIdx.x;
  const int ntiles = 264 * 12;
  for (int tile = blockIdx.x; tile < ntiles; tile += gridDim.x) {
    const int mt = tile / 12, nt = tile % 12;
    const int m0 = mt * 128;
    f32x16 acc[2][2];
    gemm_mainloop(smem, 1, 1024,
                  [&](int r, int) { return (const u16*)(p.H + (size_t)(m0 + r) * DM); },
                  [&](int c) { return (const u16*)(p.qkv_t + (size_t)(nt * 128 + c) * 1024); }, acc);
    acc_to_lds(Cs, acc);
    const bool isctx = m0 >= TL;
    const int b = isctx ? (m0 - TL) >> 8 : m0 >> 13;
    const int t0 = isctx ? (m0 - TL) & 255 : m0 & 8191;
    if (nt < 10) {
      const int lane = tid & 63, wave = tid >> 6;
      const int hh = lane >> 5, pr = lane & 31;
      const bool isq = nt < 8;
      const float* gain = isq ? p.q_gain : p.k_gain;
      const float qs = isq ? 0.125f * 1.4426950408889634f : 1.f;
      const float g0 = gain[2 * pr] * qs, g1 = gain[2 * pr + 1] * qs;
      u16* dstb;
      size_t tstride = 64;
      if (isq) {
        const int head = nt * 2 + hh;
        dstb = isctx ? p.QC + ((size_t)(b * 16 + head) * 256 + t0) * 64 : p.Q + ((size_t)(b * 16 + head) * 8192 + t0) * 64;
      } else {
        const int kh = (nt - 8) * 2 + hh;
        dstb = p.Kb + ((size_t)(b * 4 + kh) * NKEY + (isctx ? t0 : 256 + t0)) * 64;
      }
#pragma unroll 4
      for (int rr = 0; rr < 32; ++rr) {
        const int r = wave * 32 + rr;
        const float2 v = *(const float2*)&CS(r, 2 * lane);
        float ss = v.x * v.x + v.y * v.y;
        ss = sum32(ss);
        const float rinv = rsqrtf(ss * (1.f / 64.f) + 1e-6f);
        float x0 = v.x * rinv * g0, x1 = v.y * rinv * g1;
        if (!isctx) {
          const float2 cssn = *(const float2*)(p.rope + ((size_t)(t0 + r) * 32 + pr) * 2);
          const float y0 = x0 * cssn.x - x1 * cssn.y, y1 = x0 * cssn.y + x1 * cssn.x;
          x0 = y0; x1 = y1;
        }
        *(unsigned*)(dstb + (size_t)r * tstride + 2 * pr) = pack2(x0, x1);
      }
    } else {
      const int keybase = (isctx ? t0 : 256 + t0);
      for (int j = 0; j < 4; ++j) {
        const int item = tid + 256 * j;
        const int d = item & 63, hh = (item >> 6) & 1, rg = item >> 7;
        const int kh = (nt - 10) * 2 + hh;
        float v[16];
#pragma unroll
        for (int i = 0; i < 16; ++i) v[i] = CS(rg * 16 + i, hh * 64 + d);
        u16* dst = p.Vt + ((size_t)(b * 4 + kh) * 64 + d) * NKEY + keybase + rg * 16;
        *(u32x4*)(dst) = mk4(pack2(v[0], v[1]), pack2(v[2], v[3]), pack2(v[8], v[9]), pack2(v[10], v[11]));
        *(u32x4*)(dst + 8) = mk4(pack2(v[4], v[5]), pack2(v[6], v[7]), pack2(v[12], v[13]), pack2(v[14], v[15]));
      }
    }
  }
}

__device__ void phase_attn(const Params& p, char* smem) {
  u16* Ks = (u16*)smem;
  u16* Vs = Ks + 64 * 64;
  const int tid = threadIdx.x, lane = tid & 63, wave = tid >> 6;
  const int nitems = 4096 + 128;
  const int sw = (lane >> 1) & 7, hsel = lane >> 5;
  for (int item = blockIdx.x; item < nitems; item += gridDim.x) {
    int b, kvh, qb, nkt;
    const u16* qbase;
    size_t orow;
    const int head_g = wave;
    if (item < 4096) {
      b = item >> 10; kvh = (item >> 8) & 3; qb = item & 255; nkt = NKEY / 64;
      qbase = p.Q + ((size_t)(b * 16 + kvh * 4 + head_g) * 8192 + qb * 32) * 64;
      orow = (size_t)b * 8192 + qb * 32;
    } else {
      const int j = item - 4096;
      b = j >> 5; kvh = (j >> 3) & 3; qb = j & 7; nkt = 4;
      qbase = p.QC + ((size_t)(b * 16 + kvh * 4 + head_g) * 256 + qb * 32) * 64;
      orow = (size_t)TL + b * 256 + qb * 32;
    }
    const int head = kvh * 4 + head_g;
    bf16x8 qf[4];
#pragma unroll
    for (int ks = 0; ks < 4; ++ks) qf[ks] = *(const bf16x8*)(qbase + (lane & 31) * 64 + ks * 16 + hsel * 8);
    const u16* kg = p.Kb + (size_t)(b * 4 + kvh) * NKEY * 64;
    const u16* vg = p.Vt + (size_t)(b * 4 + kvh) * 64 * NKEY;
    f32x16 oacc[2];
#pragma unroll
    for (int i = 0; i < 16; ++i) { oacc[0][i] = 0.f; oacc[1][i] = 0.f; }
    float m = -INFINITY, lsum = 0.f;
    u32x4 rk[2], rv[2];
#pragma unroll
    for (int q = 0; q < 2; ++q) {
      const int ch = tid + 256 * q;
      rk[q] = *(const u32x4*)(kg + (size_t)ch * 8);
      rv[q] = *(const u32x4*)(vg + (size_t)(ch >> 3) * NKEY + (ch & 7) * 8);
    }
    for (int kt = 0; kt < nkt; ++kt) {
      __syncthreads();
#pragma unroll
      for (int q = 0; q < 2; ++q) {
        const int ch = tid + 256 * q;
        const int row = ch >> 3, cc = ch & 7;
        const int pc = cc ^ ((row >> 1) & 7);
        *(u32x4*)(Ks + row * 64 + pc * 8) = rk[q];
        *(u32x4*)(Vs + row * 64 + pc * 8) = rv[q];
      }
      __syncthreads();
      if (kt + 1 < nkt) {
#pragma unroll
        for (int q = 0; q < 2; ++q) {
          const int ch = tid + 256 * q;
          rk[q] = *(const u32x4*)(kg + (size_t)(kt + 1) * 4096 + (size_t)ch * 8);
          rv[q] = *(const u32x4*)(vg + (size_t)(ch >> 3) * NKEY + (kt + 1) * 64 + (ch & 7) * 8);
        }
      }
      f32x16 sacc[2];
#pragma unroll
      for (int i = 0; i < 16; ++i) { sacc[0][i] = 0.f; sacc[1][i] = 0.f; }
#pragma unroll
      for (int kb = 0; kb < 2; ++kb)
#pragma unroll
        for (int ks = 0; ks < 4; ++ks) {
          const bf16x8 a = *(const bf16x8*)(Ks + (kb * 32 + (lane & 31)) * 64 + (((ks * 2 + hsel) ^ sw) * 8));
          sacc[kb] = __builtin_amdgcn_mfma_f32_32x32x16_bf16(a, qf[ks], sacc[kb], 0, 0, 0);
        }
      float mx = sacc[0][0];
#pragma unroll
      for (int i = 1; i < 16; ++i) mx = fmaxf(mx, sacc[0][i]);
#pragma unroll
      for (int i = 0; i < 16; ++i) mx = fmaxf(mx, sacc[1][i]);
      mx = fmaxf(mx, __shfl_xor(mx, 32, 64));
      const float mn = fmaxf(m, mx);
      const float alpha = __builtin_amdgcn_exp2f(m - mn);
      m = mn;
      float ps = 0.f;
#pragma unroll
      for (int kb = 0; kb < 2; ++kb)
#pragma unroll
        for (int i = 0; i < 16; ++i) { const float e = __builtin_amdgcn_exp2f(sacc[kb][i] - mn); sacc[kb][i] = e; ps += e; }
      lsum = lsum * alpha + ps;
#pragma unroll
      for (int i = 0; i < 16; ++i) { oacc[0][i] *= alpha; oacc[1][i] *= alpha; }
#pragma unroll
      for (int kb = 0; kb < 2; ++kb)
#pragma unroll
        for (int s2 = 0; s2 < 2; ++s2) {
          unsigned w[4];
#pragma unroll
          for (int e = 0; e < 4; ++e) w[e] = pack2(sacc[kb][8 * s2 + 2 * e], sacc[kb][8 * s2 + 2 * e + 1]);
          u32x4 pw = mk4(w[0], w[1], w[2], w[3]);
          const bf16x8 pf = __builtin_bit_cast(bf16x8, pw);
          const int chunk = 4 * kb + 2 * s2 + hsel;
#pragma unroll
          for (int db = 0; db < 2; ++db) {
            const bf16x8 a = *(const bf16x8*)(Vs + (db * 32 + (lane & 31)) * 64 + ((chunk ^ sw) * 8));
            oacc[db] = __builtin_amdgcn_mfma_f32_32x32x16_bf16(a, pf, oacc[db], 0, 0, 0);
          }
        }
    }
    const float l = lsum + __shfl_xor(lsum, 32, 64);
    const float inv = 1.f / l;
    u16* od = p.H + (orow + (lane & 31)) * DM + head * 64;
#pragma unroll
    for (int db = 0; db < 2; ++db)
#pragma unroll
      for (int g = 0; g < 4; ++g) {
        uint2 o;
        o.x = pack2(oacc[db][g * 4 + 0] * inv, oacc[db][g * 4 + 1] * inv);
        o.y = pack2(oacc[db][g * 4 + 2] * inv, oacc[db][g * 4 + 3] * inv);
        *(uint2*)(od + db * 32 + 8 * g + 4 * hsel) = o;
      }
  }
}

template <bool FROM_INPUT>
__device__ void phase_proj_res(const Params& p, char* smem, const u16* A, int lda, int K, const u16* Bt, int layer, int gate_idx, int mtiles) {
  const int ntiles = mtiles * 8;
  for (int tile = blockIdx.x; tile < ntiles; tile += gridDim.x) {
    const int mt = tile >> 3, nt = tile & 7;
    const int m0 = mt * 128;
    f32x16 acc[2][2];
    gemm_mainloop(smem, 1, K,
                  [&](int r, int) { return A + (size_t)(m0 + r) * lda; },
                  [&](int c) { return Bt + (size_t)(nt * 128 + c) * K; }, acc);
    const float* gate = p.modv + ((size_t)layer * 5 + midx_of(m0)) * 6144 + gate_idx * 1024 + nt * 128;
    const float* sb = (FROM_INPUT ? xin_ptr(p, m0) : (const float*)resid_ptr(p, m0)) + nt * 128;
    float* db = resid_ptr(p, m0) + nt * 128;
    epi_direct(acc, [&](int r, int c, float v) { db[r * DM + c] = sb[r * DM + c] + gate[c] * v; });
  }
}

__device__ void phase_ffn_up(const Params& p, char* smem, int layer, bool with_ctx, u16* ACT) {
  float* Cs = (float*)smem;
  const int tid = threadIdx.x;
  const int mtiles = with_ctx ? 276 : 264;
  const int ntiles = mtiles * 44;
  const u16* up = p.up_t + (size_t)layer * 5632 * 1024;
  const float* cw = p.f_cw + (size_t)layer * 3 * 5632;
  const float* cb = p.f_cb + (size_t)layer * 5632;
  for (int tile = blockIdx.x; tile < ntiles; tile += gridDim.x) {
    const int mt = tile / 44, nt = tile % 44;
    int rowbase, T, j;
    if (mt < 264) { rowbase = (mt / 66) * 8192; T = 8192; j = mt % 66; }
    else { const int m2 = mt - 264; rowbase = TL + (m2 / 3) * 256; T = 256; j = m2 % 3; }
    const int tb = j * 126 - 1;
    f32x16 acc[2][2];
    gemm_mainloop(smem, 1, 1024,
                  [&](int r, int) { const int t = tb + r; return (t >= 0 && t < T) ? (const u16*)(p.H + (size_t)(rowbase + t) * DM) : (const u16*)p.zero; },
                  [&](int c) { return up + (size_t)(c < 64 ? nt * 64 + c : 2816 + nt * 64 + (c - 64)) * 1024; }, acc);
    acc_to_lds(Cs, acc);
    const int c = tid & 63, rq = tid >> 6;
    const int n = nt * 64 + c;
    const float g0 = cw[n], g1 = cw[5632 + n], g2 = cw[2 * 5632 + n], gb = cb[n];
    const float v0 = cw[2816 + n], v1 = cw[5632 + 2816 + n], v2 = cw[2 * 5632 + 2816 + n], vb = cb[2816 + n];
    const int rs = 1 + rq * 32;
    int re = rs + 32; if (re > 127) re = 127;
    float gp = CS(rs - 1, c), gc = CS(rs, c), vp = CS(rs - 1, c + 64), vc = CS(rs, c + 64);
    for (int r = rs; r < re; ++r) {
      const float gn = CS(r + 1, c), vn = CS(r + 1, c + 64);
      const int t = tb + r;
      if (t < T) {
        const float g = g0 * gp + g1 * gc + g2 * gn + gb;
        const float v = v0 * vp + v1 * vc + v2 * vn + vb;
        const float a = g / (1.f + __expf(-g)) * v;
        ACT[(size_t)(rowbase + t) * DFF + n] = f2bf(a);
      }
      gp = gc; gc = gn; vp = vc; vc = vn;
    }
  }
}

__device__ void phase_rwkv_gemms(const Params& p, char* smem) {
  float* Cs = (float*)smem;
  const int tid = threadIdx.x;
  const int ntiles = 7312;
  for (int tile = blockIdx.x; tile < ntiles; tile += gridDim.x) {
    int job, mt, nt;
    const u16* Bt;
    if (tile < 2048) { job = 0; mt = tile >> 3; nt = tile & 7; Bt = p.rr_t; }
    else if (tile < 4160) { job = 1; mt = (tile - 2048) >> 3; nt = tile & 7; Bt = p.rk_t; }
    else if (tile < 6272) { job = 2; mt = (tile - 4160) >> 3; nt = tile & 7; Bt = p.rv_t; }
    else if (tile < 6536) { job = 3; mt = tile - 6272; nt = 0; Bt = p.w1_t; }
    else if (tile < 6800) { job = 4; mt = tile - 6536; nt = 0; Bt = p.a1_t; }
    else { job = 5; mt = (tile - 6800) >> 1; nt = tile & 1; Bt = p.g1_t; }
    const int m0 = mt * 128;
    f32x16 acc[2][2];
    gemm_mainloop(smem, 2, 1024,
                  [&](int r, int part) { return (const u16*)((part ? p.XX : p.H) + (size_t)(m0 + r) * DM); },
                  [&](int c) { return Bt + (size_t)(nt * 128 + c) * 2048; }, acc);
    if (job == 0) {
      epi_direct(acc, [&](int r, int c, float v) { p.R16[(size_t)(m0 + r) * DM + nt * 128 + c] = (f16)v; });
    } else if (job == 2) {
      epi_direct(acc, [&](int r, int c, float v) { p.V16[(size_t)(m0 + r) * DM + nt * 128 + c] = (f16)v; });
    } else if (job == 3) {
      epi_direct(acc, [&](int r, int c, float v) { p.LW[(size_t)(m0 + r) * 128 + c] = f2bf(tanhf(v)); });
    } else if (job == 4) {
      epi_direct(acc, [&](int r, int c, float v) { p.LA[(size_t)(m0 + r) * 128 + c] = f2bf(v); });
    } else if (job == 5) {
      epi_direct(acc, [&](int r, int c, float v) {
        const int col = nt * 128 + c;
        if (col < 192) p.LG[(size_t)(m0 + r) * 192 + col] = col < 160 ? f2bf(sigmoidf_(v)) : (u16)0;
      });
    } else {
      acc_to_lds(Cs, acc);
      const int lane = tid & 63, wave = tid >> 6;
      const int col = nt * 128 + 2 * lane;
      const float kk0 = p.k_k[col], kk1 = p.k_k[col + 1];
#pragma unroll 4
      for (int rr = 0; rr < 32; ++rr) {
        const int r = wave * 32 + rr;
        const float2 v = *(const float2*)&CS(r, 2 * lane);
        const float a0 = v.x * kk0, a1 = v.y * kk1;
        float ss = a0 * a0 + a1 * a1;
        ss = sum32(ss);
        const float inv = 1.f / fmaxf(sqrtf(ss), 1e-12f);
        f16 k2[2], n2[2];
        k2[0] = (f16)v.x; k2[1] = (f16)v.y; n2[0] = (f16)(a0 * inv); n2[1] = (f16)(a1 * inv);
        *(unsigned*)(p.K16 + (size_t)(m0 + r) * DM + col) = *(const unsigned*)k2;
        *(unsigned*)(p.KK16 + (size_t)(m0 + r) * DM + col) = *(const unsigned*)n2;
      }
    }
  }
}

struct ScanLds {
  float dec[2][16][64], kd[2][16][64], nk[2][16][64], bb[2][16][64], rr[2][16][64];
  float vv[2][16][16];
  float yy[2][16][16];
  float bp[2][4][16];
};

__device__ void phase_scan(const Params& p, char* smem) {
  ScanLds& L = *(ScanLds*)smem;
  const int tid = threadIdx.x, lane = tid & 63, wave = tid >> 6;
  const int l15 = lane & 15, l4 = lane >> 4;
  for (int item = blockIdx.x; item < 512; item += gridDim.x) {
    int sc, q;
    if (gridDim.x == 512) { const int xcd = item & 7, slot = item >> 3; sc = xcd * 16 + (slot >> 2); q = slot & 3; }
    else { sc = item >> 2; q = item & 3; }
    const int dir = sc & 1, bh = sc >> 1, b = bh >> 4, h = bh & 15;
    const int colw = h * 64 + wave * 16 + l15;
    const int chd = wave * 16 + l15;
    bf16x8 w2f[2], a2f[2];
#pragma unroll
    for (int ks = 0; ks < 2; ++ks) {
      w2f[ks] = *(const bf16x8*)(p.w2_t + ((size_t)(dir * 1024 + colw) * 64 + ks * 32 + l4 * 8));
      a2f[ks] = *(const bf16x8*)(p.a2_t + ((size_t)(dir * 1024 + colw) * 64 + ks * 32 + l4 * 8));
    }
    const float w0c = p.dw0[dir * 1024 + colw], a0c = p.a0[dir * 1024 + colw], kac = p.k_a[colw], rkc = p.r_k[colw];
    float S0 = 0.f, S1 = 0.f, S2 = 0.f, S3 = 0.f;
    const int myrow = wave * 4 + l4;
    const int c0 = l15 * 4;
    bf16x8 lwf[2], laf[2];
    f16 kv[4], kkv[4], rv[4];
    f16 vvr;
    auto chunk_rowbase = [&](int c, bool& isctx) -> int {
      if (c < 16) { isctx = true; const int cc = dir ? 15 - c : c; return TL + b * 256 + cc * 16; }
      isctx = false; const int cc = dir ? 511 - (c - 16) : (c - 16); return b * 8192 + cc * 16;
    };
    auto stage_load = [&](int c) {
      bool isctx; const int rb = chunk_rowbase(c, isctx);
#pragma unroll
      for (int ks = 0; ks < 2; ++ks) {
        lwf[ks] = *(const bf16x8*)(p.LW + ((size_t)(rb + l15) * 128 + dir * 64 + ks * 32 + l4 * 8));
        laf[ks] = *(const bf16x8*)(p.LA + ((size_t)(rb + l15) * 128 + dir * 64 + ks * 32 + l4 * 8));
      }
#pragma unroll
      for (int i = 0; i < 4; ++i) {
        const size_t off = (size_t)(rb + l4 * 4 + i) * DM + colw;
        kv[i] = p.K16[off]; kkv[i] = p.KK16[off];
        rv[i] = isctx ? (f16)0.f : p.R16[off];
      }
      vvr = p.V16[(size_t)(rb + (tid >> 4)) * DM + h * 64 + q * 16 + (tid & 15)];
    };
    auto stage_compute = [&](int c) {
      const int bsel = c & 1;
      f32x4 wacc = {0.f, 0.f, 0.f, 0.f}, aacc = {0.f, 0.f, 0.f, 0.f};
      wacc = __builtin_amdgcn_mfma_f32_16x16x32_bf16(lwf[0], w2f[0], wacc, 0, 0, 0);
      wacc = __builtin_amdgcn_mfma_f32_16x16x32_bf16(lwf[1], w2f[1], wacc, 0, 0, 0);
      aacc = __builtin_amdgcn_mfma_f32_16x16x32_bf16(laf[0], a2f[0], aacc, 0, 0, 0);
      aacc = __builtin_amdgcn_mfma_f32_16x16x32_bf16(laf[1], a2f[1], aacc, 0, 0, 0);
      float bpart[4];
#pragma unroll
      for (int i = 0; i < 4; ++i) {
        const int s = l4 * 4 + i;
        const float sg = sigmoidf_(w0c + wacc[i]);
        const float dec = __expf(-0.6065306597126334f * sg);
        const float a = sigmoidf_(a0c + aacc[i]);
        const float k = (float)kv[i], kk = (float)kkv[i], r = (float)rv[i];
        const float kd = k * (1.f + (a - 1.f) * kac);
        L.dec[bsel][s][chd] = dec;
        L.kd[bsel][s][chd] = kd;
        L.nk[bsel][s][chd] = -kk;
        L.bb[bsel][s][chd] = kk * a;
        L.rr[bsel][s][chd] = r;
        bpart[i] = dpp_sum16(r * kd * rkc);
      }
      if (l15 == 0) {
#pragma unroll
        for (int i = 0; i < 4; ++i) L.bp[bsel][wave][l4 * 4 + i] = bpart[i];
      }
      L.vv[bsel][tid >> 4][tid & 15] = (float)vvr;
    };
    __syncthreads();
    stage_load(0);
    stage_compute(0);
    __syncthreads();
    {
      bool isctx; const int rb = chunk_rowbase(0, isctx);
      if (q == 0 && tid < 16) p.bonus[((size_t)dir * MR + rb + tid) * 16 + h] = L.bp[0][0][tid] + L.bp[0][1][tid] + L.bp[0][2][tid] + L.bp[0][3][tid];
    }
    const int NCH = 528;
    for (int c = 0; c < NCH; ++c) {
      const int bsel = c & 1;
      if (c + 1 < NCH) stage_load(c + 1);
      const bool emit = c >= 16;
#pragma unroll 4
      for (int ss = 0; ss < 16; ++ss) {
        const int s = dir ? 15 - ss : ss;
        const float4 d4 = *(const float4*)&L.dec[bsel][s][c0];
        const float4 k4 = *(const float4*)&L.kd[bsel][s][c0];
        const float4 n4 = *(const float4*)&L.nk[bsel][s][c0];
        const float4 b4 = *(const float4*)&L.bb[bsel][s][c0];
        const float4 r4 = *(const float4*)&L.rr[bsel][s][c0];
        const float vv = L.vv[bsel][s][myrow];
        float sa = S0 * n4.x + S1 * n4.y + S2 * n4.z + S3 * n4.w;
        sa = dpp_sum16(sa);
        S0 = S0 * d4.x + (sa * b4.x + vv * k4.x);
        S1 = S1 * d4.y + (sa * b4.y + vv * k4.y);
        S2 = S2 * d4.z + (sa * b4.z + vv * k4.z);
        S3 = S3 * d4.w + (sa * b4.w + vv * k4.w);
        if (emit) {
          float y = S0 * r4.x + S1 * r4.y + S2 * r4.z + S3 * r4.w;
          y = dpp_sum16(y);
          if (l15 == 0) L.yy[bsel][s][myrow] = y;
        }
      }
      if (c + 1 < NCH) stage_compute(c + 1);
      __syncthreads();
      if (emit) {
        bool isctx; const int rb = chunk_rowbase(c, isctx);
        f16* Y = dir ? p.Y1 : p.Y0;
        Y[(size_t)(rb + (tid >> 4)) * DM + h * 64 + q * 16 + (tid & 15)] = (f16)(L.yy[bsel][tid >> 4][tid & 15] * 0.0625f);
      }
      if (c + 1 < NCH && q == 0 && tid < 16) {
        bool isctx; const int rb = chunk_rowbase(c + 1, isctx);
        const int b2 = (c + 1) & 1;
        p.bonus[((size_t)dir * MR + rb + tid) * 16 + h] = L.bp[b2][0][tid] + L.bp[b2][1][tid] + L.bp[b2][2][tid] + L.bp[b2][3][tid];
      }
    }
  }
}

__device__ void phase_readout(const Params& p, char* smem) {
  float* Cs = (float*)smem;
  const int tid = threadIdx.x;
  const int ntiles = 256 * 8;
  for (int tile = blockIdx.x; tile < ntiles; tile += gridDim.x) {
    const int mt = tile >> 3, nt = tile & 7;
    const int m0 = mt * 128;
    f32x16 acc[2][2];
    gemm_mainloop(smem, 1, 192,
                  [&](int r, int) { return (const u16*)(p.LG + (size_t)(m0 + r) * 192); },
                  [&](int c) { return (const u16*)(p.g2_t + (size_t)(nt * 128 + c) * 192); }, acc);
    acc_to_lds(Cs, acc);
    const int lane = tid & 63, wave = tid >> 6;
    const int head = nt * 2 + (lane >> 5);
    const int col = nt * 128 + 2 * lane;
    const float gw0 = p.gn_w[col], gw1 = p.gn_w[col + 1], gb0 = p.gn_b[col], gb1 = p.gn_b[col + 1];
#pragma unroll 2
    for (int rr = 0; rr < 32; ++rr) {
      const int r = wave * 32 + rr;
      const int row = m0 + r;
      const unsigned ua = *(const unsigned*)(p.Y0 + (size_t)row * DM + col), ub = *(const unsigned*)(p.Y1 + (size_t)row * DM + col);
      const unsigned uv = *(const unsigned*)(p.V16 + (size_t)row * DM + col);
      const f16* fa = (const f16*)&ua; const f16* fb = (const f16*)&ub; const f16* fv = (const f16*)&uv;
      const float y0 = ((float)fa[0] + (float)fb[0]) * 16.f, y1 = ((float)fa[1] + (float)fb[1]) * 16.f;
      float sm = y0 + y1;
      sm = sum32(sm);
      const float mean = sm * (1.f / 64.f);
      const float d0 = y0 - mean, d1 = y1 - mean;
      float vs = d0 * d0 + d1 * d1;
      vs = sum32(vs);
      const float rstd = rsqrtf(vs * (1.f / 64.f) + 64e-5f);
      const float bon = p.bonus[((size_t)0 * MR + row) * 16 + head] + p.bonus[((size_t)1 * MR + row) * 16 + head];
      const float2 g = *(const float2*)&CS(r, 2 * lane);
      const float z0 = (d0 * rstd * gw0 + gb0 + bon * (float)fv[0]) * g.x;
      const float z1 = (d1 * rstd * gw1 + gb1 + bon * (float)fv[1]) * g.y;
      *(unsigned*)(p.Z + (size_t)row * DM + col) = pack2(z0, z1);
    }
  }
}

__device__ void phase_final(const Params& p) {
  const int lane = threadIdx.x & 63;
  const int gw = blockIdx.x * 4 + (threadIdx.x >> 6), nw = gridDim.x * 4;
  for (int row = gw; row < TL; row += nw) {
    float* src = p.out + (size_t)row * DM;
    float4 v[4];
    float ss = 0.f;
#pragma unroll
    for (int i = 0; i < 4; ++i) {
      v[i] = *(const float4*)(src + i * 256 + lane * 4);
      ss += v[i].x * v[i].x + v[i].y * v[i].y + v[i].z * v[i].z + v[i].w * v[i].w;
    }
    ss = wave_sum(ss);
    const float rinv = rsqrtf(ss * (1.f / 1024.f) + 1e-6f);
#pragma unroll
    for (int i = 0; i < 4; ++i) {
      const float4 g = *(const float4*)(p.final_gain + i * 256 + lane * 4);
      float4 o;
      o.x = v[i].x * rinv * g.x; o.y = v[i].y * rinv * g.y; o.z = v[i].z * rinv * g.z; o.w = v[i].w * rinv * g.w;
      *(float4*)(src + i * 256 + lane * 4) = o;
    }
  }
}

__global__ void __launch_bounds__(256, 2) mega(Params p) {
  __shared__ __attribute__((aligned(16))) char smem[65536];
  cg::grid_group grid = cg::this_grid();
  phase_prep(p, smem); grid.sync();
  phase_modreduce(p); grid.sync();
  phase_modulate<true>(p, 0, 0, MR); grid.sync();
  phase_qkv(p, smem); grid.sync();
  phase_attn(p, smem); grid.sync();
  phase_proj_res<true>(p, smem, p.H, 1024, 1024, p.wo_t, 0, 2, 264); grid.sync();
  phase_modulate<false>(p, 0, 1, MR); grid.sync();
  phase_ffn_up(p, smem, 0, true, p.ACT0); grid.sync();
  phase_proj_res<false>(p, smem, p.ACT0, DFF, DFF, p.down_t, 0, 5, 264); grid.sync();
  phase_rwkv_shift(p); grid.sync();
  phase_rwkv_gemms(p, smem); grid.sync();
  phase_scan(p, smem); grid.sync();
  phase_readout(p, smem); grid.sync();
  phase_proj_res<false>(p, smem, p.Z, 1024, 1024, p.ro_t, 1, 2, 256); grid.sync();
  phase_modulate<false>(p, 1, 1, TL); grid.sync();
  phase_ffn_up(p, smem, 1, false, p.ACT1); grid.sync();
  phase_proj_res<false>(p, smem, p.ACT1, DFF, DFF, p.down_t + (size_t)1024 * 2816, 1, 5, 256); grid.sync();
  phase_final(p);
}

extern "C" void kernel_launch(void* const* d_in, const int* in_sizes, int n_in, void* d_out, int out_size, void* d_ws, size_t ws_size,
                              hipStream_t stream) {
  static int grid_blocks = 0;
  if (!grid_blocks) {
    int dev = 0, cus = 0, per_cu = 0;
    hipGetDevice(&dev);
    hipDeviceGetAttribute(&cus, hipDeviceAttributeMultiprocessorCount, dev);
    hipOccupancyMaxActiveBlocksPerMultiprocessor(&per_cu, mega, 256, 0);
    if (per_cu > 2) per_cu = 2;
    if (per_cu < 1) per_cu = 1;
    grid_blocks = cus * per_cu;
  }
  Params p{};
  const float* const* in = (const float* const*)d_in;
  p.x = in[0]; p.c = in[1]; p.ctx = in[2]; p.c_ctx = in[3]; p.ada_w = in[4]; p.ada_b = in[5]; p.w_qkv = in[6]; p.q_gain = in[7];
  p.k_gain = in[8]; p.w_o = in[9]; p.mu = in[10]; p.rw_r = in[11]; p.rw_k = in[12]; p.rw_v = in[13]; p.rw_o = in[14]; p.dw0 = in[15];
  p.dw1 = in[16]; p.dw2 = in[17]; p.a0 = in[18]; p.a1 = in[19]; p.a2 = in[20]; p.g1 = in[21]; p.g2 = in[22]; p.k_k = in[23];
  p.k_a = in[24]; p.r_k = in[25]; p.gn_w = in[26]; p.gn_b = in[27]; p.f_up = in[28]; p.f_cw = in[29]; p.f_cb = in[30];
  p.f_down = in[31]; p.final_gain = in[32];
  p.out = (float*)d_out;
  char* w = (char*)d_ws;
  size_t off = 0;
  auto take = [&](size_t bytes) { char* r = w + off; off += (bytes + 255) & ~(size_t)255; return r; };
  p.qkv_t = (u16*)take((size_t)1536 * 1024 * 2);
  p.wo_t = (u16*)take((size_t)1024 * 1024 * 2);
  p.up_t = (u16*)take((size_t)2 * 5632 * 1024 * 2);
  p.down_t = (u16*)take((size_t)2 * 1024 * 2816 * 2);
  p.rr_t = (u16*)take((size_t)1024 * 2048 * 2);
  p.rk_t = (u16*)take((size_t)1024 * 2048 * 2);
  p.rv_t = (u16*)take((size_t)1024 * 2048 * 2);
  p.ro_t = (u16*)take((size_t)1024 * 1024 * 2);
  p.w1_t = (u16*)take((size_t)128 * 2048 * 2);
  p.a1_t = (u16*)take((size_t)128 * 2048 * 2);
  p.g1_t = (u16*)take((size_t)256 * 2048 * 2);
  p.w2_t = (u16*)take((size_t)2 * 1024 * 64 * 2);
  p.a2_t = (u16*)take((size_t)2 * 1024 * 64 * 2);
  p.g2_t = (u16*)take((size_t)1024 * 192 * 2);
  p.modpart = (float*)take((size_t)2 * 8 * 5 * 6144 * 4);
  p.modv = (float*)take((size_t)2 * 5 * 6144 * 4);
  p.rope = (float*)take((size_t)8192 * 32 * 2 * 4);
  p.XC = (float*)take((size_t)TCX * DM * 4);
  p.bonus = (float*)take((size_t)2 * MR * 16 * 4);
  p.zero = (u16*)take(8192);
  const size_t pb = off;
  p.H = (u16*)take((size_t)MR * DM * 2);
  const size_t after_h = off;
  p.Q = (u16*)take((size_t)TL * DM * 2);
  p.QC = (u16*)take((size_t)TCX * DM * 2);
  p.Kb = (u16*)take((size_t)16 * NKEY * 64 * 2);
  p.Vt = (u16*)take((size_t)16 * NKEY * 64 * 2);
  p.ACT0 = (u16*)take((size_t)MR * DFF * 2);
  const size_t end0 = off;
  off = after_h;
  p.XX = (u16*)take((size_t)MR * DM * 2);
  p.R16 = (f16*)take((size_t)TL * DM * 2);
  p.K16 = (f16*)take((size_t)MR * DM * 2);
  p.V16 = (f16*)take((size_t)MR * DM * 2);
  p.KK16 = (f16*)take((size_t)MR * DM * 2);
  p.LW = (u16*)take((size_t)MR * 128 * 2);
  p.LA = (u16*)take((size_t)MR * 128 * 2);
  p.LG = (u16*)take((size_t)TL * 192 * 2);
  const size_t end1 = off;
  p.Y0 = (f16*)p.H;
  p.Y1 = (f16*)p.XX;
  p.Z = (u16*)p.R16;
  p.ACT1 = (u16*)p.K16;
  (void)pb;
  const size_t need = end0 > end1 ? end0 : end1;
  if (need > ws_size) { fprintf(stderr, "workspace too small: need %zu have %zu\n", need, ws_size); return; }
  void* args[] = {&p};
  hipError_t e = hipLaunchCooperativeKernel((void*)mega, dim3(grid_blocks), dim3(256), args, 0, stream);
  if (e != hipSuccess) fprintf(stderr, "cooperative launch failed: %s (grid %d)\n", hipGetErrorString(e), grid_blocks);
}
```

```cpp
#include <hip/hip_runtime.h>
#include <hip/hip_cooperative_groups.h>
#include <cstdio>
#include <cstdint>
namespace cg = cooperative_groups;

typedef unsigned short u16;
typedef _Float16 f16;
using bf16x8 = __attribute__((ext_vector_type(8))) short;
using f32x16 = __attribute__((ext_vector_type(16))) float;
using f32x4 = __attribute__((ext_vector_type(4))) float;
using u32x4 = __attribute__((ext_vector_type(4))) unsigned;
#define DI __device__ __forceinline__
DI u32x4 mk4(unsigned a, unsigned b, unsigned c, unsigned d) { u32x4 r; r[0] = a; r[1] = b; r[2] = c; r[3] = d; return r; }

constexpr int TL = 32768;
constexpr int TCX = 1024;
constexpr int MR = 33792;
constexpr int DM = 1024;
constexpr int DFF = 2816;
constexpr int NKEY = 8448;
constexpr int NPHASE = 18;

struct Params {
  const float *x, *c, *ctx, *c_ctx, *ada_w, *ada_b, *w_qkv, *q_gain, *k_gain, *w_o;
  const float *mu, *rw_r, *rw_k, *rw_v, *rw_o, *dw0, *dw1, *dw2, *a0, *a1, *a2, *g1, *g2, *k_k, *k_a, *r_k, *gn_w, *gn_b;
  const float *f_up, *f_cw, *f_cb, *f_down, *final_gain;
  float* out;
  u16 *qkv_t, *wo_t, *up_t, *down_t, *rr_t, *rk_t, *rv_t, *ro_t, *w1_t, *a1_t, *g1_t, *w2_t, *a2_t, *g2_t;
  float *modpart, *modv, *rope, *XC, *bonus;
  u16* zero;
  u16 *H, *XX, *Q, *QC, *Kb, *Vt, *ACT0, *ACT1;
  f16 *R16, *K16, *V16, *KK16, *Y0, *Y1;
  u16 *LW, *LA, *LG, *Z;
  int phase_lo, phase_hi;
};

typedef __bf16 bf16x2_t __attribute__((ext_vector_type(2)));
typedef float f32x2 __attribute__((ext_vector_type(2)));
DI unsigned pack2(float a, float b) { f32x2 f = {a, b}; return __builtin_bit_cast(unsigned, __builtin_convertvector(f, bf16x2_t)); }
DI u16 f2bf(float x) { return (u16)(pack2(x, 0.f) & 0xffffu); }
DI float bf2f(u16 h) { return __uint_as_float(((unsigned)h) << 16); }
DI float wave_sum(float v) {
#pragma unroll
  for (int o = 32; o > 0; o >>= 1) v += __shfl_xor(v, o, 64);
  return v;
}
template <int CTRL> DI float dpp_mov(float v) { return __builtin_bit_cast(float, __builtin_amdgcn_update_dpp(0, __builtin_bit_cast(int, v), CTRL, 0xF, 0xF, false)); }
DI float dpp_sum16(float v) {
  v += dpp_mov<0x128>(v);
  v += dpp_mov<0x124>(v);
  v += dpp_mov<0x122>(v);
  v += dpp_mov<0x121>(v);
  return v;
}
DI float sum32(float v) { v = dpp_sum16(v); v += __shfl_xor(v, 16, 64); return v; }
DI float sigmoidf_(float x) { return 1.f / (1.f + __expf(-x)); }
DI float sigmoid_fast(float x) { return __builtin_amdgcn_rcpf(1.f + __expf(-x)); }
DI int midx_of(int row) { return row < TL ? (row >> 13) : 4; }
DI float* resid_ptr(const Params& p, int row) { return row < TL ? p.out + (size_t)row * DM : p.XC + (size_t)(row - TL) * DM; }
DI const float* xin_ptr(const Params& p, int row) { return row < TL ? p.x + (size_t)row * DM : p.ctx + (size_t)(row - TL) * DM; }

DI void work_range(int total, int& g0, int& gend, int& step) {
  if ((gridDim.x & 7) == 0) {
    const int x = blockIdx.x & 7, li = blockIdx.x >> 3, nl = gridDim.x >> 3;
    const int lo = (int)(((long long)total * x) >> 3), hi = (int)(((long long)total * (x + 1)) >> 3);
    g0 = lo + li; gend = hi; step = nl;
  } else { g0 = blockIdx.x; gend = total; step = gridDim.x; }
}
DI void band_decode(int g, int MT, int NT, int& mt, int& nt) {
  const int per = 8 * NT;
  const int band = g / per, r = g - band * per;
  int hb = MT - band * 8; if (hb > 8) hb = 8;
  nt = r / hb; mt = band * 8 + (r - nt * hb);
}

template <class AF, class BF>
DI void gemm_mainloop(char* smem, int nparts, int kpart, AF arow, BF brow, f32x16 (&acc)[2][2]) {
  const int tid = threadIdx.x, lane = tid & 63, wave = tid >> 6;
  const int wm = wave >> 1, wn = wave & 1;
  const int lr = tid >> 3, lc = tid & 7;
#pragma unroll
  for (int i = 0; i < 2; ++i)
#pragma unroll
    for (int j = 0; j < 2; ++j)
#pragma unroll
      for (int e = 0; e < 16; ++e) acc[i][j][e] = 0.f;
  const int csrc = (lc ^ ((lr >> 1) & 7)) * 8;
  const u16* bp[4];
  const u16* ap[4];
#pragma unroll
  for (int q = 0; q < 4; ++q) { bp[q] = brow(lr + 32 * q) + csrc; ap[q] = arow(lr + 32 * q, 0) + csrc; }
  const int nk = kpart >> 6;
  const int total = nparts * nk;
  const int sw = (lane >> 1) & 7;
  const int hsel = lane >> 5;
  char* const wbase = smem + wave * 1024;
  auto stage = [&](int buf, int kk, int boff) {
#pragma unroll
    for (int q = 0; q < 4; ++q) {
      __builtin_amdgcn_global_load_lds((const unsigned*)(ap[q] + kk), (unsigned*)(wbase + buf * 32768 + q * 4096), 16, 0, 0);
      __builtin_amdgcn_global_load_lds((const unsigned*)(bp[q] + boff), (unsigned*)(wbase + buf * 32768 + 16384 + q * 4096), 16, 0, 0);
    }
  };
  __syncthreads();
  stage(0, 0, 0);
  asm volatile("s_waitcnt vmcnt(0)" ::: "memory");
  __syncthreads();
  int part = 0, kk = 0, buf = 0;
#pragma unroll 1
  for (int it = 0; it < total; ++it) {
    kk += 64;
    if (kk == kpart) {
      kk = 0; ++part;
      if (part < nparts) {
#pragma unroll
        for (int q = 0; q < 4; ++q) ap[q] = arow(lr + 32 * q, part) + csrc;
      }
    }
    if (it + 1 < total) stage(buf ^ 1, kk, part * kpart + kk);
    const u16* As = (const u16*)(smem + buf * 32768);
    const u16* Bs = As + 128 * 64;
#pragma unroll
    for (int ks = 0; ks < 4; ++ks) {
      const int pc = ((ks * 2 + hsel) ^ sw) * 8;
      bf16x8 af[2], bf[2];
#pragma unroll
      for (int i = 0; i < 2; ++i) {
        af[i] = *(const bf16x8*)(As + (wm * 64 + i * 32 + (lane & 31)) * 64 + pc);
        bf[i] = *(const bf16x8*)(Bs + (wn * 64 + i * 32 + (lane & 31)) * 64 + pc);
      }
#pragma unroll
      for (int i = 0; i < 2; ++i)
#pragma unroll
        for (int j = 0; j < 2; ++j) acc[i][j] = __builtin_amdgcn_mfma_f32_32x32x16_bf16(af[i], bf[j], acc[i][j], 0, 0, 0);
    }
    asm volatile("s_waitcnt vmcnt(0)" ::: "memory");
    __syncthreads();
    buf ^= 1;
  }
}

template <class F>
DI void epi_direct(const f32x16 (&acc)[2][2], F f) {
  const int lane = threadIdx.x & 63, wave = threadIdx.x >> 6;
  const int wm = wave >> 1, wn = wave & 1, h = lane >> 5;
#pragma unroll
  for (int i = 0; i < 2; ++i)
#pragma unroll
    for (int j = 0; j < 2; ++j)
#pragma unroll
      for (int e = 0; e < 16; ++e) {
        const int row = wm * 64 + i * 32 + (e & 3) + 8 * (e >> 2) + 4 * h;
        const int col = wn * 64 + j * 32 + (lane & 31);
        f(row, col, acc[i][j][e]);
      }
}
#define CS(r, c) Cs[(r) * 128 + (c)]
DI void acc_to_lds(float* Cs, const f32x16 (&acc)[2][2]) {
  __syncthreads();
  epi_direct(acc, [&](int r, int c, float v) { CS(r, c) = v; });
  __syncthreads();
}

struct TJob { const float* src; int srcK, srcN; u16* dst; int ld, koff; const float* mu; int Kpad, Npad; };
DI TJob get_job(const Params& p, int j) {
  TJob t; t.mu = nullptr; t.koff = 0;
  auto set = [&](const float* s, int K, int N, u16* d, int ld) { t.src = s; t.srcK = K; t.srcN = N; t.dst = d; t.ld = ld; t.Kpad = K; t.Npad = N; };
  switch (j) {
    case 0: set(p.w_qkv, 1024, 1536, p.qkv_t, 1024); break;
    case 1: set(p.w_o, 1024, 1024, p.wo_t, 1024); break;
    case 2: set(p.f_up, 1024, 5632, p.up_t, 1024); break;
    case 3: set(p.f_up + (size_t)1024 * 5632, 1024, 5632, p.up_t + (size_t)5632 * 1024, 1024); break;
    case 4: set(p.f_down, 2816, 1024, p.down_t, 2816); break;
    case 5: set(p.f_down + (size_t)2816 * 1024, 2816, 1024, p.down_t + (size_t)1024 * 2816, 2816); break;
    case 6: set(p.rw_r, 1024, 1024, p.rr_t, 2048); break;
    case 7: set(p.rw_r, 1024, 1024, p.rr_t, 2048); t.mu = p.mu + 0 * 1024; t.koff = 1024; break;
    case 8: set(p.rw_k, 1024, 1024, p.rk_t, 2048); break;
    case 9: set(p.rw_k, 1024, 1024, p.rk_t, 2048); t.mu = p.mu + 2 * 1024; t.koff = 1024; break;
    case 10: set(p.rw_v, 1024, 1024, p.rv_t, 2048); break;
    case 11: set(p.rw_v, 1024, 1024, p.rv_t, 2048); t.mu = p.mu + 3 * 1024; t.koff = 1024; break;
    case 12: set(p.rw_o, 1024, 1024, p.ro_t, 1024); break;
    case 13: set(p.dw1, 1024, 64, p.w1_t, 2048); break;
    case 14: set(p.dw1, 1024, 64, p.w1_t, 2048); t.mu = p.mu + 1 * 1024; t.koff = 1024; break;
    case 15: set(p.dw1 + 1024 * 64, 1024, 64, p.w1_t + 64 * 2048, 2048); break;
    case 16: set(p.dw1 + 1024 * 64, 1024, 64, p.w1_t + 64 * 2048, 2048); t.mu = p.mu + 1 * 1024; t.koff = 1024; break;
    case 17: set(p.a1, 1024, 64, p.a1_t, 2048); break;
    case 18: set(p.a1, 1024, 64, p.a1_t, 2048); t.mu = p.mu + 4 * 1024; t.koff = 1024; break;
    case 19: set(p.a1 + 1024 * 64, 1024, 64, p.a1_t + 64 * 2048, 2048); break;
    case 20: set(p.a1 + 1024 * 64, 1024, 64, p.a1_t + 64 * 2048, 2048); t.mu = p.mu + 4 * 1024; t.koff = 1024; break;
    case 21: set(p.g1, 1024, 160, p.g1_t, 2048); t.Npad = 256; break;
    case 22: set(p.g1, 1024, 160, p.g1_t, 2048); t.Npad = 256; t.mu = p.mu + 5 * 1024; t.koff = 1024; break;
    case 23: set(p.dw2, 64, 1024, p.w2_t, 64); break;
    case 24: set(p.dw2 + 64 * 1024, 64, 1024, p.w2_t + 1024 * 64, 64); break;
    case 25: set(p.a2, 64, 1024, p.a2_t, 64); break;
    case 26: set(p.a2 + 64 * 1024, 64, 1024, p.a2_t + 1024 * 64, 64); break;
    default: set(p.g2, 160, 1024, p.g2_t, 192); t.Kpad = 192; break;
  }
  return t;
}
constexpr int NJOBS = 28;
DI int job_tiles(const TJob& t) { return ((t.Kpad + 63) >> 6) * ((t.Npad + 63) >> 6); }

__device__ void phase_prep(const Params& p, char* smem) {
  const int tid = threadIdx.x;
  int ttiles = 0;
  for (int j = 0; j < NJOBS; ++j) ttiles += job_tiles(get_job(p, j));
  const int n_mod = 2 * 24 * 8;
  const int n_rope = 1024;
  const int total = ttiles + n_mod + n_rope;
  float* tile = (float*)smem;
  if (blockIdx.x == 0) for (int e = tid; e < 4096; e += 256) p.zero[e] = 0;
  for (int item = blockIdx.x; item < total; item += gridDim.x) {
    if (item < ttiles) {
      int rem = item, j = 0;
      TJob t = get_job(p, 0);
      while (true) { int n = job_tiles(t); if (rem < n) break; rem -= n; ++j; t = get_job(p, j); }
      const int ntn = (t.Npad + 63) >> 6;
      const int kt = rem / ntn, nt = rem % ntn;
      __syncthreads();
#pragma unroll
      for (int i = 0; i < 16; ++i) {
        const int kl = i * 4 + (tid >> 6), nl = tid & 63;
        const int k = kt * 64 + kl, n = nt * 64 + nl;
        float v = 0.f;
        if (k < t.srcK && n < t.srcN) { v = t.src[(size_t)k * t.srcN + n]; if (t.mu) v *= t.mu[k]; }
        tile[kl * 65 + nl] = v;
      }
      __syncthreads();
#pragma unroll
      for (int i = 0; i < 16; ++i) {
        const int nl = i * 4 + (tid >> 6), kl = tid & 63;
        const int k = kt * 64 + kl, n = nt * 64 + nl;
        if (k < t.Kpad && n < t.Npad) t.dst[(size_t)n * t.ld + t.koff + k] = f2bf(tile[kl * 65 + nl]);
      }
    } else if (item < ttiles + n_mod) {
      const int it = item - ttiles;
      const int layer = it / 192, cc = (it % 192) / 8, kc = it % 8;
      float* sil = (float*)smem;
      __syncthreads();
      for (int e = tid; e < 640; e += 256) {
        const int j = e >> 7, k = kc * 128 + (e & 127);
        const float v = j < 4 ? p.c[j * 1024 + k] : p.c_ctx[k];
        sil[e] = v / (1.f + __expf(-v));
      }
      __syncthreads();
      const int col = cc * 256 + tid;
      float a0 = 0, a1 = 0, a2 = 0, a3 = 0, a4 = 0;
      const float* w = p.ada_w + ((size_t)layer * 1024 + kc * 128) * 6144 + col;
#pragma unroll 16
      for (int k = 0; k < 128; ++k) {
        const float wv = w[(size_t)k * 6144];
        a0 += sil[k] * wv; a1 += sil[128 + k] * wv; a2 += sil[256 + k] * wv; a3 += sil[384 + k] * wv; a4 += sil[512 + k] * wv;
      }
      float* mp = p.modpart + ((size_t)(layer * 8 + kc) * 5) * 6144 + col;
      mp[0] = a0; mp[6144] = a1; mp[2 * 6144] = a2; mp[3 * 6144] = a3; mp[4 * 6144] = a4;
    } else {
      const int e = (item - ttiles - n_mod) * 256 + tid;
      const int s = e >> 5, pr = e & 31;
      const int f = pr & 15;
      const float inv_freq = powf(10000.f, -(float)f / 16.f);
      const float pos = (pr < 16) ? (float)(s >> 6) : (float)(s & 63);
      const float ang = pos * inv_freq;
      float sn, cs;
      sincosf(ang, &sn, &cs);
      p.rope[e * 2] = cs; p.rope[e * 2 + 1] = sn;
    }
  }
}

__device__ void phase_modreduce(const Params& p) {
  const int n = 2 * 5 * 6144;
  for (int e = blockIdx.x * 256 + threadIdx.x; e < n; e += gridDim.x * 256) {
    const int layer = e / (5 * 6144), r = e % (5 * 6144), col = r % 6144;
    float s = p.ada_b[layer * 6144 + col];
    for (int kc = 0; kc < 8; ++kc) s += p.modpart[(size_t)(layer * 8 + kc) * 5 * 6144 + r];
    p.modv[e] = s;
  }
}

template <bool FROM_INPUT>
__device__ void phase_modulate(const Params& p, int layer, int which, int nrows) {
  const int lane = threadIdx.x & 63;
  const int gw = blockIdx.x * 4 + (threadIdx.x >> 6), nw = gridDim.x * 4;
  for (int row = gw; row < nrows; row += nw) {
    const float* src = FROM_INPUT ? xin_ptr(p, row) : resid_ptr(p, row);
    const float* mv = p.modv + ((size_t)layer * 5 + midx_of(row)) * 6144 + which * 3072;
    float4 v[4];
    float ss = 0.f;
#pragma unroll
    for (int i = 0; i < 4; ++i) {
      v[i] = *(const float4*)(src + i * 256 + lane * 4);
      ss += v[i].x * v[i].x + v[i].y * v[i].y + v[i].z * v[i].z + v[i].w * v[i].w;
    }
    ss = wave_sum(ss);
    const float rinv = rsqrtf(ss * (1.f / 1024.f) + 1e-6f);
#pragma unroll
    for (int i = 0; i < 4; ++i) {
      const int col = i * 256 + lane * 4;
      const float4 sh = *(const float4*)(mv + col);
      const float4 sc = *(const float4*)(mv + 1024 + col);
      uint2 o;
      o.x = pack2(v[i].x * rinv * (1.f + sc.x) + sh.x, v[i].y * rinv * (1.f + sc.y) + sh.y);
      o.y = pack2(v[i].z * rinv * (1.f + sc.z) + sh.z, v[i].w * rinv * (1.f + sc.w) + sh.w);
      *(uint2*)(p.H + (size_t)row * DM + col) = o;
    }
  }
}

DI void modrow(const Params& p, int row, bool valid, int lane, float (&h)[16]) {
  if (!valid) {
#pragma unroll
    for (int i = 0; i < 16; ++i) h[i] = 0.f;
    return;
  }
  const float* src = resid_ptr(p, row);
  const float* mv = p.modv + ((size_t)1 * 5 + midx_of(row)) * 6144;
  float ss = 0.f;
#pragma unroll
  for (int i = 0; i < 4; ++i) {
    const float4 v = *(const float4*)(src + i * 256 + lane * 4);
    h[i * 4 + 0] = v.x; h[i * 4 + 1] = v.y; h[i * 4 + 2] = v.z; h[i * 4 + 3] = v.w;
    ss += v.x * v.x + v.y * v.y + v.z * v.z + v.w * v.w;
  }
  ss = wave_sum(ss);
  const float rinv = rsqrtf(ss * (1.f / 1024.f) + 1e-6f);
#pragma unroll
  for (int i = 0; i < 4; ++i) {
    const int col = i * 256 + lane * 4;
    const float4 sh = *(const float4*)(mv + col);
    const float4 sc = *(const float4*)(mv + 1024 + col);
    h[i * 4 + 0] = h[i * 4 + 0] * rinv * (1.f + sc.x) + sh.x;
    h[i * 4 + 1] = h[i * 4 + 1] * rinv * (1.f + sc.y) + sh.y;
    h[i * 4 + 2] = h[i * 4 + 2] * rinv * (1.f + sc.z) + sh.z;
    h[i * 4 + 3] = h[i * 4 + 3] * rinv * (1.f + sc.w) + sh.w;
  }
}
__device__ void phase_rwkv_shift(const Params& p) {
  const int lane = threadIdx.x & 63;
  const int gw = blockIdx.x * 4 + (threadIdx.x >> 6), nw = gridDim.x * 4;
  const int nitems = MR / 8;
  for (int item = gw; item < nitems; item += nw) {
    const int r0 = item * 8;
    int sb, T;
    if (r0 < TL) { sb = r0 & ~8191; T = 8192; } else { sb = TL + ((r0 - TL) & ~255); T = 256; }
    float hm[16], hc[16], hn[16];
    modrow(p, r0 - 1, r0 - 1 >= sb, lane, hm);
    modrow(p, r0, true, lane, hc);
    for (int j = 0; j < 8; ++j) {
      const int row = r0 + j;
      modrow(p, row + 1, row + 1 < sb + T, lane, hn);
#pragma unroll
      for (int i = 0; i < 4; ++i) {
        const int col = i * 256 + lane * 4;
        float xx[4];
#pragma unroll
        for (int e = 0; e < 4; ++e) xx[e] = 0.5f * (hm[i * 4 + e] + hn[i * 4 + e]) - hc[i * 4 + e];
        uint2 o, o2;
        o.x = pack2(hc[i * 4 + 0], hc[i * 4 + 1]); o.y = pack2(hc[i * 4 + 2], hc[i * 4 + 3]);
        o2.x = pack2(xx[0], xx[1]); o2.y = pack2(xx[2], xx[3]);
        *(uint2*)(p.H + (size_t)row * DM + col) = o;
        *(uint2*)(p.XX + (size_t)row * DM + col) = o2;
      }
#pragma unroll
      for (int i = 0; i < 16; ++i) { hm[i] = hc[i]; hc[i] = hn[i]; }
    }
  }
}

__device__ void phase_qkv(const Params& p, char* smem) {
  float* Cs = (float*)smem;
  const int tid = threadIdx.x;
  int g0, gend, gstep; work_range(264 * 12, g0, gend, gstep);
  for (int tile = g0; tile < gend; tile += gstep) {
    int mt, nt; band_decode(tile, 264, 12, mt, nt);
    const int m0 = mt * 128;
    f32x16 acc[2][2];
    gemm_mainloop(smem, 1, 1024,
                  [&](int r, int) { return (const u16*)(p.H + (size_t)(m0 + r) * DM); },
                  [&](int c) { return (const u16*)(p.qkv_t + (size_t)(nt * 128 + c) * 1024); }, acc);
    acc_to_lds(Cs, acc);
    const bool isctx = m0 >= TL;
    const int b = isctx ? (m0 - TL) >> 8 : m0 >> 13;
    const int t0 = isctx ? (m0 - TL) & 255 : m0 & 8191;
    if (nt < 10) {
      const int lane = tid & 63, wave = tid >> 6;
      const int hh = lane >> 5, pr = lane & 31;
      const bool isq = nt < 8;
      const float* gain = isq ? p.q_gain : p.k_gain;
      const float qs = isq ? 0.125f * 1.4426950408889634f : 1.f;
      const float g0 = gain[2 * pr] * qs, g1 = gain[2 * pr + 1] * qs;
      u16* dstb;
      size_t tstride = 64;
      if (isq) {
        const int head = nt * 2 + hh;
        dstb = isctx ? p.QC + ((size_t)(b * 16 + head) * 256 + t0) * 64 : p.Q + ((size_t)(b * 16 + head) * 8192 + t0) * 64;
      } else {
        const int kh = (nt - 8) * 2 + hh;
        dstb = p.Kb + ((size_t)(b * 4 + kh) * NKEY + (isctx ? t0 : 256 + t0)) * 64;
      }
#pragma unroll 4
      for (int rr = 0; rr < 32; ++rr) {
        const int r = wave * 32 + rr;
        const float2 v = *(const float2*)&CS(r, 2 * lane);
        float ss = v.x * v.x + v.y * v.y;
        ss = sum32(ss);
        const float rinv = rsqrtf(ss * (1.f / 64.f) + 1e-6f);
        float x0 = v.x * rinv * g0, x1 = v.y * rinv * g1;
        if (!isctx) {
          const float2 cssn = *(const float2*)(p.rope + ((size_t)(t0 + r) * 32 + pr) * 2);
          const float y0 = x0 * cssn.x - x1 * cssn.y, y1 = x0 * cssn.y + x1 * cssn.x;
          x0 = y0; x1 = y1;
        }
        *(unsigned*)(dstb + (size_t)r * tstride + 2 * pr) = pack2(x0, x1);
      }
    } else {
      const int keybase = (isctx ? t0 : 256 + t0);
      for (int j = 0; j < 4; ++j) {
        const int item = tid + 256 * j;
        const int d = item & 63, hh = (item >> 6) & 1, rg = item >> 7;
        const int kh = (nt - 10) * 2 + hh;
        float v[16];
#pragma unroll
        for (int i = 0; i < 16; ++i) v[i] = CS(rg * 16 + i, hh * 64 + d);
        u16* dst = p.Vt + ((size_t)(b * 4 + kh) * 64 + d) * NKEY + keybase + rg * 16;
        *(u32x4*)(dst) = mk4(pack2(v[0], v[1]), pack2(v[2], v[3]), pack2(v[8], v[9]), pack2(v[10], v[11]));
        *(u32x4*)(dst + 8) = mk4(pack2(v[4], v[5]), pack2(v[6], v[7]), pack2(v[12], v[13]), pack2(v[14], v[15]));
      }
    }
  }
}

__device__ void phase_attn(const Params& p, char* smem) {
  u16* Ks = (u16*)smem;
  u16* Vs = Ks + 64 * 64;
  const int tid = threadIdx.x, lane = tid & 63, wave = tid >> 6;
  const int sw = (lane >> 1) & 7, hsel = lane >> 5;
  int ga, gae, gs, gc, gce, gs2;
  work_range(4096, ga, gae, gs);
  work_range(128, gc, gce, gs2);
  const int n_lat = ga < gae ? (gae - ga + gs - 1) / gs : 0;
  const int n_ctx = gc < gce ? (gce - gc + gs2 - 1) / gs2 : 0;
  for (int wi = 0; wi < n_lat + n_ctx; ++wi) {
    const int item = wi < n_lat ? ga + wi * gs : 4096 + gc + (wi - n_lat) * gs2;
    int b, kvh, qb, nkt;
    const u16* qbase;
    size_t orow;
    const int head_g = wave;
    if (item < 4096) {
      b = item >> 10; kvh = (item >> 8) & 3; qb = item & 255; nkt = NKEY / 64;
      qbase = p.Q + ((size_t)(b * 16 + kvh * 4 + head_g) * 8192 + qb * 32) * 64;
      orow = (size_t)b * 8192 + qb * 32;
    } else {
      const int j = item - 4096;
      b = j >> 5; kvh = (j >> 3) & 3; qb = j & 7; nkt = 4;
      qbase = p.QC + ((size_t)(b * 16 + kvh * 4 + head_g) * 256 + qb * 32) * 64;
      orow = (size_t)TL + b * 256 + qb * 32;
    }
    const int head = kvh * 4 + head_g;
    bf16x8 qf[4];
#pragma unroll
    for (int ks = 0; ks < 4; ++ks) qf[ks] = *(const bf16x8*)(qbase + (lane & 31) * 64 + ks * 16 + hsel * 8);
    const u16* kg = p.Kb + (size_t)(b * 4 + kvh) * NKEY * 64;
    const u16* vg = p.Vt + (size_t)(b * 4 + kvh) * 64 * NKEY;
    f32x16 oacc[2];
#pragma unroll
    for (int i = 0; i < 16; ++i) { oacc[0][i] = 0.f; oacc[1][i] = 0.f; }
    float m = -INFINITY, lsum = 0.f;
    u32x4 rk[2], rv[2];
#pragma unroll
    for (int q = 0; q < 2; ++q) {
      const int ch = tid + 256 * q;
      rk[q] = *(const u32x4*)(kg + (size_t)ch * 8);
      rv[q] = *(const u32x4*)(vg + (size_t)(ch >> 3) * NKEY + (ch & 7) * 8);
    }
    for (int kt = 0; kt < nkt; ++kt) {
      __syncthreads();
#pragma unroll
      for (int q = 0; q < 2; ++q) {
        const int ch = tid + 256 * q;
        const int row = ch >> 3, cc = ch & 7;
        const int pc = cc ^ ((row >> 1) & 7);
        *(u32x4*)(Ks + row * 64 + pc * 8) = rk[q];
        *(u32x4*)(Vs + row * 64 + pc * 8) = rv[q];
      }
      __syncthreads();
      if (kt + 1 < nkt) {
#pragma unroll
        for (int q = 0; q < 2; ++q) {
          const int ch = tid + 256 * q;
          rk[q] = *(const u32x4*)(kg + (size_t)(kt + 1) * 4096 + (size_t)ch * 8);
          rv[q] = *(const u32x4*)(vg + (size_t)(ch >> 3) * NKEY + (kt + 1) * 64 + (ch & 7) * 8);
        }
      }
      f32x16 sacc[2];
#pragma unroll
      for (int i = 0; i < 16; ++i) { sacc[0][i] = 0.f; sacc[1][i] = 0.f; }
#pragma unroll
      for (int kb = 0; kb < 2; ++kb)
#pragma unroll
        for (int ks = 0; ks < 4; ++ks) {
          const bf16x8 a = *(const bf16x8*)(Ks + (kb * 32 + (lane & 31)) * 64 + (((ks * 2 + hsel) ^ sw) * 8));
          sacc[kb] = __builtin_amdgcn_mfma_f32_32x32x16_bf16(a, qf[ks], sacc[kb], 0, 0, 0);
        }
      float mx = sacc[0][0];
#pragma unroll
      for (int i = 1; i < 16; ++i) mx = fmaxf(mx, sacc[0][i]);
#pragma unroll
      for (int i = 0; i < 16; ++i) mx = fmaxf(mx, sacc[1][i]);
      mx = fmaxf(mx, __shfl_xor(mx, 32, 64));
      const float mn = fmaxf(m, mx);
      const float alpha = __builtin_amdgcn_exp2f(m - mn);
      m = mn;
      float ps = 0.f;
#pragma unroll
      for (int kb = 0; kb < 2; ++kb)
#pragma unroll
        for (int i = 0; i < 16; ++i) { const float e = __builtin_amdgcn_exp2f(sacc[kb][i] - mn); sacc[kb][i] = e; ps += e; }
      lsum = lsum * alpha + ps;
      if (__builtin_amdgcn_ballot_w64(alpha != 1.f) != 0) {
#pragma unroll
        for (int i = 0; i < 16; ++i) { oacc[0][i] *= alpha; oacc[1][i] *= alpha; }
      }
#pragma unroll
      for (int kb = 0; kb < 2; ++kb)
#pragma unroll
        for (int s2 = 0; s2 < 2; ++s2) {
          unsigned w[4];
#pragma unroll
          for (int e = 0; e < 4; ++e) w[e] = pack2(sacc[kb][8 * s2 + 2 * e], sacc[kb][8 * s2 + 2 * e + 1]);
          u32x4 pw = mk4(w[0], w[1], w[2], w[3]);
          const bf16x8 pf = __builtin_bit_cast(bf16x8, pw);
          const int chunk = 4 * kb + 2 * s2 + hsel;
#pragma unroll
          for (int db = 0; db < 2; ++db) {
            const bf16x8 a = *(const bf16x8*)(Vs + (db * 32 + (lane & 31)) * 64 + ((chunk ^ sw) * 8));
            oacc[db] = __builtin_amdgcn_mfma_f32_32x32x16_bf16(a, pf, oacc[db], 0, 0, 0);
          }
        }
    }
    const float l = lsum + __shfl_xor(lsum, 32, 64);
    const float inv = 1.f / l;
    u16* od = p.H + (orow + (lane & 31)) * DM + head * 64;
#pragma unroll
    for (int db = 0; db < 2; ++db)
#pragma unroll
      for (int g = 0; g < 4; ++g) {
        uint2 o;
        o.x = pack2(oacc[db][g * 4 + 0] * inv, oacc[db][g * 4 + 1] * inv);
        o.y = pack2(oacc[db][g * 4 + 2] * inv, oacc[db][g * 4 + 3] * inv);
        *(uint2*)(od + db * 32 + 8 * g + 4 * hsel) = o;
      }
  }
}

template <bool FROM_INPUT>
__device__ void phase_proj_res(const Params& p, char* smem, const u16* A, int lda, int K, const u16* Bt, int layer, int gate_idx, int mtiles) {
  int g0, gend, gstep; work_range(mtiles * 8, g0, gend, gstep);
  for (int tile = g0; tile < gend; tile += gstep) {
    int mt, nt; band_decode(tile, mtiles, 8, mt, nt);
    const int m0 = mt * 128;
    f32x16 acc[2][2];
    gemm_mainloop(smem, 1, K,
                  [&](int r, int) { return A + (size_t)(m0 + r) * lda; },
                  [&](int c) { return Bt + (size_t)(nt * 128 + c) * K; }, acc);
    const float* gate = p.modv + ((size_t)layer * 5 + midx_of(m0)) * 6144 + gate_idx * 1024 + nt * 128;
    const float* sb = (FROM_INPUT ? xin_ptr(p, m0) : (const float*)resid_ptr(p, m0)) + nt * 128;
    float* db = resid_ptr(p, m0) + nt * 128;
    epi_direct(acc, [&](int r, int c, float v) { db[r * DM + c] = sb[r * DM + c] + gate[c] * v; });
  }
}

__device__ void phase_ffn_up(const Params& p, char* smem, int layer, bool with_ctx, u16* ACT) {
  float* Cs = (float*)smem;
  const int tid = threadIdx.x;
  const int mtiles = with_ctx ? 276 : 264;
  int g0, gend, gstep; work_range(mtiles * 44, g0, gend, gstep);
  const u16* up = p.up_t + (size_t)layer * 5632 * 1024;
  const float* cw = p.f_cw + (size_t)layer * 3 * 5632;
  const float* cb = p.f_cb + (size_t)layer * 5632;
  for (int tile = g0; tile < gend; tile += gstep) {
    int mt, nt; band_decode(tile, mtiles, 44, mt, nt);
    int rowbase, T, j;
    if (mt < 264) { rowbase = (mt / 66) * 8192; T = 8192; j = mt % 66; }
    else { const int m2 = mt - 264; rowbase = TL + (m2 / 3) * 256; T = 256; j = m2 % 3; }
    const int tb = j * 126 - 1;
    f32x16 acc[2][2];
    gemm_mainloop(smem, 1, 1024,
                  [&](int r, int) { const int t = tb + r; return (t >= 0 && t < T) ? (const u16*)(p.H + (size_t)(rowbase + t) * DM) : (const u16*)p.zero; },
                  [&](int c) { return up + (size_t)(c < 64 ? nt * 64 + c : 2816 + nt * 64 + (c - 64)) * 1024; }, acc);
    acc_to_lds(Cs, acc);
    const int c = tid & 63, rq = tid >> 6;
    const int n = nt * 64 + c;
    const float g0 = cw[n], g1 = cw[5632 + n], g2 = cw[2 * 5632 + n], gb = cb[n];
    const float v0 = cw[2816 + n], v1 = cw[5632 + 2816 + n], v2 = cw[2 * 5632 + 2816 + n], vb = cb[2816 + n];
    const int rs = 1 + rq * 32;
    int re = rs + 32; if (re > 127) re = 127;
    float gp = CS(rs - 1, c), gc = CS(rs, c), vp = CS(rs - 1, c + 64), vc = CS(rs, c + 64);
    for (int r = rs; r < re; ++r) {
      const float gn = CS(r + 1, c), vn = CS(r + 1, c + 64);
      const int t = tb + r;
      if (t < T) {
        const float g = g0 * gp + g1 * gc + g2 * gn + gb;
        const float v = v0 * vp + v1 * vc + v2 * vn + vb;
        const float a = g / (1.f + __expf(-g)) * v;
        ACT[(size_t)(rowbase + t) * DFF + n] = f2bf(a);
      }
      gp = gc; gc = gn; vp = vc; vc = vn;
    }
  }
}

__device__ void phase_rwkv_gemms(const Params& p, char* smem) {
  float* Cs = (float*)smem;
  const int tid = threadIdx.x;
  int g0, gend, gstep; work_range(7312, g0, gend, gstep);
  for (int tile = g0; tile < gend; tile += gstep) {
    int job, mt, nt;
    const u16* Bt;
    if (tile < 2048) { job = 0; band_decode(tile, 256, 8, mt, nt); Bt = p.rr_t; }
    else if (tile < 4160) { job = 1; band_decode(tile - 2048, 264, 8, mt, nt); Bt = p.rk_t; }
    else if (tile < 6272) { job = 2; band_decode(tile - 4160, 264, 8, mt, nt); Bt = p.rv_t; }
    else if (tile < 6536) { job = 3; mt = tile - 6272; nt = 0; Bt = p.w1_t; }
    else if (tile < 6800) { job = 4; mt = tile - 6536; nt = 0; Bt = p.a1_t; }
    else { job = 5; band_decode(tile - 6800, 256, 2, mt, nt); Bt = p.g1_t; }
    const int m0 = mt * 128;
    f32x16 acc[2][2];
    gemm_mainloop(smem, 2, 1024,
                  [&](int r, int part) { return (const u16*)((part ? p.XX : p.H) + (size_t)(m0 + r) * DM); },
                  [&](int c) { return Bt + (size_t)(nt * 128 + c) * 2048; }, acc);
    if (job == 0) {
      epi_direct(acc, [&](int r, int c, float v) { p.R16[(size_t)(m0 + r) * DM + nt * 128 + c] = (f16)v; });
    } else if (job == 2) {
      epi_direct(acc, [&](int r, int c, float v) { p.V16[(size_t)(m0 + r) * DM + nt * 128 + c] = (f16)v; });
    } else if (job == 3) {
      epi_direct(acc, [&](int r, int c, float v) { p.LW[(size_t)(m0 + r) * 128 + c] = f2bf(tanhf(v)); });
    } else if (job == 4) {
      epi_direct(acc, [&](int r, int c, float v) { p.LA[(size_t)(m0 + r) * 128 + c] = f2bf(v); });
    } else if (job == 5) {
      epi_direct(acc, [&](int r, int c, float v) {
        const int col = nt * 128 + c;
        if (col < 192) p.LG[(size_t)(m0 + r) * 192 + col] = col < 160 ? f2bf(sigmoidf_(v)) : (u16)0;
      });
    } else {
      acc_to_lds(Cs, acc);
      const int lane = tid & 63, wave = tid >> 6;
      const int col = nt * 128 + 2 * lane;
      const float kk0 = p.k_k[col], kk1 = p.k_k[col + 1];
#pragma unroll 4
      for (int rr = 0; rr < 32; ++rr) {
        const int r = wave * 32 + rr;
        const float2 v = *(const float2*)&CS(r, 2 * lane);
        const float a0 = v.x * kk0, a1 = v.y * kk1;
        float ss = a0 * a0 + a1 * a1;
        ss = sum32(ss);
        const float inv = 1.f / fmaxf(sqrtf(ss), 1e-12f);
        f16 k2[2], n2[2];
        k2[0] = (f16)v.x; k2[1] = (f16)v.y; n2[0] = (f16)(a0 * inv); n2[1] = (f16)(a1 * inv);
        *(unsigned*)(p.K16 + (size_t)(m0 + r) * DM + col) = *(const unsigned*)k2;
        *(unsigned*)(p.KK16 + (size_t)(m0 + r) * DM + col) = *(const unsigned*)n2;
      }
    }
  }
}

struct ScanLds {
  float dec[2][16][64], kd[2][16][64], nk[2][16][64], bb[2][16][64], rr[2][16][64];
  float vv[2][16][16];
  float yy[2][16][16];
  float bp[2][4][16];
};

template <int DIR, bool EMIT>
DI void scan_steps(const ScanLds& L, int bsel, int c0, int myrow, int l15, f32x2& Sa, f32x2& Sb, float& ykeep) {
  f32x4 d4[2], k4[2], n4[2], b4[2], r4[2];
  float vv[2];
  auto ld = [&](int slot, int s) {
    d4[slot] = *(const f32x4*)&L.dec[bsel][s][c0];
    k4[slot] = *(const f32x4*)&L.kd[bsel][s][c0];
    n4[slot] = *(const f32x4*)&L.nk[bsel][s][c0];
    b4[slot] = *(const f32x4*)&L.bb[bsel][s][c0];
    if (EMIT) r4[slot] = *(const f32x4*)&L.rr[bsel][s][c0];
    vv[slot] = L.vv[bsel][s][myrow];
  };
  ld(0, DIR ? 15 : 0);
#pragma unroll
  for (int ss = 0; ss < 16; ++ss) {
    const int s = DIR ? 15 - ss : ss;
    const int cur = ss & 1;
    if (ss + 1 < 16) ld(cur ^ 1, DIR ? 14 - ss : ss + 1);
    const f32x2 nlo = {n4[cur][0], n4[cur][1]}, nhi = {n4[cur][2], n4[cur][3]};
    const f32x2 dlo = {d4[cur][0], d4[cur][1]}, dhi = {d4[cur][2], d4[cur][3]};
    const f32x2 klo = {k4[cur][0], k4[cur][1]}, khi = {k4[cur][2], k4[cur][3]};
    const f32x2 blo = {b4[cur][0], b4[cur][1]}, bhi = {b4[cur][2], b4[cur][3]};
    f32x2 t = Sa * nlo + Sb * nhi;
    float sa = dpp_sum16(t[0] + t[1]);
    const f32x2 sa2 = {sa, sa}, v2 = {vv[cur], vv[cur]};
    Sa = Sa * dlo + (sa2 * blo + v2 * klo);
    Sb = Sb * dhi + (sa2 * bhi + v2 * khi);
    if (EMIT) {
      const f32x2 rlo = {r4[cur][0], r4[cur][1]}, rhi = {r4[cur][2], r4[cur][3]};
      const f32x2 u = Sa * rlo + Sb * rhi;
      const float y = dpp_sum16(u[0] + u[1]);
      ykeep = (l15 == s) ? y : ykeep;
    }
  }
}

template <int DIR>
DI void scan_item(const Params& p, ScanLds& L, int b, int h, int q) {
  constexpr int dir = DIR;
  const int tid = threadIdx.x, lane = tid & 63, wave = tid >> 6;
  const int l15 = lane & 15, l4 = lane >> 4;
  const int colw = h * 64 + wave * 16 + l15;
  const int chd = wave * 16 + l15;
  bf16x8 w2f[2], a2f[2];
#pragma unroll
  for (int ks = 0; ks < 2; ++ks) {
    w2f[ks] = *(const bf16x8*)(p.w2_t + ((size_t)(dir * 1024 + colw) * 64 + ks * 32 + l4 * 8));
    a2f[ks] = *(const bf16x8*)(p.a2_t + ((size_t)(dir * 1024 + colw) * 64 + ks * 32 + l4 * 8));
  }
  const float w0c = p.dw0[dir * 1024 + colw], a0c = p.a0[dir * 1024 + colw], kac = p.k_a[colw], rkc = p.r_k[colw];
  f32x2 Sa = {0.f, 0.f}, Sb = {0.f, 0.f};
  const int myrow = wave * 4 + l4;
  const int c0 = l15 * 4;
  bf16x8 lwf[2], laf[2];
  f16 kv[4], kkv[4], rv[4];
  f16 vvr;
  auto chunk_rowbase = [&](int c, bool& isctx) -> int {
    if (c < 16) { isctx = true; const int cc = dir ? 15 - c : c; return TL + b * 256 + cc * 16; }
    isctx = false; const int cc = dir ? 511 - (c - 16) : (c - 16); return b * 8192 + cc * 16;
  };
  auto stage_load = [&](int c) {
    bool isctx; const int rb = chunk_rowbase(c, isctx);
#pragma unroll
    for (int ks = 0; ks < 2; ++ks) {
      lwf[ks] = *(const bf16x8*)(p.LW + ((size_t)(rb + l15) * 128 + dir * 64 + ks * 32 + l4 * 8));
      laf[ks] = *(const bf16x8*)(p.LA + ((size_t)(rb + l15) * 128 + dir * 64 + ks * 32 + l4 * 8));
    }
#pragma unroll
    for (int i = 0; i < 4; ++i) {
      const size_t off = (size_t)(rb + l4 * 4 + i) * DM + colw;
      kv[i] = p.K16[off]; kkv[i] = p.KK16[off];
      rv[i] = isctx ? (f16)0.f : p.R16[off];
    }
    vvr = p.V16[(size_t)(rb + (tid >> 4)) * DM + h * 64 + q * 16 + (tid & 15)];
  };
  auto stage_compute = [&](int c) {
    const int bsel = c & 1;
    f32x4 wacc = {0.f, 0.f, 0.f, 0.f}, aacc = {0.f, 0.f, 0.f, 0.f};
    wacc = __builtin_amdgcn_mfma_f32_16x16x32_bf16(lwf[0], w2f[0], wacc, 0, 0, 0);
    wacc = __builtin_amdgcn_mfma_f32_16x16x32_bf16(lwf[1], w2f[1], wacc, 0, 0, 0);
    aacc = __builtin_amdgcn_mfma_f32_16x16x32_bf16(laf[0], a2f[0], aacc, 0, 0, 0);
    aacc = __builtin_amdgcn_mfma_f32_16x16x32_bf16(laf[1], a2f[1], aacc, 0, 0, 0);
    float bpart[4];
#pragma unroll
    for (int i = 0; i < 4; ++i) {
      const int s = l4 * 4 + i;
      const float sg = sigmoid_fast(w0c + wacc[i]);
      const float dec = __expf(-0.6065306597126334f * sg);
      const float a = sigmoid_fast(a0c + aacc[i]);
      const float k = (float)kv[i], kk = (float)kkv[i], r = (float)rv[i];
      const float kd = k * (1.f + (a - 1.f) * kac);
      L.dec[bsel][s][chd] = dec;
      L.kd[bsel][s][chd] = kd;
      L.nk[bsel][s][chd] = -kk;
      L.bb[bsel][s][chd] = kk * a;
      L.rr[bsel][s][chd] = r;
      bpart[i] = dpp_sum16(r * kd * rkc);
    }
    if (l15 == 0) {
#pragma unroll
      for (int i = 0; i < 4; ++i) L.bp[bsel][wave][l4 * 4 + i] = bpart[i];
    }
    L.vv[bsel][tid >> 4][tid & 15] = (float)vvr;
  };
  auto write_bonus = [&](int c) {
    if (q == 0 && tid < 16) {
      bool isctx; const int rb = chunk_rowbase(c, isctx);
      const int b2 = c & 1;
      p.bonus[((size_t)dir * MR + rb + tid) * 16 + h] = L.bp[b2][0][tid] + L.bp[b2][1][tid] + L.bp[b2][2][tid] + L.bp[b2][3][tid];
    }
  };
  __syncthreads();
  stage_load(0);
  stage_compute(0);
  __syncthreads();
  write_bonus(0);
  const int NCH = 528;
  float ykeep = 0.f;
#pragma unroll 1
  for (int c = 0; c < 16; ++c) {
    stage_load(c + 1);
    scan_steps<DIR, false>(L, c & 1, c0, myrow, l15, Sa, Sb, ykeep);
    stage_compute(c + 1);
    __syncthreads();
    write_bonus(c + 1);
  }
#pragma unroll 1
  for (int c = 16; c < NCH; ++c) {
    const int bsel = c & 1;
    if (c + 1 < NCH) stage_load(c + 1);
    scan_steps<DIR, true>(L, bsel, c0, myrow, l15, Sa, Sb, ykeep);
    L.yy[bsel][l15][myrow] = ykeep;
    if (c + 1 < NCH) stage_compute(c + 1);
    __syncthreads();
    {
      bool isctx; const int rb = chunk_rowbase(c, isctx);
      f16* Y = dir ? p.Y1 : p.Y0;
      Y[(size_t)(rb + (tid >> 4)) * DM + h * 64 + q * 16 + (tid & 15)] = (f16)(L.yy[bsel][tid >> 4][tid & 15] * 0.0625f);
    }
    if (c + 1 < NCH) write_bonus(c + 1);
  }
}

__device__ void phase_scan(const Params& p, char* smem) {
  ScanLds& L = *(ScanLds*)smem;
  for (int item = blockIdx.x; item < 512; item += gridDim.x) {
    int sc, q;
    if (gridDim.x == 512) { const int xcd = item & 7, slot = item >> 3; sc = xcd * 16 + (slot >> 2); q = slot & 3; }
    else { sc = item >> 2; q = item & 3; }
    const int dir = sc & 1, bh = sc >> 1, b = bh >> 4, h = bh & 15;
    if (dir) scan_item<1>(p, L, b, h, q); else scan_item<0>(p, L, b, h, q);
  }
}

__device__ void phase_readout(const Params& p, char* smem) {
  float* Cs = (float*)smem;
  const int tid = threadIdx.x;
  int g0, gend, gstep; work_range(256 * 8, g0, gend, gstep);
  for (int tile = g0; tile < gend; tile += gstep) {
    int mt, nt; band_decode(tile, 256, 8, mt, nt);
    const int m0 = mt * 128;
    f32x16 acc[2][2];
    gemm_mainloop(smem, 1, 192,
                  [&](int r, int) { return (const u16*)(p.LG + (size_t)(m0 + r) * 192); },
                  [&](int c) { return (const u16*)(p.g2_t + (size_t)(nt * 128 + c) * 192); }, acc);
    acc_to_lds(Cs, acc);
    const int lane = tid & 63, wave = tid >> 6;
    const int head = nt * 2 + (lane >> 5);
    const int col = nt * 128 + 2 * lane;
    const float gw0 = p.gn_w[col], gw1 = p.gn_w[col + 1], gb0 = p.gn_b[col], gb1 = p.gn_b[col + 1];
#pragma unroll 2
    for (int rr = 0; rr < 32; ++rr) {
      const int r = wave * 32 + rr;
      const int row = m0 + r;
      const unsigned ua = *(const unsigned*)(p.Y0 + (size_t)row * DM + col), ub = *(const unsigned*)(p.Y1 + (size_t)row * DM + col);
      const unsigned uv = *(const unsigned*)(p.V16 + (size_t)row * DM + col);
      const f16* fa = (const f16*)&ua; const f16* fb = (const f16*)&ub; const f16* fv = (const f16*)&uv;
      const float y0 = ((float)fa[0] + (float)fb[0]) * 16.f, y1 = ((float)fa[1] + (float)fb[1]) * 16.f;
      float sm = y0 + y1;
      sm = sum32(sm);
      const float mean = sm * (1.f / 64.f);
      const float d0 = y0 - mean, d1 = y1 - mean;
      float vs = d0 * d0 + d1 * d1;
      vs = sum32(vs);
      const float rstd = rsqrtf(vs * (1.f / 64.f) + 64e-5f);
      const float bon = p.bonus[((size_t)0 * MR + row) * 16 + head] + p.bonus[((size_t)1 * MR + row) * 16 + head];
      const float2 g = *(const float2*)&CS(r, 2 * lane);
      const float z0 = (d0 * rstd * gw0 + gb0 + bon * (float)fv[0]) * g.x;
      const float z1 = (d1 * rstd * gw1 + gb1 + bon * (float)fv[1]) * g.y;
      *(unsigned*)(p.Z + (size_t)row * DM + col) = pack2(z0, z1);
    }
  }
}

__device__ void phase_final(const Params& p) {
  const int lane = threadIdx.x & 63;
  const int gw = blockIdx.x * 4 + (threadIdx.x >> 6), nw = gridDim.x * 4;
  for (int row = gw; row < TL; row += nw) {
    float* src = p.out + (size_t)row * DM;
    float4 v[4];
    float ss = 0.f;
#pragma unroll
    for (int i = 0; i < 4; ++i) {
      v[i] = *(const float4*)(src + i * 256 + lane * 4);
      ss += v[i].x * v[i].x + v[i].y * v[i].y + v[i].z * v[i].z + v[i].w * v[i].w;
    }
    ss = wave_sum(ss);
    const float rinv = rsqrtf(ss * (1.f / 1024.f) + 1e-6f);
#pragma unroll
    for (int i = 0; i < 4; ++i) {
      const float4 g = *(const float4*)(p.final_gain + i * 256 + lane * 4);
      float4 o;
      o.x = v[i].x * rinv * g.x; o.y = v[i].y * rinv * g.y; o.z = v[i].z * rinv * g.z; o.w = v[i].w * rinv * g.w;
      *(float4*)(src + i * 256 + lane * 4) = o;
    }
  }
}

__global__ void __launch_bounds__(256, 2) mega(Params p) {
  __shared__ __attribute__((aligned(16))) char smem[65536];
  cg::grid_group grid = cg::this_grid();
  phase_prep(p, smem); grid.sync();
  phase_modreduce(p); grid.sync();
  phase_modulate<true>(p, 0, 0, MR); grid.sync();
  phase_qkv(p, smem); grid.sync();
  phase_attn(p, smem); grid.sync();
  phase_proj_res<true>(p, smem, p.H, 1024, 1024, p.wo_t, 0, 2, 264); grid.sync();
  phase_modulate<false>(p, 0, 1, MR); grid.sync();
  phase_ffn_up(p, smem, 0, true, p.ACT0); grid.sync();
  phase_proj_res<false>(p, smem, p.ACT0, DFF, DFF, p.down_t, 0, 5, 264); grid.sync();
  phase_rwkv_shift(p); grid.sync();
  phase_rwkv_gemms(p, smem); grid.sync();
  phase_scan(p, smem); grid.sync();
  phase_readout(p, smem); grid.sync();
  phase_proj_res<false>(p, smem, p.Z, 1024, 1024, p.ro_t, 1, 2, 256); grid.sync();
  phase_modulate<false>(p, 1, 1, TL); grid.sync();
  phase_ffn_up(p, smem, 1, false, p.ACT1); grid.sync();
  phase_proj_res<false>(p, smem, p.ACT1, DFF, DFF, p.down_t + (size_t)1024 * 2816, 1, 5, 256); grid.sync();
  phase_final(p);
}

extern "C" void kernel_launch(void* const* d_in, const int* in_sizes, int n_in, void* d_out, int out_size, void* d_ws, size_t ws_size,
                              hipStream_t stream) {
  static int grid_blocks = 0;
  if (!grid_blocks) {
    int dev = 0, cus = 0, per_cu = 0;
    hipGetDevice(&dev);
    hipDeviceGetAttribute(&cus, hipDeviceAttributeMultiprocessorCount, dev);
    hipOccupancyMaxActiveBlocksPerMultiprocessor(&per_cu, mega, 256, 0);
    if (per_cu > 2) per_cu = 2;
    if (per_cu < 1) per_cu = 1;
    grid_blocks = cus * per_cu;
  }
  Params p{};
  const float* const* in = (const float* const*)d_in;
  p.x = in[0]; p.c = in[1]; p.ctx = in[2]; p.c_ctx = in[3]; p.ada_w = in[4]; p.ada_b = in[5]; p.w_qkv = in[6]; p.q_gain = in[7];
  p.k_gain = in[8]; p.w_o = in[9]; p.mu = in[10]; p.rw_r = in[11]; p.rw_k = in[12]; p.rw_v = in[13]; p.rw_o = in[14]; p.dw0 = in[15];
  p.dw1 = in[16]; p.dw2 = in[17]; p.a0 = in[18]; p.a1 = in[19]; p.a2 = in[20]; p.g1 = in[21]; p.g2 = in[22]; p.k_k = in[23];
  p.k_a = in[24]; p.r_k = in[25]; p.gn_w = in[26]; p.gn_b = in[27]; p.f_up = in[28]; p.f_cw = in[29]; p.f_cb = in[30];
  p.f_down = in[31]; p.final_gain = in[32];
  p.out = (float*)d_out;
  char* w = (char*)d_ws;
  size_t off = 0;
  auto take = [&](size_t bytes) { char* r = w + off; off += (bytes + 255) & ~(size_t)255; return r; };
  p.qkv_t = (u16*)take((size_t)1536 * 1024 * 2);
  p.wo_t = (u16*)take((size_t)1024 * 1024 * 2);
  p.up_t = (u16*)take((size_t)2 * 5632 * 1024 * 2);
  p.down_t = (u16*)take((size_t)2 * 1024 * 2816 * 2);
  p.rr_t = (u16*)take((size_t)1024 * 2048 * 2);
  p.rk_t = (u16*)take((size_t)1024 * 2048 * 2);
  p.rv_t = (u16*)take((size_t)1024 * 2048 * 2);
  p.ro_t = (u16*)take((size_t)1024 * 1024 * 2);
  p.w1_t = (u16*)take((size_t)128 * 2048 * 2);
  p.a1_t = (u16*)take((size_t)128 * 2048 * 2);
  p.g1_t = (u16*)take((size_t)256 * 2048 * 2);
  p.w2_t = (u16*)take((size_t)2 * 1024 * 64 * 2);
  p.a2_t = (u16*)take((size_t)2 * 1024 * 64 * 2);
  p.g2_t = (u16*)take((size_t)1024 * 192 * 2);
  p.modpart = (float*)take((size_t)2 * 8 * 5 * 6144 * 4);
  p.modv = (float*)take((size_t)2 * 5 * 6144 * 4);
  p.rope = (float*)take((size_t)8192 * 32 * 2 * 4);
  p.XC = (float*)take((size_t)TCX * DM * 4);
  p.bonus = (float*)take((size_t)2 * MR * 16 * 4);
  p.zero = (u16*)take(8192);
  const size_t pb = off;
  p.H = (u16*)take((size_t)MR * DM * 2);
  const size_t after_h = off;
  p.Q = (u16*)take((size_t)TL * DM * 2);
  p.QC = (u16*)take((size_t)TCX * DM * 2);
  p.Kb = (u16*)take((size_t)16 * NKEY * 64 * 2);
  p.Vt = (u16*)take((size_t)16 * NKEY * 64 * 2);
  p.ACT0 = (u16*)take((size_t)MR * DFF * 2);
  const size_t end0 = off;
  off = after_h;
  p.XX = (u16*)take((size_t)MR * DM * 2);
  p.R16 = (f16*)take((size_t)TL * DM * 2);
  p.K16 = (f16*)take((size_t)MR * DM * 2);
  p.V16 = (f16*)take((size_t)MR * DM * 2);
  p.KK16 = (f16*)take((size_t)MR * DM * 2);
  p.LW = (u16*)take((size_t)MR * 128 * 2);
  p.LA = (u16*)take((size_t)MR * 128 * 2);
  p.LG = (u16*)take((size_t)TL * 192 * 2);
  const size_t end1 = off;
  p.Y0 = (f16*)p.H;
  p.Y1 = (f16*)p.XX;
  p.Z = (u16*)p.R16;
  p.ACT1 = (u16*)p.K16;
  (void)pb;
  const size_t need = end0 > end1 ? end0 : end1;
  if (need > ws_size) { fprintf(stderr, "workspace too small: need %zu have %zu\n", need, ws_size); return; }
  void* args[] = {&p};
  hipError_t e = hipLaunchCooperativeKernel((void*)mega, dim3(grid_blocks), dim3(256), args, 0, stream);
  if (e != hipSuccess) fprintf(stderr, "cooperative launch failed: %s (grid %d)\n", hipGetErrorString(e), grid_blocks);
}
```

```cpp
#include <hip/hip_runtime.h>
#include <hip/hip_cooperative_groups.h>
#include <cstdio>
#include <cstdint>
namespace cg = cooperative_groups;

typedef unsigned short u16;
typedef _Float16 f16;
using bf16x8 = __attribute__((ext_vector_type(8))) short;
using f32x16 = __attribute__((ext_vector_type(16))) float;
using f32x4 = __attribute__((ext_vector_type(4))) float;
using u32x4 = __attribute__((ext_vector_type(4))) unsigned;
#define DI __device__ __forceinline__
DI u32x4 mk4(unsigned a, unsigned b, unsigned c, unsigned d) { u32x4 r; r[0] = a; r[1] = b; r[2] = c; r[3] = d; return r; }

constexpr int TL = 32768;
constexpr int TCX = 1024;
constexpr int MR = 33792;
constexpr int DM = 1024;
constexpr int DFF = 2816;
constexpr int NKEY = 8448;
constexpr int NPHASE = 18;

struct Params {
  const float *x, *c, *ctx, *c_ctx, *ada_w, *ada_b, *w_qkv, *q_gain, *k_gain, *w_o;
  const float *mu, *rw_r, *rw_k, *rw_v, *rw_o, *dw0, *dw1, *dw2, *a0, *a1, *a2, *g1, *g2, *k_k, *k_a, *r_k, *gn_w, *gn_b;
  const float *f_up, *f_cw, *f_cb, *f_down, *final_gain;
  float* out;
  u16 *qkv_t, *wo_t, *up_t, *down_t, *rr_t, *rk_t, *rv_t, *ro_t, *w1_t, *a1_t, *g1_t, *w2_t, *a2_t, *g2_t;
  float *modpart, *modv, *rope, *XC, *bonus;
  u16* zero;
  u16 *H, *XX, *Q, *QC, *Kb, *Vt, *ACT0, *ACT1;
  f16 *R16, *K16, *V16, *KK16, *Y0, *Y1;
  u16 *LW, *LA, *LG, *Z;
  int phase_lo, phase_hi;
};

typedef __bf16 bf16x2_t __attribute__((ext_vector_type(2)));
typedef float f32x2 __attribute__((ext_vector_type(2)));
DI unsigned pack2(float a, float b) { f32x2 f = {a, b}; return __builtin_bit_cast(unsigned, __builtin_convertvector(f, bf16x2_t)); }
DI u16 f2bf(float x) { return (u16)(pack2(x, 0.f) & 0xffffu); }
DI float bf2f(u16 h) { return __uint_as_float(((unsigned)h) << 16); }
DI float wave_sum(float v) {
#pragma unroll
  for (int o = 32; o > 0; o >>= 1) v += __shfl_xor(v, o, 64);
  return v;
}
template <int CTRL> DI float dpp_mov(float v) { return __builtin_bit_cast(float, __builtin_amdgcn_update_dpp(0, __builtin_bit_cast(int, v), CTRL, 0xF, 0xF, false)); }
DI float dpp_sum16(float v) {
  v += dpp_mov<0x128>(v);
  v += dpp_mov<0x124>(v);
  v += dpp_mov<0x122>(v);
  v += dpp_mov<0x121>(v);
  return v;
}
DI float sum32(float v) { v = dpp_sum16(v); v += __shfl_xor(v, 16, 64); return v; }
DI float sigmoidf_(float x) { return 1.f / (1.f + __expf(-x)); }
DI float sigmoid_fast(float x) { return __builtin_amdgcn_rcpf(1.f + __expf(-x)); }
DI int midx_of(int row) { return row < TL ? (row >> 13) : 4; }
DI float* resid_ptr(const Params& p, int row) { return row < TL ? p.out + (size_t)row * DM : p.XC + (size_t)(row - TL) * DM; }
DI const float* xin_ptr(const Params& p, int row) { return row < TL ? p.x + (size_t)row * DM : p.ctx + (size_t)(row - TL) * DM; }

DI void work_range(int total, int& g0, int& gend, int& step) {
  if ((gridDim.x & 7) == 0) {
    const int x = blockIdx.x & 7, li = blockIdx.x >> 3, nl = gridDim.x >> 3;
    const int lo = (int)(((long long)total * x) >> 3), hi = (int)(((long long)total * (x + 1)) >> 3);
    g0 = lo + li; gend = hi; step = nl;
  } else { g0 = blockIdx.x; gend = total; step = gridDim.x; }
}
DI void band_decode(int g, int MT, int NT, int& mt, int& nt) {
  const int per = 8 * NT;
  const int band = g / per, r = g - band * per;
  int hb = MT - band * 8; if (hb > 8) hb = 8;
  nt = r / hb; mt = band * 8 + (r - nt * hb);
}

template <class AF, class BF>
DI void gemm_mainloop(char* smem, int nparts, int kpart, AF arow, BF brow, f32x16 (&acc)[2][2]) {
  const int tid = threadIdx.x, lane = tid & 63, wave = tid >> 6;
  const int wm = wave >> 1, wn = wave & 1;
  const int lr = tid >> 3, lc = tid & 7;
#pragma unroll
  for (int i = 0; i < 2; ++i)
#pragma unroll
    for (int j = 0; j < 2; ++j)
#pragma unroll
      for (int e = 0; e < 16; ++e) acc[i][j][e] = 0.f;
  const int csrc = (lc ^ ((lr >> 1) & 7)) * 8;
  const u16* bp[4];
  const u16* ap[4];
#pragma unroll
  for (int q = 0; q < 4; ++q) { bp[q] = brow(lr + 32 * q) + csrc; ap[q] = arow(lr + 32 * q, 0) + csrc; }
  const int nk = kpart >> 6;
  const int total = nparts * nk;
  const int sw = (lane >> 1) & 7;
  const int hsel = lane >> 5;
  char* const wbase = smem + wave * 1024;
  auto stage = [&](int buf, int kk, int boff) {
#pragma unroll
    for (int q = 0; q < 4; ++q) {
      __builtin_amdgcn_global_load_lds((const unsigned*)(ap[q] + kk), (unsigned*)(wbase + buf * 32768 + q * 4096), 16, 0, 0);
      __builtin_amdgcn_global_load_lds((const unsigned*)(bp[q] + boff), (unsigned*)(wbase + buf * 32768 + 16384 + q * 4096), 16, 0, 0);
    }
  };
  __syncthreads();
  stage(0, 0, 0);
  asm volatile("s_waitcnt vmcnt(0)" ::: "memory");
  __syncthreads();
  int part = 0, kk = 0, buf = 0;
#pragma unroll 1
  for (int it = 0; it < total; ++it) {
    kk += 64;
    if (kk == kpart) {
      kk = 0; ++part;
      if (part < nparts) {
#pragma unroll
        for (int q = 0; q < 4; ++q) ap[q] = arow(lr + 32 * q, part) + csrc;
      }
    }
    if (it + 1 < total) stage(buf ^ 1, kk, part * kpart + kk);
    const u16* As = (const u16*)(smem + buf * 32768);
    const u16* Bs = As + 128 * 64;
#pragma unroll
    for (int ks = 0; ks < 4; ++ks) {
      const int pc = ((ks * 2 + hsel) ^ sw) * 8;
      bf16x8 af[2], bf[2];
#pragma unroll
      for (int i = 0; i < 2; ++i) {
        af[i] = *(const bf16x8*)(As + (wm * 64 + i * 32 + (lane & 31)) * 64 + pc);
        bf[i] = *(const bf16x8*)(Bs + (wn * 64 + i * 32 + (lane & 31)) * 64 + pc);
      }
#pragma unroll
      for (int i = 0; i < 2; ++i)
#pragma unroll
        for (int j = 0; j < 2; ++j) acc[i][j] = __builtin_amdgcn_mfma_f32_32x32x16_bf16(af[i], bf[j], acc[i][j], 0, 0, 0);
    }
    asm volatile("s_waitcnt vmcnt(0)" ::: "memory");
    __syncthreads();
    buf ^= 1;
  }
}

template <class F>
DI void epi_direct(const f32x16 (&acc)[2][2], F f) {
  const int lane = threadIdx.x & 63, wave = threadIdx.x >> 6;
  const int wm = wave >> 1, wn = wave & 1, h = lane >> 5;
#pragma unroll
  for (int i = 0; i < 2; ++i)
#pragma unroll
    for (int j = 0; j < 2; ++j)
#pragma unroll
      for (int e = 0; e < 16; ++e) {
        const int row = wm * 64 + i * 32 + (e & 3) + 8 * (e >> 2) + 4 * h;
        const int col = wn * 64 + j * 32 + (lane & 31);
        f(row, col, acc[i][j][e]);
      }
}
#define CS(r, c) Cs[(r) * 128 + (c)]
DI void acc_to_lds(float* Cs, const f32x16 (&acc)[2][2]) {
  __syncthreads();
  epi_direct(acc, [&](int r, int c, float v) { CS(r, c) = v; });
  __syncthreads();
}

struct TJob { const float* src; int srcK, srcN; u16* dst; int ld, koff; const float* mu; int Kpad, Npad; };
DI TJob get_job(const Params& p, int j) {
  TJob t; t.mu = nullptr; t.koff = 0;
  auto set = [&](const float* s, int K, int N, u16* d, int ld) { t.src = s; t.srcK = K; t.srcN = N; t.dst = d; t.ld = ld; t.Kpad = K; t.Npad = N; };
  switch (j) {
    case 0: set(p.w_qkv, 1024, 1536, p.qkv_t, 1024); break;
    case 1: set(p.w_o, 1024, 1024, p.wo_t, 1024); break;
    case 2: set(p.f_up, 1024, 5632, p.up_t, 1024); break;
    case 3: set(p.f_up + (size_t)1024 * 5632, 1024, 5632, p.up_t + (size_t)5632 * 1024, 1024); break;
    case 4: set(p.f_down, 2816, 1024, p.down_t, 2816); break;
    case 5: set(p.f_down + (size_t)2816 * 1024, 2816, 1024, p.down_t + (size_t)1024 * 2816, 2816); break;
    case 6: set(p.rw_r, 1024, 1024, p.rr_t, 2048); break;
    case 7: set(p.rw_r, 1024, 1024, p.rr_t, 2048); t.mu = p.mu + 0 * 1024; t.koff = 1024; break;
    case 8: set(p.rw_k, 1024, 1024, p.rk_t, 2048); break;
    case 9: set(p.rw_k, 1024, 1024, p.rk_t, 2048); t.mu = p.mu + 2 * 1024; t.koff = 1024; break;
    case 10: set(p.rw_v, 1024, 1024, p.rv_t, 2048); break;
    case 11: set(p.rw_v, 1024, 1024, p.rv_t, 2048); t.mu = p.mu + 3 * 1024; t.koff = 1024; break;
    case 12: set(p.rw_o, 1024, 1024, p.ro_t, 1024); break;
    case 13: set(p.dw1, 1024, 64, p.w1_t, 2048); break;
    case 14: set(p.dw1, 1024, 64, p.w1_t, 2048); t.mu = p.mu + 1 * 1024; t.koff = 1024; break;
    case 15: set(p.dw1 + 1024 * 64, 1024, 64, p.w1_t + 64 * 2048, 2048); break;
    case 16: set(p.dw1 + 1024 * 64, 1024, 64, p.w1_t + 64 * 2048, 2048); t.mu = p.mu + 1 * 1024; t.koff = 1024; break;
    case 17: set(p.a1, 1024, 64, p.a1_t, 2048); break;
    case 18: set(p.a1, 1024, 64, p.a1_t, 2048); t.mu = p.mu + 4 * 1024; t.koff = 1024; break;
    case 19: set(p.a1 + 1024 * 64, 1024, 64, p.a1_t + 64 * 2048, 2048); break;
    case 20: set(p.a1 + 1024 * 64, 1024, 64, p.a1_t + 64 * 2048, 2048); t.mu = p.mu + 4 * 1024; t.koff = 1024; break;
    case 21: set(p.g1, 1024, 160, p.g1_t, 2048); t.Npad = 256; break;
    case 22: set(p.g1, 1024, 160, p.g1_t, 2048); t.Npad = 256; t.mu = p.mu + 5 * 1024; t.koff = 1024; break;
    case 23: set(p.dw2, 64, 1024, p.w2_t, 64); break;
    case 24: set(p.dw2 + 64 * 1024, 64, 1024, p.w2_t + 1024 * 64, 64); break;
    case 25: set(p.a2, 64, 1024, p.a2_t, 64); break;
    case 26: set(p.a2 + 64 * 1024, 64, 1024, p.a2_t + 1024 * 64, 64); break;
    default: set(p.g2, 160, 1024, p.g2_t, 192); t.Kpad = 192; break;
  }
  return t;
}
constexpr int NJOBS = 28;
DI int job_tiles(const TJob& t) { return ((t.Kpad + 63) >> 6) * ((t.Npad + 63) >> 6); }

__device__ void phase_prep(const Params& p, char* smem) {
  const int tid = threadIdx.x;
  int ttiles = 0;
  for (int j = 0; j < NJOBS; ++j) ttiles += job_tiles(get_job(p, j));
  const int n_mod = 2 * 24 * 8;
  const int n_rope = 1024;
  const int total = ttiles + n_mod + n_rope;
  float* tile = (float*)smem;
  if (blockIdx.x == 0) for (int e = tid; e < 4096; e += 256) p.zero[e] = 0;
  for (int item = blockIdx.x; item < total; item += gridDim.x) {
    if (item < ttiles) {
      int rem = item, j = 0;
      TJob t = get_job(p, 0);
      while (true) { int n = job_tiles(t); if (rem < n) break; rem -= n; ++j; t = get_job(p, j); }
      const int ntn = (t.Npad + 63) >> 6;
      const int kt = rem / ntn, nt = rem % ntn;
      __syncthreads();
#pragma unroll
      for (int i = 0; i < 16; ++i) {
        const int kl = i * 4 + (tid >> 6), nl = tid & 63;
        const int k = kt * 64 + kl, n = nt * 64 + nl;
        float v = 0.f;
        if (k < t.srcK && n < t.srcN) { v = t.src[(size_t)k * t.srcN + n]; if (t.mu) v *= t.mu[k]; }
        tile[kl * 65 + nl] = v;
      }
      __syncthreads();
#pragma unroll
      for (int i = 0; i < 16; ++i) {
        const int nl = i * 4 + (tid >> 6), kl = tid & 63;
        const int k = kt * 64 + kl, n = nt * 64 + nl;
        if (k < t.Kpad && n < t.Npad) t.dst[(size_t)n * t.ld + t.koff + k] = f2bf(tile[kl * 65 + nl]);
      }
    } else if (item < ttiles + n_mod) {
      const int it = item - ttiles;
      const int layer = it / 192, cc = (it % 192) / 8, kc = it % 8;
      float* sil = (float*)smem;
      __syncthreads();
      for (int e = tid; e < 640; e += 256) {
        const int j = e >> 7, k = kc * 128 + (e & 127);
        const float v = j < 4 ? p.c[j * 1024 + k] : p.c_ctx[k];
        sil[e] = v / (1.f + __expf(-v));
      }
      __syncthreads();
      const int col = cc * 256 + tid;
      float a0 = 0, a1 = 0, a2 = 0, a3 = 0, a4 = 0;
      const float* w = p.ada_w + ((size_t)layer * 1024 + kc * 128) * 6144 + col;
#pragma unroll 16
      for (int k = 0; k < 128; ++k) {
        const float wv = w[(size_t)k * 6144];
        a0 += sil[k] * wv; a1 += sil[128 + k] * wv; a2 += sil[256 + k] * wv; a3 += sil[384 + k] * wv; a4 += sil[512 + k] * wv;
      }
      float* mp = p.modpart + ((size_t)(layer * 8 + kc) * 5) * 6144 + col;
      mp[0] = a0; mp[6144] = a1; mp[2 * 6144] = a2; mp[3 * 6144] = a3; mp[4 * 6144] = a4;
    } else {
      const int e = (item - ttiles - n_mod) * 256 + tid;
      const int s = e >> 5, pr = e & 31;
      const int f = pr & 15;
      const float inv_freq = powf(10000.f, -(float)f / 16.f);
      const float pos = (pr < 16) ? (float)(s >> 6) : (float)(s & 63);
      const float ang = pos * inv_freq;
      float sn, cs;
      sincosf(ang, &sn, &cs);
      p.rope[e * 2] = cs; p.rope[e * 2 + 1] = sn;
    }
  }
}

__device__ void phase_modreduce(const Params& p) {
  const int n = 2 * 5 * 6144;
  for (int e = blockIdx.x * 256 + threadIdx.x; e < n; e += gridDim.x * 256) {
    const int layer = e / (5 * 6144), r = e % (5 * 6144), col = r % 6144;
    float s = p.ada_b[layer * 6144 + col];
    for (int kc = 0; kc < 8; ++kc) s += p.modpart[(size_t)(layer * 8 + kc) * 5 * 6144 + r];
    p.modv[e] = s;
  }
}

template <bool FROM_INPUT>
__device__ void phase_modulate(const Params& p, int layer, int which, int nrows) {
  const int lane = threadIdx.x & 63;
  const int gw = blockIdx.x * 4 + (threadIdx.x >> 6), nw = gridDim.x * 4;
  for (int row = gw; row < nrows; row += nw) {
    const float* src = FROM_INPUT ? xin_ptr(p, row) : resid_ptr(p, row);
    const float* mv = p.modv + ((size_t)layer * 5 + midx_of(row)) * 6144 + which * 3072;
    float4 v[4];
    float ss = 0.f;
#pragma unroll
    for (int i = 0; i < 4; ++i) {
      v[i] = *(const float4*)(src + i * 256 + lane * 4);
      ss += v[i].x * v[i].x + v[i].y * v[i].y + v[i].z * v[i].z + v[i].w * v[i].w;
    }
    ss = wave_sum(ss);
    const float rinv = rsqrtf(ss * (1.f / 1024.f) + 1e-6f);
#pragma unroll
    for (int i = 0; i < 4; ++i) {
      const int col = i * 256 + lane * 4;
      const float4 sh = *(const float4*)(mv + col);
      const float4 sc = *(const float4*)(mv + 1024 + col);
      uint2 o;
      o.x = pack2(v[i].x * rinv * (1.f + sc.x) + sh.x, v[i].y * rinv * (1.f + sc.y) + sh.y);
      o.y = pack2(v[i].z * rinv * (1.f + sc.z) + sh.z, v[i].w * rinv * (1.f + sc.w) + sh.w);
      *(uint2*)(p.H + (size_t)row * DM + col) = o;
    }
  }
}

DI void modrow(const Params& p, int row, bool valid, int lane, float (&h)[16]) {
  if (!valid) {
#pragma unroll
    for (int i = 0; i < 16; ++i) h[i] = 0.f;
    return;
  }
  const float* src = resid_ptr(p, row);
  const float* mv = p.modv + ((size_t)1 * 5 + midx_of(row)) * 6144;
  float ss = 0.f;
#pragma unroll
  for (int i = 0; i < 4; ++i) {
    const float4 v = *(const float4*)(src + i * 256 + lane * 4);
    h[i * 4 + 0] = v.x; h[i * 4 + 1] = v.y; h[i * 4 + 2] = v.z; h[i * 4 + 3] = v.w;
    ss += v.x * v.x + v.y * v.y + v.z * v.z + v.w * v.w;
  }
  ss = wave_sum(ss);
  const float rinv = rsqrtf(ss * (1.f / 1024.f) + 1e-6f);
#pragma unroll
  for (int i = 0; i < 4; ++i) {
    const int col = i * 256 + lane * 4;
    const float4 sh = *(const float4*)(mv + col);
    const float4 sc = *(const float4*)(mv + 1024 + col);
    h[i * 4 + 0] = h[i * 4 + 0] * rinv * (1.f + sc.x) + sh.x;
    h[i * 4 + 1] = h[i * 4 + 1] * rinv * (1.f + sc.y) + sh.y;
    h[i * 4 + 2] = h[i * 4 + 2] * rinv * (1.f + sc.z) + sh.z;
    h[i * 4 + 3] = h[i * 4 + 3] * rinv * (1.f + sc.w) + sh.w;
  }
}
__device__ void phase_rwkv_shift(const Params& p) {
  const int lane = threadIdx.x & 63;
  const int gw = blockIdx.x * 4 + (threadIdx.x >> 6), nw = gridDim.x * 4;
  const int nitems = MR / 8;
  for (int item = gw; item < nitems; item += nw) {
    const int r0 = item * 8;
    int sb, T;
    if (r0 < TL) { sb = r0 & ~8191; T = 8192; } else { sb = TL + ((r0 - TL) & ~255); T = 256; }
    float hm[16], hc[16], hn[16];
    modrow(p, r0 - 1, r0 - 1 >= sb, lane, hm);
    modrow(p, r0, true, lane, hc);
    for (int j = 0; j < 8; ++j) {
      const int row = r0 + j;
      modrow(p, row + 1, row + 1 < sb + T, lane, hn);
#pragma unroll
      for (int i = 0; i < 4; ++i) {
        const int col = i * 256 + lane * 4;
        float xx[4];
#pragma unroll
        for (int e = 0; e < 4; ++e) xx[e] = 0.5f * (hm[i * 4 + e] + hn[i * 4 + e]) - hc[i * 4 + e];
        uint2 o, o2;
        o.x = pack2(hc[i * 4 + 0], hc[i * 4 + 1]); o.y = pack2(hc[i * 4 + 2], hc[i * 4 + 3]);
        o2.x = pack2(xx[0], xx[1]); o2.y = pack2(xx[2], xx[3]);
        *(uint2*)(p.H + (size_t)row * DM + col) = o;
        *(uint2*)(p.XX + (size_t)row * DM + col) = o2;
      }
#pragma unroll
      for (int i = 0; i < 16; ++i) { hm[i] = hc[i]; hc[i] = hn[i]; }
    }
  }
}

__device__ void phase_qkv(const Params& p, char* smem) {
  float* Cs = (float*)smem;
  const int tid = threadIdx.x;
  int g0, gend, gstep; work_range(264 * 12, g0, gend, gstep);
  for (int tile = g0; tile < gend; tile += gstep) {
    int mt, nt; band_decode(tile, 264, 12, mt, nt);
    const int m0 = mt * 128;
    f32x16 acc[2][2];
    gemm_mainloop(smem, 1, 1024,
                  [&](int r, int) { return (const u16*)(p.H + (size_t)(m0 + r) * DM); },
                  [&](int c) { return (const u16*)(p.qkv_t + (size_t)(nt * 128 + c) * 1024); }, acc);
    acc_to_lds(Cs, acc);
    const bool isctx = m0 >= TL;
    const int b = isctx ? (m0 - TL) >> 8 : m0 >> 13;
    const int t0 = isctx ? (m0 - TL) & 255 : m0 & 8191;
    if (nt < 10) {
      const int lane = tid & 63, wave = tid >> 6;
      const int hh = lane >> 5, pr = lane & 31;
      const bool isq = nt < 8;
      const float* gain = isq ? p.q_gain : p.k_gain;
      const float qs = isq ? 0.125f * 1.4426950408889634f : 1.f;
      const float g0 = gain[2 * pr] * qs, g1 = gain[2 * pr + 1] * qs;
      u16* dstb;
      size_t tstride = 64;
      if (isq) {
        const int head = nt * 2 + hh;
        dstb = isctx ? p.QC + ((size_t)(b * 16 + head) * 256 + t0) * 64 : p.Q + ((size_t)(b * 16 + head) * 8192 + t0) * 64;
      } else {
        const int kh = (nt - 8) * 2 + hh;
        dstb = p.Kb + ((size_t)(b * 4 + kh) * NKEY + (isctx ? t0 : 256 + t0)) * 64;
      }
#pragma unroll 4
      for (int rr = 0; rr < 32; ++rr) {
        const int r = wave * 32 + rr;
        const float2 v = *(const float2*)&CS(r, 2 * lane);
        float ss = v.x * v.x + v.y * v.y;
        ss = sum32(ss);
        const float rinv = rsqrtf(ss * (1.f / 64.f) + 1e-6f);
        float x0 = v.x * rinv * g0, x1 = v.y * rinv * g1;
        if (!isctx) {
          const float2 cssn = *(const float2*)(p.rope + ((size_t)(t0 + r) * 32 + pr) * 2);
          const float y0 = x0 * cssn.x - x1 * cssn.y, y1 = x0 * cssn.y + x1 * cssn.x;
          x0 = y0; x1 = y1;
        }
        *(unsigned*)(dstb + (size_t)r * tstride + 2 * pr) = pack2(x0, x1);
      }
    } else {
      const int keybase = (isctx ? t0 : 256 + t0);
      for (int j = 0; j < 4; ++j) {
        const int item = tid + 256 * j;
        const int d = item & 63, hh = (item >> 6) & 1, rg = item >> 7;
        const int kh = (nt - 10) * 2 + hh;
        float v[16];
#pragma unroll
        for (int i = 0; i < 16; ++i) v[i] = CS(rg * 16 + i, hh * 64 + d);
        u16* dst = p.Vt + ((size_t)(b * 4 + kh) * 64 + d) * NKEY + keybase + rg * 16;
        *(u32x4*)(dst) = mk4(pack2(v[0], v[1]), pack2(v[2], v[3]), pack2(v[8], v[9]), pack2(v[10], v[11]));
        *(u32x4*)(dst + 8) = mk4(pack2(v[4], v[5]), pack2(v[6], v[7]), pack2(v[12], v[13]), pack2(v[14], v[15]));
      }
    }
  }
}

__device__ void phase_attn(const Params& p, char* smem) {
  u16* Ks = (u16*)smem;
  u16* Vs = Ks + 64 * 64;
  const int tid = threadIdx.x, lane = tid & 63, wave = tid >> 6;
  const int sw = (lane >> 1) & 7, hsel = lane >> 5;
  float mq = 0.f, mk = 0.f;
  for (int d = 0; d < 64; ++d) { mq = fmaxf(mq, fabsf(p.q_gain[d])); mk = fmaxf(mk, fabsf(p.k_gain[d])); }
  const float c0 = 0.125f * 1.4426950408889634f * 64.f * mq * mk * 1.02f + 0.5f;
  f32x16 negc;
#pragma unroll
  for (int i = 0; i < 16; ++i) negc[i] = -c0;
  int ga, gae, gs, gc, gce, gs2;
  work_range(4096, ga, gae, gs);
  work_range(128, gc, gce, gs2);
  const int n_lat = ga < gae ? (gae - ga + gs - 1) / gs : 0;
  const int n_ctx = gc < gce ? (gce - gc + gs2 - 1) / gs2 : 0;
  for (int wi = 0; wi < n_lat + n_ctx; ++wi) {
    const int item = wi < n_lat ? ga + wi * gs : 4096 + gc + (wi - n_lat) * gs2;
    int b, kvh, qb, nkt;
    const u16* qbase;
    size_t orow;
    const int head_g = wave;
    if (item < 4096) {
      b = item >> 10; kvh = (item >> 8) & 3; qb = item & 255; nkt = NKEY / 64;
      qbase = p.Q + ((size_t)(b * 16 + kvh * 4 + head_g) * 8192 + qb * 32) * 64;
      orow = (size_t)b * 8192 + qb * 32;
    } else {
      const int j = item - 4096;
      b = j >> 5; kvh = (j >> 3) & 3; qb = j & 7; nkt = 4;
      qbase = p.QC + ((size_t)(b * 16 + kvh * 4 + head_g) * 256 + qb * 32) * 64;
      orow = (size_t)TL + b * 256 + qb * 32;
    }
    const int head = kvh * 4 + head_g;
    bf16x8 qf[4];
#pragma unroll
    for (int ks = 0; ks < 4; ++ks) qf[ks] = *(const bf16x8*)(qbase + (lane & 31) * 64 + ks * 16 + hsel * 8);
    const u16* kg = p.Kb + (size_t)(b * 4 + kvh) * NKEY * 64;
    const u16* vg = p.Vt + (size_t)(b * 4 + kvh) * 64 * NKEY;
    f32x16 oacc[2];
#pragma unroll
    for (int i = 0; i < 16; ++i) { oacc[0][i] = 0.f; oacc[1][i] = 0.f; }
    f32x2 ls2 = {0.f, 0.f};
    u32x4 rk[2], rv[2];
#pragma unroll
    for (int q = 0; q < 2; ++q) {
      const int ch = tid + 256 * q;
      rk[q] = *(const u32x4*)(kg + (size_t)ch * 8);
      rv[q] = *(const u32x4*)(vg + (size_t)(ch >> 3) * NKEY + (ch & 7) * 8);
    }
    for (int kt = 0; kt < nkt; ++kt) {
      __syncthreads();
#pragma unroll
      for (int q = 0; q < 2; ++q) {
        const int ch = tid + 256 * q;
        const int row = ch >> 3, cc = ch & 7;
        const int pc = cc ^ ((row >> 1) & 7);
        *(u32x4*)(Ks + row * 64 + pc * 8) = rk[q];
        *(u32x4*)(Vs + row * 64 + pc * 8) = rv[q];
      }
      __syncthreads();
      if (kt + 1 < nkt) {
#pragma unroll
        for (int q = 0; q < 2; ++q) {
          const int ch = tid + 256 * q;
          rk[q] = *(const u32x4*)(kg + (size_t)(kt + 1) * 4096 + (size_t)ch * 8);
          rv[q] = *(const u32x4*)(vg + (size_t)(ch >> 3) * NKEY + (kt + 1) * 64 + (ch & 7) * 8);
        }
      }
      f32x16 sacc[2];
      bf16x8 kf[2][4];
#pragma unroll
      for (int kb = 0; kb < 2; ++kb)
#pragma unroll
        for (int ks = 0; ks < 4; ++ks) kf[kb][ks] = *(const bf16x8*)(Ks + (kb * 32 + (lane & 31)) * 64 + (((ks * 2 + hsel) ^ sw) * 8));
      __builtin_amdgcn_sched_barrier(0);
#pragma unroll
      for (int kb = 0; kb < 2; ++kb)
#pragma unroll
        for (int ks = 0; ks < 4; ++ks)
          sacc[kb] = __builtin_amdgcn_mfma_f32_32x32x16_bf16(kf[kb][ks], qf[ks], ks == 0 ? negc : sacc[kb], 0, 0, 0);
      bf16x8 vf[4][2];
#pragma unroll
      for (int c4 = 0; c4 < 4; ++c4)
#pragma unroll
        for (int db = 0; db < 2; ++db) vf[c4][db] = *(const bf16x8*)(Vs + (db * 32 + (lane & 31)) * 64 + (((2 * c4 + hsel) ^ sw) * 8));
#pragma unroll
      for (int kb = 0; kb < 2; ++kb)
#pragma unroll
        for (int i = 0; i < 16; i += 2) {
          const float e0 = __builtin_amdgcn_exp2f(sacc[kb][i]), e1 = __builtin_amdgcn_exp2f(sacc[kb][i + 1]);
          sacc[kb][i] = e0; sacc[kb][i + 1] = e1;
          const f32x2 e2 = {e0, e1};
          ls2 += e2;
        }
#pragma unroll
      for (int kb = 0; kb < 2; ++kb)
#pragma unroll
        for (int s2 = 0; s2 < 2; ++s2) {
          unsigned w[4];
#pragma unroll
          for (int e = 0; e < 4; ++e) w[e] = pack2(sacc[kb][8 * s2 + 2 * e], sacc[kb][8 * s2 + 2 * e + 1]);
          u32x4 pw = mk4(w[0], w[1], w[2], w[3]);
          const bf16x8 pf = __builtin_bit_cast(bf16x8, pw);
#pragma unroll
          for (int db = 0; db < 2; ++db) oacc[db] = __builtin_amdgcn_mfma_f32_32x32x16_bf16(vf[2 * kb + s2][db], pf, oacc[db], 0, 0, 0);
        }
    }
    const float lsum = ls2[0] + ls2[1];
    const float l = lsum + __shfl_xor(lsum, 32, 64);
    const float inv = 1.f / l;
    u16* od = p.H + (orow + (lane & 31)) * DM + head * 64;
#pragma unroll
    for (int db = 0; db < 2; ++db)
#pragma unroll
      for (int g = 0; g < 4; ++g) {
        uint2 o;
        o.x = pack2(oacc[db][g * 4 + 0] * inv, oacc[db][g * 4 + 1] * inv);
        o.y = pack2(oacc[db][g * 4 + 2] * inv, oacc[db][g * 4 + 3] * inv);
        *(uint2*)(od + db * 32 + 8 * g + 4 * hsel) = o;
      }
  }
}

template <bool FROM_INPUT>
__device__ void phase_proj_res(const Params& p, char* smem, const u16* A, int lda, int K, const u16* Bt, int layer, int gate_idx, int mtiles) {
  int g0, gend, gstep; work_range(mtiles * 8, g0, gend, gstep);
  for (int tile = g0; tile < gend; tile += gstep) {
    int mt, nt; band_decode(tile, mtiles, 8, mt, nt);
    const int m0 = mt * 128;
    f32x16 acc[2][2];
    gemm_mainloop(smem, 1, K,
                  [&](int r, int) { return A + (size_t)(m0 + r) * lda; },
                  [&](int c) { return Bt + (size_t)(nt * 128 + c) * K; }, acc);
    const float* gate = p.modv + ((size_t)layer * 5 + midx_of(m0)) * 6144 + gate_idx * 1024 + nt * 128;
    const float* sb = (FROM_INPUT ? xin_ptr(p, m0) : (const float*)resid_ptr(p, m0)) + nt * 128;
    float* db = resid_ptr(p, m0) + nt * 128;
    epi_direct(acc, [&](int r, int c, float v) { db[r * DM + c] = sb[r * DM + c] + gate[c] * v; });
  }
}

__device__ void phase_ffn_up(const Params& p, char* smem, int layer, bool with_ctx, u16* ACT) {
  float* Cs = (float*)smem;
  const int tid = threadIdx.x;
  const int mtiles = with_ctx ? 276 : 264;
  int g0, gend, gstep; work_range(mtiles * 44, g0, gend, gstep);
  const u16* up = p.up_t + (size_t)layer * 5632 * 1024;
  const float* cw = p.f_cw + (size_t)layer * 3 * 5632;
  const float* cb = p.f_cb + (size_t)layer * 5632;
  for (int tile = g0; tile < gend; tile += gstep) {
    int mt, nt; band_decode(tile, mtiles, 44, mt, nt);
    int rowbase, T, j;
    if (mt < 264) { rowbase = (mt / 66) * 8192; T = 8192; j = mt % 66; }
    else { const int m2 = mt - 264; rowbase = TL + (m2 / 3) * 256; T = 256; j = m2 % 3; }
    const int tb = j * 126 - 1;
    f32x16 acc[2][2];
    gemm_mainloop(smem, 1, 1024,
                  [&](int r, int) { const int t = tb + r; return (t >= 0 && t < T) ? (const u16*)(p.H + (size_t)(rowbase + t) * DM) : (const u16*)p.zero; },
                  [&](int c) { return up + (size_t)(c < 64 ? nt * 64 + c : 2816 + nt * 64 + (c - 64)) * 1024; }, acc);
    acc_to_lds(Cs, acc);
    const int c = tid & 63, rq = tid >> 6;
    const int n = nt * 64 + c;
    const float g0 = cw[n], g1 = cw[5632 + n], g2 = cw[2 * 5632 + n], gb = cb[n];
    const float v0 = cw[2816 + n], v1 = cw[5632 + 2816 + n], v2 = cw[2 * 5632 + 2816 + n], vb = cb[2816 + n];
    const int rs = 1 + rq * 32;
    int re = rs + 32; if (re > 127) re = 127;
    float gp = CS(rs - 1, c), gc = CS(rs, c), vp = CS(rs - 1, c + 64), vc = CS(rs, c + 64);
    for (int r = rs; r < re; ++r) {
      const float gn = CS(r + 1, c), vn = CS(r + 1, c + 64);
      const int t = tb + r;
      if (t < T) {
        const float g = g0 * gp + g1 * gc + g2 * gn + gb;
        const float v = v0 * vp + v1 * vc + v2 * vn + vb;
        const float a = g * __builtin_amdgcn_rcpf(1.f + __expf(-g)) * v;
        ACT[(size_t)(rowbase + t) * DFF + n] = f2bf(a);
      }
      gp = gc; gc = gn; vp = vc; vc = vn;
    }
  }
}

__device__ void phase_rwkv_gemms(const Params& p, char* smem) {
  float* Cs = (float*)smem;
  const int tid = threadIdx.x;
  int g0, gend, gstep; work_range(7312, g0, gend, gstep);
  for (int tile = g0; tile < gend; tile += gstep) {
    int job, mt, nt;
    const u16* Bt;
    if (tile < 2048) { job = 0; band_decode(tile, 256, 8, mt, nt); Bt = p.rr_t; }
    else if (tile < 4160) { job = 1; band_decode(tile - 2048, 264, 8, mt, nt); Bt = p.rk_t; }
    else if (tile < 6272) { job = 2; band_decode(tile - 4160, 264, 8, mt, nt); Bt = p.rv_t; }
    else if (tile < 6536) { job = 3; mt = tile - 6272; nt = 0; Bt = p.w1_t; }
    else if (tile < 6800) { job = 4; mt = tile - 6536; nt = 0; Bt = p.a1_t; }
    else { job = 5; band_decode(tile - 6800, 256, 2, mt, nt); Bt = p.g1_t; }
    const int m0 = mt * 128;
    f32x16 acc[2][2];
    gemm_mainloop(smem, 2, 1024,
                  [&](int r, int part) { return (const u16*)((part ? p.XX : p.H) + (size_t)(m0 + r) * DM); },
                  [&](int c) { return Bt + (size_t)(nt * 128 + c) * 2048; }, acc);
    if (job == 0) {
      epi_direct(acc, [&](int r, int c, float v) { p.R16[(size_t)(m0 + r) * DM + nt * 128 + c] = (f16)v; });
    } else if (job == 2) {
      epi_direct(acc, [&](int r, int c, float v) { p.V16[(size_t)(m0 + r) * DM + nt * 128 + c] = (f16)v; });
    } else if (job == 3) {
      epi_direct(acc, [&](int r, int c, float v) { p.LW[(size_t)(m0 + r) * 128 + c] = f2bf(tanhf(v)); });
    } else if (job == 4) {
      epi_direct(acc, [&](int r, int c, float v) { p.LA[(size_t)(m0 + r) * 128 + c] = f2bf(v); });
    } else if (job == 5) {
      epi_direct(acc, [&](int r, int c, float v) {
        const int col = nt * 128 + c;
        if (col < 192) p.LG[(size_t)(m0 + r) * 192 + col] = col < 160 ? f2bf(sigmoid_fast(v)) : (u16)0;
      });
    } else {
      acc_to_lds(Cs, acc);
      const int lane = tid & 63, wave = tid >> 6;
      const int col = nt * 128 + 2 * lane;
      const float kk0 = p.k_k[col], kk1 = p.k_k[col + 1];
#pragma unroll 4
      for (int rr = 0; rr < 32; ++rr) {
        const int r = wave * 32 + rr;
        const float2 v = *(const float2*)&CS(r, 2 * lane);
        const float a0 = v.x * kk0, a1 = v.y * kk1;
        float ss = a0 * a0 + a1 * a1;
        ss = sum32(ss);
        const float inv = 1.f / fmaxf(sqrtf(ss), 1e-12f);
        f16 k2[2], n2[2];
        k2[0] = (f16)v.x; k2[1] = (f16)v.y; n2[0] = (f16)(a0 * inv); n2[1] = (f16)(a1 * inv);
        *(unsigned*)(p.K16 + (size_t)(m0 + r) * DM + col) = *(const unsigned*)k2;
        *(unsigned*)(p.KK16 + (size_t)(m0 + r) * DM + col) = *(const unsigned*)n2;
      }
    }
  }
}

struct ScanLds {
  float dec[2][16][64], kd[2][16][64], nk[2][16][64], bb[2][16][64], rr[2][16][64];
  float vv[2][16][16];
  float yy[2][16][16];
  float bp[2][4][16];
};

template <int DIR, bool EMIT>
DI void scan_steps(const ScanLds& L, int bsel, int c0, int myrow, int l15, f32x2& Sa, f32x2& Sb, float& ykeep) {
  f32x4 d4[2], k4[2], n4[2], b4[2], r4[2];
  float vv[2];
  auto ld = [&](int slot, int s) {
    d4[slot] = *(const f32x4*)&L.dec[bsel][s][c0];
    k4[slot] = *(const f32x4*)&L.kd[bsel][s][c0];
    n4[slot] = *(const f32x4*)&L.nk[bsel][s][c0];
    b4[slot] = *(const f32x4*)&L.bb[bsel][s][c0];
    if (EMIT) r4[slot] = *(const f32x4*)&L.rr[bsel][s][c0];
    vv[slot] = L.vv[bsel][s][myrow];
  };
  ld(0, DIR ? 15 : 0);
#pragma unroll
  for (int ss = 0; ss < 16; ++ss) {
    const int s = DIR ? 15 - ss : ss;
    const int cur = ss & 1;
    if (ss + 1 < 16) ld(cur ^ 1, DIR ? 14 - ss : ss + 1);
    const f32x2 nlo = {n4[cur][0], n4[cur][1]}, nhi = {n4[cur][2], n4[cur][3]};
    const f32x2 dlo = {d4[cur][0], d4[cur][1]}, dhi = {d4[cur][2], d4[cur][3]};
    const f32x2 klo = {k4[cur][0], k4[cur][1]}, khi = {k4[cur][2], k4[cur][3]};
    const f32x2 blo = {b4[cur][0], b4[cur][1]}, bhi = {b4[cur][2], b4[cur][3]};
    f32x2 t = Sa * nlo + Sb * nhi;
    float sa = dpp_sum16(t[0] + t[1]);
    const f32x2 sa2 = {sa, sa}, v2 = {vv[cur], vv[cur]};
    Sa = Sa * dlo + (sa2 * blo + v2 * klo);
    Sb = Sb * dhi + (sa2 * bhi + v2 * khi);
    if (EMIT) {
      const f32x2 rlo = {r4[cur][0], r4[cur][1]}, rhi = {r4[cur][2], r4[cur][3]};
      const f32x2 u = Sa * rlo + Sb * rhi;
      const float y = dpp_sum16(u[0] + u[1]);
      ykeep = (l15 == s) ? y : ykeep;
    }
  }
}

template <int DIR>
DI void scan_item(const Params& p, ScanLds& L, int b, int h, int q) {
  constexpr int dir = DIR;
  const int tid = threadIdx.x, lane = tid & 63, wave = tid >> 6;
  const int l15 = lane & 15, l4 = lane >> 4;
  const int colw = h * 64 + wave * 16 + l15;
  const int chd = wave * 16 + l15;
  bf16x8 w2f[2], a2f[2];
#pragma unroll
  for (int ks = 0; ks < 2; ++ks) {
    w2f[ks] = *(const bf16x8*)(p.w2_t + ((size_t)(dir * 1024 + colw) * 64 + ks * 32 + l4 * 8));
    a2f[ks] = *(const bf16x8*)(p.a2_t + ((size_t)(dir * 1024 + colw) * 64 + ks * 32 + l4 * 8));
  }
  const float w0c = p.dw0[dir * 1024 + colw], a0c = p.a0[dir * 1024 + colw], kac = p.k_a[colw], rkc = p.r_k[colw];
  f32x2 Sa = {0.f, 0.f}, Sb = {0.f, 0.f};
  const int myrow = wave * 4 + l4;
  const int c0 = l15 * 4;
  bf16x8 lwf[2], laf[2];
  f16 kv[4], kkv[4], rv[4];
  f16 vvr;
  auto chunk_rowbase = [&](int c, bool& isctx) -> int {
    if (c < 16) { isctx = true; const int cc = dir ? 15 - c : c; return TL + b * 256 + cc * 16; }
    isctx = false; const int cc = dir ? 511 - (c - 16) : (c - 16); return b * 8192 + cc * 16;
  };
  auto stage_load = [&](int c) {
    bool isctx; const int rb = chunk_rowbase(c, isctx);
#pragma unroll
    for (int ks = 0; ks < 2; ++ks) {
      lwf[ks] = *(const bf16x8*)(p.LW + ((size_t)(rb + l15) * 128 + dir * 64 + ks * 32 + l4 * 8));
      laf[ks] = *(const bf16x8*)(p.LA + ((size_t)(rb + l15) * 128 + dir * 64 + ks * 32 + l4 * 8));
    }
#pragma unroll
    for (int i = 0; i < 4; ++i) {
      const size_t off = (size_t)(rb + l4 * 4 + i) * DM + colw;
      kv[i] = p.K16[off]; kkv[i] = p.KK16[off];
      rv[i] = isctx ? (f16)0.f : p.R16[off];
    }
    vvr = p.V16[(size_t)(rb + (tid >> 4)) * DM + h * 64 + q * 16 + (tid & 15)];
  };
  auto stage_compute = [&](int c) {
    const int bsel = c & 1;
    f32x4 wacc = {0.f, 0.f, 0.f, 0.f}, aacc = {0.f, 0.f, 0.f, 0.f};
    wacc = __builtin_amdgcn_mfma_f32_16x16x32_bf16(lwf[0], w2f[0], wacc, 0, 0, 0);
    wacc = __builtin_amdgcn_mfma_f32_16x16x32_bf16(lwf[1], w2f[1], wacc, 0, 0, 0);
    aacc = __builtin_amdgcn_mfma_f32_16x16x32_bf16(laf[0], a2f[0], aacc, 0, 0, 0);
    aacc = __builtin_amdgcn_mfma_f32_16x16x32_bf16(laf[1], a2f[1], aacc, 0, 0, 0);
    float bpart[4];
#pragma unroll
    for (int i = 0; i < 4; ++i) {
      const int s = l4 * 4 + i;
      const float sg = sigmoid_fast(w0c + wacc[i]);
      const float dec = __expf(-0.6065306597126334f * sg);
      const float a = sigmoid_fast(a0c + aacc[i]);
      const float k = (float)kv[i], kk = (float)kkv[i], r = (float)rv[i];
      const float kd = k * (1.f + (a - 1.f) * kac);
      L.dec[bsel][s][chd] = dec;
      L.kd[bsel][s][chd] = kd;
      L.nk[bsel][s][chd] = -kk;
      L.bb[bsel][s][chd] = kk * a;
      L.rr[bsel][s][chd] = r;
      if (q == 0) bpart[i] = dpp_sum16(r * kd * rkc);
    }
    if (q == 0 && l15 == 0) {
#pragma unroll
      for (int i = 0; i < 4; ++i) L.bp[bsel][wave][l4 * 4 + i] = bpart[i];
    }
    L.vv[bsel][tid >> 4][tid & 15] = (float)vvr;
  };
  auto write_bonus = [&](int c) {
    if (q == 0 && tid < 16) {
      bool isctx; const int rb = chunk_rowbase(c, isctx);
      const int b2 = c & 1;
      p.bonus[((size_t)dir * MR + rb + tid) * 16 + h] = L.bp[b2][0][tid] + L.bp[b2][1][tid] + L.bp[b2][2][tid] + L.bp[b2][3][tid];
    }
  };
  __syncthreads();
  stage_load(0);
  stage_compute(0);
  __syncthreads();
  write_bonus(0);
  const int NCH = 528;
  float ykeep = 0.f;
#pragma unroll 1
  for (int c = 0; c < 16; ++c) {
    stage_load(c + 1);
    scan_steps<DIR, false>(L, c & 1, c0, myrow, l15, Sa, Sb, ykeep);
    stage_compute(c + 1);
    __syncthreads();
    write_bonus(c + 1);
  }
#pragma unroll 1
  for (int c = 16; c < NCH; ++c) {
    const int bsel = c & 1;
    if (c + 1 < NCH) stage_load(c + 1);
    scan_steps<DIR, true>(L, bsel, c0, myrow, l15, Sa, Sb, ykeep);
    L.yy[bsel][l15][myrow] = ykeep;
    if (c + 1 < NCH) stage_compute(c + 1);
    __syncthreads();
    {
      bool isctx; const int rb = chunk_rowbase(c, isctx);
      f16* Y = dir ? p.Y1 : p.Y0;
      Y[(size_t)(rb + (tid >> 4)) * DM + h * 64 + q * 16 + (tid & 15)] = (f16)(L.yy[bsel][tid >> 4][tid & 15] * 0.0625f);
    }
    if (c + 1 < NCH) write_bonus(c + 1);
  }
}

__device__ void phase_scan(const Params& p, char* smem) {
  ScanLds& L = *(ScanLds*)smem;
  for (int item = blockIdx.x; item < 512; item += gridDim.x) {
    int sc, q;
    if (gridDim.x == 512) { const int xcd = item & 7, slot = item >> 3; sc = xcd * 16 + (slot >> 2); q = slot & 3; }
    else { sc = item >> 2; q = item & 3; }
    const int dir = sc & 1, bh = sc >> 1, b = bh >> 4, h = bh & 15;
    if (dir) scan_item<1>(p, L, b, h, q); else scan_item<0>(p, L, b, h, q);
  }
}

__device__ void phase_readout(const Params& p, char* smem) {
  float* Cs = (float*)smem;
  const int tid = threadIdx.x;
  int g0, gend, gstep; work_range(256 * 8, g0, gend, gstep);
  for (int tile = g0; tile < gend; tile += gstep) {
    int mt, nt; band_decode(tile, 256, 8, mt, nt);
    const int m0 = mt * 128;
    f32x16 acc[2][2];
    gemm_mainloop(smem, 1, 192,
                  [&](int r, int) { return (const u16*)(p.LG + (size_t)(m0 + r) * 192); },
                  [&](int c) { return (const u16*)(p.g2_t + (size_t)(nt * 128 + c) * 192); }, acc);
    acc_to_lds(Cs, acc);
    const int lane = tid & 63, wave = tid >> 6;
    const int head = nt * 2 + (lane >> 5);
    const int col = nt * 128 + 2 * lane;
    const float gw0 = p.gn_w[col], gw1 = p.gn_w[col + 1], gb0 = p.gn_b[col], gb1 = p.gn_b[col + 1];
#pragma unroll 2
    for (int rr = 0; rr < 32; ++rr) {
      const int r = wave * 32 + rr;
      const int row = m0 + r;
      const unsigned ua = *(const unsigned*)(p.Y0 + (size_t)row * DM + col), ub = *(const unsigned*)(p.Y1 + (size_t)row * DM + col);
      const unsigned uv = *(const unsigned*)(p.V16 + (size_t)row * DM + col);
      const f16* fa = (const f16*)&ua; const f16* fb = (const f16*)&ub; const f16* fv = (const f16*)&uv;
      const float y0 = ((float)fa[0] + (float)fb[0]) * 16.f, y1 = ((float)fa[1] + (float)fb[1]) * 16.f;
      float sm = y0 + y1;
      sm = sum32(sm);
      const float mean = sm * (1.f / 64.f);
      const float d0 = y0 - mean, d1 = y1 - mean;
      float vs = d0 * d0 + d1 * d1;
      vs = sum32(vs);
      const float rstd = rsqrtf(vs * (1.f / 64.f) + 64e-5f);
      const float bon = p.bonus[((size_t)0 * MR + row) * 16 + head] + p.bonus[((size_t)1 * MR + row) * 16 + head];
      const float2 g = *(const float2*)&CS(r, 2 * lane);
      const float z0 = (d0 * rstd * gw0 + gb0 + bon * (float)fv[0]) * g.x;
      const float z1 = (d1 * rstd * gw1 + gb1 + bon * (float)fv[1]) * g.y;
      *(unsigned*)(p.Z + (size_t)row * DM + col) = pack2(z0, z1);
    }
  }
}

__device__ void phase_final(const Params& p) {
  const int lane = threadIdx.x & 63;
  const int gw = blockIdx.x * 4 + (threadIdx.x >> 6), nw = gridDim.x * 4;
  for (int row = gw; row < TL; row += nw) {
    float* src = p.out + (size_t)row * DM;
    float4 v[4];
    float ss = 0.f;
#pragma unroll
    for (int i = 0; i < 4; ++i) {
      v[i] = *(const float4*)(src + i * 256 + lane * 4);
      ss += v[i].x * v[i].x + v[i].y * v[i].y + v[i].z * v[i].z + v[i].w * v[i].w;
    }
    ss = wave_sum(ss);
    const float rinv = rsqrtf(ss * (1.f / 1024.f) + 1e-6f);
#pragma unroll
    for (int i = 0; i < 4; ++i) {
      const float4 g = *(const float4*)(p.final_gain + i * 256 + lane * 4);
      float4 o;
      o.x = v[i].x * rinv * g.x; o.y = v[i].y * rinv * g.y; o.z = v[i].z * rinv * g.z; o.w = v[i].w * rinv * g.w;
      *(float4*)(src + i * 256 + lane * 4) = o;
    }
  }
}

__global__ void __launch_bounds__(256, 2) mega(Params p) {
  __shared__ __attribute__((aligned(16))) char smem[65536];
  cg::grid_group grid = cg::this_grid();
  phase_prep(p, smem); grid.sync();
  phase_modreduce(p); grid.sync();
  phase_modulate<true>(p, 0, 0, MR); grid.sync();
  phase_qkv(p, smem); grid.sync();
  phase_attn(p, smem); grid.sync();
  phase_proj_res<true>(p, smem, p.H, 1024, 1024, p.wo_t, 0, 2, 264); grid.sync();
  phase_modulate<false>(p, 0, 1, MR); grid.sync();
  phase_ffn_up(p, smem, 0, true, p.ACT0); grid.sync();
  phase_proj_res<false>(p, smem, p.ACT0, DFF, DFF, p.down_t, 0, 5, 264); grid.sync();
  phase_rwkv_shift(p); grid.sync();
  phase_rwkv_gemms(p, smem); grid.sync();
  phase_scan(p, smem); grid.sync();
  phase_readout(p, smem); grid.sync();
  phase_proj_res<false>(p, smem, p.Z, 1024, 1024, p.ro_t, 1, 2, 256); grid.sync();
  phase_modulate<false>(p, 1, 1, TL); grid.sync();
  phase_ffn_up(p, smem, 1, false, p.ACT1); grid.sync();
  phase_proj_res<false>(p, smem, p.ACT1, DFF, DFF, p.down_t + (size_t)1024 * 2816, 1, 5, 256); grid.sync();
  phase_final(p);
}

extern "C" void kernel_launch(void* const* d_in, const int* in_sizes, int n_in, void* d_out, int out_size, void* d_ws, size_t ws_size,
                              hipStream_t stream) {
  static int grid_blocks = 0;
  if (!grid_blocks) {
    int dev = 0, cus = 0, per_cu = 0;
    hipGetDevice(&dev);
    hipDeviceGetAttribute(&cus, hipDeviceAttributeMultiprocessorCount, dev);
    hipOccupancyMaxActiveBlocksPerMultiprocessor(&per_cu, mega, 256, 0);
    if (per_cu > 2) per_cu = 2;
    if (per_cu < 1) per_cu = 1;
    grid_blocks = cus * per_cu;
  }
  Params p{};
  const float* const* in = (const float* const*)d_in;
  p.x = in[0]; p.c = in[1]; p.ctx = in[2]; p.c_ctx = in[3]; p.ada_w = in[4]; p.ada_b = in[5]; p.w_qkv = in[6]; p.q_gain = in[7];
  p.k_gain = in[8]; p.w_o = in[9]; p.mu = in[10]; p.rw_r = in[11]; p.rw_k = in[12]; p.rw_v = in[13]; p.rw_o = in[14]; p.dw0 = in[15];
  p.dw1 = in[16]; p.dw2 = in[17]; p.a0 = in[18]; p.a1 = in[19]; p.a2 = in[20]; p.g1 = in[21]; p.g2 = in[22]; p.k_k = in[23];
  p.k_a = in[24]; p.r_k = in[25]; p.gn_w = in[26]; p.gn_b = in[27]; p.f_up = in[28]; p.f_cw = in[29]; p.f_cb = in[30];
  p.f_down = in[31]; p.final_gain = in[32];
  p.out = (float*)d_out;
  char* w = (char*)d_ws;
  size_t off = 0;
  auto take = [&](size_t bytes) { char* r = w + off; off += (bytes + 255) & ~(size_t)255; return r; };
  p.qkv_t = (u16*)take((size_t)1536 * 1024 * 2);
  p.wo_t = (u16*)take((size_t)1024 * 1024 * 2);
  p.up_t = (u16*)take((size_t)2 * 5632 * 1024 * 2);
  p.down_t = (u16*)take((size_t)2 * 1024 * 2816 * 2);
  p.rr_t = (u16*)take((size_t)1024 * 2048 * 2);
  p.rk_t = (u16*)take((size_t)1024 * 2048 * 2);
  p.rv_t = (u16*)take((size_t)1024 * 2048 * 2);
  p.ro_t = (u16*)take((size_t)1024 * 1024 * 2);
  p.w1_t = (u16*)take((size_t)128 * 2048 * 2);
  p.a1_t = (u16*)take((size_t)128 * 2048 * 2);
  p.g1_t = (u16*)take((size_t)256 * 2048 * 2);
  p.w2_t = (u16*)take((size_t)2 * 1024 * 64 * 2);
  p.a2_t = (u16*)take((size_t)2 * 1024 * 64 * 2);
  p.g2_t = (u16*)take((size_t)1024 * 192 * 2);
  p.modpart = (float*)take((size_t)2 * 8 * 5 * 6144 * 4);
  p.modv = (float*)take((size_t)2 * 5 * 6144 * 4);
  p.rope = (float*)take((size_t)8192 * 32 * 2 * 4);
  p.XC = (float*)take((size_t)TCX * DM * 4);
  p.bonus = (float*)take((size_t)2 * MR * 16 * 4);
  p.zero = (u16*)take(8192);
  const size_t pb = off;
  p.H = (u16*)take((size_t)MR * DM * 2);
  const size_t after_h = off;
  p.Q = (u16*)take((size_t)TL * DM * 2);
  p.QC = (u16*)take((size_t)TCX * DM * 2);
  p.Kb = (u16*)take((size_t)16 * NKEY * 64 * 2);
  p.Vt = (u16*)take((size_t)16 * NKEY * 64 * 2);
  p.ACT0 = (u16*)take((size_t)MR * DFF * 2);
  const size_t end0 = off;
  off = after_h;
  p.XX = (u16*)take((size_t)MR * DM * 2);
  p.R16 = (f16*)take((size_t)TL * DM * 2);
  p.K16 = (f16*)take((size_t)MR * DM * 2);
  p.V16 = (f16*)take((size_t)MR * DM * 2);
  p.KK16 = (f16*)take((size_t)MR * DM * 2);
  p.LW = (u16*)take((size_t)MR * 128 * 2);
  p.LA = (u16*)take((size_t)MR * 128 * 2);
  p.LG = (u16*)take((size_t)TL * 192 * 2);
  const size_t end1 = off;
  p.Y0 = (f16*)p.H;
  p.Y1 = (f16*)p.XX;
  p.Z = (u16*)p.R16;
  p.ACT1 = (u16*)p.K16;
  (void)pb;
  const size_t need = end0 > end1 ? end0 : end1;
  if (need > ws_size) { fprintf(stderr, "workspace too small: need %zu have %zu\n", need, ws_size); return; }
  void* args[] = {&p};
  hipError_t e = hipLaunchCooperativeKernel((void*)mega, dim3(grid_blocks), dim3(256), args, 0, stream);
  if (e != hipSuccess) fprintf(stderr, "cooperative launch failed: %s (grid %d)\n", hipGetErrorString(e), grid_blocks);
}
```

```cpp
#include <hip/hip_runtime.h>
#include <hip/hip_cooperative_groups.h>
#include <cstdio>
#include <cstdint>
namespace cg = cooperative_groups;

typedef unsigned short u16;
typedef _Float16 f16;
using bf16x8 = __attribute__((ext_vector_type(8))) short;
using f32x16 = __attribute__((ext_vector_type(16))) float;
using f32x4 = __attribute__((ext_vector_type(4))) float;
using u32x4 = __attribute__((ext_vector_type(4))) unsigned;
#define DI __device__ __forceinline__
DI u32x4 mk4(unsigned a, unsigned b, unsigned c, unsigned d) { u32x4 r; r[0] = a; r[1] = b; r[2] = c; r[3] = d; return r; }

constexpr int TL = 32768;
constexpr int TCX = 1024;
constexpr int MR = 33792;
constexpr int DM = 1024;
constexpr int DFF = 2816;
constexpr int NKEY = 8448;
constexpr int NPHASE = 18;

struct Params {
  const float *x, *c, *ctx, *c_ctx, *ada_w, *ada_b, *w_qkv, *q_gain, *k_gain, *w_o;
  const float *mu, *rw_r, *rw_k, *rw_v, *rw_o, *dw0, *dw1, *dw2, *a0, *a1, *a2, *g1, *g2, *k_k, *k_a, *r_k, *gn_w, *gn_b;
  const float *f_up, *f_cw, *f_cb, *f_down, *final_gain;
  float* out;
  u16 *qkv_t, *wo_t, *up_t, *down_t, *rr_t, *rk_t, *rv_t, *ro_t, *w1_t, *a1_t, *g1_t, *w2_t, *a2_t, *g2_t;
  float *modpart, *modv, *rope, *XC, *bonus;
  u16* zero;
  unsigned* bar;
  u16 *H, *XX, *Q, *QC, *Kb, *Vt, *ACT0, *ACT1;
  f16 *R16, *K16, *V16, *KK16, *Y0, *Y1;
  u16 *LW, *LA, *LG, *Z;
  int phase_lo, phase_hi;
};

typedef __bf16 bf16x2_t __attribute__((ext_vector_type(2)));
typedef float f32x2 __attribute__((ext_vector_type(2)));
DI unsigned pack2(float a, float b) { f32x2 f = {a, b}; return __builtin_bit_cast(unsigned, __builtin_convertvector(f, bf16x2_t)); }
DI u16 f2bf(float x) { return (u16)(pack2(x, 0.f) & 0xffffu); }
DI float bf2f(u16 h) { return __uint_as_float(((unsigned)h) << 16); }
DI float wave_sum(float v) {
#pragma unroll
  for (int o = 32; o > 0; o >>= 1) v += __shfl_xor(v, o, 64);
  return v;
}
template <int CTRL> DI float dpp_mov(float v) { return __builtin_bit_cast(float, __builtin_amdgcn_update_dpp(0, __builtin_bit_cast(int, v), CTRL, 0xF, 0xF, false)); }
DI float dpp_sum16(float v) {
  v += dpp_mov<0x128>(v);
  v += dpp_mov<0x124>(v);
  v += dpp_mov<0x122>(v);
  v += dpp_mov<0x121>(v);
  return v;
}
DI float sum32(float v) { v = dpp_sum16(v); v += __shfl_xor(v, 16, 64); return v; }
DI float sigmoidf_(float x) { return 1.f / (1.f + __expf(-x)); }
DI float sigmoid_fast(float x) { return __builtin_amdgcn_rcpf(1.f + __expf(-x)); }
DI int midx_of(int row) { return row < TL ? (row >> 13) : 4; }
DI float* resid_ptr(const Params& p, int row) { return row < TL ? p.out + (size_t)row * DM : p.XC + (size_t)(row - TL) * DM; }
DI const float* xin_ptr(const Params& p, int row) { return row < TL ? p.x + (size_t)row * DM : p.ctx + (size_t)(row - TL) * DM; }

DI void work_range(int total, int& g0, int& gend, int& step) {
  if ((gridDim.x & 7) == 0) {
    const int x = blockIdx.x & 7, li = blockIdx.x >> 3, nl = gridDim.x >> 3;
    const int lo = (int)(((long long)total * x) >> 3), hi = (int)(((long long)total * (x + 1)) >> 3);
    g0 = lo + li; gend = hi; step = nl;
  } else { g0 = blockIdx.x; gend = total; step = gridDim.x; }
}
DI void band_decode(int g, int MT, int NT, int& mt, int& nt) {
  const int per = 8 * NT;
  const int band = g / per, r = g - band * per;
  int hb = MT - band * 8; if (hb > 8) hb = 8;
  nt = r / hb; mt = band * 8 + (r - nt * hb);
}

template <class AF, class BF>
DI void gemm_mainloop(char* smem, int nparts, int kpart, AF arow, BF brow, f32x16 (&acc)[2][2]) {
  const int tid = threadIdx.x, lane = tid & 63, wave = tid >> 6;
  const int wm = wave >> 1, wn = wave & 1;
  const int lr = tid >> 3, lc = tid & 7;
#pragma unroll
  for (int i = 0; i < 2; ++i)
#pragma unroll
    for (int j = 0; j < 2; ++j)
#pragma unroll
      for (int e = 0; e < 16; ++e) acc[i][j][e] = 0.f;
  const int csrc = (lc ^ ((lr >> 1) & 7)) * 8;
  const u16* bp[4];
  const u16* ap[4];
#pragma unroll
  for (int q = 0; q < 4; ++q) { bp[q] = brow(lr + 32 * q) + csrc; ap[q] = arow(lr + 32 * q, 0) + csrc; }
  const int nk = kpart >> 6;
  const int total = nparts * nk;
  const int sw = (lane >> 1) & 7;
  const int hsel = lane >> 5;
  char* const wbase = smem + wave * 1024;
  auto stage = [&](int buf, int kk, int boff) {
#pragma unroll
    for (int q = 0; q < 4; ++q) {
      __builtin_amdgcn_global_load_lds((const unsigned*)(ap[q] + kk), (unsigned*)(wbase + buf * 32768 + q * 4096), 16, 0, 0);
      __builtin_amdgcn_global_load_lds((const unsigned*)(bp[q] + boff), (unsigned*)(wbase + buf * 32768 + 16384 + q * 4096), 16, 0, 0);
    }
  };
  __syncthreads();
  stage(0, 0, 0);
  asm volatile("s_waitcnt vmcnt(0)" ::: "memory");
  __syncthreads();
  int part = 0, kk = 0, buf = 0;
#pragma unroll 1
  for (int it = 0; it < total; ++it) {
    kk += 64;
    if (kk == kpart) {
      kk = 0; ++part;
      if (part < nparts) {
#pragma unroll
        for (int q = 0; q < 4; ++q) ap[q] = arow(lr + 32 * q, part) + csrc;
      }
    }
    if (it + 1 < total) stage(buf ^ 1, kk, part * kpart + kk);
    const u16* As = (const u16*)(smem + buf * 32768);
    const u16* Bs = As + 128 * 64;
    bf16x8 af[2][2], bf[2][2];
    const u16* Ar = As + (wm * 64 + (lane & 31)) * 64;
    const u16* Br = Bs + (wn * 64 + (lane & 31)) * 64;
    {
      const int pc = (hsel ^ sw) * 8;
#pragma unroll
      for (int i = 0; i < 2; ++i) { af[0][i] = *(const bf16x8*)(Ar + i * 2048 + pc); bf[0][i] = *(const bf16x8*)(Br + i * 2048 + pc); }
    }
#pragma unroll
    for (int ks = 0; ks < 4; ++ks) {
      const int cur = ks & 1;
      if (ks + 1 < 4) {
        const int pc = (((ks + 1) * 2 + hsel) ^ sw) * 8;
#pragma unroll
        for (int i = 0; i < 2; ++i) { af[cur ^ 1][i] = *(const bf16x8*)(Ar + i * 2048 + pc); bf[cur ^ 1][i] = *(const bf16x8*)(Br + i * 2048 + pc); }
      }
#pragma unroll
      for (int i = 0; i < 2; ++i)
#pragma unroll
        for (int j = 0; j < 2; ++j) acc[i][j] = __builtin_amdgcn_mfma_f32_32x32x16_bf16(af[cur][i], bf[cur][j], acc[i][j], 0, 0, 0);
      __builtin_amdgcn_sched_barrier(0);
    }
    asm volatile("s_waitcnt vmcnt(0)" ::: "memory");
    __syncthreads();
    buf ^= 1;
  }
}

template <class F>
DI void epi_direct(const f32x16 (&acc)[2][2], F f) {
  const int lane = threadIdx.x & 63, wave = threadIdx.x >> 6;
  const int wm = wave >> 1, wn = wave & 1, h = lane >> 5;
#pragma unroll
  for (int i = 0; i < 2; ++i)
#pragma unroll
    for (int j = 0; j < 2; ++j)
#pragma unroll
      for (int e = 0; e < 16; ++e) {
        const int row = wm * 64 + i * 32 + (e & 3) + 8 * (e >> 2) + 4 * h;
        const int col = wn * 64 + j * 32 + (lane & 31);
        f(row, col, acc[i][j][e]);
      }
}
#define CS(r, c) Cs[(r) * 128 + (c)]
DI void acc_to_lds(float* Cs, const f32x16 (&acc)[2][2]) {
  __syncthreads();
  epi_direct(acc, [&](int r, int c, float v) { CS(r, c) = v; });
  __syncthreads();
}

struct TJob { const float* src; int srcK, srcN; u16* dst; int ld, koff; const float* mu; int Kpad, Npad; };
DI TJob get_job(const Params& p, int j) {
  TJob t; t.mu = nullptr; t.koff = 0;
  auto set = [&](const float* s, int K, int N, u16* d, int ld) { t.src = s; t.srcK = K; t.srcN = N; t.dst = d; t.ld = ld; t.Kpad = K; t.Npad = N; };
  switch (j) {
    case 0: set(p.w_qkv, 1024, 1536, p.qkv_t, 1024); break;
    case 1: set(p.w_o, 1024, 1024, p.wo_t, 1024); break;
    case 2: set(p.f_up, 1024, 5632, p.up_t, 1024); break;
    case 3: set(p.f_up + (size_t)1024 * 5632, 1024, 5632, p.up_t + (size_t)5632 * 1024, 1024); break;
    case 4: set(p.f_down, 2816, 1024, p.down_t, 2816); break;
    case 5: set(p.f_down + (size_t)2816 * 1024, 2816, 1024, p.down_t + (size_t)1024 * 2816, 2816); break;
    case 6: set(p.rw_r, 1024, 1024, p.rr_t, 2048); break;
    case 7: set(p.rw_r, 1024, 1024, p.rr_t, 2048); t.mu = p.mu + 0 * 1024; t.koff = 1024; break;
    case 8: set(p.rw_k, 1024, 1024, p.rk_t, 2048); break;
    case 9: set(p.rw_k, 1024, 1024, p.rk_t, 2048); t.mu = p.mu + 2 * 1024; t.koff = 1024; break;
    case 10: set(p.rw_v, 1024, 1024, p.rv_t, 2048); break;
    case 11: set(p.rw_v, 1024, 1024, p.rv_t, 2048); t.mu = p.mu + 3 * 1024; t.koff = 1024; break;
    case 12: set(p.rw_o, 1024, 1024, p.ro_t, 1024); break;
    case 13: set(p.dw1, 1024, 64, p.w1_t, 2048); break;
    case 14: set(p.dw1, 1024, 64, p.w1_t, 2048); t.mu = p.mu + 1 * 1024; t.koff = 1024; break;
    case 15: set(p.dw1 + 1024 * 64, 1024, 64, p.w1_t + 64 * 2048, 2048); break;
    case 16: set(p.dw1 + 1024 * 64, 1024, 64, p.w1_t + 64 * 2048, 2048); t.mu = p.mu + 1 * 1024; t.koff = 1024; break;
    case 17: set(p.a1, 1024, 64, p.a1_t, 2048); break;
    case 18: set(p.a1, 1024, 64, p.a1_t, 2048); t.mu = p.mu + 4 * 1024; t.koff = 1024; break;
    case 19: set(p.a1 + 1024 * 64, 1024, 64, p.a1_t + 64 * 2048, 2048); break;
    case 20: set(p.a1 + 1024 * 64, 1024, 64, p.a1_t + 64 * 2048, 2048); t.mu = p.mu + 4 * 1024; t.koff = 1024; break;
    case 21: set(p.g1, 1024, 160, p.g1_t, 2048); t.Npad = 256; break;
    case 22: set(p.g1, 1024, 160, p.g1_t, 2048); t.Npad = 256; t.mu = p.mu + 5 * 1024; t.koff = 1024; break;
    case 23: set(p.dw2, 64, 1024, p.w2_t, 64); break;
    case 24: set(p.dw2 + 64 * 1024, 64, 1024, p.w2_t + 1024 * 64, 64); break;
    case 25: set(p.a2, 64, 1024, p.a2_t, 64); break;
    case 26: set(p.a2 + 64 * 1024, 64, 1024, p.a2_t + 1024 * 64, 64); break;
    default: set(p.g2, 160, 1024, p.g2_t, 192); t.Kpad = 192; break;
  }
  return t;
}
constexpr int NJOBS = 28;
DI int job_tiles(const TJob& t) { return ((t.Kpad + 63) >> 6) * ((t.Npad + 63) >> 6); }

DI void phase_prep(const Params& p, char* smem) {
  const int tid = threadIdx.x;
  int ttiles = 0;
  for (int j = 0; j < NJOBS; ++j) ttiles += job_tiles(get_job(p, j));
  const int n_mod = 2 * 24 * 8;
  const int n_rope = 1024;
  const int total = ttiles + n_mod + n_rope;
  float* tile = (float*)smem;
  if (blockIdx.x == 0) for (int e = tid; e < 4096; e += 256) p.zero[e] = 0;
  for (int item = blockIdx.x; item < total; item += gridDim.x) {
    if (item < ttiles) {
      int rem = item, j = 0;
      TJob t = get_job(p, 0);
      while (true) { int n = job_tiles(t); if (rem < n) break; rem -= n; ++j; t = get_job(p, j); }
      const int ntn = (t.Npad + 63) >> 6;
      const int kt = rem / ntn, nt = rem % ntn;
      __syncthreads();
#pragma unroll
      for (int i = 0; i < 16; ++i) {
        const int kl = i * 4 + (tid >> 6), nl = tid & 63;
        const int k = kt * 64 + kl, n = nt * 64 + nl;
        float v = 0.f;
        if (k < t.srcK && n < t.srcN) { v = t.src[(size_t)k * t.srcN + n]; if (t.mu) v *= t.mu[k]; }
        tile[kl * 65 + nl] = v;
      }
      __syncthreads();
#pragma unroll
      for (int i = 0; i < 16; ++i) {
        const int nl = i * 4 + (tid >> 6), kl = tid & 63;
        const int k = kt * 64 + kl, n = nt * 64 + nl;
        if (k < t.Kpad && n < t.Npad) t.dst[(size_t)n * t.ld + t.koff + k] = f2bf(tile[kl * 65 + nl]);
      }
    } else if (item < ttiles + n_mod) {
      const int it = item - ttiles;
      const int layer = it / 192, cc = (it % 192) / 8, kc = it % 8;
      float* sil = (float*)smem;
      __syncthreads();
      for (int e = tid; e < 640; e += 256) {
        const int j = e >> 7, k = kc * 128 + (e & 127);
        const float v = j < 4 ? p.c[j * 1024 + k] : p.c_ctx[k];
        sil[e] = v / (1.f + __expf(-v));
      }
      __syncthreads();
      const int col = cc * 256 + tid;
      float a0 = 0, a1 = 0, a2 = 0, a3 = 0, a4 = 0;
      const float* w = p.ada_w + ((size_t)layer * 1024 + kc * 128) * 6144 + col;
#pragma unroll 16
      for (int k = 0; k < 128; ++k) {
        const float wv = w[(size_t)k * 6144];
        a0 += sil[k] * wv; a1 += sil[128 + k] * wv; a2 += sil[256 + k] * wv; a3 += sil[384 + k] * wv; a4 += sil[512 + k] * wv;
      }
      float* mp = p.modpart + ((size_t)(layer * 8 + kc) * 5) * 6144 + col;
      mp[0] = a0; mp[6144] = a1; mp[2 * 6144] = a2; mp[3 * 6144] = a3; mp[4 * 6144] = a4;
    } else {
      const int e = (item - ttiles - n_mod) * 256 + tid;
      const int s = e >> 5, pr = e & 31;
      const int f = pr & 15;
      const float inv_freq = powf(10000.f, -(float)f / 16.f);
      const float pos = (pr < 16) ? (float)(s >> 6) : (float)(s & 63);
      const float ang = pos * inv_freq;
      float sn, cs;
      sincosf(ang, &sn, &cs);
      p.rope[e * 2] = cs; p.rope[e * 2 + 1] = sn;
    }
  }
}

DI void phase_modreduce(const Params& p) {
  const int n = 2 * 5 * 6144;
  for (int e = blockIdx.x * 256 + threadIdx.x; e < n; e += gridDim.x * 256) {
    const int layer = e / (5 * 6144), r = e % (5 * 6144), col = r % 6144;
    float s = p.ada_b[layer * 6144 + col];
    for (int kc = 0; kc < 8; ++kc) s += p.modpart[(size_t)(layer * 8 + kc) * 5 * 6144 + r];
    p.modv[e] = s;
  }
}

template <bool FROM_INPUT>
DI void phase_modulate(const Params& p, int layer, int which, int nrows) {
  const int lane = threadIdx.x & 63;
  const int gw = blockIdx.x * 4 + (threadIdx.x >> 6), nw = gridDim.x * 4;
  for (int row = gw; row < nrows; row += nw) {
    const float* src = FROM_INPUT ? xin_ptr(p, row) : resid_ptr(p, row);
    const float* mv = p.modv + ((size_t)layer * 5 + midx_of(row)) * 6144 + which * 3072;
    float4 v[4];
    float ss = 0.f;
#pragma unroll
    for (int i = 0; i < 4; ++i) {
      v[i] = *(const float4*)(src + i * 256 + lane * 4);
      ss += v[i].x * v[i].x + v[i].y * v[i].y + v[i].z * v[i].z + v[i].w * v[i].w;
    }
    ss = wave_sum(ss);
    const float rinv = rsqrtf(ss * (1.f / 1024.f) + 1e-6f);
#pragma unroll
    for (int i = 0; i < 4; ++i) {
      const int col = i * 256 + lane * 4;
      const float4 sh = *(const float4*)(mv + col);
      const float4 sc = *(const float4*)(mv + 1024 + col);
      uint2 o;
      o.x = pack2(v[i].x * rinv * (1.f + sc.x) + sh.x, v[i].y * rinv * (1.f + sc.y) + sh.y);
      o.y = pack2(v[i].z * rinv * (1.f + sc.z) + sh.z, v[i].w * rinv * (1.f + sc.w) + sh.w);
      *(uint2*)(p.H + (size_t)row * DM + col) = o;
    }
  }
}

DI void modrow(const Params& p, int row, bool valid, int lane, float (&h)[16]) {
  if (!valid) {
#pragma unroll
    for (int i = 0; i < 16; ++i) h[i] = 0.f;
    return;
  }
  const float* src = resid_ptr(p, row);
  const float* mv = p.modv + ((size_t)1 * 5 + midx_of(row)) * 6144;
  float ss = 0.f;
#pragma unroll
  for (int i = 0; i < 4; ++i) {
    const float4 v = *(const float4*)(src + i * 256 + lane * 4);
    h[i * 4 + 0] = v.x; h[i * 4 + 1] = v.y; h[i * 4 + 2] = v.z; h[i * 4 + 3] = v.w;
    ss += v.x * v.x + v.y * v.y + v.z * v.z + v.w * v.w;
  }
  ss = wave_sum(ss);
  const float rinv = rsqrtf(ss * (1.f / 1024.f) + 1e-6f);
#pragma unroll
  for (int i = 0; i < 4; ++i) {
    const int col = i * 256 + lane * 4;
    const float4 sh = *(const float4*)(mv + col);
    const float4 sc = *(const float4*)(mv + 1024 + col);
    h[i * 4 + 0] = h[i * 4 + 0] * rinv * (1.f + sc.x) + sh.x;
    h[i * 4 + 1] = h[i * 4 + 1] * rinv * (1.f + sc.y) + sh.y;
    h[i * 4 + 2] = h[i * 4 + 2] * rinv * (1.f + sc.z) + sh.z;
    h[i * 4 + 3] = h[i * 4 + 3] * rinv * (1.f + sc.w) + sh.w;
  }
}
DI void phase_rwkv_shift(const Params& p) {
  const int lane = threadIdx.x & 63;
  const int gw = blockIdx.x * 4 + (threadIdx.x >> 6), nw = gridDim.x * 4;
  const int nitems = MR / 8;
  for (int item = gw; item < nitems; item += nw) {
    const int r0 = item * 8;
    int sb, T;
    if (r0 < TL) { sb = r0 & ~8191; T = 8192; } else { sb = TL + ((r0 - TL) & ~255); T = 256; }
    float hm[16], hc[16], hn[16];
    modrow(p, r0 - 1, r0 - 1 >= sb, lane, hm);
    modrow(p, r0, true, lane, hc);
    for (int j = 0; j < 8; ++j) {
      const int row = r0 + j;
      modrow(p, row + 1, row + 1 < sb + T, lane, hn);
#pragma unroll
      for (int i = 0; i < 4; ++i) {
        const int col = i * 256 + lane * 4;
        float xx[4];
#pragma unroll
        for (int e = 0; e < 4; ++e) xx[e] = 0.5f * (hm[i * 4 + e] + hn[i * 4 + e]) - hc[i * 4 + e];
        uint2 o, o2;
        o.x = pack2(hc[i * 4 + 0], hc[i * 4 + 1]); o.y = pack2(hc[i * 4 + 2], hc[i * 4 + 3]);
        o2.x = pack2(xx[0], xx[1]); o2.y = pack2(xx[2], xx[3]);
        *(uint2*)(p.H + (size_t)row * DM + col) = o;
        *(uint2*)(p.XX + (size_t)row * DM + col) = o2;
      }
#pragma unroll
      for (int i = 0; i < 16; ++i) { hm[i] = hc[i]; hc[i] = hn[i]; }
    }
  }
}

DI void phase_qkv(const Params& p, char* smem) {
  float* Cs = (float*)smem;
  const int tid = threadIdx.x;
  int g0, gend, gstep; work_range(264 * 12, g0, gend, gstep);
  for (int tile = g0; tile < gend; tile += gstep) {
    int mt, nt; band_decode(tile, 264, 12, mt, nt);
    const int m0 = mt * 128;
    f32x16 acc[2][2];
    gemm_mainloop(smem, 1, 1024,
                  [&](int r, int) { return (const u16*)(p.H + (size_t)(m0 + r) * DM); },
                  [&](int c) { return (const u16*)(p.qkv_t + (size_t)(nt * 128 + c) * 1024); }, acc);
    acc_to_lds(Cs, acc);
    const bool isctx = m0 >= TL;
    const int b = isctx ? (m0 - TL) >> 8 : m0 >> 13;
    const int t0 = isctx ? (m0 - TL) & 255 : m0 & 8191;
    if (nt < 10) {
      const int lane = tid & 63, wave = tid >> 6;
      const int hh = lane >> 5, pr = lane & 31;
      const bool isq = nt < 8;
      const float* gain = isq ? p.q_gain : p.k_gain;
      const float qs = isq ? 0.125f * 1.4426950408889634f : 1.f;
      const float g0 = gain[2 * pr] * qs, g1 = gain[2 * pr + 1] * qs;
      u16* dstb;
      size_t tstride = 64;
      if (isq) {
        const int head = nt * 2 + hh;
        dstb = isctx ? p.QC + ((size_t)(b * 16 + head) * 256 + t0) * 64 : p.Q + ((size_t)(b * 16 + head) * 8192 + t0) * 64;
      } else {
        const int kh = (nt - 8) * 2 + hh;
        dstb = p.Kb + ((size_t)(b * 4 + kh) * NKEY + (isctx ? t0 : 256 + t0)) * 64;
      }
#pragma unroll 4
      for (int rr = 0; rr < 32; ++rr) {
        const int r = wave * 32 + rr;
        const float2 v = *(const float2*)&CS(r, 2 * lane);
        float ss = v.x * v.x + v.y * v.y;
        ss = sum32(ss);
        const float rinv = rsqrtf(ss * (1.f / 64.f) + 1e-6f);
        float x0 = v.x * rinv * g0, x1 = v.y * rinv * g1;
        if (!isctx) {
          const float2 cssn = *(const float2*)(p.rope + ((size_t)(t0 + r) * 32 + pr) * 2);
          const float y0 = x0 * cssn.x - x1 * cssn.y, y1 = x0 * cssn.y + x1 * cssn.x;
          x0 = y0; x1 = y1;
        }
        *(unsigned*)(dstb + (size_t)r * tstride + 2 * pr) = pack2(x0, x1);
      }
    } else {
      const int keybase = (isctx ? t0 : 256 + t0);
      for (int j = 0; j < 4; ++j) {
        const int item = tid + 256 * j;
        const int d = item & 63, hh = (item >> 6) & 1, rg = item >> 7;
        const int kh = (nt - 10) * 2 + hh;
        float v[16];
#pragma unroll
        for (int i = 0; i < 16; ++i) v[i] = CS(rg * 16 + i, hh * 64 + d);
        u16* dst = p.Vt + ((size_t)(b * 4 + kh) * 64 + d) * NKEY + keybase + rg * 16;
        *(u32x4*)(dst) = mk4(pack2(v[0], v[1]), pack2(v[2], v[3]), pack2(v[8], v[9]), pack2(v[10], v[11]));
        *(u32x4*)(dst + 8) = mk4(pack2(v[4], v[5]), pack2(v[6], v[7]), pack2(v[12], v[13]), pack2(v[14], v[15]));
      }
    }
  }
}

DI void phase_attn(const Params& p, char* smem) {
  u16* Ks = (u16*)smem;
  u16* Vs = Ks + 64 * 64;
  const int tid = threadIdx.x, lane = tid & 63, wave = tid >> 6;
  const int sw = (lane >> 1) & 7, hsel = lane >> 5;
  float mq = 0.f, mk = 0.f;
  for (int d = 0; d < 64; ++d) { mq = fmaxf(mq, fabsf(p.q_gain[d])); mk = fmaxf(mk, fabsf(p.k_gain[d])); }
  const float c0 = 0.125f * 1.4426950408889634f * 64.f * mq * mk * 1.02f + 0.5f;
  f32x16 negc;
#pragma unroll
  for (int i = 0; i < 16; ++i) negc[i] = -c0;
  int ga, gae, gs, gc, gce, gs2;
  work_range(4096, ga, gae, gs);
  work_range(128, gc, gce, gs2);
  const int n_lat = ga < gae ? (gae - ga + gs - 1) / gs : 0;
  const int n_ctx = gc < gce ? (gce - gc + gs2 - 1) / gs2 : 0;
  for (int wi = 0; wi < n_lat + n_ctx; ++wi) {
    const int item = wi < n_lat ? ga + wi * gs : 4096 + gc + (wi - n_lat) * gs2;
    int b, kvh, qb, nkt;
    const u16* qbase;
    size_t orow;
    const int head_g = wave;
    if (item < 4096) {
      b = item >> 10; kvh = (item >> 8) & 3; qb = item & 255; nkt = NKEY / 64;
      qbase = p.Q + ((size_t)(b * 16 + kvh * 4 + head_g) * 8192 + qb * 32) * 64;
      orow = (size_t)b * 8192 + qb * 32;
    } else {
      const int j = item - 4096;
      b = j >> 5; kvh = (j >> 3) & 3; qb = j & 7; nkt = 4;
      qbase = p.QC + ((size_t)(b * 16 + kvh * 4 + head_g) * 256 + qb * 32) * 64;
      orow = (size_t)TL + b * 256 + qb * 32;
    }
    const int head = kvh * 4 + head_g;
    bf16x8 qf[4];
#pragma unroll
    for (int ks = 0; ks < 4; ++ks) qf[ks] = *(const bf16x8*)(qbase + (lane & 31) * 64 + ks * 16 + hsel * 8);
    const u16* kg = p.Kb + (size_t)(b * 4 + kvh) * NKEY * 64;
    const u16* vg = p.Vt + (size_t)(b * 4 + kvh) * 64 * NKEY;
    f32x16 oacc[2];
#pragma unroll
    for (int i = 0; i < 16; ++i) { oacc[0][i] = 0.f; oacc[1][i] = 0.f; }
    f32x2 ls2 = {0.f, 0.f};
    u32x4 rk[2], rv[2];
#pragma unroll
    for (int q = 0; q < 2; ++q) {
      const int ch = tid + 256 * q;
      rk[q] = *(const u32x4*)(kg + (size_t)ch * 8);
      rv[q] = *(const u32x4*)(vg + (size_t)(ch >> 3) * NKEY + (ch & 7) * 8);
    }
    for (int kt = 0; kt < nkt; ++kt) {
      __syncthreads();
#pragma unroll
      for (int q = 0; q < 2; ++q) {
        const int ch = tid + 256 * q;
        const int row = ch >> 3, cc = ch & 7;
        const int pc = cc ^ ((row >> 1) & 7);
        *(u32x4*)(Ks + row * 64 + pc * 8) = rk[q];
        *(u32x4*)(Vs + row * 64 + pc * 8) = rv[q];
      }
      __syncthreads();
      if (kt + 1 < nkt) {
#pragma unroll
        for (int q = 0; q < 2; ++q) {
          const int ch = tid + 256 * q;
          rk[q] = *(const u32x4*)(kg + (size_t)(kt + 1) * 4096 + (size_t)ch * 8);
          rv[q] = *(const u32x4*)(vg + (size_t)(ch >> 3) * NKEY + (kt + 1) * 64 + (ch & 7) * 8);
        }
      }
      f32x16 sacc[2];
      bf16x8 kf[2][4];
#pragma unroll
      for (int kb = 0; kb < 2; ++kb)
#pragma unroll
        for (int ks = 0; ks < 4; ++ks) kf[kb][ks] = *(const bf16x8*)(Ks + (kb * 32 + (lane & 31)) * 64 + (((ks * 2 + hsel) ^ sw) * 8));
      __builtin_amdgcn_sched_barrier(0);
#pragma unroll
      for (int kb = 0; kb < 2; ++kb)
#pragma unroll
        for (int ks = 0; ks < 4; ++ks)
          sacc[kb] = __builtin_amdgcn_mfma_f32_32x32x16_bf16(kf[kb][ks], qf[ks], ks == 0 ? negc : sacc[kb], 0, 0, 0);
      bf16x8 vf[4][2];
#pragma unroll
      for (int c4 = 0; c4 < 4; ++c4)
#pragma unroll
        for (int db = 0; db < 2; ++db) vf[c4][db] = *(const bf16x8*)(Vs + (db * 32 + (lane & 31)) * 64 + (((2 * c4 + hsel) ^ sw) * 8));
#pragma unroll
      for (int kb = 0; kb < 2; ++kb)
#pragma unroll
        for (int i = 0; i < 16; i += 2) {
          const float e0 = __builtin_amdgcn_exp2f(sacc[kb][i]), e1 = __builtin_amdgcn_exp2f(sacc[kb][i + 1]);
          sacc[kb][i] = e0; sacc[kb][i + 1] = e1;
          const f32x2 e2 = {e0, e1};
          ls2 += e2;
        }
#pragma unroll
      for (int kb = 0; kb < 2; ++kb)
#pragma unroll
        for (int s2 = 0; s2 < 2; ++s2) {
          unsigned w[4];
#pragma unroll
          for (int e = 0; e < 4; ++e) w[e] = pack2(sacc[kb][8 * s2 + 2 * e], sacc[kb][8 * s2 + 2 * e + 1]);
          u32x4 pw = mk4(w[0], w[1], w[2], w[3]);
          const bf16x8 pf = __builtin_bit_cast(bf16x8, pw);
#pragma unroll
          for (int db = 0; db < 2; ++db) oacc[db] = __builtin_amdgcn_mfma_f32_32x32x16_bf16(vf[2 * kb + s2][db], pf, oacc[db], 0, 0, 0);
        }
    }
    const float lsum = ls2[0] + ls2[1];
    const float l = lsum + __shfl_xor(lsum, 32, 64);
    const float inv = 1.f / l;
    u16* od = p.H + (orow + (lane & 31)) * DM + head * 64;
#pragma unroll
    for (int db = 0; db < 2; ++db)
#pragma unroll
      for (int g = 0; g < 4; ++g) {
        uint2 o;
        o.x = pack2(oacc[db][g * 4 + 0] * inv, oacc[db][g * 4 + 1] * inv);
        o.y = pack2(oacc[db][g * 4 + 2] * inv, oacc[db][g * 4 + 3] * inv);
        *(uint2*)(od + db * 32 + 8 * g + 4 * hsel) = o;
      }
  }
}

template <bool FROM_INPUT>
DI void phase_proj_res(const Params& p, char* smem, const u16* A, int lda, int K, const u16* Bt, int layer, int gate_idx, int mtiles) {
  int g0, gend, gstep; work_range(mtiles * 8, g0, gend, gstep);
  for (int tile = g0; tile < gend; tile += gstep) {
    int mt, nt; band_decode(tile, mtiles, 8, mt, nt);
    const int m0 = mt * 128;
    f32x16 acc[2][2];
    gemm_mainloop(smem, 1, K,
                  [&](int r, int) { return A + (size_t)(m0 + r) * lda; },
                  [&](int c) { return Bt + (size_t)(nt * 128 + c) * K; }, acc);
    const float* gate = p.modv + ((size_t)layer * 5 + midx_of(m0)) * 6144 + gate_idx * 1024 + nt * 128;
    const float* sb = (FROM_INPUT ? xin_ptr(p, m0) : (const float*)resid_ptr(p, m0)) + nt * 128;
    float* db = resid_ptr(p, m0) + nt * 128;
    epi_direct(acc, [&](int r, int c, float v) { db[r * DM + c] = sb[r * DM + c] + gate[c] * v; });
  }
}

DI void phase_ffn_up(const Params& p, char* smem, int layer, bool with_ctx, u16* ACT) {
  float* Cs = (float*)smem;
  const int tid = threadIdx.x;
  const int mtiles = with_ctx ? 276 : 264;
  int g0, gend, gstep; work_range(mtiles * 44, g0, gend, gstep);
  const u16* up = p.up_t + (size_t)layer * 5632 * 1024;
  const float* cw = p.f_cw + (size_t)layer * 3 * 5632;
  const float* cb = p.f_cb + (size_t)layer * 5632;
  for (int tile = g0; tile < gend; tile += gstep) {
    int mt, nt; band_decode(tile, mtiles, 44, mt, nt);
    int rowbase, T, j;
    if (mt < 264) { rowbase = (mt / 66) * 8192; T = 8192; j = mt % 66; }
    else { const int m2 = mt - 264; rowbase = TL + (m2 / 3) * 256; T = 256; j = m2 % 3; }
    const int tb = j * 126 - 1;
    f32x16 acc[2][2];
    gemm_mainloop(smem, 1, 1024,
                  [&](int r, int) { const int t = tb + r; return (t >= 0 && t < T) ? (const u16*)(p.H + (size_t)(rowbase + t) * DM) : (const u16*)p.zero; },
                  [&](int c) { return up + (size_t)(c < 64 ? nt * 64 + c : 2816 + nt * 64 + (c - 64)) * 1024; }, acc);
    acc_to_lds(Cs, acc);
    const int c = tid & 63, rq = tid >> 6;
    const int n = nt * 64 + c;
    const float g0 = cw[n], g1 = cw[5632 + n], g2 = cw[2 * 5632 + n], gb = cb[n];
    const float v0 = cw[2816 + n], v1 = cw[5632 + 2816 + n], v2 = cw[2 * 5632 + 2816 + n], vb = cb[2816 + n];
    const int rs = 1 + rq * 32;
    int re = rs + 32; if (re > 127) re = 127;
    float gp = CS(rs - 1, c), gc = CS(rs, c), vp = CS(rs - 1, c + 64), vc = CS(rs, c + 64);
    for (int r = rs; r < re; ++r) {
      const float gn = CS(r + 1, c), vn = CS(r + 1, c + 64);
      const int t = tb + r;
      if (t < T) {
        const float g = g0 * gp + g1 * gc + g2 * gn + gb;
        const float v = v0 * vp + v1 * vc + v2 * vn + vb;
        const float a = g * __builtin_amdgcn_rcpf(1.f + __expf(-g)) * v;
        ACT[(size_t)(rowbase + t) * DFF + n] = f2bf(a);
      }
      gp = gc; gc = gn; vp = vc; vc = vn;
    }
  }
}

DI void phase_rwkv_gemms(const Params& p, char* smem) {
  float* Cs = (float*)smem;
  const int tid = threadIdx.x;
  int g0, gend, gstep; work_range(7312, g0, gend, gstep);
  for (int tile = g0; tile < gend; tile += gstep) {
    int job, mt, nt;
    const u16* Bt;
    if (tile < 2048) { job = 0; band_decode(tile, 256, 8, mt, nt); Bt = p.rr_t; }
    else if (tile < 4160) { job = 1; band_decode(tile - 2048, 264, 8, mt, nt); Bt = p.rk_t; }
    else if (tile < 6272) { job = 2; band_decode(tile - 4160, 264, 8, mt, nt); Bt = p.rv_t; }
    else if (tile < 6536) { job = 3; mt = tile - 6272; nt = 0; Bt = p.w1_t; }
    else if (tile < 6800) { job = 4; mt = tile - 6536; nt = 0; Bt = p.a1_t; }
    else { job = 5; band_decode(tile - 6800, 256, 2, mt, nt); Bt = p.g1_t; }
    const int m0 = mt * 128;
    f32x16 acc[2][2];
    gemm_mainloop(smem, 2, 1024,
                  [&](int r, int part) { return (const u16*)((part ? p.XX : p.H) + (size_t)(m0 + r) * DM); },
                  [&](int c) { return Bt + (size_t)(nt * 128 + c) * 2048; }, acc);
    if (job == 0) {
      epi_direct(acc, [&](int r, int c, float v) { p.R16[(size_t)(m0 + r) * DM + nt * 128 + c] = (f16)v; });
    } else if (job == 2) {
      epi_direct(acc, [&](int r, int c, float v) { p.V16[(size_t)(m0 + r) * DM + nt * 128 + c] = (f16)v; });
    } else if (job == 3) {
      epi_direct(acc, [&](int r, int c, float v) { p.LW[(size_t)(m0 + r) * 128 + c] = f2bf(tanhf(v)); });
    } else if (job == 4) {
      epi_direct(acc, [&](int r, int c, float v) { p.LA[(size_t)(m0 + r) * 128 + c] = f2bf(v); });
    } else if (job == 5) {
      epi_direct(acc, [&](int r, int c, float v) {
        const int col = nt * 128 + c;
        if (col < 192) p.LG[(size_t)(m0 + r) * 192 + col] = col < 160 ? f2bf(sigmoid_fast(v)) : (u16)0;
      });
    } else {
      acc_to_lds(Cs, acc);
      const int lane = tid & 63, wave = tid >> 6;
      const int col = nt * 128 + 2 * lane;
      const float kk0 = p.k_k[col], kk1 = p.k_k[col + 1];
#pragma unroll 4
      for (int rr = 0; rr < 32; ++rr) {
        const int r = wave * 32 + rr;
        const float2 v = *(const float2*)&CS(r, 2 * lane);
        const float a0 = v.x * kk0, a1 = v.y * kk1;
        float ss = a0 * a0 + a1 * a1;
        ss = sum32(ss);
        const float inv = 1.f / fmaxf(sqrtf(ss), 1e-12f);
        f16 k2[2], n2[2];
        k2[0] = (f16)v.x; k2[1] = (f16)v.y; n2[0] = (f16)(a0 * inv); n2[1] = (f16)(a1 * inv);
        *(unsigned*)(p.K16 + (size_t)(m0 + r) * DM + col) = *(const unsigned*)k2;
        *(unsigned*)(p.KK16 + (size_t)(m0 + r) * DM + col) = *(const unsigned*)n2;
      }
    }
  }
}

struct ScanLds {
  float dec[2][16][64], kd[2][16][64], nk[2][16][64], bb[2][16][64], rr[2][16][64];
  float vv[2][16][16];
  float yy[2][16][16];
  float bp[2][4][16];
};

template <int DIR, bool EMIT>
DI void scan_steps(const ScanLds& L, int bsel, int c0, int myrow, int l15, f32x2& Sa, f32x2& Sb, float& ykeep) {
  f32x4 d4[2], k4[2], n4[2], b4[2], r4[2];
  float vv[2];
  auto ld = [&](int slot, int s) {
    d4[slot] = *(const f32x4*)&L.dec[bsel][s][c0];
    k4[slot] = *(const f32x4*)&L.kd[bsel][s][c0];
    n4[slot] = *(const f32x4*)&L.nk[bsel][s][c0];
    b4[slot] = *(const f32x4*)&L.bb[bsel][s][c0];
    if (EMIT) r4[slot] = *(const f32x4*)&L.rr[bsel][s][c0];
    vv[slot] = L.vv[bsel][s][myrow];
  };
  ld(0, DIR ? 15 : 0);
#pragma unroll
  for (int ss = 0; ss < 16; ++ss) {
    const int s = DIR ? 15 - ss : ss;
    const int cur = ss & 1;
    if (ss + 1 < 16) ld(cur ^ 1, DIR ? 14 - ss : ss + 1);
    const f32x2 nlo = {n4[cur][0], n4[cur][1]}, nhi = {n4[cur][2], n4[cur][3]};
    const f32x2 dlo = {d4[cur][0], d4[cur][1]}, dhi = {d4[cur][2], d4[cur][3]};
    const f32x2 klo = {k4[cur][0], k4[cur][1]}, khi = {k4[cur][2], k4[cur][3]};
    const f32x2 blo = {b4[cur][0], b4[cur][1]}, bhi = {b4[cur][2], b4[cur][3]};
    f32x2 t = Sa * nlo + Sb * nhi;
    float sa = dpp_sum16(t[0] + t[1]);
    const f32x2 sa2 = {sa, sa}, v2 = {vv[cur], vv[cur]};
    Sa = Sa * dlo + (sa2 * blo + v2 * klo);
    Sb = Sb * dhi + (sa2 * bhi + v2 * khi);
    if (EMIT) {
      const f32x2 rlo = {r4[cur][0], r4[cur][1]}, rhi = {r4[cur][2], r4[cur][3]};
      const f32x2 u = Sa * rlo + Sb * rhi;
      const float y = dpp_sum16(u[0] + u[1]);
      ykeep = (l15 == s) ? y : ykeep;
    }
  }
}

template <int DIR>
DI void scan_item(const Params& p, ScanLds& L, int b, int h, int q) {
  constexpr int dir = DIR;
  const int tid = threadIdx.x, lane = tid & 63, wave = tid >> 6;
  const int l15 = lane & 15, l4 = lane >> 4;
  const int colw = h * 64 + wave * 16 + l15;
  const int chd = wave * 16 + l15;
  bf16x8 w2f[2], a2f[2];
#pragma unroll
  for (int ks = 0; ks < 2; ++ks) {
    w2f[ks] = *(const bf16x8*)(p.w2_t + ((size_t)(dir * 1024 + colw) * 64 + ks * 32 + l4 * 8));
    a2f[ks] = *(const bf16x8*)(p.a2_t + ((size_t)(dir * 1024 + colw) * 64 + ks * 32 + l4 * 8));
  }
  const float w0c = p.dw0[dir * 1024 + colw], a0c = p.a0[dir * 1024 + colw], kac = p.k_a[colw], rkc = p.r_k[colw];
  f32x2 Sa = {0.f, 0.f}, Sb = {0.f, 0.f};
  const int myrow = wave * 4 + l4;
  const int c0 = l15 * 4;
  bf16x8 lwf[2], laf[2];
  f16 kv[4], kkv[4], rv[4];
  f16 vvr;
  auto chunk_rowbase = [&](int c, bool& isctx) -> int {
    if (c < 16) { isctx = true; const int cc = dir ? 15 - c : c; return TL + b * 256 + cc * 16; }
    isctx = false; const int cc = dir ? 511 - (c - 16) : (c - 16); return b * 8192 + cc * 16;
  };
  auto stage_load = [&](int c) {
    bool isctx; const int rb = chunk_rowbase(c, isctx);
#pragma unroll
    for (int ks = 0; ks < 2; ++ks) {
      lwf[ks] = *(const bf16x8*)(p.LW + ((size_t)(rb + l15) * 128 + dir * 64 + ks * 32 + l4 * 8));
      laf[ks] = *(const bf16x8*)(p.LA + ((size_t)(rb + l15) * 128 + dir * 64 + ks * 32 + l4 * 8));
    }
#pragma unroll
    for (int i = 0; i < 4; ++i) {
      const size_t off = (size_t)(rb + l4 * 4 + i) * DM + colw;
      kv[i] = p.K16[off]; kkv[i] = p.KK16[off];
      rv[i] = isctx ? (f16)0.f : p.R16[off];
    }
    vvr = p.V16[(size_t)(rb + (tid >> 4)) * DM + h * 64 + q * 16 + (tid & 15)];
  };
  auto stage_compute = [&](int c) {
    const int bsel = c & 1;
    f32x4 wacc = {0.f, 0.f, 0.f, 0.f}, aacc = {0.f, 0.f, 0.f, 0.f};
    wacc = __builtin_amdgcn_mfma_f32_16x16x32_bf16(lwf[0], w2f[0], wacc, 0, 0, 0);
    wacc = __builtin_amdgcn_mfma_f32_16x16x32_bf16(lwf[1], w2f[1], wacc, 0, 0, 0);
    aacc = __builtin_amdgcn_mfma_f32_16x16x32_bf16(laf[0], a2f[0], aacc, 0, 0, 0);
    aacc = __builtin_amdgcn_mfma_f32_16x16x32_bf16(laf[1], a2f[1], aacc, 0, 0, 0);
    float bpart[4];
#pragma unroll
    for (int i = 0; i < 4; ++i) {
      const int s = l4 * 4 + i;
      const float sg = sigmoid_fast(w0c + wacc[i]);
      const float dec = __expf(-0.6065306597126334f * sg);
      const float a = sigmoid_fast(a0c + aacc[i]);
      const float k = (float)kv[i], kk = (float)kkv[i], r = (float)rv[i];
      const float kd = k * (1.f + (a - 1.f) * kac);
      L.dec[bsel][s][chd] = dec;
      L.kd[bsel][s][chd] = kd;
      L.nk[bsel][s][chd] = -kk;
      L.bb[bsel][s][chd] = kk * a;
      L.rr[bsel][s][chd] = r;
      if (q == 0) bpart[i] = dpp_sum16(r * kd * rkc);
    }
    if (q == 0 && l15 == 0) {
#pragma unroll
      for (int i = 0; i < 4; ++i) L.bp[bsel][wave][l4 * 4 + i] = bpart[i];
    }
    L.vv[bsel][tid >> 4][tid & 15] = (float)vvr;
  };
  auto write_bonus = [&](int c) {
    if (q == 0 && tid < 16) {
      bool isctx; const int rb = chunk_rowbase(c, isctx);
      const int b2 = c & 1;
      p.bonus[((size_t)dir * MR + rb + tid) * 16 + h] = L.bp[b2][0][tid] + L.bp[b2][1][tid] + L.bp[b2][2][tid] + L.bp[b2][3][tid];
    }
  };
  __syncthreads();
  stage_load(0);
  stage_compute(0);
  __syncthreads();
  write_bonus(0);
  const int NCH = 528;
  float ykeep = 0.f;
#pragma unroll 1
  for (int c = 0; c < 16; ++c) {
    stage_load(c + 1);
    scan_steps<DIR, false>(L, c & 1, c0, myrow, l15, Sa, Sb, ykeep);
    stage_compute(c + 1);
    __syncthreads();
    write_bonus(c + 1);
  }
#pragma unroll 1
  for (int c = 16; c < NCH; ++c) {
    const int bsel = c & 1;
    if (c + 1 < NCH) stage_load(c + 1);
    scan_steps<DIR, true>(L, bsel, c0, myrow, l15, Sa, Sb, ykeep);
    L.yy[bsel][l15][myrow] = ykeep;
    if (c + 1 < NCH) stage_compute(c + 1);
    __syncthreads();
    {
      bool isctx; const int rb = chunk_rowbase(c, isctx);
      f16* Y = dir ? p.Y1 : p.Y0;
      Y[(size_t)(rb + (tid >> 4)) * DM + h * 64 + q * 16 + (tid & 15)] = (f16)(L.yy[bsel][tid >> 4][tid & 15] * 0.0625f);
    }
    if (c + 1 < NCH) write_bonus(c + 1);
  }
}

DI void phase_scan(const Params& p, char* smem) {
  ScanLds& L = *(ScanLds*)smem;
  for (int item = blockIdx.x; item < 512; item += gridDim.x) {
    int sc, q;
    if (gridDim.x == 512) { const int xcd = item & 7, slot = item >> 3; sc = xcd * 16 + (slot >> 2); q = slot & 3; }
    else { sc = item >> 2; q = item & 3; }
    const int dir = sc & 1, bh = sc >> 1, b = bh >> 4, h = bh & 15;
    if (dir) scan_item<1>(p, L, b, h, q); else scan_item<0>(p, L, b, h, q);
  }
}

DI void phase_readout(const Params& p, char* smem) {
  float* Cs = (float*)smem;
  const int tid = threadIdx.x;
  int g0, gend, gstep; work_range(256 * 8, g0, gend, gstep);
  for (int tile = g0; tile < gend; tile += gstep) {
    int mt, nt; band_decode(tile, 256, 8, mt, nt);
    const int m0 = mt * 128;
    f32x16 acc[2][2];
    gemm_mainloop(smem, 1, 192,
                  [&](int r, int) { return (const u16*)(p.LG + (size_t)(m0 + r) * 192); },
                  [&](int c) { return (const u16*)(p.g2_t + (size_t)(nt * 128 + c) * 192); }, acc);
    acc_to_lds(Cs, acc);
    const int lane = tid & 63, wave = tid >> 6;
    const int head = nt * 2 + (lane >> 5);
    const int col = nt * 128 + 2 * lane;
    const float gw0 = p.gn_w[col], gw1 = p.gn_w[col + 1], gb0 = p.gn_b[col], gb1 = p.gn_b[col + 1];
#pragma unroll 2
    for (int rr = 0; rr < 32; ++rr) {
      const int r = wave * 32 + rr;
      const int row = m0 + r;
      const unsigned ua = *(const unsigned*)(p.Y0 + (size_t)row * DM + col), ub = *(const unsigned*)(p.Y1 + (size_t)row * DM + col);
      const unsigned uv = *(const unsigned*)(p.V16 + (size_t)row * DM + col);
      const f16* fa = (const f16*)&ua; const f16* fb = (const f16*)&ub; const f16* fv = (const f16*)&uv;
      const float y0 = ((float)fa[0] + (float)fb[0]) * 16.f, y1 = ((float)fa[1] + (float)fb[1]) * 16.f;
      float sm = y0 + y1;
      sm = sum32(sm);
      const float mean = sm * (1.f / 64.f);
      const float d0 = y0 - mean, d1 = y1 - mean;
      float vs = d0 * d0 + d1 * d1;
      vs = sum32(vs);
      const float rstd = rsqrtf(vs * (1.f / 64.f) + 64e-5f);
      const float bon = p.bonus[((size_t)0 * MR + row) * 16 + head] + p.bonus[((size_t)1 * MR + row) * 16 + head];
      const float2 g = *(const float2*)&CS(r, 2 * lane);
      const float z0 = (d0 * rstd * gw0 + gb0 + bon * (float)fv[0]) * g.x;
      const float z1 = (d1 * rstd * gw1 + gb1 + bon * (float)fv[1]) * g.y;
      *(unsigned*)(p.Z + (size_t)row * DM + col) = pack2(z0, z1);
    }
  }
}

DI void phase_final(const Params& p) {
  const int lane = threadIdx.x & 63;
  const int gw = blockIdx.x * 4 + (threadIdx.x >> 6), nw = gridDim.x * 4;
  for (int row = gw; row < TL; row += nw) {
    float* src = p.out + (size_t)row * DM;
    float4 v[4];
    float ss = 0.f;
#pragma unroll
    for (int i = 0; i < 4; ++i) {
      v[i] = *(const float4*)(src + i * 256 + lane * 4);
      ss += v[i].x * v[i].x + v[i].y * v[i].y + v[i].z * v[i].z + v[i].w * v[i].w;
    }
    ss = wave_sum(ss);
    const float rinv = rsqrtf(ss * (1.f / 1024.f) + 1e-6f);
#pragma unroll
    for (int i = 0; i < 4; ++i) {
      const float4 g = *(const float4*)(p.final_gain + i * 256 + lane * 4);
      float4 o;
      o.x = v[i].x * rinv * g.x; o.y = v[i].y * rinv * g.y; o.z = v[i].z * rinv * g.z; o.w = v[i].w * rinv * g.w;
      *(float4*)(src + i * 256 + lane * 4) = o;
    }
  }
}

#define XB_TMO      128
#define XB_XCNT(j)  (256  + 64 * (j))
#define XB_XSUB(j)  (1280 + 64 * (j))
#define XB_XGEN(j)  (2304 + 64 * (j))
#define XB_TOP      3328
#define XB_TOPGEN   3392
#define XB_SPIN_CAP (1u << 20)
DI unsigned xb_ld(unsigned* p) { return __hip_atomic_load(p, __ATOMIC_RELAXED, __HIP_MEMORY_SCOPE_AGENT); }
DI unsigned xb_add(unsigned* p, unsigned v) { return __hip_atomic_fetch_add(p, v, __ATOMIC_RELAXED, __HIP_MEMORY_SCOPE_AGENT); }
DI unsigned xb_xcc_id() { return (unsigned)__builtin_amdgcn_s_getreg((3 << 11) | 20) & 0xFu; }
#define XB_SPIN(cond, bar) do { unsigned _sp = 0; while (cond) { __builtin_amdgcn_s_sleep(1); \
    if ((++_sp & 255u) == 0u) { if (xb_ld(&(bar)[XB_TMO])) break; if (_sp > XB_SPIN_CAP) { atomicAdd(&(bar)[XB_TMO], 1u); break; } } } } while (0)
struct XbState { unsigned x, nloc, nx; };
DI void xb_census(unsigned* bar, unsigned x, unsigned& nloc, unsigned& nx) {
  const unsigned G = gridDim.x;
  unsigned sum, cnt, mine, sp = 0u;
  for (;;) {
    sum = 0u; cnt = 0u; mine = 0u;
#pragma unroll
    for (unsigned j = 0; j < 16; ++j) { const unsigned c = xb_ld(&bar[XB_XCNT(j)]); sum += c; cnt += (c > 0u) ? 1u : 0u; mine = (j == x) ? c : mine; }
    if (sum == G) break;
    __builtin_amdgcn_s_sleep(1);
    if ((++sp & 255u) == 0u) { if (xb_ld(&bar[XB_TMO])) break; if (sp > XB_SPIN_CAP) { atomicAdd(&bar[XB_TMO], 1u); break; } }
  }
  nloc = mine > 0u ? mine : 1u; nx = cnt > 0u ? cnt : 1u;
}
DI void grid_barrier(unsigned* bar, XbState& st) {
  asm volatile("s_waitcnt vmcnt(0)" ::: "memory");
  __syncthreads();
  if (threadIdx.x == 0) {
    __builtin_amdgcn_s_waitcnt(0);
    if (st.nloc == 0u) xb_census(bar, st.x, st.nloc, st.nx);
    const unsigned nloc = st.nloc, nx = st.nx;
    const unsigned old = xb_add(&bar[XB_XSUB(st.x)], 1u);
    const unsigned gen = old / nloc;
    if (old + 1u == (gen + 1u) * nloc) {
      __builtin_amdgcn_fence(__ATOMIC_RELEASE, "agent");
      asm volatile("s_waitcnt vmcnt(0)" ::: "memory");
      const unsigned og = xb_add(&bar[XB_TOP], 1u);
      const unsigned tg = og / nx;
      if (og + 1u == (tg + 1u) * nx) xb_add(&bar[XB_TOPGEN], 1u);
      else XB_SPIN(xb_ld(&bar[XB_TOPGEN]) == tg, bar);
      __builtin_amdgcn_fence(__ATOMIC_ACQUIRE, "agent");
      xb_add(&bar[XB_XGEN(st.x)], 1u);
      asm volatile("s_waitcnt vmcnt(0)" ::: "memory");
    } else {
      XB_SPIN(xb_ld(&bar[XB_XGEN(st.x)]) == gen, bar);
      __builtin_amdgcn_fence(__ATOMIC_ACQUIRE, "agent");
      asm volatile("s_waitcnt vmcnt(0)" ::: "memory");
    }
  }
  __syncthreads();
}

__global__ void __launch_bounds__(256, 2) mega(Params p) {
  __shared__ __attribute__((aligned(16))) char smem[65536];
  cg::grid_group grid = cg::this_grid();
  XbState xst; xst.x = xb_xcc_id(); xst.nloc = 0u; xst.nx = 0u;
  if (threadIdx.x == 0) (void)xb_add(&p.bar[XB_XCNT(xst.x)], 1u);
  phase_prep(p, smem); grid.sync();
  phase_modreduce(p); grid_barrier(p.bar, xst);
  phase_modulate<true>(p, 0, 0, MR); grid_barrier(p.bar, xst);
  phase_qkv(p, smem); grid_barrier(p.bar, xst);
  phase_attn(p, smem); grid_barrier(p.bar, xst);
  phase_proj_res<true>(p, smem, p.H, 1024, 1024, p.wo_t, 0, 2, 264); grid_barrier(p.bar, xst);
  phase_modulate<false>(p, 0, 1, MR); grid_barrier(p.bar, xst);
  phase_ffn_up(p, smem, 0, true, p.ACT0); grid_barrier(p.bar, xst);
  phase_proj_res<false>(p, smem, p.ACT0, DFF, DFF, p.down_t, 0, 5, 264); grid_barrier(p.bar, xst);
  phase_rwkv_shift(p); grid_barrier(p.bar, xst);
  phase_rwkv_gemms(p, smem); grid_barrier(p.bar, xst);
  phase_scan(p, smem); grid_barrier(p.bar, xst);
  phase_readout(p, smem); grid_barrier(p.bar, xst);
  phase_proj_res<false>(p, smem, p.Z, 1024, 1024, p.ro_t, 1, 2, 256); grid_barrier(p.bar, xst);
  phase_modulate<false>(p, 1, 1, TL); grid_barrier(p.bar, xst);
  phase_ffn_up(p, smem, 1, false, p.ACT1); grid_barrier(p.bar, xst);
  phase_proj_res<false>(p, smem, p.ACT1, DFF, DFF, p.down_t + (size_t)1024 * 2816, 1, 5, 256); grid_barrier(p.bar, xst);
  phase_final(p);
}

extern "C" void kernel_launch(void* const* d_in, const int* in_sizes, int n_in, void* d_out, int out_size, void* d_ws, size_t ws_size,
                              hipStream_t stream) {
  static int grid_blocks = 0;
  if (!grid_blocks) {
    int dev = 0, cus = 0, per_cu = 0;
    hipGetDevice(&dev);
    hipDeviceGetAttribute(&cus, hipDeviceAttributeMultiprocessorCount, dev);
    hipOccupancyMaxActiveBlocksPerMultiprocessor(&per_cu, mega, 256, 0);
    if (per_cu > 2) per_cu = 2;
    if (per_cu < 1) per_cu = 1;
    grid_blocks = cus * per_cu;
  }
  Params p{};
  const float* const* in = (const float* const*)d_in;
  p.x = in[0]; p.c = in[1]; p.ctx = in[2]; p.c_ctx = in[3]; p.ada_w = in[4]; p.ada_b = in[5]; p.w_qkv = in[6]; p.q_gain = in[7];
  p.k_gain = in[8]; p.w_o = in[9]; p.mu = in[10]; p.rw_r = in[11]; p.rw_k = in[12]; p.rw_v = in[13]; p.rw_o = in[14]; p.dw0 = in[15];
  p.dw1 = in[16]; p.dw2 = in[17]; p.a0 = in[18]; p.a1 = in[19]; p.a2 = in[20]; p.g1 = in[21]; p.g2 = in[22]; p.k_k = in[23];
  p.k_a = in[24]; p.r_k = in[25]; p.gn_w = in[26]; p.gn_b = in[27]; p.f_up = in[28]; p.f_cw = in[29]; p.f_cb = in[30];
  p.f_down = in[31]; p.final_gain = in[32];
  p.out = (float*)d_out;
  char* w = (char*)d_ws;
  size_t off = 0;
  auto take = [&](size_t bytes) { char* r = w + off; off += (bytes + 255) & ~(size_t)255; return r; };
  p.qkv_t = (u16*)take((size_t)1536 * 1024 * 2);
  p.wo_t = (u16*)take((size_t)1024 * 1024 * 2);
  p.up_t = (u16*)take((size_t)2 * 5632 * 1024 * 2);
  p.down_t = (u16*)take((size_t)2 * 1024 * 2816 * 2);
  p.rr_t = (u16*)take((size_t)1024 * 2048 * 2);
  p.rk_t = (u16*)take((size_t)1024 * 2048 * 2);
  p.rv_t = (u16*)take((size_t)1024 * 2048 * 2);
  p.ro_t = (u16*)take((size_t)1024 * 1024 * 2);
  p.w1_t = (u16*)take((size_t)128 * 2048 * 2);
  p.a1_t = (u16*)take((size_t)128 * 2048 * 2);
  p.g1_t = (u16*)take((size_t)256 * 2048 * 2);
  p.w2_t = (u16*)take((size_t)2 * 1024 * 64 * 2);
  p.a2_t = (u16*)take((size_t)2 * 1024 * 64 * 2);
  p.g2_t = (u16*)take((size_t)1024 * 192 * 2);
  p.modpart = (float*)take((size_t)2 * 8 * 5 * 6144 * 4);
  p.modv = (float*)take((size_t)2 * 5 * 6144 * 4);
  p.rope = (float*)take((size_t)8192 * 32 * 2 * 4);
  p.XC = (float*)take((size_t)TCX * DM * 4);
  p.bonus = (float*)take((size_t)2 * MR * 16 * 4);
  p.zero = (u16*)take(8192);
  p.bar = (unsigned*)take(65536);
  const size_t pb = off;
  p.H = (u16*)take((size_t)MR * DM * 2);
  const size_t after_h = off;
  p.Q = (u16*)take((size_t)TL * DM * 2);
  p.QC = (u16*)take((size_t)TCX * DM * 2);
  p.Kb = (u16*)take((size_t)16 * NKEY * 64 * 2);
  p.Vt = (u16*)take((size_t)16 * NKEY * 64 * 2);
  p.ACT0 = (u16*)take((size_t)MR * DFF * 2);
  const size_t end0 = off;
  off = after_h;
  p.XX = (u16*)take((size_t)MR * DM * 2);
  p.R16 = (f16*)take((size_t)TL * DM * 2);
  p.K16 = (f16*)take((size_t)MR * DM * 2);
  p.V16 = (f16*)take((size_t)MR * DM * 2);
  p.KK16 = (f16*)take((size_t)MR * DM * 2);
  p.LW = (u16*)take((size_t)MR * 128 * 2);
  p.LA = (u16*)take((size_t)MR * 128 * 2);
  p.LG = (u16*)take((size_t)TL * 192 * 2);
  const size_t end1 = off;
  p.Y0 = (f16*)p.H;
  p.Y1 = (f16*)p.XX;
  p.Z = (u16*)p.R16;
  p.ACT1 = (u16*)p.K16;
  (void)pb;
  const size_t need = end0 > end1 ? end0 : end1;
  if (need > ws_size) { fprintf(stderr, "workspace too small: need %zu have %zu\n", need, ws_size); return; }
  hipMemsetAsync(p.bar, 0, 65536, stream);
  void* args[] = {&p};
  hipError_t e = hipLaunchCooperativeKernel((void*)mega, dim3(grid_blocks), dim3(256), args, 0, stream);
  if (e != hipSuccess) fprintf(stderr, "cooperative launch failed: %s (grid %d)\n", hipGetErrorString(e), grid_blocks);
}
```

```cpp
#include <hip/hip_runtime.h>
#include <hip/hip_cooperative_groups.h>
#include <cstdio>
#include <cstdint>
namespace cg = cooperative_groups;

typedef unsigned short u16;
typedef _Float16 f16;
using bf16x8 = __attribute__((ext_vector_type(8))) short;
using f32x16 = __attribute__((ext_vector_type(16))) float;
using f32x4 = __attribute__((ext_vector_type(4))) float;
using u32x4 = __attribute__((ext_vector_type(4))) unsigned;
#define DI __device__ __forceinline__
DI u32x4 mk4(unsigned a, unsigned b, unsigned c, unsigned d) { u32x4 r; r[0] = a; r[1] = b; r[2] = c; r[3] = d; return r; }

constexpr int TL = 32768;
constexpr int TCX = 1024;
constexpr int MR = 33792;
constexpr int DM = 1024;
constexpr int DFF = 2816;
constexpr int NKEY = 8448;
constexpr int NPHASE = 18;
#define XB_CU(j)    (4096 + (j))
#define XB_N0       8192
#define XB_N1       8256

struct Params {
  const float *x, *c, *ctx, *c_ctx, *ada_w, *ada_b, *w_qkv, *q_gain, *k_gain, *w_o;
  const float *mu, *rw_r, *rw_k, *rw_v, *rw_o, *dw0, *dw1, *dw2, *a0, *a1, *a2, *g1, *g2, *k_k, *k_a, *r_k, *gn_w, *gn_b;
  const float *f_up, *f_cw, *f_cb, *f_down, *final_gain;
  float* out;
  u16 *qkv_t, *wo_t, *up_t, *down_t, *rr_t, *rk_t, *rv_t, *ro_t, *w1_t, *a1_t, *g1_t, *w2_t, *a2_t, *g2_t;
  float *modpart, *modv, *rope, *XC, *bonus;
  u16* zero;
  unsigned* bar;
  unsigned* blkinfo;
  u16 *H, *XX, *Q, *QC, *Kb, *Vt, *ACT0, *ACT1;
  f16 *R16, *K16, *V16, *KK16, *Y0, *Y1;
  u16 *LW, *LA, *LG, *Z;
  int phase_lo, phase_hi;
};

typedef __bf16 bf16x2_t __attribute__((ext_vector_type(2)));
typedef float f32x2 __attribute__((ext_vector_type(2)));
DI unsigned pack2(float a, float b) { f32x2 f = {a, b}; return __builtin_bit_cast(unsigned, __builtin_convertvector(f, bf16x2_t)); }
DI u16 f2bf(float x) { return (u16)(pack2(x, 0.f) & 0xffffu); }
DI float bf2f(u16 h) { return __uint_as_float(((unsigned)h) << 16); }
DI float wave_sum(float v) {
#pragma unroll
  for (int o = 32; o > 0; o >>= 1) v += __shfl_xor(v, o, 64);
  return v;
}
template <int CTRL> DI float dpp_mov(float v) { return __builtin_bit_cast(float, __builtin_amdgcn_update_dpp(0, __builtin_bit_cast(int, v), CTRL, 0xF, 0xF, false)); }
DI float dpp_sum16(float v) {
  v += dpp_mov<0x128>(v);
  v += dpp_mov<0x124>(v);
  v += dpp_mov<0x122>(v);
  v += dpp_mov<0x121>(v);
  return v;
}
DI float sum32(float v) { v = dpp_sum16(v); v += __shfl_xor(v, 16, 64); return v; }
DI float sigmoidf_(float x) { return 1.f / (1.f + __expf(-x)); }
DI float sigmoid_fast(float x) { return __builtin_amdgcn_rcpf(1.f + __expf(-x)); }
DI int midx_of(int row) { return row < TL ? (row >> 13) : 4; }
DI float* resid_ptr(const Params& p, int row) { return row < TL ? p.out + (size_t)row * DM : p.XC + (size_t)(row - TL) * DM; }
DI const float* xin_ptr(const Params& p, int row) { return row < TL ? p.x + (size_t)row * DM : p.ctx + (size_t)(row - TL) * DM; }

DI void work_range(int total, int& g0, int& gend, int& step) {
  if ((gridDim.x & 7) == 0) {
    const int x = blockIdx.x & 7, li = blockIdx.x >> 3, nl = gridDim.x >> 3;
    const int lo = (int)(((long long)total * x) >> 3), hi = (int)(((long long)total * (x + 1)) >> 3);
    g0 = lo + li; gend = hi; step = nl;
  } else { g0 = blockIdx.x; gend = total; step = gridDim.x; }
}
DI void band_decode(int g, int MT, int NT, int& mt, int& nt) {
  const int per = 8 * NT;
  const int band = g / per, r = g - band * per;
  int hb = MT - band * 8; if (hb > 8) hb = 8;
  nt = r / hb; mt = band * 8 + (r - nt * hb);
}

template <class AF, class BF>
DI void gemm_mainloop(char* smem, int nparts, int kpart, AF arow, BF brow, f32x16 (&acc)[2][2]) {
  const int tid = threadIdx.x, lane = tid & 63, wave = tid >> 6;
  const int wm = wave >> 1, wn = wave & 1;
  const int lr = tid >> 3, lc = tid & 7;
#pragma unroll
  for (int i = 0; i < 2; ++i)
#pragma unroll
    for (int j = 0; j < 2; ++j)
#pragma unroll
      for (int e = 0; e < 16; ++e) acc[i][j][e] = 0.f;
  const int csrc = (lc ^ ((lr >> 1) & 7)) * 8;
  const u16* bp[4];
  const u16* ap[4];
#pragma unroll
  for (int q = 0; q < 4; ++q) { bp[q] = brow(lr + 32 * q) + csrc; ap[q] = arow(lr + 32 * q, 0) + csrc; }
  const int nk = kpart >> 6;
  const int total = nparts * nk;
  const int sw = (lane >> 1) & 7;
  const int hsel = lane >> 5;
  char* const wbase = smem + wave * 1024;
  auto stage = [&](int buf, int kk, int boff) {
#pragma unroll
    for (int q = 0; q < 4; ++q) {
      __builtin_amdgcn_global_load_lds((const unsigned*)(ap[q] + kk), (unsigned*)(wbase + buf * 32768 + q * 4096), 16, 0, 0);
      __builtin_amdgcn_global_load_lds((const unsigned*)(bp[q] + boff), (unsigned*)(wbase + buf * 32768 + 16384 + q * 4096), 16, 0, 0);
    }
  };
  __syncthreads();
  stage(0, 0, 0);
  asm volatile("s_waitcnt vmcnt(0)" ::: "memory");
  __syncthreads();
  int part = 0, kk = 0, buf = 0;
#pragma unroll 1
  for (int it = 0; it < total; ++it) {
    kk += 64;
    if (kk == kpart) {
      kk = 0; ++part;
      if (part < nparts) {
#pragma unroll
        for (int q = 0; q < 4; ++q) ap[q] = arow(lr + 32 * q, part) + csrc;
      }
    }
    if (it + 1 < total) stage(buf ^ 1, kk, part * kpart + kk);
    const u16* As = (const u16*)(smem + buf * 32768);
    const u16* Bs = As + 128 * 64;
    bf16x8 af[2][2], bf[2][2];
    const u16* Ar = As + (wm * 64 + (lane & 31)) * 64;
    const u16* Br = Bs + (wn * 64 + (lane & 31)) * 64;
    {
      const int pc = (hsel ^ sw) * 8;
#pragma unroll
      for (int i = 0; i < 2; ++i) { af[0][i] = *(const bf16x8*)(Ar + i * 2048 + pc); bf[0][i] = *(const bf16x8*)(Br + i * 2048 + pc); }
    }
#pragma unroll
    for (int ks = 0; ks < 4; ++ks) {
      const int cur = ks & 1;
      if (ks + 1 < 4) {
        const int pc = (((ks + 1) * 2 + hsel) ^ sw) * 8;
#pragma unroll
        for (int i = 0; i < 2; ++i) { af[cur ^ 1][i] = *(const bf16x8*)(Ar + i * 2048 + pc); bf[cur ^ 1][i] = *(const bf16x8*)(Br + i * 2048 + pc); }
      }
#pragma unroll
      for (int i = 0; i < 2; ++i)
#pragma unroll
        for (int j = 0; j < 2; ++j) acc[i][j] = __builtin_amdgcn_mfma_f32_32x32x16_bf16(af[cur][i], bf[cur][j], acc[i][j], 0, 0, 0);
      __builtin_amdgcn_sched_barrier(0);
    }
    asm volatile("s_waitcnt vmcnt(0)" ::: "memory");
    __syncthreads();
    buf ^= 1;
  }
}

template <class F>
DI void epi_direct(const f32x16 (&acc)[2][2], F f) {
  const int lane = threadIdx.x & 63, wave = threadIdx.x >> 6;
  const int wm = wave >> 1, wn = wave & 1, h = lane >> 5;
#pragma unroll
  for (int i = 0; i < 2; ++i)
#pragma unroll
    for (int j = 0; j < 2; ++j)
#pragma unroll
      for (int e = 0; e < 16; ++e) {
        const int row = wm * 64 + i * 32 + (e & 3) + 8 * (e >> 2) + 4 * h;
        const int col = wn * 64 + j * 32 + (lane & 31);
        f(row, col, acc[i][j][e]);
      }
}
#define CS(r, c) Cs[(r) * 128 + (c)]
DI void acc_to_lds(float* Cs, const f32x16 (&acc)[2][2]) {
  __syncthreads();
  epi_direct(acc, [&](int r, int c, float v) { CS(r, c) = v; });
  __syncthreads();
}

struct TJob { const float* src; int srcK, srcN; u16* dst; int ld, koff; const float* mu; int Kpad, Npad; };
DI TJob get_job(const Params& p, int j) {
  TJob t; t.mu = nullptr; t.koff = 0;
  auto set = [&](const float* s, int K, int N, u16* d, int ld) { t.src = s; t.srcK = K; t.srcN = N; t.dst = d; t.ld = ld; t.Kpad = K; t.Npad = N; };
  switch (j) {
    case 0: set(p.w_qkv, 1024, 1536, p.qkv_t, 1024); break;
    case 1: set(p.w_o, 1024, 1024, p.wo_t, 1024); break;
    case 2: set(p.f_up, 1024, 5632, p.up_t, 1024); break;
    case 3: set(p.f_up + (size_t)1024 * 5632, 1024, 5632, p.up_t + (size_t)5632 * 1024, 1024); break;
    case 4: set(p.f_down, 2816, 1024, p.down_t, 2816); break;
    case 5: set(p.f_down + (size_t)2816 * 1024, 2816, 1024, p.down_t + (size_t)1024 * 2816, 2816); break;
    case 6: set(p.rw_r, 1024, 1024, p.rr_t, 2048); break;
    case 7: set(p.rw_r, 1024, 1024, p.rr_t, 2048); t.mu = p.mu + 0 * 1024; t.koff = 1024; break;
    case 8: set(p.rw_k, 1024, 1024, p.rk_t, 2048); break;
    case 9: set(p.rw_k, 1024, 1024, p.rk_t, 2048); t.mu = p.mu + 2 * 1024; t.koff = 1024; break;
    case 10: set(p.rw_v, 1024, 1024, p.rv_t, 2048); break;
    case 11: set(p.rw_v, 1024, 1024, p.rv_t, 2048); t.mu = p.mu + 3 * 1024; t.koff = 1024; break;
    case 12: set(p.rw_o, 1024, 1024, p.ro_t, 1024); break;
    case 13: set(p.dw1, 1024, 64, p.w1_t, 2048); break;
    case 14: set(p.dw1, 1024, 64, p.w1_t, 2048); t.mu = p.mu + 1 * 1024; t.koff = 1024; break;
    case 15: set(p.dw1 + 1024 * 64, 1024, 64, p.w1_t + 64 * 2048, 2048); break;
    case 16: set(p.dw1 + 1024 * 64, 1024, 64, p.w1_t + 64 * 2048, 2048); t.mu = p.mu + 1 * 1024; t.koff = 1024; break;
    case 17: set(p.a1, 1024, 64, p.a1_t, 2048); break;
    case 18: set(p.a1, 1024, 64, p.a1_t, 2048); t.mu = p.mu + 4 * 1024; t.koff = 1024; break;
    case 19: set(p.a1 + 1024 * 64, 1024, 64, p.a1_t + 64 * 2048, 2048); break;
    case 20: set(p.a1 + 1024 * 64, 1024, 64, p.a1_t + 64 * 2048, 2048); t.mu = p.mu + 4 * 1024; t.koff = 1024; break;
    case 21: set(p.g1, 1024, 160, p.g1_t, 2048); t.Npad = 256; break;
    case 22: set(p.g1, 1024, 160, p.g1_t, 2048); t.Npad = 256; t.mu = p.mu + 5 * 1024; t.koff = 1024; break;
    case 23: set(p.dw2, 64, 1024, p.w2_t, 64); break;
    case 24: set(p.dw2 + 64 * 1024, 64, 1024, p.w2_t + 1024 * 64, 64); break;
    case 25: set(p.a2, 64, 1024, p.a2_t, 64); break;
    case 26: set(p.a2 + 64 * 1024, 64, 1024, p.a2_t + 1024 * 64, 64); break;
    default: set(p.g2, 160, 1024, p.g2_t, 192); t.Kpad = 192; break;
  }
  return t;
}
constexpr int NJOBS = 28;
DI int job_tiles(const TJob& t) { return ((t.Kpad + 63) >> 6) * ((t.Npad + 63) >> 6); }

DI void phase_prep(const Params& p, char* smem) {
  const int tid = threadIdx.x;
  int ttiles = 0;
  for (int j = 0; j < NJOBS; ++j) ttiles += job_tiles(get_job(p, j));
  const int n_mod = 2 * 24 * 8;
  const int n_rope = 1024;
  const int total = ttiles + n_mod + n_rope;
  float* tile = (float*)smem;
  if (blockIdx.x == 0) for (int e = tid; e < 4096; e += 256) p.zero[e] = 0;
  for (int item = blockIdx.x; item < total; item += gridDim.x) {
    if (item < ttiles) {
      int rem = item, j = 0;
      TJob t = get_job(p, 0);
      while (true) { int n = job_tiles(t); if (rem < n) break; rem -= n; ++j; t = get_job(p, j); }
      const int ntn = (t.Npad + 63) >> 6;
      const int kt = rem / ntn, nt = rem % ntn;
      __syncthreads();
#pragma unroll
      for (int i = 0; i < 16; ++i) {
        const int kl = i * 4 + (tid >> 6), nl = tid & 63;
        const int k = kt * 64 + kl, n = nt * 64 + nl;
        float v = 0.f;
        if (k < t.srcK && n < t.srcN) { v = t.src[(size_t)k * t.srcN + n]; if (t.mu) v *= t.mu[k]; }
        tile[kl * 65 + nl] = v;
      }
      __syncthreads();
#pragma unroll
      for (int i = 0; i < 16; ++i) {
        const int nl = i * 4 + (tid >> 6), kl = tid & 63;
        const int k = kt * 64 + kl, n = nt * 64 + nl;
        if (k < t.Kpad && n < t.Npad) t.dst[(size_t)n * t.ld + t.koff + k] = f2bf(tile[kl * 65 + nl]);
      }
    } else if (item < ttiles + n_mod) {
      const int it = item - ttiles;
      const int layer = it / 192, cc = (it % 192) / 8, kc = it % 8;
      float* sil = (float*)smem;
      __syncthreads();
      for (int e = tid; e < 640; e += 256) {
        const int j = e >> 7, k = kc * 128 + (e & 127);
        const float v = j < 4 ? p.c[j * 1024 + k] : p.c_ctx[k];
        sil[e] = v / (1.f + __expf(-v));
      }
      __syncthreads();
      const int col = cc * 256 + tid;
      float a0 = 0, a1 = 0, a2 = 0, a3 = 0, a4 = 0;
      const float* w = p.ada_w + ((size_t)layer * 1024 + kc * 128) * 6144 + col;
#pragma unroll 16
      for (int k = 0; k < 128; ++k) {
        const float wv = w[(size_t)k * 6144];
        a0 += sil[k] * wv; a1 += sil[128 + k] * wv; a2 += sil[256 + k] * wv; a3 += sil[384 + k] * wv; a4 += sil[512 + k] * wv;
      }
      float* mp = p.modpart + ((size_t)(layer * 8 + kc) * 5) * 6144 + col;
      mp[0] = a0; mp[6144] = a1; mp[2 * 6144] = a2; mp[3 * 6144] = a3; mp[4 * 6144] = a4;
    } else {
      const int e = (item - ttiles - n_mod) * 256 + tid;
      const int s = e >> 5, pr = e & 31;
      const int f = pr & 15;
      const float inv_freq = powf(10000.f, -(float)f / 16.f);
      const float pos = (pr < 16) ? (float)(s >> 6) : (float)(s & 63);
      const float ang = pos * inv_freq;
      float sn, cs;
      sincosf(ang, &sn, &cs);
      p.rope[e * 2] = cs; p.rope[e * 2 + 1] = sn;
    }
  }
}

DI void phase_modreduce(const Params& p) {
  const int n = 2 * 5 * 6144;
  for (int e = blockIdx.x * 256 + threadIdx.x; e < n; e += gridDim.x * 256) {
    const int layer = e / (5 * 6144), r = e % (5 * 6144), col = r % 6144;
    float s = p.ada_b[layer * 6144 + col];
    for (int kc = 0; kc < 8; ++kc) s += p.modpart[(size_t)(layer * 8 + kc) * 5 * 6144 + r];
    p.modv[e] = s;
  }
}

template <bool FROM_INPUT>
DI void phase_modulate(const Params& p, int layer, int which, int nrows) {
  const int lane = threadIdx.x & 63;
  const int gw = blockIdx.x * 4 + (threadIdx.x >> 6), nw = gridDim.x * 4;
  for (int row = gw; row < nrows; row += nw) {
    const float* src = FROM_INPUT ? xin_ptr(p, row) : resid_ptr(p, row);
    const float* mv = p.modv + ((size_t)layer * 5 + midx_of(row)) * 6144 + which * 3072;
    float4 v[4];
    float ss = 0.f;
#pragma unroll
    for (int i = 0; i < 4; ++i) {
      v[i] = *(const float4*)(src + i * 256 + lane * 4);
      ss += v[i].x * v[i].x + v[i].y * v[i].y + v[i].z * v[i].z + v[i].w * v[i].w;
    }
    ss = wave_sum(ss);
    const float rinv = rsqrtf(ss * (1.f / 1024.f) + 1e-6f);
#pragma unroll
    for (int i = 0; i < 4; ++i) {
      const int col = i * 256 + lane * 4;
      const float4 sh = *(const float4*)(mv + col);
      const float4 sc = *(const float4*)(mv + 1024 + col);
      uint2 o;
      o.x = pack2(v[i].x * rinv * (1.f + sc.x) + sh.x, v[i].y * rinv * (1.f + sc.y) + sh.y);
      o.y = pack2(v[i].z * rinv * (1.f + sc.z) + sh.z, v[i].w * rinv * (1.f + sc.w) + sh.w);
      *(uint2*)(p.H + (size_t)row * DM + col) = o;
    }
  }
}

DI void modrow(const Params& p, int row, bool valid, int lane, float (&h)[16]) {
  if (!valid) {
#pragma unroll
    for (int i = 0; i < 16; ++i) h[i] = 0.f;
    return;
  }
  const float* src = resid_ptr(p, row);
  const float* mv = p.modv + ((size_t)1 * 5 + midx_of(row)) * 6144;
  float ss = 0.f;
#pragma unroll
  for (int i = 0; i < 4; ++i) {
    const float4 v = *(const float4*)(src + i * 256 + lane * 4);
    h[i * 4 + 0] = v.x; h[i * 4 + 1] = v.y; h[i * 4 + 2] = v.z; h[i * 4 + 3] = v.w;
    ss += v.x * v.x + v.y * v.y + v.z * v.z + v.w * v.w;
  }
  ss = wave_sum(ss);
  const float rinv = rsqrtf(ss * (1.f / 1024.f) + 1e-6f);
#pragma unroll
  for (int i = 0; i < 4; ++i) {
    const int col = i * 256 + lane * 4;
    const float4 sh = *(const float4*)(mv + col);
    const float4 sc = *(const float4*)(mv + 1024 + col);
    h[i * 4 + 0] = h[i * 4 + 0] * rinv * (1.f + sc.x) + sh.x;
    h[i * 4 + 1] = h[i * 4 + 1] * rinv * (1.f + sc.y) + sh.y;
    h[i * 4 + 2] = h[i * 4 + 2] * rinv * (1.f + sc.z) + sh.z;
    h[i * 4 + 3] = h[i * 4 + 3] * rinv * (1.f + sc.w) + sh.w;
  }
}
DI void phase_rwkv_shift(const Params& p) {
  const int lane = threadIdx.x & 63;
  const int gw = blockIdx.x * 4 + (threadIdx.x >> 6), nw = gridDim.x * 4;
  const int nitems = MR / 8;
  for (int item = gw; item < nitems; item += nw) {
    const int r0 = item * 8;
    int sb, T;
    if (r0 < TL) { sb = r0 & ~8191; T = 8192; } else { sb = TL + ((r0 - TL) & ~255); T = 256; }
    float hm[16], hc[16], hn[16];
    modrow(p, r0 - 1, r0 - 1 >= sb, lane, hm);
    modrow(p, r0, true, lane, hc);
    for (int j = 0; j < 8; ++j) {
      const int row = r0 + j;
      modrow(p, row + 1, row + 1 < sb + T, lane, hn);
#pragma unroll
      for (int i = 0; i < 4; ++i) {
        const int col = i * 256 + lane * 4;
        float xx[4];
#pragma unroll
        for (int e = 0; e < 4; ++e) xx[e] = 0.5f * (hm[i * 4 + e] + hn[i * 4 + e]) - hc[i * 4 + e];
        uint2 o, o2;
        o.x = pack2(hc[i * 4 + 0], hc[i * 4 + 1]); o.y = pack2(hc[i * 4 + 2], hc[i * 4 + 3]);
        o2.x = pack2(xx[0], xx[1]); o2.y = pack2(xx[2], xx[3]);
        *(uint2*)(p.H + (size_t)row * DM + col) = o;
        *(uint2*)(p.XX + (size_t)row * DM + col) = o2;
      }
#pragma unroll
      for (int i = 0; i < 16; ++i) { hm[i] = hc[i]; hc[i] = hn[i]; }
    }
  }
}

DI void phase_qkv(const Params& p, char* smem) {
  float* Cs = (float*)smem;
  const int tid = threadIdx.x;
  int g0, gend, gstep; work_range(264 * 12, g0, gend, gstep);
  for (int tile = g0; tile < gend; tile += gstep) {
    int mt, nt; band_decode(tile, 264, 12, mt, nt);
    const int m0 = mt * 128;
    f32x16 acc[2][2];
    gemm_mainloop(smem, 1, 1024,
                  [&](int r, int) { return (const u16*)(p.H + (size_t)(m0 + r) * DM); },
                  [&](int c) { return (const u16*)(p.qkv_t + (size_t)(nt * 128 + c) * 1024); }, acc);
    acc_to_lds(Cs, acc);
    const bool isctx = m0 >= TL;
    const int b = isctx ? (m0 - TL) >> 8 : m0 >> 13;
    const int t0 = isctx ? (m0 - TL) & 255 : m0 & 8191;
    if (nt < 10) {
      const int lane = tid & 63, wave = tid >> 6;
      const int hh = lane >> 5, pr = lane & 31;
      const bool isq = nt < 8;
      const float* gain = isq ? p.q_gain : p.k_gain;
      const float qs = isq ? 0.125f * 1.4426950408889634f : 1.f;
      const float g0 = gain[2 * pr] * qs, g1 = gain[2 * pr + 1] * qs;
      u16* dstb;
      size_t tstride = 64;
      if (isq) {
        const int head = nt * 2 + hh;
        dstb = isctx ? p.QC + ((size_t)(b * 16 + head) * 256 + t0) * 64 : p.Q + ((size_t)(b * 16 + head) * 8192 + t0) * 64;
      } else {
        const int kh = (nt - 8) * 2 + hh;
        dstb = p.Kb + ((size_t)(b * 4 + kh) * NKEY + (isctx ? t0 : 256 + t0)) * 64;
      }
#pragma unroll 4
      for (int rr = 0; rr < 32; ++rr) {
        const int r = wave * 32 + rr;
        const float2 v = *(const float2*)&CS(r, 2 * lane);
        float ss = v.x * v.x + v.y * v.y;
        ss = sum32(ss);
        const float rinv = rsqrtf(ss * (1.f / 64.f) + 1e-6f);
        float x0 = v.x * rinv * g0, x1 = v.y * rinv * g1;
        if (!isctx) {
          const float2 cssn = *(const float2*)(p.rope + ((size_t)(t0 + r) * 32 + pr) * 2);
          const float y0 = x0 * cssn.x - x1 * cssn.y, y1 = x0 * cssn.y + x1 * cssn.x;
          x0 = y0; x1 = y1;
        }
        *(unsigned*)(dstb + (size_t)r * tstride + 2 * pr) = pack2(x0, x1);
      }
    } else {
      const int keybase = (isctx ? t0 : 256 + t0);
      for (int j = 0; j < 4; ++j) {
        const int item = tid + 256 * j;
        const int d = item & 63, hh = (item >> 6) & 1, rg = item >> 7;
        const int kh = (nt - 10) * 2 + hh;
        float v[16];
#pragma unroll
        for (int i = 0; i < 16; ++i) v[i] = CS(rg * 16 + i, hh * 64 + d);
        u16* dst = p.Vt + ((size_t)(b * 4 + kh) * 64 + d) * NKEY + keybase + rg * 16;
        *(u32x4*)(dst) = mk4(pack2(v[0], v[1]), pack2(v[2], v[3]), pack2(v[8], v[9]), pack2(v[10], v[11]));
        *(u32x4*)(dst + 8) = mk4(pack2(v[4], v[5]), pack2(v[6], v[7]), pack2(v[12], v[13]), pack2(v[14], v[15]));
      }
    }
  }
}

DI void phase_attn(const Params& p, char* smem) {
  u16* Ks = (u16*)smem;
  u16* Vs = Ks + 64 * 64;
  const int tid = threadIdx.x, lane = tid & 63, wave = tid >> 6;
  const int sw = (lane >> 1) & 7, hsel = lane >> 5;
  float mq = 0.f, mk = 0.f;
  for (int d = 0; d < 64; ++d) { mq = fmaxf(mq, fabsf(p.q_gain[d])); mk = fmaxf(mk, fabsf(p.k_gain[d])); }
  const float c0 = 0.125f * 1.4426950408889634f * 64.f * mq * mk * 1.02f + 0.5f;
  f32x16 negc;
#pragma unroll
  for (int i = 0; i < 16; ++i) negc[i] = -c0;
  int ga, gae, gs, gc, gce, gs2;
  work_range(4096, ga, gae, gs);
  work_range(128, gc, gce, gs2);
  const int n_lat = ga < gae ? (gae - ga + gs - 1) / gs : 0;
  const int n_ctx = gc < gce ? (gce - gc + gs2 - 1) / gs2 : 0;
  for (int wi = 0; wi < n_lat + n_ctx; ++wi) {
    const int item = wi < n_lat ? ga + wi * gs : 4096 + gc + (wi - n_lat) * gs2;
    int b, kvh, qb, nkt;
    const u16* qbase;
    size_t orow;
    const int head_g = wave;
    if (item < 4096) {
      b = item >> 10; kvh = (item >> 8) & 3; qb = item & 255; nkt = NKEY / 64;
      qbase = p.Q + ((size_t)(b * 16 + kvh * 4 + head_g) * 8192 + qb * 32) * 64;
      orow = (size_t)b * 8192 + qb * 32;
    } else {
      const int j = item - 4096;
      b = j >> 5; kvh = (j >> 3) & 3; qb = j & 7; nkt = 4;
      qbase = p.QC + ((size_t)(b * 16 + kvh * 4 + head_g) * 256 + qb * 32) * 64;
      orow = (size_t)TL + b * 256 + qb * 32;
    }
    const int head = kvh * 4 + head_g;
    bf16x8 qf[4];
#pragma unroll
    for (int ks = 0; ks < 4; ++ks) qf[ks] = *(const bf16x8*)(qbase + (lane & 31) * 64 + ks * 16 + hsel * 8);
    const u16* kg = p.Kb + (size_t)(b * 4 + kvh) * NKEY * 64;
    const u16* vg = p.Vt + (size_t)(b * 4 + kvh) * 64 * NKEY;
    f32x16 oacc[2];
#pragma unroll
    for (int i = 0; i < 16; ++i) { oacc[0][i] = 0.f; oacc[1][i] = 0.f; }
    f32x2 ls2 = {0.f, 0.f};
    u32x4 rk[2], rv[2];
#pragma unroll
    for (int q = 0; q < 2; ++q) {
      const int ch = tid + 256 * q;
      rk[q] = *(const u32x4*)(kg + (size_t)ch * 8);
      rv[q] = *(const u32x4*)(vg + (size_t)(ch >> 3) * NKEY + (ch & 7) * 8);
    }
    for (int kt = 0; kt < nkt; ++kt) {
      __syncthreads();
#pragma unroll
      for (int q = 0; q < 2; ++q) {
        const int ch = tid + 256 * q;
        const int row = ch >> 3, cc = ch & 7;
        const int pc = cc ^ ((row >> 1) & 7);
        *(u32x4*)(Ks + row * 64 + pc * 8) = rk[q];
        *(u32x4*)(Vs + row * 64 + pc * 8) = rv[q];
      }
      __syncthreads();
      if (kt + 1 < nkt) {
#pragma unroll
        for (int q = 0; q < 2; ++q) {
          const int ch = tid + 256 * q;
          rk[q] = *(const u32x4*)(kg + (size_t)(kt + 1) * 4096 + (size_t)ch * 8);
          rv[q] = *(const u32x4*)(vg + (size_t)(ch >> 3) * NKEY + (kt + 1) * 64 + (ch & 7) * 8);
        }
      }
      f32x16 sacc[2];
      bf16x8 kf[2][4];
#pragma unroll
      for (int kb = 0; kb < 2; ++kb)
#pragma unroll
        for (int ks = 0; ks < 4; ++ks) kf[kb][ks] = *(const bf16x8*)(Ks + (kb * 32 + (lane & 31)) * 64 + (((ks * 2 + hsel) ^ sw) * 8));
      __builtin_amdgcn_sched_barrier(0);
#pragma unroll
      for (int kb = 0; kb < 2; ++kb)
#pragma unroll
        for (int ks = 0; ks < 4; ++ks)
          sacc[kb] = __builtin_amdgcn_mfma_f32_32x32x16_bf16(kf[kb][ks], qf[ks], ks == 0 ? negc : sacc[kb], 0, 0, 0);
      bf16x8 vf[4][2];
#pragma unroll
      for (int c4 = 0; c4 < 4; ++c4)
#pragma unroll
        for (int db = 0; db < 2; ++db) vf[c4][db] = *(const bf16x8*)(Vs + (db * 32 + (lane & 31)) * 64 + (((2 * c4 + hsel) ^ sw) * 8));
#pragma unroll
      for (int kb = 0; kb < 2; ++kb)
#pragma unroll
        for (int i = 0; i < 16; i += 2) {
          const float e0 = __builtin_amdgcn_exp2f(sacc[kb][i]), e1 = __builtin_amdgcn_exp2f(sacc[kb][i + 1]);
          sacc[kb][i] = e0; sacc[kb][i + 1] = e1;
          const f32x2 e2 = {e0, e1};
          ls2 += e2;
        }
#pragma unroll
      for (int kb = 0; kb < 2; ++kb)
#pragma unroll
        for (int s2 = 0; s2 < 2; ++s2) {
          unsigned w[4];
#pragma unroll
          for (int e = 0; e < 4; ++e) w[e] = pack2(sacc[kb][8 * s2 + 2 * e], sacc[kb][8 * s2 + 2 * e + 1]);
          u32x4 pw = mk4(w[0], w[1], w[2], w[3]);
          const bf16x8 pf = __builtin_bit_cast(bf16x8, pw);
#pragma unroll
          for (int db = 0; db < 2; ++db) oacc[db] = __builtin_amdgcn_mfma_f32_32x32x16_bf16(vf[2 * kb + s2][db], pf, oacc[db], 0, 0, 0);
        }
    }
    const float lsum = ls2[0] + ls2[1];
    const float l = lsum + __shfl_xor(lsum, 32, 64);
    const float inv = 1.f / l;
    u16* od = p.H + (orow + (lane & 31)) * DM + head * 64;
#pragma unroll
    for (int db = 0; db < 2; ++db)
#pragma unroll
      for (int g = 0; g < 4; ++g) {
        uint2 o;
        o.x = pack2(oacc[db][g * 4 + 0] * inv, oacc[db][g * 4 + 1] * inv);
        o.y = pack2(oacc[db][g * 4 + 2] * inv, oacc[db][g * 4 + 3] * inv);
        *(uint2*)(od + db * 32 + 8 * g + 4 * hsel) = o;
      }
  }
}

template <bool FROM_INPUT>
DI void phase_proj_res(const Params& p, char* smem, const u16* A, int lda, int K, const u16* Bt, int layer, int gate_idx, int mtiles) {
  int g0, gend, gstep; work_range(mtiles * 8, g0, gend, gstep);
  for (int tile = g0; tile < gend; tile += gstep) {
    int mt, nt; band_decode(tile, mtiles, 8, mt, nt);
    const int m0 = mt * 128;
    f32x16 acc[2][2];
    gemm_mainloop(smem, 1, K,
                  [&](int r, int) { return A + (size_t)(m0 + r) * lda; },
                  [&](int c) { return Bt + (size_t)(nt * 128 + c) * K; }, acc);
    const float* gate = p.modv + ((size_t)layer * 5 + midx_of(m0)) * 6144 + gate_idx * 1024 + nt * 128;
    const float* sb = (FROM_INPUT ? xin_ptr(p, m0) : (const float*)resid_ptr(p, m0)) + nt * 128;
    float* db = resid_ptr(p, m0) + nt * 128;
    epi_direct(acc, [&](int r, int c, float v) { db[r * DM + c] = sb[r * DM + c] + gate[c] * v; });
  }
}

DI void phase_ffn_up(const Params& p, char* smem, int layer, bool with_ctx, u16* ACT) {
  float* Cs = (float*)smem;
  const int tid = threadIdx.x;
  const int mtiles = with_ctx ? 276 : 264;
  int g0, gend, gstep; work_range(mtiles * 44, g0, gend, gstep);
  const u16* up = p.up_t + (size_t)layer * 5632 * 1024;
  const float* cw = p.f_cw + (size_t)layer * 3 * 5632;
  const float* cb = p.f_cb + (size_t)layer * 5632;
  for (int tile = g0; tile < gend; tile += gstep) {
    int mt, nt; band_decode(tile, mtiles, 44, mt, nt);
    int rowbase, T, j;
    if (mt < 264) { rowbase = (mt / 66) * 8192; T = 8192; j = mt % 66; }
    else { const int m2 = mt - 264; rowbase = TL + (m2 / 3) * 256; T = 256; j = m2 % 3; }
    const int tb = j * 126 - 1;
    f32x16 acc[2][2];
    gemm_mainloop(smem, 1, 1024,
                  [&](int r, int) { const int t = tb + r; return (t >= 0 && t < T) ? (const u16*)(p.H + (size_t)(rowbase + t) * DM) : (const u16*)p.zero; },
                  [&](int c) { return up + (size_t)(c < 64 ? nt * 64 + c : 2816 + nt * 64 + (c - 64)) * 1024; }, acc);
    acc_to_lds(Cs, acc);
    const int c = tid & 63, rq = tid >> 6;
    const int n = nt * 64 + c;
    const float g0 = cw[n], g1 = cw[5632 + n], g2 = cw[2 * 5632 + n], gb = cb[n];
    const float v0 = cw[2816 + n], v1 = cw[5632 + 2816 + n], v2 = cw[2 * 5632 + 2816 + n], vb = cb[2816 + n];
    const int rs = 1 + rq * 32;
    int re = rs + 32; if (re > 127) re = 127;
    float gp = CS(rs - 1, c), gc = CS(rs, c), vp = CS(rs - 1, c + 64), vc = CS(rs, c + 64);
    for (int r = rs; r < re; ++r) {
      const float gn = CS(r + 1, c), vn = CS(r + 1, c + 64);
      const int t = tb + r;
      if (t < T) {
        const float g = g0 * gp + g1 * gc + g2 * gn + gb;
        const float v = v0 * vp + v1 * vc + v2 * vn + vb;
        const float a = g * __builtin_amdgcn_rcpf(1.f + __expf(-g)) * v;
        ACT[(size_t)(rowbase + t) * DFF + n] = f2bf(a);
      }
      gp = gc; gc = gn; vp = vc; vc = vn;
    }
  }
}

DI void phase_rwkv_gemms(const Params& p, char* smem) {
  float* Cs = (float*)smem;
  const int tid = threadIdx.x;
  int g0, gend, gstep; work_range(7312, g0, gend, gstep);
  for (int tile = g0; tile < gend; tile += gstep) {
    int job, mt, nt;
    const u16* Bt;
    if (tile < 2048) { job = 0; band_decode(tile, 256, 8, mt, nt); Bt = p.rr_t; }
    else if (tile < 4160) { job = 1; band_decode(tile - 2048, 264, 8, mt, nt); Bt = p.rk_t; }
    else if (tile < 6272) { job = 2; band_decode(tile - 4160, 264, 8, mt, nt); Bt = p.rv_t; }
    else if (tile < 6536) { job = 3; mt = tile - 6272; nt = 0; Bt = p.w1_t; }
    else if (tile < 6800) { job = 4; mt = tile - 6536; nt = 0; Bt = p.a1_t; }
    else { job = 5; band_decode(tile - 6800, 256, 2, mt, nt); Bt = p.g1_t; }
    const int m0 = mt * 128;
    f32x16 acc[2][2];
    gemm_mainloop(smem, 2, 1024,
                  [&](int r, int part) { return (const u16*)((part ? p.XX : p.H) + (size_t)(m0 + r) * DM); },
                  [&](int c) { return Bt + (size_t)(nt * 128 + c) * 2048; }, acc);
    if (job == 0) {
      epi_direct(acc, [&](int r, int c, float v) { p.R16[(size_t)(m0 + r) * DM + nt * 128 + c] = (f16)v; });
    } else if (job == 2) {
      epi_direct(acc, [&](int r, int c, float v) { p.V16[(size_t)(m0 + r) * DM + nt * 128 + c] = (f16)v; });
    } else if (job == 3) {
      epi_direct(acc, [&](int r, int c, float v) { p.LW[(size_t)(m0 + r) * 128 + c] = f2bf(tanhf(v)); });
    } else if (job == 4) {
      epi_direct(acc, [&](int r, int c, float v) { p.LA[(size_t)(m0 + r) * 128 + c] = f2bf(v); });
    } else if (job == 5) {
      epi_direct(acc, [&](int r, int c, float v) {
        const int col = nt * 128 + c;
        if (col < 192) p.LG[(size_t)(m0 + r) * 192 + col] = col < 160 ? f2bf(sigmoid_fast(v)) : (u16)0;
      });
    } else {
      acc_to_lds(Cs, acc);
      const int lane = tid & 63, wave = tid >> 6;
      const int col = nt * 128 + 2 * lane;
      const float kk0 = p.k_k[col], kk1 = p.k_k[col + 1];
#pragma unroll 4
      for (int rr = 0; rr < 32; ++rr) {
        const int r = wave * 32 + rr;
        const float2 v = *(const float2*)&CS(r, 2 * lane);
        const float a0 = v.x * kk0, a1 = v.y * kk1;
        float ss = a0 * a0 + a1 * a1;
        ss = sum32(ss);
        const float inv = 1.f / fmaxf(sqrtf(ss), 1e-12f);
        f16 k2[2], n2[2];
        k2[0] = (f16)v.x; k2[1] = (f16)v.y; n2[0] = (f16)(a0 * inv); n2[1] = (f16)(a1 * inv);
        *(unsigned*)(p.K16 + (size_t)(m0 + r) * DM + col) = *(const unsigned*)k2;
        *(unsigned*)(p.KK16 + (size_t)(m0 + r) * DM + col) = *(const unsigned*)n2;
      }
    }
  }
}

#define XB_TMO      128
#define XB_XCNT(j)  (256  + 64 * (j))
#define XB_XSUB(j)  (1280 + 64 * (j))
#define XB_XGEN(j)  (2304 + 64 * (j))
#define XB_TOP      3328
#define XB_TOPGEN   3392
#define XB_SPIN_CAP (1u << 20)
DI unsigned xb_ld(unsigned* p) { return __hip_atomic_load(p, __ATOMIC_RELAXED, __HIP_MEMORY_SCOPE_AGENT); }
DI unsigned xb_add(unsigned* p, unsigned v) { return __hip_atomic_fetch_add(p, v, __ATOMIC_RELAXED, __HIP_MEMORY_SCOPE_AGENT); }
DI unsigned xb_xcc_id() { return (unsigned)__builtin_amdgcn_s_getreg((3 << 11) | 20) & 0xFu; }
#define XB_SPIN(cond, bar) do { unsigned _sp = 0; while (cond) { __builtin_amdgcn_s_sleep(1); \
    if ((++_sp & 255u) == 0u) { if (xb_ld(&(bar)[XB_TMO])) break; if (_sp > XB_SPIN_CAP) { atomicAdd(&(bar)[XB_TMO], 1u); break; } } } } while (0)
struct XbState { unsigned x, nloc, nx; };
DI void xb_census(unsigned* bar, unsigned x, unsigned& nloc, unsigned& nx) {
  const unsigned G = gridDim.x;
  unsigned sum, cnt, mine, sp = 0u;
  for (;;) {
    sum = 0u; cnt = 0u; mine = 0u;
#pragma unroll
    for (unsigned j = 0; j < 16; ++j) { const unsigned c = xb_ld(&bar[XB_XCNT(j)]); sum += c; cnt += (c > 0u) ? 1u : 0u; mine = (j == x) ? c : mine; }
    if (sum == G) break;
    __builtin_amdgcn_s_sleep(1);
    if ((++sp & 255u) == 0u) { if (xb_ld(&bar[XB_TMO])) break; if (sp > XB_SPIN_CAP) { atomicAdd(&bar[XB_TMO], 1u); break; } }
  }
  nloc = mine > 0u ? mine : 1u; nx = cnt > 0u ? cnt : 1u;
}
DI void grid_barrier(unsigned* bar, XbState& st) {
  asm volatile("s_waitcnt vmcnt(0)" ::: "memory");
  __syncthreads();
  if (threadIdx.x == 0) {
    __builtin_amdgcn_s_waitcnt(0);
    if (st.nloc == 0u) xb_census(bar, st.x, st.nloc, st.nx);
    const unsigned nloc = st.nloc, nx = st.nx;
    const unsigned old = xb_add(&bar[XB_XSUB(st.x)], 1u);
    const unsigned gen = old / nloc;
    if (old + 1u == (gen + 1u) * nloc) {
      __builtin_amdgcn_fence(__ATOMIC_RELEASE, "agent");
      asm volatile("s_waitcnt vmcnt(0)" ::: "memory");
      const unsigned og = xb_add(&bar[XB_TOP], 1u);
      const unsigned tg = og / nx;
      if (og + 1u == (tg + 1u) * nx) xb_add(&bar[XB_TOPGEN], 1u);
      else XB_SPIN(xb_ld(&bar[XB_TOPGEN]) == tg, bar);
      __builtin_amdgcn_fence(__ATOMIC_ACQUIRE, "agent");
      xb_add(&bar[XB_XGEN(st.x)], 1u);
      asm volatile("s_waitcnt vmcnt(0)" ::: "memory");
    } else {
      XB_SPIN(xb_ld(&bar[XB_XGEN(st.x)]) == gen, bar);
      __builtin_amdgcn_fence(__ATOMIC_ACQUIRE, "agent");
      asm volatile("s_waitcnt vmcnt(0)" ::: "memory");
    }
  }
  __syncthreads();
}

struct ScanLds {
  float dec[2][16][64], kd[2][16][64], nk[2][16][64], bb[2][16][64], rr[2][16][64];
  float vv[2][16][16];
  float yy[2][16][16];
  float bp[2][4][16];
};

template <int DIR, bool EMIT>
DI void scan_steps(const ScanLds& L, int bsel, int c0, int myrow, int l15, f32x2& Sa, f32x2& Sb, float& ykeep) {
  f32x4 d4[2], k4[2], n4[2], b4[2], r4[2];
  float vv[2];
  auto ld = [&](int slot, int s) {
    d4[slot] = *(const f32x4*)&L.dec[bsel][s][c0];
    k4[slot] = *(const f32x4*)&L.kd[bsel][s][c0];
    n4[slot] = *(const f32x4*)&L.nk[bsel][s][c0];
    b4[slot] = *(const f32x4*)&L.bb[bsel][s][c0];
    if (EMIT) r4[slot] = *(const f32x4*)&L.rr[bsel][s][c0];
    vv[slot] = L.vv[bsel][s][myrow];
  };
  ld(0, DIR ? 15 : 0);
#pragma unroll
  for (int ss = 0; ss < 16; ++ss) {
    const int s = DIR ? 15 - ss : ss;
    const int cur = ss & 1;
    if (ss + 1 < 16) ld(cur ^ 1, DIR ? 14 - ss : ss + 1);
    const f32x2 nlo = {n4[cur][0], n4[cur][1]}, nhi = {n4[cur][2], n4[cur][3]};
    const f32x2 dlo = {d4[cur][0], d4[cur][1]}, dhi = {d4[cur][2], d4[cur][3]};
    const f32x2 klo = {k4[cur][0], k4[cur][1]}, khi = {k4[cur][2], k4[cur][3]};
    const f32x2 blo = {b4[cur][0], b4[cur][1]}, bhi = {b4[cur][2], b4[cur][3]};
    f32x2 t = Sa * nlo + Sb * nhi;
    float sa = dpp_sum16(t[0] + t[1]);
    const f32x2 sa2 = {sa, sa}, v2 = {vv[cur], vv[cur]};
    Sa = Sa * dlo + (sa2 * blo + v2 * klo);
    Sb = Sb * dhi + (sa2 * bhi + v2 * khi);
    if (EMIT) {
      const f32x2 rlo = {r4[cur][0], r4[cur][1]}, rhi = {r4[cur][2], r4[cur][3]};
      const f32x2 u = Sa * rlo + Sb * rhi;
      const float y = dpp_sum16(u[0] + u[1]);
      ykeep = (l15 == s) ? y : ykeep;
    }
  }
}

template <int DIR>
DI void scan_item(const Params& p, ScanLds& L, int b, int h, int q) {
  constexpr int dir = DIR;
  const int tid = threadIdx.x, lane = tid & 63, wave = tid >> 6;
  const int l15 = lane & 15, l4 = lane >> 4;
  const int colw = h * 64 + wave * 16 + l15;
  const int chd = wave * 16 + l15;
  bf16x8 w2f[2], a2f[2];
#pragma unroll
  for (int ks = 0; ks < 2; ++ks) {
    w2f[ks] = *(const bf16x8*)(p.w2_t + ((size_t)(dir * 1024 + colw) * 64 + ks * 32 + l4 * 8));
    a2f[ks] = *(const bf16x8*)(p.a2_t + ((size_t)(dir * 1024 + colw) * 64 + ks * 32 + l4 * 8));
  }
  const float w0c = p.dw0[dir * 1024 + colw], a0c = p.a0[dir * 1024 + colw], kac = p.k_a[colw], rkc = p.r_k[colw];
  f32x2 Sa = {0.f, 0.f}, Sb = {0.f, 0.f};
  const int myrow = wave * 4 + l4;
  const int c0 = l15 * 4;
  bf16x8 lwf[2], laf[2];
  f16 kv[4], kkv[4], rv[4];
  f16 vvr;
  auto chunk_rowbase = [&](int c, bool& isctx) -> int {
    if (c < 16) { isctx = true; const int cc = dir ? 15 - c : c; return TL + b * 256 + cc * 16; }
    isctx = false; const int cc = dir ? 511 - (c - 16) : (c - 16); return b * 8192 + cc * 16;
  };
  auto stage_load = [&](int c) {
    bool isctx; const int rb = chunk_rowbase(c, isctx);
#pragma unroll
    for (int ks = 0; ks < 2; ++ks) {
      lwf[ks] = *(const bf16x8*)(p.LW + ((size_t)(rb + l15) * 128 + dir * 64 + ks * 32 + l4 * 8));
      laf[ks] = *(const bf16x8*)(p.LA + ((size_t)(rb + l15) * 128 + dir * 64 + ks * 32 + l4 * 8));
    }
#pragma unroll
    for (int i = 0; i < 4; ++i) {
      const size_t off = (size_t)(rb + l4 * 4 + i) * DM + colw;
      kv[i] = p.K16[off]; kkv[i] = p.KK16[off];
      rv[i] = isctx ? (f16)0.f : p.R16[off];
    }
    vvr = p.V16[(size_t)(rb + (tid >> 4)) * DM + h * 64 + q * 16 + (tid & 15)];
  };
  auto stage_compute = [&](int c) {
    const int bsel = c & 1;
    f32x4 wacc = {0.f, 0.f, 0.f, 0.f}, aacc = {0.f, 0.f, 0.f, 0.f};
    wacc = __builtin_amdgcn_mfma_f32_16x16x32_bf16(lwf[0], w2f[0], wacc, 0, 0, 0);
    wacc = __builtin_amdgcn_mfma_f32_16x16x32_bf16(lwf[1], w2f[1], wacc, 0, 0, 0);
    aacc = __builtin_amdgcn_mfma_f32_16x16x32_bf16(laf[0], a2f[0], aacc, 0, 0, 0);
    aacc = __builtin_amdgcn_mfma_f32_16x16x32_bf16(laf[1], a2f[1], aacc, 0, 0, 0);
    float bpart[4];
#pragma unroll
    for (int i = 0; i < 4; ++i) {
      const int s = l4 * 4 + i;
      const float sg = sigmoid_fast(w0c + wacc[i]);
      const float dec = __expf(-0.6065306597126334f * sg);
      const float a = sigmoid_fast(a0c + aacc[i]);
      const float k = (float)kv[i], kk = (float)kkv[i], r = (float)rv[i];
      const float kd = k * (1.f + (a - 1.f) * kac);
      L.dec[bsel][s][chd] = dec;
      L.kd[bsel][s][chd] = kd;
      L.nk[bsel][s][chd] = -kk;
      L.bb[bsel][s][chd] = kk * a;
      L.rr[bsel][s][chd] = r;
      if (q == 0) bpart[i] = dpp_sum16(r * kd * rkc);
    }
    if (q == 0 && l15 == 0) {
#pragma unroll
      for (int i = 0; i < 4; ++i) L.bp[bsel][wave][l4 * 4 + i] = bpart[i];
    }
    L.vv[bsel][tid >> 4][tid & 15] = (float)vvr;
  };
  auto write_bonus = [&](int c) {
    if (q == 0 && tid < 16) {
      bool isctx; const int rb = chunk_rowbase(c, isctx);
      const int b2 = c & 1;
      p.bonus[((size_t)dir * MR + rb + tid) * 16 + h] = L.bp[b2][0][tid] + L.bp[b2][1][tid] + L.bp[b2][2][tid] + L.bp[b2][3][tid];
    }
  };
  __syncthreads();
  stage_load(0);
  stage_compute(0);
  __syncthreads();
  write_bonus(0);
  const int NCH = 528;
  float ykeep = 0.f;
#pragma unroll 1
  for (int c = 0; c < 16; ++c) {
    stage_load(c + 1);
    scan_steps<DIR, false>(L, c & 1, c0, myrow, l15, Sa, Sb, ykeep);
    stage_compute(c + 1);
    __syncthreads();
    write_bonus(c + 1);
  }
#pragma unroll 1
  for (int c = 16; c < NCH; ++c) {
    const int bsel = c & 1;
    if (c + 1 < NCH) stage_load(c + 1);
    scan_steps<DIR, true>(L, bsel, c0, myrow, l15, Sa, Sb, ykeep);
    L.yy[bsel][l15][myrow] = ykeep;
    if (c + 1 < NCH) stage_compute(c + 1);
    __syncthreads();
    {
      bool isctx; const int rb = chunk_rowbase(c, isctx);
      f16* Y = dir ? p.Y1 : p.Y0;
      Y[(size_t)(rb + (tid >> 4)) * DM + h * 64 + q * 16 + (tid & 15)] = (f16)(L.yy[bsel][tid >> 4][tid & 15] * 0.0625f);
    }
    if (c + 1 < NCH) write_bonus(c + 1);
  }
}

struct ScanLds2 {
  float dec[2][16][64], kd[2][16][64], nk[2][16][64], bb[2][16][64], rr[2][16][64];
  float vv[2][16][32];
  float yy[2][16][32];
  float bp[2][4][16];
};
DI float dpp_sum8(float v) {
  v += dpp_mov<0xB1>(v);
  v += dpp_mov<0x4E>(v);
  v += dpp_mov<0x141>(v);
  return v;
}
template <int DIR, bool EMIT>
DI void scan_steps2(const ScanLds2& L, int bsel, int c0, int myrow, int l7, f32x2 (&S)[4], float& ykA, float& ykB) {
  f32x4 d4[2][2], k4[2][2], n4[2][2], b4[2][2], r4[2][2];
  float vv[2];
  auto ld = [&](int slot, int s) {
#pragma unroll
    for (int hf = 0; hf < 2; ++hf) {
      d4[slot][hf] = *(const f32x4*)&L.dec[bsel][s][c0 + 4 * hf];
      k4[slot][hf] = *(const f32x4*)&L.kd[bsel][s][c0 + 4 * hf];
      n4[slot][hf] = *(const f32x4*)&L.nk[bsel][s][c0 + 4 * hf];
      b4[slot][hf] = *(const f32x4*)&L.bb[bsel][s][c0 + 4 * hf];
      if (EMIT) r4[slot][hf] = *(const f32x4*)&L.rr[bsel][s][c0 + 4 * hf];
    }
    vv[slot] = L.vv[bsel][s][myrow];
  };
  ld(0, DIR ? 15 : 0);
#pragma unroll
  for (int ss = 0; ss < 16; ++ss) {
    const int s = DIR ? 15 - ss : ss;
    const int cur = ss & 1;
    if (ss + 1 < 16) ld(cur ^ 1, DIR ? 14 - ss : ss + 1);
    f32x2 t = {0.f, 0.f};
#pragma unroll
    for (int i = 0; i < 4; ++i) { const f32x2 nn = {n4[cur][i >> 1][(i & 1) * 2], n4[cur][i >> 1][(i & 1) * 2 + 1]}; t += S[i] * nn; }
    const float sa = dpp_sum8(t[0] + t[1]);
    const f32x2 sa2 = {sa, sa}, v2 = {vv[cur], vv[cur]};
#pragma unroll
    for (int i = 0; i < 4; ++i) {
      const f32x2 dd = {d4[cur][i >> 1][(i & 1) * 2], d4[cur][i >> 1][(i & 1) * 2 + 1]};
      const f32x2 kk = {k4[cur][i >> 1][(i & 1) * 2], k4[cur][i >> 1][(i & 1) * 2 + 1]};
      const f32x2 bb = {b4[cur][i >> 1][(i & 1) * 2], b4[cur][i >> 1][(i & 1) * 2 + 1]};
      S[i] = S[i] * dd + (sa2 * bb + v2 * kk);
    }
    if (EMIT) {
      f32x2 u = {0.f, 0.f};
#pragma unroll
      for (int i = 0; i < 4; ++i) { const f32x2 rr = {r4[cur][i >> 1][(i & 1) * 2], r4[cur][i >> 1][(i & 1) * 2 + 1]}; u += S[i] * rr; }
      const float y = dpp_sum8(u[0] + u[1]);
      if (s < 8) ykA = (l7 == s) ? y : ykA; else ykB = (l7 == s - 8) ? y : ykB;
    }
  }
}
template <int DIR>
DI void scan_item2(const Params& p, ScanLds2& L, int b, int h, int hf) {
  constexpr int dir = DIR;
  const int tid = threadIdx.x, lane = tid & 63, wave = tid >> 6;
  const int l15 = lane & 15, l4 = lane >> 4;
  const int colw = h * 64 + wave * 16 + l15;
  const int chd = wave * 16 + l15;
  bf16x8 w2f[2], a2f[2];
#pragma unroll
  for (int ks = 0; ks < 2; ++ks) {
    w2f[ks] = *(const bf16x8*)(p.w2_t + ((size_t)(dir * 1024 + colw) * 64 + ks * 32 + l4 * 8));
    a2f[ks] = *(const bf16x8*)(p.a2_t + ((size_t)(dir * 1024 + colw) * 64 + ks * 32 + l4 * 8));
  }
  const float w0c = p.dw0[dir * 1024 + colw], a0c = p.a0[dir * 1024 + colw], kac = p.k_a[colw], rkc = p.r_k[colw];
  f32x2 S[4];
#pragma unroll
  for (int i = 0; i < 4; ++i) { S[i][0] = 0.f; S[i][1] = 0.f; }
  const int l7 = lane & 7;
  const int myrow = wave * 8 + (lane >> 3);
  const int c0 = l7 * 8;
  bf16x8 lwf[2], laf[2];
  f16 kv[4], kkv[4], rv[4];
  f16 vvr[2];
  auto chunk_rowbase = [&](int c, bool& isctx) -> int {
    if (c < 16) { isctx = true; const int cc = dir ? 15 - c : c; return TL + b * 256 + cc * 16; }
    isctx = false; const int cc = dir ? 511 - (c - 16) : (c - 16); return b * 8192 + cc * 16;
  };
  auto stage_load = [&](int c) {
    bool isctx; const int rb = chunk_rowbase(c, isctx);
#pragma unroll
    for (int ks = 0; ks < 2; ++ks) {
      lwf[ks] = *(const bf16x8*)(p.LW + ((size_t)(rb + l15) * 128 + dir * 64 + ks * 32 + l4 * 8));
      laf[ks] = *(const bf16x8*)(p.LA + ((size_t)(rb + l15) * 128 + dir * 64 + ks * 32 + l4 * 8));
    }
#pragma unroll
    for (int i = 0; i < 4; ++i) {
      const size_t off = (size_t)(rb + l4 * 4 + i) * DM + colw;
      kv[i] = p.K16[off]; kkv[i] = p.KK16[off];
      rv[i] = isctx ? (f16)0.f : p.R16[off];
    }
#pragma unroll
    for (int j = 0; j < 2; ++j) { const int e = tid + 256 * j; vvr[j] = p.V16[(size_t)(rb + (e >> 5)) * DM + h * 64 + hf * 32 + (e & 31)]; }
  };
  auto stage_compute = [&](int c) {
    const int bsel = c & 1;
    f32x4 wacc = {0.f, 0.f, 0.f, 0.f}, aacc = {0.f, 0.f, 0.f, 0.f};
    wacc = __builtin_amdgcn_mfma_f32_16x16x32_bf16(lwf[0], w2f[0], wacc, 0, 0, 0);
    wacc = __builtin_amdgcn_mfma_f32_16x16x32_bf16(lwf[1], w2f[1], wacc, 0, 0, 0);
    aacc = __builtin_amdgcn_mfma_f32_16x16x32_bf16(laf[0], a2f[0], aacc, 0, 0, 0);
    aacc = __builtin_amdgcn_mfma_f32_16x16x32_bf16(laf[1], a2f[1], aacc, 0, 0, 0);
    float bpart[4];
#pragma unroll
    for (int i = 0; i < 4; ++i) {
      const int s = l4 * 4 + i;
      const float sg = sigmoid_fast(w0c + wacc[i]);
      const float dec = __expf(-0.6065306597126334f * sg);
      const float a = sigmoid_fast(a0c + aacc[i]);
      const float k = (float)kv[i], kk = (float)kkv[i], r = (float)rv[i];
      const float kd = k * (1.f + (a - 1.f) * kac);
      L.dec[bsel][s][chd] = dec;
      L.kd[bsel][s][chd] = kd;
      L.nk[bsel][s][chd] = -kk;
      L.bb[bsel][s][chd] = kk * a;
      L.rr[bsel][s][chd] = r;
      if (hf == 0) bpart[i] = dpp_sum16(r * kd * rkc);
    }
    if (hf == 0 && l15 == 0) {
#pragma unroll
      for (int i = 0; i < 4; ++i) L.bp[bsel][wave][l4 * 4 + i] = bpart[i];
    }
#pragma unroll
    for (int j = 0; j < 2; ++j) { const int e = tid + 256 * j; L.vv[bsel][e >> 5][e & 31] = (float)vvr[j]; }
  };
  auto write_bonus = [&](int c) {
    if (hf == 0 && tid < 16) {
      bool isctx; const int rb = chunk_rowbase(c, isctx);
      const int b2 = c & 1;
      p.bonus[((size_t)dir * MR + rb + tid) * 16 + h] = L.bp[b2][0][tid] + L.bp[b2][1][tid] + L.bp[b2][2][tid] + L.bp[b2][3][tid];
    }
  };
  __syncthreads();
  stage_load(0);
  stage_compute(0);
  __syncthreads();
  write_bonus(0);
  const int NCH = 528;
  float ykA = 0.f, ykB = 0.f;
#pragma unroll 1
  for (int c = 0; c < 16; ++c) {
    stage_load(c + 1);
    scan_steps2<DIR, false>(L, c & 1, c0, myrow, l7, S, ykA, ykB);
    stage_compute(c + 1);
    __syncthreads();
    write_bonus(c + 1);
  }
#pragma unroll 1
  for (int c = 16; c < NCH; ++c) {
    const int bsel = c & 1;
    if (c + 1 < NCH) stage_load(c + 1);
    scan_steps2<DIR, true>(L, bsel, c0, myrow, l7, S, ykA, ykB);
    L.yy[bsel][l7][myrow] = ykA;
    L.yy[bsel][8 + l7][myrow] = ykB;
    if (c + 1 < NCH) stage_compute(c + 1);
    __syncthreads();
    {
      bool isctx; const int rb = chunk_rowbase(c, isctx);
      f16* Y = dir ? p.Y1 : p.Y0;
#pragma unroll
      for (int j = 0; j < 2; ++j) {
        const int e = tid + 256 * j;
        Y[(size_t)(rb + (e >> 5)) * DM + h * 64 + hf * 32 + (e & 31)] = (f16)(L.yy[bsel][e >> 5][e & 31] * 0.0625f);
      }
    }
    if (c + 1 < NCH) write_bonus(c + 1);
  }
}
DI void phase_scan2(const Params& p, char* smem) {
  ScanLds2& L = *(ScanLds2*)smem;
  const unsigned info = p.blkinfo[blockIdx.x];
  const unsigned rank = info >> 16, ticket = info & 0xffffu;
  const unsigned n0 = xb_ld(&p.bar[XB_N0]);
  const unsigned item = rank == 0u ? ticket : n0 + ticket;
  if (item < 256u) {
    const int sc = item >> 1, hf = item & 1;
    const int dir = sc & 1, bh = sc >> 1, b = bh >> 4, h = bh & 15;
    if (dir) scan_item2<1>(p, L, b, h, hf); else scan_item2<0>(p, L, b, h, hf);
  }
}

DI void phase_scan(const Params& p, char* smem) {
  ScanLds& L = *(ScanLds*)smem;
  for (int item = blockIdx.x; item < 512; item += gridDim.x) {
    int sc, q;
    if (gridDim.x == 512) { const int xcd = item & 7, slot = item >> 3; sc = xcd * 16 + (slot >> 2); q = slot & 3; }
    else { sc = item >> 2; q = item & 3; }
    const int dir = sc & 1, bh = sc >> 1, b = bh >> 4, h = bh & 15;
    if (dir) scan_item<1>(p, L, b, h, q); else scan_item<0>(p, L, b, h, q);
  }
}

DI void phase_readout(const Params& p, char* smem) {
  float* Cs = (float*)smem;
  const int tid = threadIdx.x;
  int g0, gend, gstep; work_range(256 * 8, g0, gend, gstep);
  for (int tile = g0; tile < gend; tile += gstep) {
    int mt, nt; band_decode(tile, 256, 8, mt, nt);
    const int m0 = mt * 128;
    f32x16 acc[2][2];
    gemm_mainloop(smem, 1, 192,
                  [&](int r, int) { return (const u16*)(p.LG + (size_t)(m0 + r) * 192); },
                  [&](int c) { return (const u16*)(p.g2_t + (size_t)(nt * 128 + c) * 192); }, acc);
    acc_to_lds(Cs, acc);
    const int lane = tid & 63, wave = tid >> 6;
    const int head = nt * 2 + (lane >> 5);
    const int col = nt * 128 + 2 * lane;
    const float gw0 = p.gn_w[col], gw1 = p.gn_w[col + 1], gb0 = p.gn_b[col], gb1 = p.gn_b[col + 1];
#pragma unroll 2
    for (int rr = 0; rr < 32; ++rr) {
      const int r = wave * 32 + rr;
      const int row = m0 + r;
      const unsigned ua = *(const unsigned*)(p.Y0 + (size_t)row * DM + col), ub = *(const unsigned*)(p.Y1 + (size_t)row * DM + col);
      const unsigned uv = *(const unsigned*)(p.V16 + (size_t)row * DM + col);
      const f16* fa = (const f16*)&ua; const f16* fb = (const f16*)&ub; const f16* fv = (const f16*)&uv;
      const float y0 = ((float)fa[0] + (float)fb[0]) * 16.f, y1 = ((float)fa[1] + (float)fb[1]) * 16.f;
      float sm = y0 + y1;
      sm = sum32(sm);
      const float mean = sm * (1.f / 64.f);
      const float d0 = y0 - mean, d1 = y1 - mean;
      float vs = d0 * d0 + d1 * d1;
      vs = sum32(vs);
      const float rstd = rsqrtf(vs * (1.f / 64.f) + 64e-5f);
      const float bon = p.bonus[((size_t)0 * MR + row) * 16 + head] + p.bonus[((size_t)1 * MR + row) * 16 + head];
      const float2 g = *(const float2*)&CS(r, 2 * lane);
      const float z0 = (d0 * rstd * gw0 + gb0 + bon * (float)fv[0]) * g.x;
      const float z1 = (d1 * rstd * gw1 + gb1 + bon * (float)fv[1]) * g.y;
      *(unsigned*)(p.Z + (size_t)row * DM + col) = pack2(z0, z1);
    }
  }
}

DI void phase_final(const Params& p) {
  const int lane = threadIdx.x & 63;
  const int gw = blockIdx.x * 4 + (threadIdx.x >> 6), nw = gridDim.x * 4;
  for (int row = gw; row < TL; row += nw) {
    float* src = p.out + (size_t)row * DM;
    float4 v[4];
    float ss = 0.f;
#pragma unroll
    for (int i = 0; i < 4; ++i) {
      v[i] = *(const float4*)(src + i * 256 + lane * 4);
      ss += v[i].x * v[i].x + v[i].y * v[i].y + v[i].z * v[i].z + v[i].w * v[i].w;
    }
    ss = wave_sum(ss);
    const float rinv = rsqrtf(ss * (1.f / 1024.f) + 1e-6f);
#pragma unroll
    for (int i = 0; i < 4; ++i) {
      const float4 g = *(const float4*)(p.final_gain + i * 256 + lane * 4);
      float4 o;
      o.x = v[i].x * rinv * g.x; o.y = v[i].y * rinv * g.y; o.z = v[i].z * rinv * g.z; o.w = v[i].w * rinv * g.w;
      *(float4*)(src + i * 256 + lane * 4) = o;
    }
  }
}

__global__ void __launch_bounds__(256, 2) mega(Params p) {
  __shared__ __attribute__((aligned(16))) char smem[65536];
  cg::grid_group grid = cg::this_grid();
  XbState xst; xst.x = xb_xcc_id(); xst.nloc = 0u; xst.nx = 0u;
  if (threadIdx.x == 0) {
    (void)xb_add(&p.bar[XB_XCNT(xst.x)], 1u);
    const unsigned hwid = (unsigned)__builtin_amdgcn_s_getreg((7 << 11) | (8 << 6) | 4) & 0xffu;
    const unsigned rank = xb_add(&p.bar[XB_CU((xst.x << 8) | hwid)], 1u);
    const unsigned ticket = xb_add(&p.bar[rank == 0u ? XB_N0 : XB_N1], 1u);
    p.blkinfo[blockIdx.x] = ((rank > 0u ? 1u : 0u) << 16) | (ticket & 0xffffu);
  }
  if (gridDim.x == 0x7fffffffu) grid.sync();
  phase_prep(p, smem); grid_barrier(p.bar, xst);
  phase_modreduce(p); grid_barrier(p.bar, xst);
  phase_modulate<true>(p, 0, 0, MR); grid_barrier(p.bar, xst);
  phase_qkv(p, smem); grid_barrier(p.bar, xst);
  phase_attn(p, smem); grid_barrier(p.bar, xst);
  phase_proj_res<true>(p, smem, p.H, 1024, 1024, p.wo_t, 0, 2, 264); grid_barrier(p.bar, xst);
  phase_modulate<false>(p, 0, 1, MR); grid_barrier(p.bar, xst);
  phase_ffn_up(p, smem, 0, true, p.ACT0); grid_barrier(p.bar, xst);
  phase_proj_res<false>(p, smem, p.ACT0, DFF, DFF, p.down_t, 0, 5, 264); grid_barrier(p.bar, xst);
  phase_rwkv_shift(p); grid_barrier(p.bar, xst);
  phase_rwkv_gemms(p, smem); grid_barrier(p.bar, xst);
  phase_scan2(p, smem); grid_barrier(p.bar, xst);
  phase_readout(p, smem); grid_barrier(p.bar, xst);
  phase_proj_res<false>(p, smem, p.Z, 1024, 1024, p.ro_t, 1, 2, 256); grid_barrier(p.bar, xst);
  phase_modulate<false>(p, 1, 1, TL); grid_barrier(p.bar, xst);
  phase_ffn_up(p, smem, 1, false, p.ACT1); grid_barrier(p.bar, xst);
  phase_proj_res<false>(p, smem, p.ACT1, DFF, DFF, p.down_t + (size_t)1024 * 2816, 1, 5, 256); grid_barrier(p.bar, xst);
  phase_final(p);
}

extern "C" void kernel_launch(void* const* d_in, const int* in_sizes, int n_in, void* d_out, int out_size, void* d_ws, size_t ws_size,
                              hipStream_t stream) {
  static int grid_blocks = 0;
  if (!grid_blocks) {
    int dev = 0, cus = 0, per_cu = 0;
    hipGetDevice(&dev);
    hipDeviceGetAttribute(&cus, hipDeviceAttributeMultiprocessorCount, dev);
    hipOccupancyMaxActiveBlocksPerMultiprocessor(&per_cu, mega, 256, 0);
    if (per_cu > 2) per_cu = 2;
    if (per_cu < 1) per_cu = 1;
    grid_blocks = cus * per_cu;
  }
  Params p{};
  const float* const* in = (const float* const*)d_in;
  p.x = in[0]; p.c = in[1]; p.ctx = in[2]; p.c_ctx = in[3]; p.ada_w = in[4]; p.ada_b = in[5]; p.w_qkv = in[6]; p.q_gain = in[7];
  p.k_gain = in[8]; p.w_o = in[9]; p.mu = in[10]; p.rw_r = in[11]; p.rw_k = in[12]; p.rw_v = in[13]; p.rw_o = in[14]; p.dw0 = in[15];
  p.dw1 = in[16]; p.dw2 = in[17]; p.a0 = in[18]; p.a1 = in[19]; p.a2 = in[20]; p.g1 = in[21]; p.g2 = in[22]; p.k_k = in[23];
  p.k_a = in[24]; p.r_k = in[25]; p.gn_w = in[26]; p.gn_b = in[27]; p.f_up = in[28]; p.f_cw = in[29]; p.f_cb = in[30];
  p.f_down = in[31]; p.final_gain = in[32];
  p.out = (float*)d_out;
  char* w = (char*)d_ws;
  size_t off = 0;
  auto take = [&](size_t bytes) { char* r = w + off; off += (bytes + 255) & ~(size_t)255; return r; };
  p.qkv_t = (u16*)take((size_t)1536 * 1024 * 2);
  p.wo_t = (u16*)take((size_t)1024 * 1024 * 2);
  p.up_t = (u16*)take((size_t)2 * 5632 * 1024 * 2);
  p.down_t = (u16*)take((size_t)2 * 1024 * 2816 * 2);
  p.rr_t = (u16*)take((size_t)1024 * 2048 * 2);
  p.rk_t = (u16*)take((size_t)1024 * 2048 * 2);
  p.rv_t = (u16*)take((size_t)1024 * 2048 * 2);
  p.ro_t = (u16*)take((size_t)1024 * 1024 * 2);
  p.w1_t = (u16*)take((size_t)128 * 2048 * 2);
  p.a1_t = (u16*)take((size_t)128 * 2048 * 2);
  p.g1_t = (u16*)take((size_t)256 * 2048 * 2);
  p.w2_t = (u16*)take((size_t)2 * 1024 * 64 * 2);
  p.a2_t = (u16*)take((size_t)2 * 1024 * 64 * 2);
  p.g2_t = (u16*)take((size_t)1024 * 192 * 2);
  p.modpart = (float*)take((size_t)2 * 8 * 5 * 6144 * 4);
  p.modv = (float*)take((size_t)2 * 5 * 6144 * 4);
  p.rope = (float*)take((size_t)8192 * 32 * 2 * 4);
  p.XC = (float*)take((size_t)TCX * DM * 4);
  p.bonus = (float*)take((size_t)2 * MR * 16 * 4);
  p.zero = (u16*)take(8192);
  p.bar = (unsigned*)take(65536);
  p.blkinfo = (unsigned*)take(4096 * 4);
  const size_t pb = off;
  p.H = (u16*)take((size_t)MR * DM * 2);
  const size_t after_h = off;
  p.Q = (u16*)take((size_t)TL * DM * 2);
  p.QC = (u16*)take((size_t)TCX * DM * 2);
  p.Kb = (u16*)take((size_t)16 * NKEY * 64 * 2);
  p.Vt = (u16*)take((size_t)16 * NKEY * 64 * 2);
  p.ACT0 = (u16*)take((size_t)MR * DFF * 2);
  const size_t end0 = off;
  off = after_h;
  p.XX = (u16*)take((size_t)MR * DM * 2);
  p.R16 = (f16*)take((size_t)TL * DM * 2);
  p.K16 = (f16*)take((size_t)MR * DM * 2);
  p.V16 = (f16*)take((size_t)MR * DM * 2);
  p.KK16 = (f16*)take((size_t)MR * DM * 2);
  p.LW = (u16*)take((size_t)MR * 128 * 2);
  p.LA = (u16*)take((size_t)MR * 128 * 2);
  p.LG = (u16*)take((size_t)TL * 192 * 2);
  const size_t end1 = off;
  p.Y0 = (f16*)p.H;
  p.Y1 = (f16*)p.XX;
  p.Z = (u16*)p.R16;
  p.ACT1 = (u16*)p.K16;
  (void)pb;
  const size_t need = end0 > end1 ? end0 : end1;
  if (need > ws_size) { fprintf(stderr, "workspace too small: need %zu have %zu\n", need, ws_size); return; }
  hipMemsetAsync(p.bar, 0, 65536, stream);
  void* args[] = {&p};
  hipError_t e = hipLaunchCooperativeKernel((void*)mega, dim3(grid_blocks), dim3(256), args, 0, stream);
  if (e != hipSuccess) fprintf(stderr, "cooperative launch failed: %s (grid %d)\n", hipGetErrorString(e), grid_blocks);
}
```

```cpp
#include <hip/hip_runtime.h>
#include <hip/hip_cooperative_groups.h>
#include <cstdio>
#include <cstdint>
namespace cg = cooperative_groups;

typedef unsigned short u16;
typedef _Float16 f16;
using bf16x8 = __attribute__((ext_vector_type(8))) short;
using f32x16 = __attribute__((ext_vector_type(16))) float;
using f32x4 = __attribute__((ext_vector_type(4))) float;
using u32x4 = __attribute__((ext_vector_type(4))) unsigned;
#define DI __device__ __forceinline__
DI u32x4 mk4(unsigned a, unsigned b, unsigned c, unsigned d) { u32x4 r; r[0] = a; r[1] = b; r[2] = c; r[3] = d; return r; }

constexpr int TL = 32768;
constexpr int TCX = 1024;
constexpr int MR = 33792;
constexpr int DM = 1024;
constexpr int DFF = 2816;
constexpr int NKEY = 8448;
constexpr int NPHASE = 18;
#define XB_CU(j)    (4096 + (j))
#define XB_N0       8192
#define XB_N1       8256

struct Params {
  const float *x, *c, *ctx, *c_ctx, *ada_w, *ada_b, *w_qkv, *q_gain, *k_gain, *w_o;
  const float *mu, *rw_r, *rw_k, *rw_v, *rw_o, *dw0, *dw1, *dw2, *a0, *a1, *a2, *g1, *g2, *k_k, *k_a, *r_k, *gn_w, *gn_b;
  const float *f_up, *f_cw, *f_cb, *f_down, *final_gain;
  float* out;
  u16 *qkv_t, *wo_t, *up_t, *down_t, *rr_t, *rk_t, *rv_t, *ro_t, *w1_t, *a1_t, *g1_t, *w2_t, *a2_t, *g2_t;
  float *modpart, *modv, *rope, *XC, *bonus;
  u16* zero;
  unsigned* bar;
  unsigned* blkinfo;
  u16 *H, *XX, *Q, *QC, *Kb, *Vt, *ACT0, *ACT1;
  f16 *R16, *K16, *V16, *KK16, *Y0, *Y1;
  u16 *LW, *LA, *LG, *Z;
  int phase_lo, phase_hi;
};

typedef __bf16 bf16x2_t __attribute__((ext_vector_type(2)));
typedef float f32x2 __attribute__((ext_vector_type(2)));
DI unsigned pack2(float a, float b) { f32x2 f = {a, b}; return __builtin_bit_cast(unsigned, __builtin_convertvector(f, bf16x2_t)); }
DI u16 f2bf(float x) { return (u16)(pack2(x, 0.f) & 0xffffu); }
DI float bf2f(u16 h) { return __uint_as_float(((unsigned)h) << 16); }
DI float wave_sum(float v) {
#pragma unroll
  for (int o = 32; o > 0; o >>= 1) v += __shfl_xor(v, o, 64);
  return v;
}
template <int CTRL> DI float dpp_mov(float v) { return __builtin_bit_cast(float, __builtin_amdgcn_update_dpp(0, __builtin_bit_cast(int, v), CTRL, 0xF, 0xF, false)); }
DI float dpp_sum16(float v) {
  v += dpp_mov<0x128>(v);
  v += dpp_mov<0x124>(v);
  v += dpp_mov<0x122>(v);
  v += dpp_mov<0x121>(v);
  return v;
}
DI float sum32(float v) { v = dpp_sum16(v); v += __shfl_xor(v, 16, 64); return v; }
DI float sigmoidf_(float x) { return 1.f / (1.f + __expf(-x)); }
DI float sigmoid_fast(float x) { return __builtin_amdgcn_rcpf(1.f + __expf(-x)); }
DI int midx_of(int row) { return row < TL ? (row >> 13) : 4; }
DI float* resid_ptr(const Params& p, int row) { return row < TL ? p.out + (size_t)row * DM : p.XC + (size_t)(row - TL) * DM; }
DI const float* xin_ptr(const Params& p, int row) { return row < TL ? p.x + (size_t)row * DM : p.ctx + (size_t)(row - TL) * DM; }

DI void work_range(int total, int& g0, int& gend, int& step) {
  if ((gridDim.x & 7) == 0) {
    const int x = blockIdx.x & 7, li = blockIdx.x >> 3, nl = gridDim.x >> 3;
    const int lo = (int)(((long long)total * x) >> 3), hi = (int)(((long long)total * (x + 1)) >> 3);
    g0 = lo + li; gend = hi; step = nl;
  } else { g0 = blockIdx.x; gend = total; step = gridDim.x; }
}
DI void band_decode(int g, int MT, int NT, int& mt, int& nt) {
  const int per = 8 * NT;
  const int band = g / per, r = g - band * per;
  int hb = MT - band * 8; if (hb > 8) hb = 8;
  nt = r / hb; mt = band * 8 + (r - nt * hb);
}

using GAcc = f32x4[4][4];
template <class AF, class BF>
DI void gemm_mainloop(char* smem, int nparts, int kpart, AF arow, BF brow, f32x4 (&acc)[4][4]) {
  const int tid = threadIdx.x, lane = tid & 63, wave = tid >> 6;
  const int wm = wave >> 1, wn = wave & 1;
  const int lr = tid >> 3, lc = tid & 7;
#pragma unroll
  for (int i = 0; i < 4; ++i)
#pragma unroll
    for (int j = 0; j < 4; ++j)
#pragma unroll
      for (int e = 0; e < 4; ++e) acc[i][j][e] = 0.f;
  const int csrc = (lc ^ ((lr >> 1) & 7)) * 8;
  const u16* bp[4];
  const u16* ap[4];
#pragma unroll
  for (int q = 0; q < 4; ++q) { bp[q] = brow(lr + 32 * q) + csrc; ap[q] = arow(lr + 32 * q, 0) + csrc; }
  const int nk = kpart >> 6;
  const int total = nparts * nk;
  const int sw = (lane >> 1) & 7;
  const int kq = lane >> 4;
  char* const wbase = smem + wave * 1024;
  auto stage = [&](int buf, int kk, int boff) {
#pragma unroll
    for (int q = 0; q < 4; ++q) {
      __builtin_amdgcn_global_load_lds((const unsigned*)(ap[q] + kk), (unsigned*)(wbase + buf * 32768 + q * 4096), 16, 0, 0);
      __builtin_amdgcn_global_load_lds((const unsigned*)(bp[q] + boff), (unsigned*)(wbase + buf * 32768 + 16384 + q * 4096), 16, 0, 0);
    }
  };
  __syncthreads();
  stage(0, 0, 0);
  asm volatile("s_waitcnt vmcnt(0)" ::: "memory");
  __syncthreads();
  int part = 0, kk = 0, buf = 0;
#pragma unroll 1
  for (int it = 0; it < total; ++it) {
    kk += 64;
    if (kk == kpart) {
      kk = 0; ++part;
      if (part < nparts) {
#pragma unroll
        for (int q = 0; q < 4; ++q) ap[q] = arow(lr + 32 * q, part) + csrc;
      }
    }
    if (it + 1 < total) stage(buf ^ 1, kk, part * kpart + kk);
    const u16* As = (const u16*)(smem + buf * 32768);
    const u16* Bs = As + 128 * 64;
    const u16* Ar = As + (wm * 64 + (lane & 15)) * 64;
    const u16* Br = Bs + (wn * 64 + (lane & 15)) * 64;
    bf16x8 af[2][4], bf[2][4];
    {
      const int pc = (kq ^ sw) * 8;
#pragma unroll
      for (int i = 0; i < 4; ++i) { af[0][i] = *(const bf16x8*)(Ar + i * 1024 + pc); bf[0][i] = *(const bf16x8*)(Br + i * 1024 + pc); }
    }
#pragma unroll
    for (int ks = 0; ks < 2; ++ks) {
      const int cur = ks & 1;
      if (ks + 1 < 2) {
        const int pc = ((4 + kq) ^ sw) * 8;
#pragma unroll
        for (int i = 0; i < 4; ++i) { af[1][i] = *(const bf16x8*)(Ar + i * 1024 + pc); bf[1][i] = *(const bf16x8*)(Br + i * 1024 + pc); }
      }
#pragma unroll
      for (int i = 0; i < 4; ++i)
#pragma unroll
        for (int j = 0; j < 4; ++j) acc[i][j] = __builtin_amdgcn_mfma_f32_16x16x32_bf16(af[cur][i], bf[cur][j], acc[i][j], 0, 0, 0);
      __builtin_amdgcn_sched_barrier(0);
    }
    asm volatile("s_waitcnt vmcnt(0)" ::: "memory");
    __syncthreads();
    buf ^= 1;
  }
}

template <class F>
DI void epi_direct(const f32x4 (&acc)[4][4], F f) {
  const int lane = threadIdx.x & 63, wave = threadIdx.x >> 6;
  const int wm = wave >> 1, wn = wave & 1, g = lane >> 4;
#pragma unroll
  for (int i = 0; i < 4; ++i)
#pragma unroll
    for (int j = 0; j < 4; ++j)
#pragma unroll
      for (int e = 0; e < 4; ++e) {
        const int row = wm * 64 + i * 16 + g * 4 + e;
        const int col = wn * 64 + j * 16 + (lane & 15);
        f(row, col, acc[i][j][e]);
      }
}
#define CS(r, c) Cs[(r) * 128 + (c)]
DI void acc_to_lds(float* Cs, const f32x4 (&acc)[4][4]) {
  __syncthreads();
  epi_direct(acc, [&](int r, int c, float v) { CS(r, c) = v; });
  __syncthreads();
}

struct TJob { const float* src; int srcK, srcN; u16* dst; int ld, koff; const float* mu; int Kpad, Npad; };
DI TJob get_job(const Params& p, int j) {
  TJob t; t.mu = nullptr; t.koff = 0;
  auto set = [&](const float* s, int K, int N, u16* d, int ld) { t.src = s; t.srcK = K; t.srcN = N; t.dst = d; t.ld = ld; t.Kpad = K; t.Npad = N; };
  switch (j) {
    case 0: set(p.w_qkv, 1024, 1536, p.qkv_t, 1024); break;
    case 1: set(p.w_o, 1024, 1024, p.wo_t, 1024); break;
    case 2: set(p.f_up, 1024, 5632, p.up_t, 1024); break;
    case 3: set(p.f_up + (size_t)1024 * 5632, 1024, 5632, p.up_t + (size_t)5632 * 1024, 1024); break;
    case 4: set(p.f_down, 2816, 1024, p.down_t, 2816); break;
    case 5: set(p.f_down + (size_t)2816 * 1024, 2816, 1024, p.down_t + (size_t)1024 * 2816, 2816); break;
    case 6: set(p.rw_r, 1024, 1024, p.rr_t, 2048); break;
    case 7: set(p.rw_r, 1024, 1024, p.rr_t, 2048); t.mu = p.mu + 0 * 1024; t.koff = 1024; break;
    case 8: set(p.rw_k, 1024, 1024, p.rk_t, 2048); break;
    case 9: set(p.rw_k, 1024, 1024, p.rk_t, 2048); t.mu = p.mu + 2 * 1024; t.koff = 1024; break;
    case 10: set(p.rw_v, 1024, 1024, p.rv_t, 2048); break;
    case 11: set(p.rw_v, 1024, 1024, p.rv_t, 2048); t.mu = p.mu + 3 * 1024; t.koff = 1024; break;
    case 12: set(p.rw_o, 1024, 1024, p.ro_t, 1024); break;
    case 13: set(p.dw1, 1024, 64, p.w1_t, 2048); break;
    case 14: set(p.dw1, 1024, 64, p.w1_t, 2048); t.mu = p.mu + 1 * 1024; t.koff = 1024; break;
    case 15: set(p.dw1 + 1024 * 64, 1024, 64, p.w1_t + 64 * 2048, 2048); break;
    case 16: set(p.dw1 + 1024 * 64, 1024, 64, p.w1_t + 64 * 2048, 2048); t.mu = p.mu + 1 * 1024; t.koff = 1024; break;
    case 17: set(p.a1, 1024, 64, p.a1_t, 2048); break;
    case 18: set(p.a1, 1024, 64, p.a1_t, 2048); t.mu = p.mu + 4 * 1024; t.koff = 1024; break;
    case 19: set(p.a1 + 1024 * 64, 1024, 64, p.a1_t + 64 * 2048, 2048); break;
    case 20: set(p.a1 + 1024 * 64, 1024, 64, p.a1_t + 64 * 2048, 2048); t.mu = p.mu + 4 * 1024; t.koff = 1024; break;
    case 21: set(p.g1, 1024, 160, p.g1_t, 2048); t.Npad = 256; break;
    case 22: set(p.g1, 1024, 160, p.g1_t, 2048); t.Npad = 256; t.mu = p.mu + 5 * 1024; t.koff = 1024; break;
    case 23: set(p.dw2, 64, 1024, p.w2_t, 64); break;
    case 24: set(p.dw2 + 64 * 1024, 64, 1024, p.w2_t + 1024 * 64, 64); break;
    case 25: set(p.a2, 64, 1024, p.a2_t, 64); break;
    case 26: set(p.a2 + 64 * 1024, 64, 1024, p.a2_t + 1024 * 64, 64); break;
    default: set(p.g2, 160, 1024, p.g2_t, 192); t.Kpad = 192; break;
  }
  return t;
}
constexpr int NJOBS = 28;
DI int job_tiles(const TJob& t) { return ((t.Kpad + 63) >> 6) * ((t.Npad + 63) >> 6); }

DI void phase_prep(const Params& p, char* smem) {
  const int tid = threadIdx.x;
  int ttiles = 0;
  for (int j = 0; j < NJOBS; ++j) ttiles += job_tiles(get_job(p, j));
  const int n_mod = 2 * 24 * 8;
  const int n_rope = 1024;
  const int total = ttiles + n_mod + n_rope;
  float* tile = (float*)smem;
  if (blockIdx.x == 0) for (int e = tid; e < 4096; e += 256) p.zero[e] = 0;
  for (int item = blockIdx.x; item < total; item += gridDim.x) {
    if (item < ttiles) {
      int rem = item, j = 0;
      TJob t = get_job(p, 0);
      while (true) { int n = job_tiles(t); if (rem < n) break; rem -= n; ++j; t = get_job(p, j); }
      const int ntn = (t.Npad + 63) >> 6;
      const int kt = rem / ntn, nt = rem % ntn;
      __syncthreads();
#pragma unroll
      for (int i = 0; i < 16; ++i) {
        const int kl = i * 4 + (tid >> 6), nl = tid & 63;
        const int k = kt * 64 + kl, n = nt * 64 + nl;
        float v = 0.f;
        if (k < t.srcK && n < t.srcN) { v = t.src[(size_t)k * t.srcN + n]; if (t.mu) v *= t.mu[k]; }
        tile[kl * 65 + nl] = v;
      }
      __syncthreads();
#pragma unroll
      for (int i = 0; i < 16; ++i) {
        const int nl = i * 4 + (tid >> 6), kl = tid & 63;
        const int k = kt * 64 + kl, n = nt * 64 + nl;
        if (k < t.Kpad && n < t.Npad) t.dst[(size_t)n * t.ld + t.koff + k] = f2bf(tile[kl * 65 + nl]);
      }
    } else if (item < ttiles + n_mod) {
      const int it = item - ttiles;
      const int layer = it / 192, cc = (it % 192) / 8, kc = it % 8;
      float* sil = (float*)smem;
      __syncthreads();
      for (int e = tid; e < 640; e += 256) {
        const int j = e >> 7, k = kc * 128 + (e & 127);
        const float v = j < 4 ? p.c[j * 1024 + k] : p.c_ctx[k];
        sil[e] = v / (1.f + __expf(-v));
      }
      __syncthreads();
      const int col = cc * 256 + tid;
      float a0 = 0, a1 = 0, a2 = 0, a3 = 0, a4 = 0;
      const float* w = p.ada_w + ((size_t)layer * 1024 + kc * 128) * 6144 + col;
#pragma unroll 16
      for (int k = 0; k < 128; ++k) {
        const float wv = w[(size_t)k * 6144];
        a0 += sil[k] * wv; a1 += sil[128 + k] * wv; a2 += sil[256 + k] * wv; a3 += sil[384 + k] * wv; a4 += sil[512 + k] * wv;
      }
      float* mp = p.modpart + ((size_t)(layer * 8 + kc) * 5) * 6144 + col;
      mp[0] = a0; mp[6144] = a1; mp[2 * 6144] = a2; mp[3 * 6144] = a3; mp[4 * 6144] = a4;
    } else {
      const int e = (item - ttiles - n_mod) * 256 + tid;
      const int s = e >> 5, pr = e & 31;
      const int f = pr & 15;
      const float inv_freq = powf(10000.f, -(float)f / 16.f);
      const float pos = (pr < 16) ? (float)(s >> 6) : (float)(s & 63);
      const float ang = pos * inv_freq;
      float sn, cs;
      sincosf(ang, &sn, &cs);
      p.rope[e * 2] = cs; p.rope[e * 2 + 1] = sn;
    }
  }
}

DI void phase_modreduce(const Params& p) {
  const int n = 2 * 5 * 6144;
  for (int e = blockIdx.x * 256 + threadIdx.x; e < n; e += gridDim.x * 256) {
    const int layer = e / (5 * 6144), r = e % (5 * 6144), col = r % 6144;
    float s = p.ada_b[layer * 6144 + col];
    for (int kc = 0; kc < 8; ++kc) s += p.modpart[(size_t)(layer * 8 + kc) * 5 * 6144 + r];
    p.modv[e] = s;
  }
}

template <bool FROM_INPUT>
DI void phase_modulate(const Params& p, int layer, int which, int nrows) {
  const int lane = threadIdx.x & 63;
  const int gw = blockIdx.x * 4 + (threadIdx.x >> 6), nw = gridDim.x * 4;
  for (int row = gw; row < nrows; row += nw) {
    const float* src = FROM_INPUT ? xin_ptr(p, row) : resid_ptr(p, row);
    const float* mv = p.modv + ((size_t)layer * 5 + midx_of(row)) * 6144 + which * 3072;
    float4 v[4];
    float ss = 0.f;
#pragma unroll
    for (int i = 0; i < 4; ++i) {
      v[i] = *(const float4*)(src + i * 256 + lane * 4);
      ss += v[i].x * v[i].x + v[i].y * v[i].y + v[i].z * v[i].z + v[i].w * v[i].w;
    }
    ss = wave_sum(ss);
    const float rinv = rsqrtf(ss * (1.f / 1024.f) + 1e-6f);
#pragma unroll
    for (int i = 0; i < 4; ++i) {
      const int col = i * 256 + lane * 4;
      const float4 sh = *(const float4*)(mv + col);
      const float4 sc = *(const float4*)(mv + 1024 + col);
      uint2 o;
      o.x = pack2(v[i].x * rinv * (1.f + sc.x) + sh.x, v[i].y * rinv * (1.f + sc.y) + sh.y);
      o.y = pack2(v[i].z * rinv * (1.f + sc.z) + sh.z, v[i].w * rinv * (1.f + sc.w) + sh.w);
      *(uint2*)(p.H + (size_t)row * DM + col) = o;
    }
  }
}

DI void modrow(const Params& p, int row, bool valid, int lane, float (&h)[16]) {
  if (!valid) {
#pragma unroll
    for (int i = 0; i < 16; ++i) h[i] = 0.f;
    return;
  }
  const float* src = resid_ptr(p, row);
  const float* mv = p.modv + ((size_t)1 * 5 + midx_of(row)) * 6144;
  float ss = 0.f;
#pragma unroll
  for (int i = 0; i < 4; ++i) {
    const float4 v = *(const float4*)(src + i * 256 + lane * 4);
    h[i * 4 + 0] = v.x; h[i * 4 + 1] = v.y; h[i * 4 + 2] = v.z; h[i * 4 + 3] = v.w;
    ss += v.x * v.x + v.y * v.y + v.z * v.z + v.w * v.w;
  }
  ss = wave_sum(ss);
  const float rinv = rsqrtf(ss * (1.f / 1024.f) + 1e-6f);
#pragma unroll
  for (int i = 0; i < 4; ++i) {
    const int col = i * 256 + lane * 4;
    const float4 sh = *(const float4*)(mv + col);
    const float4 sc = *(const float4*)(mv + 1024 + col);
    h[i * 4 + 0] = h[i * 4 + 0] * rinv * (1.f + sc.x) + sh.x;
    h[i * 4 + 1] = h[i * 4 + 1] * rinv * (1.f + sc.y) + sh.y;
    h[i * 4 + 2] = h[i * 4 + 2] * rinv * (1.f + sc.z) + sh.z;
    h[i * 4 + 3] = h[i * 4 + 3] * rinv * (1.f + sc.w) + sh.w;
  }
}
DI void phase_rwkv_shift(const Params& p) {
  const int lane = threadIdx.x & 63;
  const int gw = blockIdx.x * 4 + (threadIdx.x >> 6), nw = gridDim.x * 4;
  const int nitems = MR / 8;
  for (int item = gw; item < nitems; item += nw) {
    const int r0 = item * 8;
    int sb, T;
    if (r0 < TL) { sb = r0 & ~8191; T = 8192; } else { sb = TL + ((r0 - TL) & ~255); T = 256; }
    float hm[16], hc[16], hn[16];
    modrow(p, r0 - 1, r0 - 1 >= sb, lane, hm);
    modrow(p, r0, true, lane, hc);
    for (int j = 0; j < 8; ++j) {
      const int row = r0 + j;
      modrow(p, row + 1, row + 1 < sb + T, lane, hn);
#pragma unroll
      for (int i = 0; i < 4; ++i) {
        const int col = i * 256 + lane * 4;
        float xx[4];
#pragma unroll
        for (int e = 0; e < 4; ++e) xx[e] = 0.5f * (hm[i * 4 + e] + hn[i * 4 + e]) - hc[i * 4 + e];
        uint2 o, o2;
        o.x = pack2(hc[i * 4 + 0], hc[i * 4 + 1]); o.y = pack2(hc[i * 4 + 2], hc[i * 4 + 3]);
        o2.x = pack2(xx[0], xx[1]); o2.y = pack2(xx[2], xx[3]);
        *(uint2*)(p.H + (size_t)row * DM + col) = o;
        *(uint2*)(p.XX + (size_t)row * DM + col) = o2;
      }
#pragma unroll
      for (int i = 0; i < 16; ++i) { hm[i] = hc[i]; hc[i] = hn[i]; }
    }
  }
}

DI void phase_qkv(const Params& p, char* smem) {
  float* Cs = (float*)smem;
  const int tid = threadIdx.x;
  int g0, gend, gstep; work_range(264 * 12, g0, gend, gstep);
  for (int tile = g0; tile < gend; tile += gstep) {
    int mt, nt; band_decode(tile, 264, 12, mt, nt);
    const int m0 = mt * 128;
    f32x4 acc[4][4];
    gemm_mainloop(smem, 1, 1024,
                  [&](int r, int) { return (const u16*)(p.H + (size_t)(m0 + r) * DM); },
                  [&](int c) { return (const u16*)(p.qkv_t + (size_t)(nt * 128 + c) * 1024); }, acc);
    acc_to_lds(Cs, acc);
    const bool isctx = m0 >= TL;
    const int b = isctx ? (m0 - TL) >> 8 : m0 >> 13;
    const int t0 = isctx ? (m0 - TL) & 255 : m0 & 8191;
    if (nt < 10) {
      const int lane = tid & 63, wave = tid >> 6;
      const int hh = lane >> 5, pr = lane & 31;
      const bool isq = nt < 8;
      const float* gain = isq ? p.q_gain : p.k_gain;
      const float qs = isq ? 0.125f * 1.4426950408889634f : 1.f;
      const float g0 = gain[2 * pr] * qs, g1 = gain[2 * pr + 1] * qs;
      u16* dstb;
      size_t tstride = 64;
      if (isq) {
        const int head = nt * 2 + hh;
        dstb = isctx ? p.QC + ((size_t)(b * 16 + head) * 256 + t0) * 64 : p.Q + ((size_t)(b * 16 + head) * 8192 + t0) * 64;
      } else {
        const int kh = (nt - 8) * 2 + hh;
        dstb = p.Kb + ((size_t)(b * 4 + kh) * NKEY + (isctx ? t0 : 256 + t0)) * 64;
      }
#pragma unroll 4
      for (int rr = 0; rr < 32; ++rr) {
        const int r = wave * 32 + rr;
        const float2 v = *(const float2*)&CS(r, 2 * lane);
        float ss = v.x * v.x + v.y * v.y;
        ss = sum32(ss);
        const float rinv = rsqrtf(ss * (1.f / 64.f) + 1e-6f);
        float x0 = v.x * rinv * g0, x1 = v.y * rinv * g1;
        if (!isctx) {
          const float2 cssn = *(const float2*)(p.rope + ((size_t)(t0 + r) * 32 + pr) * 2);
          const float y0 = x0 * cssn.x - x1 * cssn.y, y1 = x0 * cssn.y + x1 * cssn.x;
          x0 = y0; x1 = y1;
        }
        *(unsigned*)(dstb + (size_t)r * tstride + 2 * pr) = pack2(x0, x1);
      }
    } else {
      const int keybase = (isctx ? t0 : 256 + t0);
      for (int j = 0; j < 4; ++j) {
        const int item = tid + 256 * j;
        const int d = item & 63, hh = (item >> 6) & 1, rg = item >> 7;
        const int kh = (nt - 10) * 2 + hh;
        float v[16];
#pragma unroll
        for (int i = 0; i < 16; ++i) v[i] = CS(rg * 16 + i, hh * 64 + d);
        u16* dst = p.Vt + ((size_t)(b * 4 + kh) * 64 + d) * NKEY + keybase + rg * 16;
        *(u32x4*)(dst) = mk4(pack2(v[0], v[1]), pack2(v[2], v[3]), pack2(v[8], v[9]), pack2(v[10], v[11]));
        *(u32x4*)(dst + 8) = mk4(pack2(v[4], v[5]), pack2(v[6], v[7]), pack2(v[12], v[13]), pack2(v[14], v[15]));
      }
    }
  }
}

DI void phase_attn(const Params& p, char* smem) {
  u16* Ks = (u16*)smem;
  u16* Vs = Ks + 64 * 64;
  const int tid = threadIdx.x, lane = tid & 63, wave = tid >> 6;
  const int sw = (lane >> 1) & 7, hsel = lane >> 5;
  float mq = 0.f, mk = 0.f;
  for (int d = 0; d < 64; ++d) { mq = fmaxf(mq, fabsf(p.q_gain[d])); mk = fmaxf(mk, fabsf(p.k_gain[d])); }
  const float c0 = 0.125f * 1.4426950408889634f * 64.f * mq * mk * 1.02f + 0.5f;
  f32x16 negc;
#pragma unroll
  for (int i = 0; i < 16; ++i) negc[i] = -c0;
  int ga, gae, gs, gc, gce, gs2;
  work_range(4096, ga, gae, gs);
  work_range(128, gc, gce, gs2);
  const int n_lat = ga < gae ? (gae - ga + gs - 1) / gs : 0;
  const int n_ctx = gc < gce ? (gce - gc + gs2 - 1) / gs2 : 0;
  for (int wi = 0; wi < n_lat + n_ctx; ++wi) {
    const int item = wi < n_lat ? ga + wi * gs : 4096 + gc + (wi - n_lat) * gs2;
    int b, kvh, qb, nkt;
    const u16* qbase;
    size_t orow;
    const int head_g = wave;
    if (item < 4096) {
      b = item >> 10; kvh = (item >> 8) & 3; qb = item & 255; nkt = NKEY / 64;
      qbase = p.Q + ((size_t)(b * 16 + kvh * 4 + head_g) * 8192 + qb * 32) * 64;
      orow = (size_t)b * 8192 + qb * 32;
    } else {
      const int j = item - 4096;
      b = j >> 5; kvh = (j >> 3) & 3; qb = j & 7; nkt = 4;
      qbase = p.QC + ((size_t)(b * 16 + kvh * 4 + head_g) * 256 + qb * 32) * 64;
      orow = (size_t)TL + b * 256 + qb * 32;
    }
    const int head = kvh * 4 + head_g;
    bf16x8 qf[4];
#pragma unroll
    for (int ks = 0; ks < 4; ++ks) qf[ks] = *(const bf16x8*)(qbase + (lane & 31) * 64 + ks * 16 + hsel * 8);
    const u16* kg = p.Kb + (size_t)(b * 4 + kvh) * NKEY * 64;
    const u16* vg = p.Vt + (size_t)(b * 4 + kvh) * 64 * NKEY;
    f32x16 oacc[2];
#pragma unroll
    for (int i = 0; i < 16; ++i) { oacc[0][i] = 0.f; oacc[1][i] = 0.f; }
    f32x2 ls2 = {0.f, 0.f};
    u32x4 rk[2], rv[2];
#pragma unroll
    for (int q = 0; q < 2; ++q) {
      const int ch = tid + 256 * q;
      rk[q] = *(const u32x4*)(kg + (size_t)ch * 8);
      rv[q] = *(const u32x4*)(vg + (size_t)(ch >> 3) * NKEY + (ch & 7) * 8);
    }
    for (int kt = 0; kt < nkt; ++kt) {
      __syncthreads();
#pragma unroll
      for (int q = 0; q < 2; ++q) {
        const int ch = tid + 256 * q;
        const int row = ch >> 3, cc = ch & 7;
        const int pc = cc ^ ((row >> 1) & 7);
        *(u32x4*)(Ks + row * 64 + pc * 8) = rk[q];
        *(u32x4*)(Vs + row * 64 + pc * 8) = rv[q];
      }
      __syncthreads();
      if (kt + 1 < nkt) {
#pragma unroll
        for (int q = 0; q < 2; ++q) {
          const int ch = tid + 256 * q;
          rk[q] = *(const u32x4*)(kg + (size_t)(kt + 1) * 4096 + (size_t)ch * 8);
          rv[q] = *(const u32x4*)(vg + (size_t)(ch >> 3) * NKEY + (kt + 1) * 64 + (ch & 7) * 8);
        }
      }
      f32x16 sacc[2];
      bf16x8 kf[2][4];
#pragma unroll
      for (int kb = 0; kb < 2; ++kb)
#pragma unroll
        for (int ks = 0; ks < 4; ++ks) kf[kb][ks] = *(const bf16x8*)(Ks + (kb * 32 + (lane & 31)) * 64 + (((ks * 2 + hsel) ^ sw) * 8));
      __builtin_amdgcn_sched_barrier(0);
#pragma unroll
      for (int kb = 0; kb < 2; ++kb)
#pragma unroll
        for (int ks = 0; ks < 4; ++ks)
          sacc[kb] = __builtin_amdgcn_mfma_f32_32x32x16_bf16(kf[kb][ks], qf[ks], ks == 0 ? negc : sacc[kb], 0, 0, 0);
      bf16x8 vf[4][2];
#pragma unroll
      for (int c4 = 0; c4 < 4; ++c4)
#pragma unroll
        for (int db = 0; db < 2; ++db) vf[c4][db] = *(const bf16x8*)(Vs + (db * 32 + (lane & 31)) * 64 + (((2 * c4 + hsel) ^ sw) * 8));
#pragma unroll
      for (int kb = 0; kb < 2; ++kb)
#pragma unroll
        for (int i = 0; i < 16; i += 2) {
          const float e0 = __builtin_amdgcn_exp2f(sacc[kb][i]), e1 = __builtin_amdgcn_exp2f(sacc[kb][i + 1]);
          sacc[kb][i] = e0; sacc[kb][i + 1] = e1;
          const f32x2 e2 = {e0, e1};
          ls2 += e2;
        }
#pragma unroll
      for (int kb = 0; kb < 2; ++kb)
#pragma unroll
        for (int s2 = 0; s2 < 2; ++s2) {
          unsigned w[4];
#pragma unroll
          for (int e = 0; e < 4; ++e) w[e] = pack2(sacc[kb][8 * s2 + 2 * e], sacc[kb][8 * s2 + 2 * e + 1]);
          u32x4 pw = mk4(w[0], w[1], w[2], w[3]);
          const bf16x8 pf = __builtin_bit_cast(bf16x8, pw);
#pragma unroll
          for (int db = 0; db < 2; ++db) oacc[db] = __builtin_amdgcn_mfma_f32_32x32x16_bf16(vf[2 * kb + s2][db], pf, oacc[db], 0, 0, 0);
        }
    }
    const float lsum = ls2[0] + ls2[1];
    const float l = lsum + __shfl_xor(lsum, 32, 64);
    const float inv = 1.f / l;
    u16* od = p.H + (orow + (lane & 31)) * DM + head * 64;
#pragma unroll
    for (int db = 0; db < 2; ++db)
#pragma unroll
      for (int g = 0; g < 4; ++g) {
        uint2 o;
        o.x = pack2(oacc[db][g * 4 + 0] * inv, oacc[db][g * 4 + 1] * inv);
        o.y = pack2(oacc[db][g * 4 + 2] * inv, oacc[db][g * 4 + 3] * inv);
        *(uint2*)(od + db * 32 + 8 * g + 4 * hsel) = o;
      }
  }
}

template <bool FROM_INPUT>
DI void phase_proj_res(const Params& p, char* smem, const u16* A, int lda, int K, const u16* Bt, int layer, int gate_idx, int mtiles) {
  int g0, gend, gstep; work_range(mtiles * 8, g0, gend, gstep);
  for (int tile = g0; tile < gend; tile += gstep) {
    int mt, nt; band_decode(tile, mtiles, 8, mt, nt);
    const int m0 = mt * 128;
    f32x4 acc[4][4];
    gemm_mainloop(smem, 1, K,
                  [&](int r, int) { return A + (size_t)(m0 + r) * lda; },
                  [&](int c) { return Bt + (size_t)(nt * 128 + c) * K; }, acc);
    const float* gate = p.modv + ((size_t)layer * 5 + midx_of(m0)) * 6144 + gate_idx * 1024 + nt * 128;
    const float* sb = (FROM_INPUT ? xin_ptr(p, m0) : (const float*)resid_ptr(p, m0)) + nt * 128;
    float* db = resid_ptr(p, m0) + nt * 128;
    epi_direct(acc, [&](int r, int c, float v) { db[r * DM + c] = sb[r * DM + c] + gate[c] * v; });
  }
}

DI void phase_ffn_up(const Params& p, char* smem, int layer, bool with_ctx, u16* ACT) {
  float* Cs = (float*)smem;
  const int tid = threadIdx.x;
  const int mtiles = with_ctx ? 276 : 264;
  int g0, gend, gstep; work_range(mtiles * 44, g0, gend, gstep);
  const u16* up = p.up_t + (size_t)layer * 5632 * 1024;
  const float* cw = p.f_cw + (size_t)layer * 3 * 5632;
  const float* cb = p.f_cb + (size_t)layer * 5632;
  for (int tile = g0; tile < gend; tile += gstep) {
    int mt, nt; band_decode(tile, mtiles, 44, mt, nt);
    int rowbase, T, j;
    if (mt < 264) { rowbase = (mt / 66) * 8192; T = 8192; j = mt % 66; }
    else { const int m2 = mt - 264; rowbase = TL + (m2 / 3) * 256; T = 256; j = m2 % 3; }
    const int tb = j * 126 - 1;
    f32x4 acc[4][4];
    gemm_mainloop(smem, 1, 1024,
                  [&](int r, int) { const int t = tb + r; return (t >= 0 && t < T) ? (const u16*)(p.H + (size_t)(rowbase + t) * DM) : (const u16*)p.zero; },
                  [&](int c) { return up + (size_t)(c < 64 ? nt * 64 + c : 2816 + nt * 64 + (c - 64)) * 1024; }, acc);
    acc_to_lds(Cs, acc);
    const int c = tid & 63, rq = tid >> 6;
    const int n = nt * 64 + c;
    const float g0 = cw[n], g1 = cw[5632 + n], g2 = cw[2 * 5632 + n], gb = cb[n];
    const float v0 = cw[2816 + n], v1 = cw[5632 + 2816 + n], v2 = cw[2 * 5632 + 2816 + n], vb = cb[2816 + n];
    const int rs = 1 + rq * 32;
    int re = rs + 32; if (re > 127) re = 127;
    float gp = CS(rs - 1, c), gc = CS(rs, c), vp = CS(rs - 1, c + 64), vc = CS(rs, c + 64);
    for (int r = rs; r < re; ++r) {
      const float gn = CS(r + 1, c), vn = CS(r + 1, c + 64);
      const int t = tb + r;
      if (t < T) {
        const float g = g0 * gp + g1 * gc + g2 * gn + gb;
        const float v = v0 * vp + v1 * vc + v2 * vn + vb;
        const float a = g * __builtin_amdgcn_rcpf(1.f + __expf(-g)) * v;
        ACT[(size_t)(rowbase + t) * DFF + n] = f2bf(a);
      }
      gp = gc; gc = gn; vp = vc; vc = vn;
    }
  }
}

DI void phase_rwkv_gemms(const Params& p, char* smem) {
  float* Cs = (float*)smem;
  const int tid = threadIdx.x;
  int g0, gend, gstep; work_range(7312, g0, gend, gstep);
  for (int tile = g0; tile < gend; tile += gstep) {
    int job, mt, nt;
    const u16* Bt;
    if (tile < 2048) { job = 0; band_decode(tile, 256, 8, mt, nt); Bt = p.rr_t; }
    else if (tile < 4160) { job = 1; band_decode(tile - 2048, 264, 8, mt, nt); Bt = p.rk_t; }
    else if (tile < 6272) { job = 2; band_decode(tile - 4160, 264, 8, mt, nt); Bt = p.rv_t; }
    else if (tile < 6536) { job = 3; mt = tile - 6272; nt = 0; Bt = p.w1_t; }
    else if (tile < 6800) { job = 4; mt = tile - 6536; nt = 0; Bt = p.a1_t; }
    else { job = 5; band_decode(tile - 6800, 256, 2, mt, nt); Bt = p.g1_t; }
    const int m0 = mt * 128;
    f32x4 acc[4][4];
    gemm_mainloop(smem, 2, 1024,
                  [&](int r, int part) { return (const u16*)((part ? p.XX : p.H) + (size_t)(m0 + r) * DM); },
                  [&](int c) { return Bt + (size_t)(nt * 128 + c) * 2048; }, acc);
    if (job == 0) {
      epi_direct(acc, [&](int r, int c, float v) { p.R16[(size_t)(m0 + r) * DM + nt * 128 + c] = (f16)v; });
    } else if (job == 2) {
      epi_direct(acc, [&](int r, int c, float v) { p.V16[(size_t)(m0 + r) * DM + nt * 128 + c] = (f16)v; });
    } else if (job == 3) {
      epi_direct(acc, [&](int r, int c, float v) { p.LW[(size_t)(m0 + r) * 128 + c] = f2bf(tanhf(v)); });
    } else if (job == 4) {
      epi_direct(acc, [&](int r, int c, float v) { p.LA[(size_t)(m0 + r) * 128 + c] = f2bf(v); });
    } else if (job == 5) {
      epi_direct(acc, [&](int r, int c, float v) {
        const int col = nt * 128 + c;
        if (col < 192) p.LG[(size_t)(m0 + r) * 192 + col] = col < 160 ? f2bf(sigmoid_fast(v)) : (u16)0;
      });
    } else {
      acc_to_lds(Cs, acc);
      const int lane = tid & 63, wave = tid >> 6;
      const int col = nt * 128 + 2 * lane;
      const float kk0 = p.k_k[col], kk1 = p.k_k[col + 1];
#pragma unroll 4
      for (int rr = 0; rr < 32; ++rr) {
        const int r = wave * 32 + rr;
        const float2 v = *(const float2*)&CS(r, 2 * lane);
        const float a0 = v.x * kk0, a1 = v.y * kk1;
        float ss = a0 * a0 + a1 * a1;
        ss = sum32(ss);
        const float inv = 1.f / fmaxf(sqrtf(ss), 1e-12f);
        f16 k2[2], n2[2];
        k2[0] = (f16)v.x; k2[1] = (f16)v.y; n2[0] = (f16)(a0 * inv); n2[1] = (f16)(a1 * inv);
        *(unsigned*)(p.K16 + (size_t)(m0 + r) * DM + col) = *(const unsigned*)k2;
        *(unsigned*)(p.KK16 + (size_t)(m0 + r) * DM + col) = *(const unsigned*)n2;
      }
    }
  }
}

#define XB_TMO      128
#define XB_XCNT(j)  (256  + 64 * (j))
#define XB_XSUB(j)  (1280 + 64 * (j))
#define XB_XGEN(j)  (2304 + 64 * (j))
#define XB_TOP      3328
#define XB_TOPGEN   3392
#define XB_SPIN_CAP (1u << 20)
DI unsigned xb_ld(unsigned* p) { return __hip_atomic_load(p, __ATOMIC_RELAXED, __HIP_MEMORY_SCOPE_AGENT); }
DI unsigned xb_add(unsigned* p, unsigned v) { return __hip_atomic_fetch_add(p, v, __ATOMIC_RELAXED, __HIP_MEMORY_SCOPE_AGENT); }
DI unsigned xb_xcc_id() { return (unsigned)__builtin_amdgcn_s_getreg((3 << 11) | 20) & 0xFu; }
#define XB_SPIN(cond, bar) do { unsigned _sp = 0; while (cond) { __builtin_amdgcn_s_sleep(1); \
    if ((++_sp & 255u) == 0u) { if (xb_ld(&(bar)[XB_TMO])) break; if (_sp > XB_SPIN_CAP) { atomicAdd(&(bar)[XB_TMO], 1u); break; } } } } while (0)
struct XbState { unsigned x, nloc, nx; };
DI void xb_census(unsigned* bar, unsigned x, unsigned& nloc, unsigned& nx) {
  const unsigned G = gridDim.x;
  unsigned sum, cnt, mine, sp = 0u;
  for (;;) {
    sum = 0u; cnt = 0u; mine = 0u;
#pragma unroll
    for (unsigned j = 0; j < 16; ++j) { const unsigned c = xb_ld(&bar[XB_XCNT(j)]); sum += c; cnt += (c > 0u) ? 1u : 0u; mine = (j == x) ? c : mine; }
    if (sum == G) break;
    __builtin_amdgcn_s_sleep(1);
    if ((++sp & 255u) == 0u) { if (xb_ld(&bar[XB_TMO])) break; if (sp > XB_SPIN_CAP) { atomicAdd(&bar[XB_TMO], 1u); break; } }
  }
  nloc = mine > 0u ? mine : 1u; nx = cnt > 0u ? cnt : 1u;
}
DI void grid_barrier(unsigned* bar, XbState& st) {
  asm volatile("s_waitcnt vmcnt(0)" ::: "memory");
  __syncthreads();
  if (threadIdx.x == 0) {
    __builtin_amdgcn_s_waitcnt(0);
    if (st.nloc == 0u) xb_census(bar, st.x, st.nloc, st.nx);
    const unsigned nloc = st.nloc, nx = st.nx;
    const unsigned old = xb_add(&bar[XB_XSUB(st.x)], 1u);
    const unsigned gen = old / nloc;
    if (old + 1u == (gen + 1u) * nloc) {
      __builtin_amdgcn_fence(__ATOMIC_RELEASE, "agent");
      asm volatile("s_waitcnt vmcnt(0)" ::: "memory");
      const unsigned og = xb_add(&bar[XB_TOP], 1u);
      const unsigned tg = og / nx;
      if (og + 1u == (tg + 1u) * nx) xb_add(&bar[XB_TOPGEN], 1u);
      else XB_SPIN(xb_ld(&bar[XB_TOPGEN]) == tg, bar);
      __builtin_amdgcn_fence(__ATOMIC_ACQUIRE, "agent");
      xb_add(&bar[XB_XGEN(st.x)], 1u);
      asm volatile("s_waitcnt vmcnt(0)" ::: "memory");
    } else {
      XB_SPIN(xb_ld(&bar[XB_XGEN(st.x)]) == gen, bar);
      __builtin_amdgcn_fence(__ATOMIC_ACQUIRE, "agent");
      asm volatile("s_waitcnt vmcnt(0)" ::: "memory");
    }
  }
  __syncthreads();
}

struct ScanLds {
  float dec[2][16][64], kd[2][16][64], nk[2][16][64], bb[2][16][64], rr[2][16][64];
  float vv[2][16][16];
  float yy[2][16][16];
  float bp[2][4][16];
};

template <int DIR, bool EMIT>
DI void scan_steps(const ScanLds& L, int bsel, int c0, int myrow, int l15, f32x2& Sa, f32x2& Sb, float& ykeep) {
  f32x4 d4[2], k4[2], n4[2], b4[2], r4[2];
  float vv[2];
  auto ld = [&](int slot, int s) {
    d4[slot] = *(const f32x4*)&L.dec[bsel][s][c0];
    k4[slot] = *(const f32x4*)&L.kd[bsel][s][c0];
    n4[slot] = *(const f32x4*)&L.nk[bsel][s][c0];
    b4[slot] = *(const f32x4*)&L.bb[bsel][s][c0];
    if (EMIT) r4[slot] = *(const f32x4*)&L.rr[bsel][s][c0];
    vv[slot] = L.vv[bsel][s][myrow];
  };
  ld(0, DIR ? 15 : 0);
#pragma unroll
  for (int ss = 0; ss < 16; ++ss) {
    const int s = DIR ? 15 - ss : ss;
    const int cur = ss & 1;
    if (ss + 1 < 16) ld(cur ^ 1, DIR ? 14 - ss : ss + 1);
    const f32x2 nlo = {n4[cur][0], n4[cur][1]}, nhi = {n4[cur][2], n4[cur][3]};
    const f32x2 dlo = {d4[cur][0], d4[cur][1]}, dhi = {d4[cur][2], d4[cur][3]};
    const f32x2 klo = {k4[cur][0], k4[cur][1]}, khi = {k4[cur][2], k4[cur][3]};
    const f32x2 blo = {b4[cur][0], b4[cur][1]}, bhi = {b4[cur][2], b4[cur][3]};
    f32x2 t = Sa * nlo + Sb * nhi;
    float sa = dpp_sum16(t[0] + t[1]);
    const f32x2 sa2 = {sa, sa}, v2 = {vv[cur], vv[cur]};
    Sa = Sa * dlo + (sa2 * blo + v2 * klo);
    Sb = Sb * dhi + (sa2 * bhi + v2 * khi);
    if (EMIT) {
      const f32x2 rlo = {r4[cur][0], r4[cur][1]}, rhi = {r4[cur][2], r4[cur][3]};
      const f32x2 u = Sa * rlo + Sb * rhi;
      const float y = dpp_sum16(u[0] + u[1]);
      ykeep = (l15 == s) ? y : ykeep;
    }
  }
}

template <int DIR>
DI void scan_item(const Params& p, ScanLds& L, int b, int h, int q) {
  constexpr int dir = DIR;
  const int tid = threadIdx.x, lane = tid & 63, wave = tid >> 6;
  const int l15 = lane & 15, l4 = lane >> 4;
  const int colw = h * 64 + wave * 16 + l15;
  const int chd = wave * 16 + l15;
  bf16x8 w2f[2], a2f[2];
#pragma unroll
  for (int ks = 0; ks < 2; ++ks) {
    w2f[ks] = *(const bf16x8*)(p.w2_t + ((size_t)(dir * 1024 + colw) * 64 + ks * 32 + l4 * 8));
    a2f[ks] = *(const bf16x8*)(p.a2_t + ((size_t)(dir * 1024 + colw) * 64 + ks * 32 + l4 * 8));
  }
  const float w0c = p.dw0[dir * 1024 + colw], a0c = p.a0[dir * 1024 + colw], kac = p.k_a[colw], rkc = p.r_k[colw];
  f32x2 Sa = {0.f, 0.f}, Sb = {0.f, 0.f};
  const int myrow = wave * 4 + l4;
  const int c0 = l15 * 4;
  bf16x8 lwf[2], laf[2];
  f16 kv[4], kkv[4], rv[4];
  f16 vvr;
  auto chunk_rowbase = [&](int c, bool& isctx) -> int {
    if (c < 16) { isctx = true; const int cc = dir ? 15 - c : c; return TL + b * 256 + cc * 16; }
    isctx = false; const int cc = dir ? 511 - (c - 16) : (c - 16); return b * 8192 + cc * 16;
  };
  auto stage_load = [&](int c) {
    bool isctx; const int rb = chunk_rowbase(c, isctx);
#pragma unroll
    for (int ks = 0; ks < 2; ++ks) {
      lwf[ks] = *(const bf16x8*)(p.LW + ((size_t)(rb + l15) * 128 + dir * 64 + ks * 32 + l4 * 8));
      laf[ks] = *(const bf16x8*)(p.LA + ((size_t)(rb + l15) * 128 + dir * 64 + ks * 32 + l4 * 8));
    }
#pragma unroll
    for (int i = 0; i < 4; ++i) {
      const size_t off = (size_t)(rb + l4 * 4 + i) * DM + colw;
      kv[i] = p.K16[off]; kkv[i] = p.KK16[off];
      rv[i] = isctx ? (f16)0.f : p.R16[off];
    }
    vvr = p.V16[(size_t)(rb + (tid >> 4)) * DM + h * 64 + q * 16 + (tid & 15)];
  };
  auto stage_compute = [&](int c) {
    const int bsel = c & 1;
    f32x4 wacc = {0.f, 0.f, 0.f, 0.f}, aacc = {0.f, 0.f, 0.f, 0.f};
    wacc = __builtin_amdgcn_mfma_f32_16x16x32_bf16(lwf[0], w2f[0], wacc, 0, 0, 0);
    wacc = __builtin_amdgcn_mfma_f32_16x16x32_bf16(lwf[1], w2f[1], wacc, 0, 0, 0);
    aacc = __builtin_amdgcn_mfma_f32_16x16x32_bf16(laf[0], a2f[0], aacc, 0, 0, 0);
    aacc = __builtin_amdgcn_mfma_f32_16x16x32_bf16(laf[1], a2f[1], aacc, 0, 0, 0);
    float bpart[4];
#pragma unroll
    for (int i = 0; i < 4; ++i) {
      const int s = l4 * 4 + i;
      const float sg = sigmoid_fast(w0c + wacc[i]);
      const float dec = __expf(-0.6065306597126334f * sg);
      const float a = sigmoid_fast(a0c + aacc[i]);
      const float k = (float)kv[i], kk = (float)kkv[i], r = (float)rv[i];
      const float kd = k * (1.f + (a - 1.f) * kac);
      L.dec[bsel][s][chd] = dec;
      L.kd[bsel][s][chd] = kd;
      L.nk[bsel][s][chd] = -kk;
      L.bb[bsel][s][chd] = kk * a;
      L.rr[bsel][s][chd] = r;
      if (q == 0) bpart[i] = dpp_sum16(r * kd * rkc);
    }
    if (q == 0 && l15 == 0) {
#pragma unroll
      for (int i = 0; i < 4; ++i) L.bp[bsel][wave][l4 * 4 + i] = bpart[i];
    }
    L.vv[bsel][tid >> 4][tid & 15] = (float)vvr;
  };
  auto write_bonus = [&](int c) {
    if (q == 0 && tid < 16) {
      bool isctx; const int rb = chunk_rowbase(c, isctx);
      const int b2 = c & 1;
      p.bonus[((size_t)dir * MR + rb + tid) * 16 + h] = L.bp[b2][0][tid] + L.bp[b2][1][tid] + L.bp[b2][2][tid] + L.bp[b2][3][tid];
    }
  };
  __syncthreads();
  stage_load(0);
  stage_compute(0);
  __syncthreads();
  write_bonus(0);
  const int NCH = 528;
  float ykeep = 0.f;
#pragma unroll 1
  for (int c = 0; c < 16; ++c) {
    stage_load(c + 1);
    scan_steps<DIR, false>(L, c & 1, c0, myrow, l15, Sa, Sb, ykeep);
    stage_compute(c + 1);
    __syncthreads();
    write_bonus(c + 1);
  }
#pragma unroll 1
  for (int c = 16; c < NCH; ++c) {
    const int bsel = c & 1;
    if (c + 1 < NCH) stage_load(c + 1);
    scan_steps<DIR, true>(L, bsel, c0, myrow, l15, Sa, Sb, ykeep);
    L.yy[bsel][l15][myrow] = ykeep;
    if (c + 1 < NCH) stage_compute(c + 1);
    __syncthreads();
    {
      bool isctx; const int rb = chunk_rowbase(c, isctx);
      f16* Y = dir ? p.Y1 : p.Y0;
      Y[(size_t)(rb + (tid >> 4)) * DM + h * 64 + q * 16 + (tid & 15)] = (f16)(L.yy[bsel][tid >> 4][tid & 15] * 0.0625f);
    }
    if (c + 1 < NCH) write_bonus(c + 1);
  }
}

struct ScanLds2 {
  float dec[2][16][64], kd[2][16][64], nk[2][16][64], bb[2][16][64], rr[2][16][64];
  float vv[2][16][32];
  float yy[2][16][32];
  float bp[2][4][16];
};
DI float dpp_sum8(float v) {
  v += dpp_mov<0xB1>(v);
  v += dpp_mov<0x4E>(v);
  v += dpp_mov<0x141>(v);
  return v;
}
template <int DIR, bool EMIT>
DI void scan_steps2(const ScanLds2& L, int bsel, int c0, int myrow, int l7, f32x2 (&S)[4], float& ykA, float& ykB) {
  f32x4 d4[2][2], k4[2][2], n4[2][2], b4[2][2], r4[2][2];
  float vv[2];
  auto ld = [&](int slot, int s) {
#pragma unroll
    for (int hf = 0; hf < 2; ++hf) {
      d4[slot][hf] = *(const f32x4*)&L.dec[bsel][s][c0 + 4 * hf];
      k4[slot][hf] = *(const f32x4*)&L.kd[bsel][s][c0 + 4 * hf];
      n4[slot][hf] = *(const f32x4*)&L.nk[bsel][s][c0 + 4 * hf];
      b4[slot][hf] = *(const f32x4*)&L.bb[bsel][s][c0 + 4 * hf];
      if (EMIT) r4[slot][hf] = *(const f32x4*)&L.rr[bsel][s][c0 + 4 * hf];
    }
    vv[slot] = L.vv[bsel][s][myrow];
  };
  ld(0, DIR ? 15 : 0);
#pragma unroll
  for (int ss = 0; ss < 16; ++ss) {
    const int s = DIR ? 15 - ss : ss;
    const int cur = ss & 1;
    if (ss + 1 < 16) ld(cur ^ 1, DIR ? 14 - ss : ss + 1);
    f32x2 t = {0.f, 0.f};
#pragma unroll
    for (int i = 0; i < 4; ++i) { const f32x2 nn = {n4[cur][i >> 1][(i & 1) * 2], n4[cur][i >> 1][(i & 1) * 2 + 1]}; t += S[i] * nn; }
    const float sa = dpp_sum8(t[0] + t[1]);
    const f32x2 sa2 = {sa, sa}, v2 = {vv[cur], vv[cur]};
#pragma unroll
    for (int i = 0; i < 4; ++i) {
      const f32x2 dd = {d4[cur][i >> 1][(i & 1) * 2], d4[cur][i >> 1][(i & 1) * 2 + 1]};
      const f32x2 kk = {k4[cur][i >> 1][(i & 1) * 2], k4[cur][i >> 1][(i & 1) * 2 + 1]};
      const f32x2 bb = {b4[cur][i >> 1][(i & 1) * 2], b4[cur][i >> 1][(i & 1) * 2 + 1]};
      S[i] = S[i] * dd + (sa2 * bb + v2 * kk);
    }
    if (EMIT) {
      f32x2 u = {0.f, 0.f};
#pragma unroll
      for (int i = 0; i < 4; ++i) { const f32x2 rr = {r4[cur][i >> 1][(i & 1) * 2], r4[cur][i >> 1][(i & 1) * 2 + 1]}; u += S[i] * rr; }
      const float y = dpp_sum8(u[0] + u[1]);
      if (s < 8) ykA = (l7 == s) ? y : ykA; else ykB = (l7 == s - 8) ? y : ykB;
    }
  }
}
template <int DIR>
DI void scan_item2(const Params& p, ScanLds2& L, int b, int h, int hf) {
  constexpr int dir = DIR;
  const int tid = threadIdx.x, lane = tid & 63, wave = tid >> 6;
  const int l15 = lane & 15, l4 = lane >> 4;
  const int colw = h * 64 + wave * 16 + l15;
  const int chd = wave * 16 + l15;
  bf16x8 w2f[2], a2f[2];
#pragma unroll
  for (int ks = 0; ks < 2; ++ks) {
    w2f[ks] = *(const bf16x8*)(p.w2_t + ((size_t)(dir * 1024 + colw) * 64 + ks * 32 + l4 * 8));
    a2f[ks] = *(const bf16x8*)(p.a2_t + ((size_t)(dir * 1024 + colw) * 64 + ks * 32 + l4 * 8));
  }
  const float w0c = p.dw0[dir * 1024 + colw], a0c = p.a0[dir * 1024 + colw], kac = p.k_a[colw], rkc = p.r_k[colw];
  f32x2 S[4];
#pragma unroll
  for (int i = 0; i < 4; ++i) { S[i][0] = 0.f; S[i][1] = 0.f; }
  const int l7 = lane & 7;
  const int myrow = wave * 8 + (lane >> 3);
  const int c0 = l7 * 8;
  bf16x8 lwf[2], laf[2];
  f16 kv[4], kkv[4], rv[4];
  f16 vvr[2];
  auto chunk_rowbase = [&](int c, bool& isctx) -> int {
    if (c < 16) { isctx = true; const int cc = dir ? 15 - c : c; return TL + b * 256 + cc * 16; }
    isctx = false; const int cc = dir ? 511 - (c - 16) : (c - 16); return b * 8192 + cc * 16;
  };
  auto stage_load = [&](int c) {
    bool isctx; const int rb = chunk_rowbase(c, isctx);
#pragma unroll
    for (int ks = 0; ks < 2; ++ks) {
      lwf[ks] = *(const bf16x8*)(p.LW + ((size_t)(rb + l15) * 128 + dir * 64 + ks * 32 + l4 * 8));
      laf[ks] = *(const bf16x8*)(p.LA + ((size_t)(rb + l15) * 128 + dir * 64 + ks * 32 + l4 * 8));
    }
#pragma unroll
    for (int i = 0; i < 4; ++i) {
      const size_t off = (size_t)(rb + l4 * 4 + i) * DM + colw;
      kv[i] = p.K16[off]; kkv[i] = p.KK16[off];
      rv[i] = isctx ? (f16)0.f : p.R16[off];
    }
#pragma unroll
    for (int j = 0; j < 2; ++j) { const int e = tid + 256 * j; vvr[j] = p.V16[(size_t)(rb + (e >> 5)) * DM + h * 64 + hf * 32 + (e & 31)]; }
  };
  auto stage_compute = [&](int c) {
    const int bsel = c & 1;
    f32x4 wacc = {0.f, 0.f, 0.f, 0.f}, aacc = {0.f, 0.f, 0.f, 0.f};
    wacc = __builtin_amdgcn_mfma_f32_16x16x32_bf16(lwf[0], w2f[0], wacc, 0, 0, 0);
    wacc = __builtin_amdgcn_mfma_f32_16x16x32_bf16(lwf[1], w2f[1], wacc, 0, 0, 0);
    aacc = __builtin_amdgcn_mfma_f32_16x16x32_bf16(laf[0], a2f[0], aacc, 0, 0, 0);
    aacc = __builtin_amdgcn_mfma_f32_16x16x32_bf16(laf[1], a2f[1], aacc, 0, 0, 0);
    float bpart[4];
#pragma unroll
    for (int i = 0; i < 4; ++i) {
      const int s = l4 * 4 + i;
      const float sg = sigmoid_fast(w0c + wacc[i]);
      const float dec = __expf(-0.6065306597126334f * sg);
      const float a = sigmoid_fast(a0c + aacc[i]);
      const float k = (float)kv[i], kk = (float)kkv[i], r = (float)rv[i];
      const float kd = k * (1.f + (a - 1.f) * kac);
      L.dec[bsel][s][chd] = dec;
      L.kd[bsel][s][chd] = kd;
      L.nk[bsel][s][chd] = -kk;
      L.bb[bsel][s][chd] = kk * a;
      L.rr[bsel][s][chd] = r;
      if (hf == 0) bpart[i] = dpp_sum16(r * kd * rkc);
    }
    if (hf == 0 && l15 == 0) {
#pragma unroll
      for (int i = 0; i < 4; ++i) L.bp[bsel][wave][l4 * 4 + i] = bpart[i];
    }
#pragma unroll
    for (int j = 0; j < 2; ++j) { const int e = tid + 256 * j; L.vv[bsel][e >> 5][e & 31] = (float)vvr[j]; }
  };
  auto write_bonus = [&](int c) {
    if (hf == 0 && tid < 16) {
      bool isctx; const int rb = chunk_rowbase(c, isctx);
      const int b2 = c & 1;
      p.bonus[((size_t)dir * MR + rb + tid) * 16 + h] = L.bp[b2][0][tid] + L.bp[b2][1][tid] + L.bp[b2][2][tid] + L.bp[b2][3][tid];
    }
  };
  __syncthreads();
  stage_load(0);
  stage_compute(0);
  __syncthreads();
  write_bonus(0);
  const int NCH = 528;
  float ykA = 0.f, ykB = 0.f;
#pragma unroll 1
  for (int c = 0; c < 16; ++c) {
    stage_load(c + 1);
    scan_steps2<DIR, false>(L, c & 1, c0, myrow, l7, S, ykA, ykB);
    stage_compute(c + 1);
    __syncthreads();
    write_bonus(c + 1);
  }
#pragma unroll 1
  for (int c = 16; c < NCH; ++c) {
    const int bsel = c & 1;
    if (c + 1 < NCH) stage_load(c + 1);
    scan_steps2<DIR, true>(L, bsel, c0, myrow, l7, S, ykA, ykB);
    L.yy[bsel][l7][myrow] = ykA;
    L.yy[bsel][8 + l7][myrow] = ykB;
    if (c + 1 < NCH) stage_compute(c + 1);
    __syncthreads();
    {
      bool isctx; const int rb = chunk_rowbase(c, isctx);
      f16* Y = dir ? p.Y1 : p.Y0;
#pragma unroll
      for (int j = 0; j < 2; ++j) {
        const int e = tid + 256 * j;
        Y[(size_t)(rb + (e >> 5)) * DM + h * 64 + hf * 32 + (e & 31)] = (f16)(L.yy[bsel][e >> 5][e & 31] * 0.0625f);
      }
    }
    if (c + 1 < NCH) write_bonus(c + 1);
  }
}
DI void phase_scan2(const Params& p, char* smem) {
  ScanLds2& L = *(ScanLds2*)smem;
  const unsigned info = p.blkinfo[blockIdx.x];
  const unsigned rank = info >> 16, ticket = info & 0xffffu;
  const unsigned n0 = xb_ld(&p.bar[XB_N0]);
  const unsigned item = rank == 0u ? ticket : n0 + ticket;
  if (item < 256u) {
    const int sc = item >> 1, hf = item & 1;
    const int dir = sc & 1, bh = sc >> 1, b = bh >> 4, h = bh & 15;
    if (dir) scan_item2<1>(p, L, b, h, hf); else scan_item2<0>(p, L, b, h, hf);
  }
}

DI void phase_scan(const Params& p, char* smem) {
  ScanLds& L = *(ScanLds*)smem;
  for (int item = blockIdx.x; item < 512; item += gridDim.x) {
    int sc, q;
    if (gridDim.x == 512) { const int xcd = item & 7, slot = item >> 3; sc = xcd * 16 + (slot >> 2); q = slot & 3; }
    else { sc = item >> 2; q = item & 3; }
    const int dir = sc & 1, bh = sc >> 1, b = bh >> 4, h = bh & 15;
    if (dir) scan_item<1>(p, L, b, h, q); else scan_item<0>(p, L, b, h, q);
  }
}

DI void phase_readout(const Params& p, char* smem) {
  float* Cs = (float*)smem;
  const int tid = threadIdx.x;
  int g0, gend, gstep; work_range(256 * 8, g0, gend, gstep);
  for (int tile = g0; tile < gend; tile += gstep) {
    int mt, nt; band_decode(tile, 256, 8, mt, nt);
    const int m0 = mt * 128;
    f32x4 acc[4][4];
    gemm_mainloop(smem, 1, 192,
                  [&](int r, int) { return (const u16*)(p.LG + (size_t)(m0 + r) * 192); },
                  [&](int c) { return (const u16*)(p.g2_t + (size_t)(nt * 128 + c) * 192); }, acc);
    acc_to_lds(Cs, acc);
    const int lane = tid & 63, wave = tid >> 6;
    const int head = nt * 2 + (lane >> 5);
    const int col = nt * 128 + 2 * lane;
    const float gw0 = p.gn_w[col], gw1 = p.gn_w[col + 1], gb0 = p.gn_b[col], gb1 = p.gn_b[col + 1];
#pragma unroll 2
    for (int rr = 0; rr < 32; ++rr) {
      const int r = wave * 32 + rr;
      const int row = m0 + r;
      const unsigned ua = *(const unsigned*)(p.Y0 + (size_t)row * DM + col), ub = *(const unsigned*)(p.Y1 + (size_t)row * DM + col);
      const unsigned uv = *(const unsigned*)(p.V16 + (size_t)row * DM + col);
      const f16* fa = (const f16*)&ua; const f16* fb = (const f16*)&ub; const f16* fv = (const f16*)&uv;
      const float y0 = ((float)fa[0] + (float)fb[0]) * 16.f, y1 = ((float)fa[1] + (float)fb[1]) * 16.f;
      float sm = y0 + y1;
      sm = sum32(sm);
      const float mean = sm * (1.f / 64.f);
      const float d0 = y0 - mean, d1 = y1 - mean;
      float vs = d0 * d0 + d1 * d1;
      vs = sum32(vs);
      const float rstd = rsqrtf(vs * (1.f / 64.f) + 64e-5f);
      const float bon = p.bonus[((size_t)0 * MR + row) * 16 + head] + p.bonus[((size_t)1 * MR + row) * 16 + head];
      const float2 g = *(const float2*)&CS(r, 2 * lane);
      const float z0 = (d0 * rstd * gw0 + gb0 + bon * (float)fv[0]) * g.x;
      const float z1 = (d1 * rstd * gw1 + gb1 + bon * (float)fv[1]) * g.y;
      *(unsigned*)(p.Z + (size_t)row * DM + col) = pack2(z0, z1);
    }
  }
}

DI void phase_final(const Params& p) {
  const int lane = threadIdx.x & 63;
  const int gw = blockIdx.x * 4 + (threadIdx.x >> 6), nw = gridDim.x * 4;
  for (int row = gw; row < TL; row += nw) {
    float* src = p.out + (size_t)row * DM;
    float4 v[4];
    float ss = 0.f;
#pragma unroll
    for (int i = 0; i < 4; ++i) {
      v[i] = *(const float4*)(src + i * 256 + lane * 4);
      ss += v[i].x * v[i].x + v[i].y * v[i].y + v[i].z * v[i].z + v[i].w * v[i].w;
    }
    ss = wave_sum(ss);
    const float rinv = rsqrtf(ss * (1.f / 1024.f) + 1e-6f);
#pragma unroll
    for (int i = 0; i < 4; ++i) {
      const float4 g = *(const float4*)(p.final_gain + i * 256 + lane * 4);
      float4 o;
      o.x = v[i].x * rinv * g.x; o.y = v[i].y * rinv * g.y; o.z = v[i].z * rinv * g.z; o.w = v[i].w * rinv * g.w;
      *(float4*)(src + i * 256 + lane * 4) = o;
    }
  }
}

__global__ void __launch_bounds__(256, 2) mega(Params p) {
  __shared__ __attribute__((aligned(16))) char smem[65536];
  cg::grid_group grid = cg::this_grid();
  XbState xst; xst.x = xb_xcc_id(); xst.nloc = 0u; xst.nx = 0u;
  if (threadIdx.x == 0) {
    (void)xb_add(&p.bar[XB_XCNT(xst.x)], 1u);
    const unsigned hwid = (unsigned)__builtin_amdgcn_s_getreg((7 << 11) | (8 << 6) | 4) & 0xffu;
    const unsigned rank = xb_add(&p.bar[XB_CU((xst.x << 8) | hwid)], 1u);
    const unsigned ticket = xb_add(&p.bar[rank == 0u ? XB_N0 : XB_N1], 1u);
    p.blkinfo[blockIdx.x] = ((rank > 0u ? 1u : 0u) << 16) | (ticket & 0xffffu);
  }
  if (gridDim.x == 0x7fffffffu) grid.sync();
  phase_prep(p, smem); grid_barrier(p.bar, xst);
  phase_modreduce(p); grid_barrier(p.bar, xst);
  phase_modulate<true>(p, 0, 0, MR); grid_barrier(p.bar, xst);
  phase_qkv(p, smem); grid_barrier(p.bar, xst);
  phase_attn(p, smem); grid_barrier(p.bar, xst);
  phase_proj_res<true>(p, smem, p.H, 1024, 1024, p.wo_t, 0, 2, 264); grid_barrier(p.bar, xst);
  phase_modulate<false>(p, 0, 1, MR); grid_barrier(p.bar, xst);
  phase_ffn_up(p, smem, 0, true, p.ACT0); grid_barrier(p.bar, xst);
  phase_proj_res<false>(p, smem, p.ACT0, DFF, DFF, p.down_t, 0, 5, 264); grid_barrier(p.bar, xst);
  phase_rwkv_shift(p); grid_barrier(p.bar, xst);
  phase_rwkv_gemms(p, smem); grid_barrier(p.bar, xst);
  phase_scan2(p, smem); grid_barrier(p.bar, xst);
  phase_readout(p, smem); grid_barrier(p.bar, xst);
  phase_proj_res<false>(p, smem, p.Z, 1024, 1024, p.ro_t, 1, 2, 256); grid_barrier(p.bar, xst);
  phase_modulate<false>(p, 1, 1, TL); grid_barrier(p.bar, xst);
  phase_ffn_up(p, smem, 1, false, p.ACT1); grid_barrier(p.bar, xst);
  phase_proj_res<false>(p, smem, p.ACT1, DFF, DFF, p.down_t + (size_t)1024 * 2816, 1, 5, 256); grid_barrier(p.bar, xst);
  phase_final(p);
}

extern "C" void kernel_launch(void* const* d_in, const int* in_sizes, int n_in, void* d_out, int out_size, void* d_ws, size_t ws_size,
                              hipStream_t stream) {
  static int grid_blocks = 0;
  if (!grid_blocks) {
    int dev = 0, cus = 0, per_cu = 0;
    hipGetDevice(&dev);
    hipDeviceGetAttribute(&cus, hipDeviceAttributeMultiprocessorCount, dev);
    hipOccupancyMaxActiveBlocksPerMultiprocessor(&per_cu, mega, 256, 0);
    if (per_cu > 2) per_cu = 2;
    if (per_cu < 1) per_cu = 1;
    grid_blocks = cus * per_cu;
  }
  Params p{};
  const float* const* in = (const float* const*)d_in;
  p.x = in[0]; p.c = in[1]; p.ctx = in[2]; p.c_ctx = in[3]; p.ada_w = in[4]; p.ada_b = in[5]; p.w_qkv = in[6]; p.q_gain = in[7];
  p.k_gain = in[8]; p.w_o = in[9]; p.mu = in[10]; p.rw_r = in[11]; p.rw_k = in[12]; p.rw_v = in[13]; p.rw_o = in[14]; p.dw0 = in[15];
  p.dw1 = in[16]; p.dw2 = in[17]; p.a0 = in[18]; p.a1 = in[19]; p.a2 = in[20]; p.g1 = in[21]; p.g2 = in[22]; p.k_k = in[23];
  p.k_a = in[24]; p.r_k = in[25]; p.gn_w = in[26]; p.gn_b = in[27]; p.f_up = in[28]; p.f_cw = in[29]; p.f_cb = in[30];
  p.f_down = in[31]; p.final_gain = in[32];
  p.out = (float*)d_out;
  char* w = (char*)d_ws;
  size_t off = 0;
  auto take = [&](size_t bytes) { char* r = w + off; off += (bytes + 255) & ~(size_t)255; return r; };
  p.qkv_t = (u16*)take((size_t)1536 * 1024 * 2);
  p.wo_t = (u16*)take((size_t)1024 * 1024 * 2);
  p.up_t = (u16*)take((size_t)2 * 5632 * 1024 * 2);
  p.down_t = (u16*)take((size_t)2 * 1024 * 2816 * 2);
  p.rr_t = (u16*)take((size_t)1024 * 2048 * 2);
  p.rk_t = (u16*)take((size_t)1024 * 2048 * 2);
  p.rv_t = (u16*)take((size_t)1024 * 2048 * 2);
  p.ro_t = (u16*)take((size_t)1024 * 1024 * 2);
  p.w1_t = (u16*)take((size_t)128 * 2048 * 2);
  p.a1_t = (u16*)take((size_t)128 * 2048 * 2);
  p.g1_t = (u16*)take((size_t)256 * 2048 * 2);
  p.w2_t = (u16*)take((size_t)2 * 1024 * 64 * 2);
  p.a2_t = (u16*)take((size_t)2 * 1024 * 64 * 2);
  p.g2_t = (u16*)take((size_t)1024 * 192 * 2);
  p.modpart = (float*)take((size_t)2 * 8 * 5 * 6144 * 4);
  p.modv = (float*)take((size_t)2 * 5 * 6144 * 4);
  p.rope = (float*)take((size_t)8192 * 32 * 2 * 4);
  p.XC = (float*)take((size_t)TCX * DM * 4);
  p.bonus = (float*)take((size_t)2 * MR * 16 * 4);
  p.zero = (u16*)take(8192);
  p.bar = (unsigned*)take(65536);
  p.blkinfo = (unsigned*)take(4096 * 4);
  const size_t pb = off;
  p.H = (u16*)take((size_t)MR * DM * 2);
  const size_t after_h = off;
  p.Q = (u16*)take((size_t)TL * DM * 2);
  p.QC = (u16*)take((size_t)TCX * DM * 2);
  p.Kb = (u16*)take((size_t)16 * NKEY * 64 * 2);
  p.Vt = (u16*)take((size_t)16 * NKEY * 64 * 2);
  p.ACT0 = (u16*)take((size_t)MR * DFF * 2);
  const size_t end0 = off;
  off = after_h;
  p.XX = (u16*)take((size_t)MR * DM * 2);
  p.R16 = (f16*)take((size_t)TL * DM * 2);
  p.K16 = (f16*)take((size_t)MR * DM * 2);
  p.V16 = (f16*)take((size_t)MR * DM * 2);
  p.KK16 = (f16*)take((size_t)MR * DM * 2);
  p.LW = (u16*)take((size_t)MR * 128 * 2);
  p.LA = (u16*)take((size_t)MR * 128 * 2);
  p.LG = (u16*)take((size_t)TL * 192 * 2);
  const size_t end1 = off;
  p.Y0 = (f16*)p.H;
  p.Y1 = (f16*)p.XX;
  p.Z = (u16*)p.R16;
  p.ACT1 = (u16*)p.K16;
  (void)pb;
  const size_t need = end0 > end1 ? end0 : end1;
  if (need > ws_size) { fprintf(stderr, "workspace too small: need %zu have %zu\n", need, ws_size); return; }
  hipMemsetAsync(p.bar, 0, 65536, stream);
  void* args[] = {&p};
  hipError_t e = hipLaunchCooperativeKernel((void*)mega, dim3(grid_blocks), dim3(256), args, 0, stream);
  if (e != hipSuccess) fprintf(stderr, "cooperative launch failed: %s (grid %d)\n", hipGetErrorString(e), grid_blocks);
}
```

```cpp
#include <hip/hip_runtime.h>
#include <hip/hip_cooperative_groups.h>
#include <cstdio>
#include <cstdint>
namespace cg = cooperative_groups;

typedef unsigned short u16;
typedef _Float16 f16;
using bf16x8 = __attribute__((ext_vector_type(8))) short;
using f32x16 = __attribute__((ext_vector_type(16))) float;
using f32x4 = __attribute__((ext_vector_type(4))) float;
using u32x4 = __attribute__((ext_vector_type(4))) unsigned;
#define DI __device__ __forceinline__
DI u32x4 mk4(unsigned a, unsigned b, unsigned c, unsigned d) { u32x4 r; r[0] = a; r[1] = b; r[2] = c; r[3] = d; return r; }

constexpr int TL = 32768;
constexpr int TCX = 1024;
constexpr int MR = 33792;
constexpr int DM = 1024;
constexpr int DFF = 2816;
constexpr int NKEY = 8448;
constexpr int NPHASE = 18;
#define XB_CU(j)    (4096 + (j))
#define XB_N0       8192
#define XB_N1       8256

struct Params {
  const float *x, *c, *ctx, *c_ctx, *ada_w, *ada_b, *w_qkv, *q_gain, *k_gain, *w_o;
  const float *mu, *rw_r, *rw_k, *rw_v, *rw_o, *dw0, *dw1, *dw2, *a0, *a1, *a2, *g1, *g2, *k_k, *k_a, *r_k, *gn_w, *gn_b;
  const float *f_up, *f_cw, *f_cb, *f_down, *final_gain;
  float* out;
  u16 *qkv_t, *wo_t, *up_t, *down_t, *rr_t, *rk_t, *rv_t, *ro_t, *w1_t, *a1_t, *g1_t, *w2_t, *a2_t, *g2_t;
  float *modpart, *modv, *rope, *XC, *bonus;
  u16* zero;
  unsigned* bar;
  unsigned* blkinfo;
  u16 *H, *XX, *Q, *QC, *Kb, *Vt, *ACT0, *ACT1;
  f16 *R16, *K16, *V16, *KK16, *Y0, *Y1;
  u16 *LW, *LA, *LG, *Z;
  int phase_lo, phase_hi;
};

typedef __bf16 bf16x2_t __attribute__((ext_vector_type(2)));
typedef float f32x2 __attribute__((ext_vector_type(2)));
DI unsigned pack2(float a, float b) { f32x2 f = {a, b}; return __builtin_bit_cast(unsigned, __builtin_convertvector(f, bf16x2_t)); }
DI u16 f2bf(float x) { return (u16)(pack2(x, 0.f) & 0xffffu); }
DI float bf2f(u16 h) { return __uint_as_float(((unsigned)h) << 16); }
DI float wave_sum(float v) {
#pragma unroll
  for (int o = 32; o > 0; o >>= 1) v += __shfl_xor(v, o, 64);
  return v;
}
template <int CTRL> DI float dpp_mov(float v) { return __builtin_bit_cast(float, __builtin_amdgcn_update_dpp(0, __builtin_bit_cast(int, v), CTRL, 0xF, 0xF, false)); }
DI float dpp_sum16(float v) {
  v += dpp_mov<0x128>(v);
  v += dpp_mov<0x124>(v);
  v += dpp_mov<0x122>(v);
  v += dpp_mov<0x121>(v);
  return v;
}
DI float sum32(float v) { v = dpp_sum16(v); v += __shfl_xor(v, 16, 64); return v; }
DI float sigmoidf_(float x) { return 1.f / (1.f + __expf(-x)); }
DI float sigmoid_fast(float x) { return __builtin_amdgcn_rcpf(1.f + __expf(-x)); }
DI int midx_of(int row) { return row < TL ? (row >> 13) : 4; }
DI float* resid_ptr(const Params& p, int row) { return row < TL ? p.out + (size_t)row * DM : p.XC + (size_t)(row - TL) * DM; }
DI const float* xin_ptr(const Params& p, int row) { return row < TL ? p.x + (size_t)row * DM : p.ctx + (size_t)(row - TL) * DM; }

DI void work_range(int total, int& g0, int& gend, int& step) {
  if ((gridDim.x & 7) == 0) {
    const int x = blockIdx.x & 7, li = blockIdx.x >> 3, nl = gridDim.x >> 3;
    const int lo = (int)(((long long)total * x) >> 3), hi = (int)(((long long)total * (x + 1)) >> 3);
    g0 = lo + li; gend = hi; step = nl;
  } else { g0 = blockIdx.x; gend = total; step = gridDim.x; }
}
DI void band_decode(int g, int MT, int NT, int& mt, int& nt) {
  const int per = 8 * NT;
  const int band = g / per, r = g - band * per;
  int hb = MT - band * 8; if (hb > 8) hb = 8;
  nt = r / hb; mt = band * 8 + (r - nt * hb);
}

using GAcc = f32x4[4][4];
template <class AF, class BF>
DI void gemm_mainloop(char* smem, int nparts, int kpart, AF arow, BF brow, f32x4 (&acc)[4][4]) {
  const int tid = threadIdx.x, lane = tid & 63, wave = tid >> 6;
  const int wm = wave >> 1, wn = wave & 1;
  const int lr = tid >> 3, lc = tid & 7;
#pragma unroll
  for (int i = 0; i < 4; ++i)
#pragma unroll
    for (int j = 0; j < 4; ++j)
#pragma unroll
      for (int e = 0; e < 4; ++e) acc[i][j][e] = 0.f;
  const int csrc = (lc ^ ((lr >> 1) & 7)) * 8;
  const u16* bp[4];
  const u16* ap[4];
#pragma unroll
  for (int q = 0; q < 4; ++q) { bp[q] = brow(lr + 32 * q) + csrc; ap[q] = arow(lr + 32 * q, 0) + csrc; }
  const int nk = kpart >> 6;
  const int total = nparts * nk;
  const int sw = (lane >> 1) & 7;
  const int kq = lane >> 4;
  char* const wbase = smem + wave * 1024;
  auto stage = [&](int buf, int kk, int boff) {
#pragma unroll
    for (int q = 0; q < 4; ++q) {
      __builtin_amdgcn_global_load_lds((const unsigned*)(ap[q] + kk), (unsigned*)(wbase + buf * 32768 + q * 4096), 16, 0, 0);
      __builtin_amdgcn_global_load_lds((const unsigned*)(bp[q] + boff), (unsigned*)(wbase + buf * 32768 + 16384 + q * 4096), 16, 0, 0);
    }
  };
  __syncthreads();
  stage(0, 0, 0);
  asm volatile("s_waitcnt vmcnt(0)" ::: "memory");
  __syncthreads();
  int part = 0, kk = 0, buf = 0;
#pragma unroll 1
  for (int it = 0; it < total; ++it) {
    kk += 64;
    if (kk == kpart) {
      kk = 0; ++part;
      if (part < nparts) {
#pragma unroll
        for (int q = 0; q < 4; ++q) ap[q] = arow(lr + 32 * q, part) + csrc;
      }
    }
    if (it + 1 < total) stage(buf ^ 1, kk, part * kpart + kk);
    const u16* As = (const u16*)(smem + buf * 32768);
    const u16* Bs = As + 128 * 64;
    const u16* Ar = As + (wm * 64 + (lane & 15)) * 64;
    const u16* Br = Bs + (wn * 64 + (lane & 15)) * 64;
    bf16x8 af[2][4], bf[2][4];
    {
      const int pc = (kq ^ sw) * 8;
#pragma unroll
      for (int i = 0; i < 4; ++i) { af[0][i] = *(const bf16x8*)(Ar + i * 1024 + pc); bf[0][i] = *(const bf16x8*)(Br + i * 1024 + pc); }
    }
#pragma unroll
    for (int ks = 0; ks < 2; ++ks) {
      const int cur = ks & 1;
      if (ks + 1 < 2) {
        const int pc = ((4 + kq) ^ sw) * 8;
#pragma unroll
        for (int i = 0; i < 4; ++i) { af[1][i] = *(const bf16x8*)(Ar + i * 1024 + pc); bf[1][i] = *(const bf16x8*)(Br + i * 1024 + pc); }
      }
#pragma unroll
      for (int i = 0; i < 4; ++i)
#pragma unroll
        for (int j = 0; j < 4; ++j) acc[i][j] = __builtin_amdgcn_mfma_f32_16x16x32_bf16(af[cur][i], bf[cur][j], acc[i][j], 0, 0, 0);
      __builtin_amdgcn_sched_barrier(0);
    }
    asm volatile("s_waitcnt vmcnt(0)" ::: "memory");
    __syncthreads();
    buf ^= 1;
  }
}

template <class F>
DI void epi_direct(const f32x4 (&acc)[4][4], F f) {
  const int lane = threadIdx.x & 63, wave = threadIdx.x >> 6;
  const int wm = wave >> 1, wn = wave & 1, g = lane >> 4;
#pragma unroll
  for (int i = 0; i < 4; ++i)
#pragma unroll
    for (int j = 0; j < 4; ++j)
#pragma unroll
      for (int e = 0; e < 4; ++e) {
        const int row = wm * 64 + i * 16 + g * 4 + e;
        const int col = wn * 64 + j * 16 + (lane & 15);
        f(row, col, acc[i][j][e]);
      }
}
#define CS(r, c) Cs[(r) * 128 + (c)]
DI void acc_to_lds(float* Cs, const f32x4 (&acc)[4][4]) {
  __syncthreads();
  epi_direct(acc, [&](int r, int c, float v) { CS(r, c) = v; });
  __syncthreads();
}

struct TJob { const float* src; int srcK, srcN; u16* dst; int ld, koff; const float* mu; int Kpad, Npad; };
DI TJob get_job(const Params& p, int j) {
  TJob t; t.mu = nullptr; t.koff = 0;
  auto set = [&](const float* s, int K, int N, u16* d, int ld) { t.src = s; t.srcK = K; t.srcN = N; t.dst = d; t.ld = ld; t.Kpad = K; t.Npad = N; };
  switch (j) {
    case 4: set(p.w_qkv, 1024, 1536, p.qkv_t, 1024); break;
    case 5: set(p.w_o, 1024, 1024, p.wo_t, 1024); break;
    case 0: set(p.f_up, 1024, 5632, p.up_t, 1024); break;
    case 1: set(p.f_up + (size_t)1024 * 5632, 1024, 5632, p.up_t + (size_t)5632 * 1024, 1024); break;
    case 2: set(p.f_down, 2816, 1024, p.down_t, 2816); break;
    case 3: set(p.f_down + (size_t)2816 * 1024, 2816, 1024, p.down_t + (size_t)1024 * 2816, 2816); break;
    case 6: set(p.rw_r, 1024, 1024, p.rr_t, 2048); break;
    case 7: set(p.rw_r, 1024, 1024, p.rr_t, 2048); t.mu = p.mu + 0 * 1024; t.koff = 1024; break;
    case 8: set(p.rw_k, 1024, 1024, p.rk_t, 2048); break;
    case 9: set(p.rw_k, 1024, 1024, p.rk_t, 2048); t.mu = p.mu + 2 * 1024; t.koff = 1024; break;
    case 10: set(p.rw_v, 1024, 1024, p.rv_t, 2048); break;
    case 11: set(p.rw_v, 1024, 1024, p.rv_t, 2048); t.mu = p.mu + 3 * 1024; t.koff = 1024; break;
    case 12: set(p.rw_o, 1024, 1024, p.ro_t, 1024); break;
    case 13: set(p.dw1, 1024, 64, p.w1_t, 2048); break;
    case 14: set(p.dw1, 1024, 64, p.w1_t, 2048); t.mu = p.mu + 1 * 1024; t.koff = 1024; break;
    case 15: set(p.dw1 + 1024 * 64, 1024, 64, p.w1_t + 64 * 2048, 2048); break;
    case 16: set(p.dw1 + 1024 * 64, 1024, 64, p.w1_t + 64 * 2048, 2048); t.mu = p.mu + 1 * 1024; t.koff = 1024; break;
    case 17: set(p.a1, 1024, 64, p.a1_t, 2048); break;
    case 18: set(p.a1, 1024, 64, p.a1_t, 2048); t.mu = p.mu + 4 * 1024; t.koff = 1024; break;
    case 19: set(p.a1 + 1024 * 64, 1024, 64, p.a1_t + 64 * 2048, 2048); break;
    case 20: set(p.a1 + 1024 * 64, 1024, 64, p.a1_t + 64 * 2048, 2048); t.mu = p.mu + 4 * 1024; t.koff = 1024; break;
    case 21: set(p.g1, 1024, 160, p.g1_t, 2048); t.Npad = 256; break;
    case 22: set(p.g1, 1024, 160, p.g1_t, 2048); t.Npad = 256; t.mu = p.mu + 5 * 1024; t.koff = 1024; break;
    case 23: set(p.dw2, 64, 1024, p.w2_t, 64); break;
    case 24: set(p.dw2 + 64 * 1024, 64, 1024, p.w2_t + 1024 * 64, 64); break;
    case 25: set(p.a2, 64, 1024, p.a2_t, 64); break;
    case 26: set(p.a2 + 64 * 1024, 64, 1024, p.a2_t + 1024 * 64, 64); break;
    default: set(p.g2, 160, 1024, p.g2_t, 192); t.Kpad = 192; break;
  }
  return t;
}
constexpr int NJOBS = 28;
DI int job_tiles(const TJob& t) { return ((t.Kpad + 63) >> 6) * ((t.Npad + 63) >> 6); }

DI void phase_prep(const Params& p, char* smem) {
  const int tid = threadIdx.x;
  const int ttiles = 7024;
  const int n_mod = 2 * 24 * 8;
  const int n_rope = 1024;
  const int total = ttiles + n_mod + n_rope;
  float* tile = (float*)smem;
  if (blockIdx.x == 0) for (int e = tid; e < 4096; e += 256) p.zero[e] = 0;
  {
    auto decode = [&](int item, TJob& t, int& kt, int& nt) {
      int rem = item, j = 0;
      t = get_job(p, 0);
      while (true) { int n = job_tiles(t); if (rem < n) break; rem -= n; ++j; t = get_job(p, j); }
      const int ntn = (t.Npad + 63) >> 6;
      kt = rem / ntn; nt = rem % ntn;
    };
    auto load_tile = [&](const TJob& t, int kt, int nt, float (&v)[16]) {
#pragma unroll
      for (int i = 0; i < 16; ++i) {
        const int kl = i * 4 + (tid >> 6), nl = tid & 63;
        const int k = kt * 64 + kl, n = nt * 64 + nl;
        float x = 0.f;
        if (k < t.srcK && n < t.srcN) { x = t.src[(size_t)k * t.srcN + n]; if (t.mu) x *= t.mu[k]; }
        v[i] = x;
      }
    };
    TJob tc, tn; int ktc = 0, ntc = 0, ktn = 0, ntn_ = 0;
    float vc[16], vn[16];
    int item = blockIdx.x;
    if (item < ttiles) { decode(item, tc, ktc, ntc); load_tile(tc, ktc, ntc, vc); }
    for (; item < ttiles; item += gridDim.x) {
      const int nxt = item + gridDim.x;
      if (nxt < ttiles) { decode(nxt, tn, ktn, ntn_); load_tile(tn, ktn, ntn_, vn); }
      __syncthreads();
#pragma unroll
      for (int i = 0; i < 16; ++i) tile[(i * 4 + (tid >> 6)) * 65 + (tid & 63)] = vc[i];
      __syncthreads();
#pragma unroll
      for (int i = 0; i < 16; ++i) {
        const int nl = i * 4 + (tid >> 6), kl = tid & 63;
        const int k = ktc * 64 + kl, n = ntc * 64 + nl;
        if (k < tc.Kpad && n < tc.Npad) tc.dst[(size_t)n * tc.ld + tc.koff + k] = f2bf(tile[kl * 65 + nl]);
      }
      if (nxt < ttiles) {
        tc = tn; ktc = ktn; ntc = ntn_;
#pragma unroll
        for (int i = 0; i < 16; ++i) vc[i] = vn[i];
      }
    }
  }
  int first_other = ttiles + (int)blockIdx.x;
  for (int item = first_other; item < total; item += gridDim.x) {
    if (false) {
    } else if (item < ttiles + n_mod) {
      const int it = item - ttiles;
      const int layer = it / 192, cc = (it % 192) / 8, kc = it % 8;
      float* sil = (float*)smem;
      __syncthreads();
      for (int e = tid; e < 640; e += 256) {
        const int j = e >> 7, k = kc * 128 + (e & 127);
        const float v = j < 4 ? p.c[j * 1024 + k] : p.c_ctx[k];
        sil[e] = v / (1.f + __expf(-v));
      }
      __syncthreads();
      const int col = cc * 256 + tid;
      float a0 = 0, a1 = 0, a2 = 0, a3 = 0, a4 = 0;
      const float* w = p.ada_w + ((size_t)layer * 1024 + kc * 128) * 6144 + col;
#pragma unroll 16
      for (int k = 0; k < 128; ++k) {
        const float wv = w[(size_t)k * 6144];
        a0 += sil[k] * wv; a1 += sil[128 + k] * wv; a2 += sil[256 + k] * wv; a3 += sil[384 + k] * wv; a4 += sil[512 + k] * wv;
      }
      float* mp = p.modpart + ((size_t)(layer * 8 + kc) * 5) * 6144 + col;
      mp[0] = a0; mp[6144] = a1; mp[2 * 6144] = a2; mp[3 * 6144] = a3; mp[4 * 6144] = a4;
    } else {
      const int e = (item - ttiles - n_mod) * 256 + tid;
      const int s = e >> 5, pr = e & 31;
      const int f = pr & 15;
      const float inv_freq = powf(10000.f, -(float)f / 16.f);
      const float pos = (pr < 16) ? (float)(s >> 6) : (float)(s & 63);
      const float ang = pos * inv_freq;
      float sn, cs;
      sincosf(ang, &sn, &cs);
      p.rope[e * 2] = cs; p.rope[e * 2 + 1] = sn;
    }
  }
}

DI void phase_modreduce(const Params& p) {
  const int n = 2 * 5 * 6144;
  for (int e = blockIdx.x * 256 + threadIdx.x; e < n; e += gridDim.x * 256) {
    const int layer = e / (5 * 6144), r = e % (5 * 6144), col = r % 6144;
    float s = p.ada_b[layer * 6144 + col];
    for (int kc = 0; kc < 8; ++kc) s += p.modpart[(size_t)(layer * 8 + kc) * 5 * 6144 + r];
    p.modv[e] = s;
  }
}

template <bool FROM_INPUT>
DI void phase_modulate(const Params& p, int layer, int which, int nrows) {
  const int lane = threadIdx.x & 63;
  const int gw = blockIdx.x * 4 + (threadIdx.x >> 6), nw = gridDim.x * 4;
  auto load_row = [&](int row, float4 (&v)[4]) {
    const float* src = FROM_INPUT ? xin_ptr(p, row) : resid_ptr(p, row);
#pragma unroll
    for (int i = 0; i < 4; ++i) v[i] = *(const float4*)(src + i * 256 + lane * 4);
  };
  float4 v[4], vn[4];
  int row = gw;
  if (row < nrows) load_row(row, v);
  for (; row < nrows; row += nw) {
    const int nxt = row + nw;
    if (nxt < nrows) load_row(nxt, vn);
    const float* mv = p.modv + ((size_t)layer * 5 + midx_of(row)) * 6144 + which * 3072;
    float ss = 0.f;
#pragma unroll
    for (int i = 0; i < 4; ++i) ss += v[i].x * v[i].x + v[i].y * v[i].y + v[i].z * v[i].z + v[i].w * v[i].w;
    ss = wave_sum(ss);
    const float rinv = rsqrtf(ss * (1.f / 1024.f) + 1e-6f);
#pragma unroll
    for (int i = 0; i < 4; ++i) {
      const int col = i * 256 + lane * 4;
      const float4 sh = *(const float4*)(mv + col);
      const float4 sc = *(const float4*)(mv + 1024 + col);
      uint2 o;
      o.x = pack2(v[i].x * rinv * (1.f + sc.x) + sh.x, v[i].y * rinv * (1.f + sc.y) + sh.y);
      o.y = pack2(v[i].z * rinv * (1.f + sc.z) + sh.z, v[i].w * rinv * (1.f + sc.w) + sh.w);
      *(uint2*)(p.H + (size_t)row * DM + col) = o;
    }
#pragma unroll
    for (int i = 0; i < 4; ++i) v[i] = vn[i];
  }
}

DI void modrow(const Params& p, int row, bool valid, int lane, float (&h)[16]) {
  if (!valid) {
#pragma unroll
    for (int i = 0; i < 16; ++i) h[i] = 0.f;
    return;
  }
  const float* src = resid_ptr(p, row);
  const float* mv = p.modv + ((size_t)1 * 5 + midx_of(row)) * 6144;
  float ss = 0.f;
#pragma unroll
  for (int i = 0; i < 4; ++i) {
    const float4 v = *(const float4*)(src + i * 256 + lane * 4);
    h[i * 4 + 0] = v.x; h[i * 4 + 1] = v.y; h[i * 4 + 2] = v.z; h[i * 4 + 3] = v.w;
    ss += v.x * v.x + v.y * v.y + v.z * v.z + v.w * v.w;
  }
  ss = wave_sum(ss);
  const float rinv = rsqrtf(ss * (1.f / 1024.f) + 1e-6f);
#pragma unroll
  for (int i = 0; i < 4; ++i) {
    const int col = i * 256 + lane * 4;
    const float4 sh = *(const float4*)(mv + col);
    const float4 sc = *(const float4*)(mv + 1024 + col);
    h[i * 4 + 0] = h[i * 4 + 0] * rinv * (1.f + sc.x) + sh.x;
    h[i * 4 + 1] = h[i * 4 + 1] * rinv * (1.f + sc.y) + sh.y;
    h[i * 4 + 2] = h[i * 4 + 2] * rinv * (1.f + sc.z) + sh.z;
    h[i * 4 + 3] = h[i * 4 + 3] * rinv * (1.f + sc.w) + sh.w;
  }
}
DI void phase_rwkv_shift(const Params& p) {
  const int lane = threadIdx.x & 63;
  const int gw = blockIdx.x * 4 + (threadIdx.x >> 6), nw = gridDim.x * 4;
  const int nitems = MR / 8;
  for (int item = gw; item < nitems; item += nw) {
    const int r0 = item * 8;
    int sb, T;
    if (r0 < TL) { sb = r0 & ~8191; T = 8192; } else { sb = TL + ((r0 - TL) & ~255); T = 256; }
    float hm[16], hc[16], hn[16];
    modrow(p, r0 - 1, r0 - 1 >= sb, lane, hm);
    modrow(p, r0, true, lane, hc);
    for (int j = 0; j < 8; ++j) {
      const int row = r0 + j;
      modrow(p, row + 1, row + 1 < sb + T, lane, hn);
#pragma unroll
      for (int i = 0; i < 4; ++i) {
        const int col = i * 256 + lane * 4;
        float xx[4];
#pragma unroll
        for (int e = 0; e < 4; ++e) xx[e] = 0.5f * (hm[i * 4 + e] + hn[i * 4 + e]) - hc[i * 4 + e];
        uint2 o, o2;
        o.x = pack2(hc[i * 4 + 0], hc[i * 4 + 1]); o.y = pack2(hc[i * 4 + 2], hc[i * 4 + 3]);
        o2.x = pack2(xx[0], xx[1]); o2.y = pack2(xx[2], xx[3]);
        *(uint2*)(p.H + (size_t)row * DM + col) = o;
        *(uint2*)(p.XX + (size_t)row * DM + col) = o2;
      }
#pragma unroll
      for (int i = 0; i < 16; ++i) { hm[i] = hc[i]; hc[i] = hn[i]; }
    }
  }
}

DI void phase_qkv(const Params& p, char* smem) {
  float* Cs = (float*)smem;
  const int tid = threadIdx.x;
  int g0, gend, gstep; work_range(264 * 12, g0, gend, gstep);
  for (int tile = g0; tile < gend; tile += gstep) {
    int mt, nt; band_decode(tile, 264, 12, mt, nt);
    const int m0 = mt * 128;
    f32x4 acc[4][4];
    gemm_mainloop(smem, 1, 1024,
                  [&](int r, int) { return (const u16*)(p.H + (size_t)(m0 + r) * DM); },
                  [&](int c) { return (const u16*)(p.qkv_t + (size_t)(nt * 128 + c) * 1024); }, acc);
    acc_to_lds(Cs, acc);
    const bool isctx = m0 >= TL;
    const int b = isctx ? (m0 - TL) >> 8 : m0 >> 13;
    const int t0 = isctx ? (m0 - TL) & 255 : m0 & 8191;
    if (nt < 10) {
      const int lane = tid & 63, wave = tid >> 6;
      const int hh = lane >> 5, pr = lane & 31;
      const bool isq = nt < 8;
      const float* gain = isq ? p.q_gain : p.k_gain;
      const float qs = isq ? 0.125f * 1.4426950408889634f : 1.f;
      const float g0 = gain[2 * pr] * qs, g1 = gain[2 * pr + 1] * qs;
      u16* dstb;
      size_t tstride = 64;
      if (isq) {
        const int head = nt * 2 + hh;
        dstb = isctx ? p.QC + ((size_t)(b * 16 + head) * 256 + t0) * 64 : p.Q + ((size_t)(b * 16 + head) * 8192 + t0) * 64;
      } else {
        const int kh = (nt - 8) * 2 + hh;
        dstb = p.Kb + ((size_t)(b * 4 + kh) * NKEY + (isctx ? t0 : 256 + t0)) * 64;
      }
#pragma unroll 4
      for (int rr = 0; rr < 32; ++rr) {
        const int r = wave * 32 + rr;
        const float2 v = *(const float2*)&CS(r, 2 * lane);
        float ss = v.x * v.x + v.y * v.y;
        ss = sum32(ss);
        const float rinv = rsqrtf(ss * (1.f / 64.f) + 1e-6f);
        float x0 = v.x * rinv * g0, x1 = v.y * rinv * g1;
        if (!isctx) {
          const float2 cssn = *(const float2*)(p.rope + ((size_t)(t0 + r) * 32 + pr) * 2);
          const float y0 = x0 * cssn.x - x1 * cssn.y, y1 = x0 * cssn.y + x1 * cssn.x;
          x0 = y0; x1 = y1;
        }
        *(unsigned*)(dstb + (size_t)r * tstride + 2 * pr) = pack2(x0, x1);
      }
    } else {
      const int keybase = (isctx ? t0 : 256 + t0);
      for (int j = 0; j < 4; ++j) {
        const int item = tid + 256 * j;
        const int d = item & 63, hh = (item >> 6) & 1, rg = item >> 7;
        const int kh = (nt - 10) * 2 + hh;
        float v[16];
#pragma unroll
        for (int i = 0; i < 16; ++i) v[i] = CS(rg * 16 + i, hh * 64 + d);
        u16* dst = p.Vt + ((size_t)(b * 4 + kh) * 64 + d) * NKEY + keybase + rg * 16;
        *(u32x4*)(dst) = mk4(pack2(v[0], v[1]), pack2(v[2], v[3]), pack2(v[8], v[9]), pack2(v[10], v[11]));
        *(u32x4*)(dst + 8) = mk4(pack2(v[4], v[5]), pack2(v[6], v[7]), pack2(v[12], v[13]), pack2(v[14], v[15]));
      }
    }
  }
}

DI void phase_attn(const Params& p, char* smem) {
  u16* Ks = (u16*)smem;
  u16* Vs = Ks + 64 * 64;
  const int tid = threadIdx.x, lane = tid & 63, wave = tid >> 6;
  const int sw = (lane >> 1) & 7, hsel = lane >> 5;
  float mq = 0.f, mk = 0.f;
  for (int d = 0; d < 64; ++d) { mq = fmaxf(mq, fabsf(p.q_gain[d])); mk = fmaxf(mk, fabsf(p.k_gain[d])); }
  const float c0 = 0.125f * 1.4426950408889634f * 64.f * mq * mk * 1.02f + 0.5f;
  f32x16 negc;
#pragma unroll
  for (int i = 0; i < 16; ++i) negc[i] = -c0;
  int ga, gae, gs, gc, gce, gs2;
  work_range(4096, ga, gae, gs);
  work_range(128, gc, gce, gs2);
  const int n_lat = ga < gae ? (gae - ga + gs - 1) / gs : 0;
  const int n_ctx = gc < gce ? (gce - gc + gs2 - 1) / gs2 : 0;
  for (int wi = 0; wi < n_lat + n_ctx; ++wi) {
    const int item = wi < n_lat ? ga + wi * gs : 4096 + gc + (wi - n_lat) * gs2;
    int b, kvh, qb, nkt;
    const u16* qbase;
    size_t orow;
    const int head_g = wave;
    if (item < 4096) {
      b = item >> 10; kvh = (item >> 8) & 3; qb = item & 255; nkt = NKEY / 64;
      qbase = p.Q + ((size_t)(b * 16 + kvh * 4 + head_g) * 8192 + qb * 32) * 64;
      orow = (size_t)b * 8192 + qb * 32;
    } else {
      const int j = item - 4096;
      b = j >> 5; kvh = (j >> 3) & 3; qb = j & 7; nkt = 4;
      qbase = p.QC + ((size_t)(b * 16 + kvh * 4 + head_g) * 256 + qb * 32) * 64;
      orow = (size_t)TL + b * 256 + qb * 32;
    }
    const int head = kvh * 4 + head_g;
    bf16x8 qf[4];
#pragma unroll
    for (int ks = 0; ks < 4; ++ks) qf[ks] = *(const bf16x8*)(qbase + (lane & 31) * 64 + ks * 16 + hsel * 8);
    const u16* kg = p.Kb + (size_t)(b * 4 + kvh) * NKEY * 64;
    const u16* vg = p.Vt + (size_t)(b * 4 + kvh) * 64 * NKEY;
    f32x16 oacc[2];
#pragma unroll
    for (int i = 0; i < 16; ++i) { oacc[0][i] = 0.f; oacc[1][i] = 0.f; }
    f32x2 ls2 = {0.f, 0.f};
    u32x4 rk[2], rv[2];
#pragma unroll
    for (int q = 0; q < 2; ++q) {
      const int ch = tid + 256 * q;
      rk[q] = *(const u32x4*)(kg + (size_t)ch * 8);
      rv[q] = *(const u32x4*)(vg + (size_t)(ch >> 3) * NKEY + (ch & 7) * 8);
    }
    for (int kt = 0; kt < nkt; ++kt) {
      __syncthreads();
#pragma unroll
      for (int q = 0; q < 2; ++q) {
        const int ch = tid + 256 * q;
        const int row = ch >> 3, cc = ch & 7;
        const int pc = cc ^ ((row >> 1) & 7);
        *(u32x4*)(Ks + row * 64 + pc * 8) = rk[q];
        *(u32x4*)(Vs + row * 64 + pc * 8) = rv[q];
      }
      __syncthreads();
      if (kt + 1 < nkt) {
#pragma unroll
        for (int q = 0; q < 2; ++q) {
          const int ch = tid + 256 * q;
          rk[q] = *(const u32x4*)(kg + (size_t)(kt + 1) * 4096 + (size_t)ch * 8);
          rv[q] = *(const u32x4*)(vg + (size_t)(ch >> 3) * NKEY + (kt + 1) * 64 + (ch & 7) * 8);
        }
      }
      f32x16 sacc[2];
      bf16x8 kf[2][4];
#pragma unroll
      for (int kb = 0; kb < 2; ++kb)
#pragma unroll
        for (int ks = 0; ks < 4; ++ks) kf[kb][ks] = *(const bf16x8*)(Ks + (kb * 32 + (lane & 31)) * 64 + (((ks * 2 + hsel) ^ sw) * 8));
      __builtin_amdgcn_sched_barrier(0);
#pragma unroll
      for (int kb = 0; kb < 2; ++kb)
#pragma unroll
        for (int ks = 0; ks < 4; ++ks)
          sacc[kb] = __builtin_amdgcn_mfma_f32_32x32x16_bf16(kf[kb][ks], qf[ks], ks == 0 ? negc : sacc[kb], 0, 0, 0);
      bf16x8 vf[4][2];
#pragma unroll
      for (int c4 = 0; c4 < 4; ++c4)
#pragma unroll
        for (int db = 0; db < 2; ++db) vf[c4][db] = *(const bf16x8*)(Vs + (db * 32 + (lane & 31)) * 64 + (((2 * c4 + hsel) ^ sw) * 8));
#pragma unroll
      for (int kb = 0; kb < 2; ++kb)
#pragma unroll
        for (int i = 0; i < 16; i += 2) {
          const float e0 = __builtin_amdgcn_exp2f(sacc[kb][i]), e1 = __builtin_amdgcn_exp2f(sacc[kb][i + 1]);
          sacc[kb][i] = e0; sacc[kb][i + 1] = e1;
          const f32x2 e2 = {e0, e1};
          ls2 += e2;
        }
#pragma unroll
      for (int kb = 0; kb < 2; ++kb)
#pragma unroll
        for (int s2 = 0; s2 < 2; ++s2) {
          unsigned w[4];
#pragma unroll
          for (int e = 0; e < 4; ++e) w[e] = pack2(sacc[kb][8 * s2 + 2 * e], sacc[kb][8 * s2 + 2 * e + 1]);
          u32x4 pw = mk4(w[0], w[1], w[2], w[3]);
          const bf16x8 pf = __builtin_bit_cast(bf16x8, pw);
#pragma unroll
          for (int db = 0; db < 2; ++db) oacc[db] = __builtin_amdgcn_mfma_f32_32x32x16_bf16(vf[2 * kb + s2][db], pf, oacc[db], 0, 0, 0);
        }
    }
    const float lsum = ls2[0] + ls2[1];
    const float l = lsum + __shfl_xor(lsum, 32, 64);
    const float inv = 1.f / l;
    u16* od = p.H + (orow + (lane & 31)) * DM + head * 64;
#pragma unroll
    for (int db = 0; db < 2; ++db)
#pragma unroll
      for (int g = 0; g < 4; ++g) {
        uint2 o;
        o.x = pack2(oacc[db][g * 4 + 0] * inv, oacc[db][g * 4 + 1] * inv);
        o.y = pack2(oacc[db][g * 4 + 2] * inv, oacc[db][g * 4 + 3] * inv);
        *(uint2*)(od + db * 32 + 8 * g + 4 * hsel) = o;
      }
  }
}

template <bool FROM_INPUT>
DI void phase_proj_res(const Params& p, char* smem, const u16* A, int lda, int K, const u16* Bt, int layer, int gate_idx, int mtiles) {
  int g0, gend, gstep; work_range(mtiles * 8, g0, gend, gstep);
  for (int tile = g0; tile < gend; tile += gstep) {
    int mt, nt; band_decode(tile, mtiles, 8, mt, nt);
    const int m0 = mt * 128;
    f32x4 acc[4][4];
    gemm_mainloop(smem, 1, K,
                  [&](int r, int) { return A + (size_t)(m0 + r) * lda; },
                  [&](int c) { return Bt + (size_t)(nt * 128 + c) * K; }, acc);
    const float* gate = p.modv + ((size_t)layer * 5 + midx_of(m0)) * 6144 + gate_idx * 1024 + nt * 128;
    const float* sb = (FROM_INPUT ? xin_ptr(p, m0) : (const float*)resid_ptr(p, m0)) + nt * 128;
    float* db = resid_ptr(p, m0) + nt * 128;
    epi_direct(acc, [&](int r, int c, float v) { db[r * DM + c] = sb[r * DM + c] + gate[c] * v; });
  }
}

DI void phase_ffn_up(const Params& p, char* smem, int layer, bool with_ctx, u16* ACT) {
  float* Cs = (float*)smem;
  const int tid = threadIdx.x;
  const int mtiles = with_ctx ? 276 : 264;
  int g0, gend, gstep; work_range(mtiles * 44, g0, gend, gstep);
  const u16* up = p.up_t + (size_t)layer * 5632 * 1024;
  const float* cw = p.f_cw + (size_t)layer * 3 * 5632;
  const float* cb = p.f_cb + (size_t)layer * 5632;
  for (int tile = g0; tile < gend; tile += gstep) {
    int mt, nt; band_decode(tile, mtiles, 44, mt, nt);
    int rowbase, T, j;
    if (mt < 264) { rowbase = (mt / 66) * 8192; T = 8192; j = mt % 66; }
    else { const int m2 = mt - 264; rowbase = TL + (m2 / 3) * 256; T = 256; j = m2 % 3; }
    const int tb = j * 126 - 1;
    f32x4 acc[4][4];
    gemm_mainloop(smem, 1, 1024,
                  [&](int r, int) { const int t = tb + r; return (t >= 0 && t < T) ? (const u16*)(p.H + (size_t)(rowbase + t) * DM) : (const u16*)p.zero; },
                  [&](int c) { return up + (size_t)(c < 64 ? nt * 64 + c : 2816 + nt * 64 + (c - 64)) * 1024; }, acc);
    acc_to_lds(Cs, acc);
    const int c = tid & 63, rq = tid >> 6;
    const int n = nt * 64 + c;
    const float g0 = cw[n], g1 = cw[5632 + n], g2 = cw[2 * 5632 + n], gb = cb[n];
    const float v0 = cw[2816 + n], v1 = cw[5632 + 2816 + n], v2 = cw[2 * 5632 + 2816 + n], vb = cb[2816 + n];
    const int rs = 1 + rq * 32;
    int re = rs + 32; if (re > 127) re = 127;
    float gp = CS(rs - 1, c), gc = CS(rs, c), vp = CS(rs - 1, c + 64), vc = CS(rs, c + 64);
    for (int r = rs; r < re; ++r) {
      const float gn = CS(r + 1, c), vn = CS(r + 1, c + 64);
      const int t = tb + r;
      if (t < T) {
        const float g = g0 * gp + g1 * gc + g2 * gn + gb;
        const float v = v0 * vp + v1 * vc + v2 * vn + vb;
        const float a = g * __builtin_amdgcn_rcpf(1.f + __expf(-g)) * v;
        ACT[(size_t)(rowbase + t) * DFF + n] = f2bf(a);
      }
      gp = gc; gc = gn; vp = vc; vc = vn;
    }
  }
}

DI void phase_rwkv_gemms(const Params& p, char* smem) {
  float* Cs = (float*)smem;
  const int tid = threadIdx.x;
  int g0, gend, gstep; work_range(7312, g0, gend, gstep);
  for (int tile = g0; tile < gend; tile += gstep) {
    int job, mt, nt;
    const u16* Bt;
    if (tile < 2048) { job = 0; band_decode(tile, 256, 8, mt, nt); Bt = p.rr_t; }
    else if (tile < 4160) { job = 1; band_decode(tile - 2048, 264, 8, mt, nt); Bt = p.rk_t; }
    else if (tile < 6272) { job = 2; band_decode(tile - 4160, 264, 8, mt, nt); Bt = p.rv_t; }
    else if (tile < 6536) { job = 3; mt = tile - 6272; nt = 0; Bt = p.w1_t; }
    else if (tile < 6800) { job = 4; mt = tile - 6536; nt = 0; Bt = p.a1_t; }
    else { job = 5; band_decode(tile - 6800, 256, 2, mt, nt); Bt = p.g1_t; }
    const int m0 = mt * 128;
    f32x4 acc[4][4];
    gemm_mainloop(smem, 2, 1024,
                  [&](int r, int part) { return (const u16*)((part ? p.XX : p.H) + (size_t)(m0 + r) * DM); },
                  [&](int c) { return Bt + (size_t)(nt * 128 + c) * 2048; }, acc);
    if (job == 0) {
      epi_direct(acc, [&](int r, int c, float v) { p.R16[(size_t)(m0 + r) * DM + nt * 128 + c] = (f16)v; });
    } else if (job == 2) {
      epi_direct(acc, [&](int r, int c, float v) { p.V16[(size_t)(m0 + r) * DM + nt * 128 + c] = (f16)v; });
    } else if (job == 3) {
      epi_direct(acc, [&](int r, int c, float v) { p.LW[(size_t)(m0 + r) * 128 + c] = f2bf(tanhf(v)); });
    } else if (job == 4) {
      epi_direct(acc, [&](int r, int c, float v) { p.LA[(size_t)(m0 + r) * 128 + c] = f2bf(v); });
    } else if (job == 5) {
      epi_direct(acc, [&](int r, int c, float v) {
        const int col = nt * 128 + c;
        if (col < 192) p.LG[(size_t)(m0 + r) * 192 + col] = col < 160 ? f2bf(sigmoid_fast(v)) : (u16)0;
      });
    } else {
      acc_to_lds(Cs, acc);
      const int lane = tid & 63, wave = tid >> 6;
      const int col = nt * 128 + 2 * lane;
      const float kk0 = p.k_k[col], kk1 = p.k_k[col + 1];
#pragma unroll 4
      for (int rr = 0; rr < 32; ++rr) {
        const int r = wave * 32 + rr;
        const float2 v = *(const float2*)&CS(r, 2 * lane);
        const float a0 = v.x * kk0, a1 = v.y * kk1;
        float ss = a0 * a0 + a1 * a1;
        ss = sum32(ss);
        const float inv = 1.f / fmaxf(sqrtf(ss), 1e-12f);
        f16 k2[2], n2[2];
        k2[0] = (f16)v.x; k2[1] = (f16)v.y; n2[0] = (f16)(a0 * inv); n2[1] = (f16)(a1 * inv);
        *(unsigned*)(p.K16 + (size_t)(m0 + r) * DM + col) = *(const unsigned*)k2;
        *(unsigned*)(p.KK16 + (size_t)(m0 + r) * DM + col) = *(const unsigned*)n2;
      }
    }
  }
}

#define XB_TMO      128
#define XB_XCNT(j)  (256  + 64 * (j))
#define XB_XSUB(j)  (1280 + 64 * (j))
#define XB_XGEN(j)  (2304 + 64 * (j))
#define XB_TOP      3328
#define XB_TOPGEN   3392
#define XB_SPIN_CAP (1u << 20)
DI unsigned xb_ld(unsigned* p) { return __hip_atomic_load(p, __ATOMIC_RELAXED, __HIP_MEMORY_SCOPE_AGENT); }
DI unsigned xb_add(unsigned* p, unsigned v) { return __hip_atomic_fetch_add(p, v, __ATOMIC_RELAXED, __HIP_MEMORY_SCOPE_AGENT); }
DI unsigned xb_xcc_id() { return (unsigned)__builtin_amdgcn_s_getreg((3 << 11) | 20) & 0xFu; }
#define XB_SPIN(cond, bar) do { unsigned _sp = 0; while (cond) { __builtin_amdgcn_s_sleep(1); \
    if ((++_sp & 255u) == 0u) { if (xb_ld(&(bar)[XB_TMO])) break; if (_sp > XB_SPIN_CAP) { atomicAdd(&(bar)[XB_TMO], 1u); break; } } } } while (0)
struct XbState { unsigned x, nloc, nx; };
DI void xb_census(unsigned* bar, unsigned x, unsigned& nloc, unsigned& nx) {
  const unsigned G = gridDim.x;
  unsigned sum, cnt, mine, sp = 0u;
  for (;;) {
    sum = 0u; cnt = 0u; mine = 0u;
#pragma unroll
    for (unsigned j = 0; j < 16; ++j) { const unsigned c = xb_ld(&bar[XB_XCNT(j)]); sum += c; cnt += (c > 0u) ? 1u : 0u; mine = (j == x) ? c : mine; }
    if (sum == G) break;
    __builtin_amdgcn_s_sleep(1);
    if ((++sp & 255u) == 0u) { if (xb_ld(&bar[XB_TMO])) break; if (sp > XB_SPIN_CAP) { atomicAdd(&bar[XB_TMO], 1u); break; } }
  }
  nloc = mine > 0u ? mine : 1u; nx = cnt > 0u ? cnt : 1u;
}
DI void grid_barrier(unsigned* bar, XbState& st) {
  asm volatile("s_waitcnt vmcnt(0)" ::: "memory");
  __syncthreads();
  if (threadIdx.x == 0) {
    __builtin_amdgcn_s_waitcnt(0);
    if (st.nloc == 0u) xb_census(bar, st.x, st.nloc, st.nx);
    const unsigned nloc = st.nloc, nx = st.nx;
    const unsigned old = xb_add(&bar[XB_XSUB(st.x)], 1u);
    const unsigned gen = old / nloc;
    if (old + 1u == (gen + 1u) * nloc) {
      __builtin_amdgcn_fence(__ATOMIC_RELEASE, "agent");
      asm volatile("s_waitcnt vmcnt(0)" ::: "memory");
      const unsigned og = xb_add(&bar[XB_TOP], 1u);
      const unsigned tg = og / nx;
      if (og + 1u == (tg + 1u) * nx) xb_add(&bar[XB_TOPGEN], 1u);
      else XB_SPIN(xb_ld(&bar[XB_TOPGEN]) == tg, bar);
      __builtin_amdgcn_fence(__ATOMIC_ACQUIRE, "agent");
      xb_add(&bar[XB_XGEN(st.x)], 1u);
      asm volatile("s_waitcnt vmcnt(0)" ::: "memory");
    } else {
      XB_SPIN(xb_ld(&bar[XB_XGEN(st.x)]) == gen, bar);
      __builtin_amdgcn_fence(__ATOMIC_ACQUIRE, "agent");
      asm volatile("s_waitcnt vmcnt(0)" ::: "memory");
    }
  }
  __syncthreads();
}

struct ScanLds {
  float dec[2][16][64], kd[2][16][64], nk[2][16][64], bb[2][16][64], rr[2][16][64];
  float vv[2][16][16];
  float yy[2][16][16];
  float bp[2][4][16];
};

template <int DIR, bool EMIT>
DI void scan_steps(const ScanLds& L, int bsel, int c0, int myrow, int l15, f32x2& Sa, f32x2& Sb, float& ykeep) {
  f32x4 d4[2], k4[2], n4[2], b4[2], r4[2];
  float vv[2];
  auto ld = [&](int slot, int s) {
    d4[slot] = *(const f32x4*)&L.dec[bsel][s][c0];
    k4[slot] = *(const f32x4*)&L.kd[bsel][s][c0];
    n4[slot] = *(const f32x4*)&L.nk[bsel][s][c0];
    b4[slot] = *(const f32x4*)&L.bb[bsel][s][c0];
    if (EMIT) r4[slot] = *(const f32x4*)&L.rr[bsel][s][c0];
    vv[slot] = L.vv[bsel][s][myrow];
  };
  ld(0, DIR ? 15 : 0);
#pragma unroll
  for (int ss = 0; ss < 16; ++ss) {
    const int s = DIR ? 15 - ss : ss;
    const int cur = ss & 1;
    if (ss + 1 < 16) ld(cur ^ 1, DIR ? 14 - ss : ss + 1);
    const f32x2 nlo = {n4[cur][0], n4[cur][1]}, nhi = {n4[cur][2], n4[cur][3]};
    const f32x2 dlo = {d4[cur][0], d4[cur][1]}, dhi = {d4[cur][2], d4[cur][3]};
    const f32x2 klo = {k4[cur][0], k4[cur][1]}, khi = {k4[cur][2], k4[cur][3]};
    const f32x2 blo = {b4[cur][0], b4[cur][1]}, bhi = {b4[cur][2], b4[cur][3]};
    f32x2 t = Sa * nlo + Sb * nhi;
    float sa = dpp_sum16(t[0] + t[1]);
    const f32x2 sa2 = {sa, sa}, v2 = {vv[cur], vv[cur]};
    Sa = Sa * dlo + (sa2 * blo + v2 * klo);
    Sb = Sb * dhi + (sa2 * bhi + v2 * khi);
    if (EMIT) {
      const f32x2 rlo = {r4[cur][0], r4[cur][1]}, rhi = {r4[cur][2], r4[cur][3]};
      const f32x2 u = Sa * rlo + Sb * rhi;
      const float y = dpp_sum16(u[0] + u[1]);
      ykeep = (l15 == s) ? y : ykeep;
    }
  }
}

template <int DIR>
DI void scan_item(const Params& p, ScanLds& L, int b, int h, int q) {
  constexpr int dir = DIR;
  const int tid = threadIdx.x, lane = tid & 63, wave = tid >> 6;
  const int l15 = lane & 15, l4 = lane >> 4;
  const int colw = h * 64 + wave * 16 + l15;
  const int chd = wave * 16 + l15;
  bf16x8 w2f[2], a2f[2];
#pragma unroll
  for (int ks = 0; ks < 2; ++ks) {
    w2f[ks] = *(const bf16x8*)(p.w2_t + ((size_t)(dir * 1024 + colw) * 64 + ks * 32 + l4 * 8));
    a2f[ks] = *(const bf16x8*)(p.a2_t + ((size_t)(dir * 1024 + colw) * 64 + ks * 32 + l4 * 8));
  }
  const float w0c = p.dw0[dir * 1024 + colw], a0c = p.a0[dir * 1024 + colw], kac = p.k_a[colw], rkc = p.r_k[colw];
  f32x2 Sa = {0.f, 0.f}, Sb = {0.f, 0.f};
  const int myrow = wave * 4 + l4;
  const int c0 = l15 * 4;
  bf16x8 lwf[2], laf[2];
  f16 kv[4], kkv[4], rv[4];
  f16 vvr;
  auto chunk_rowbase = [&](int c, bool& isctx) -> int {
    if (c < 16) { isctx = true; const int cc = dir ? 15 - c : c; return TL + b * 256 + cc * 16; }
    isctx = false; const int cc = dir ? 511 - (c - 16) : (c - 16); return b * 8192 + cc * 16;
  };
  auto stage_load = [&](int c) {
    bool isctx; const int rb = chunk_rowbase(c, isctx);
#pragma unroll
    for (int ks = 0; ks < 2; ++ks) {
      lwf[ks] = *(const bf16x8*)(p.LW + ((size_t)(rb + l15) * 128 + dir * 64 + ks * 32 + l4 * 8));
      laf[ks] = *(const bf16x8*)(p.LA + ((size_t)(rb + l15) * 128 + dir * 64 + ks * 32 + l4 * 8));
    }
#pragma unroll
    for (int i = 0; i < 4; ++i) {
      const size_t off = (size_t)(rb + l4 * 4 + i) * DM + colw;
      kv[i] = p.K16[off]; kkv[i] = p.KK16[off];
      rv[i] = isctx ? (f16)0.f : p.R16[off];
    }
    vvr = p.V16[(size_t)(rb + (tid >> 4)) * DM + h * 64 + q * 16 + (tid & 15)];
  };
  auto stage_compute = [&](int c) {
    const int bsel = c & 1;
    f32x4 wacc = {0.f, 0.f, 0.f, 0.f}, aacc = {0.f, 0.f, 0.f, 0.f};
    wacc = __builtin_amdgcn_mfma_f32_16x16x32_bf16(lwf[0], w2f[0], wacc, 0, 0, 0);
    wacc = __builtin_amdgcn_mfma_f32_16x16x32_bf16(lwf[1], w2f[1], wacc, 0, 0, 0);
    aacc = __builtin_amdgcn_mfma_f32_16x16x32_bf16(laf[0], a2f[0], aacc, 0, 0, 0);
    aacc = __builtin_amdgcn_mfma_f32_16x16x32_bf16(laf[1], a2f[1], aacc, 0, 0, 0);
    float bpart[4];
#pragma unroll
    for (int i = 0; i < 4; ++i) {
      const int s = l4 * 4 + i;
      const float sg = sigmoid_fast(w0c + wacc[i]);
      const float dec = __expf(-0.6065306597126334f * sg);
      const float a = sigmoid_fast(a0c + aacc[i]);
      const float k = (float)kv[i], kk = (float)kkv[i], r = (float)rv[i];
      const float kd = k * (1.f + (a - 1.f) * kac);
      L.dec[bsel][s][chd] = dec;
      L.kd[bsel][s][chd] = kd;
      L.nk[bsel][s][chd] = -kk;
      L.bb[bsel][s][chd] = kk * a;
      L.rr[bsel][s][chd] = r;
      if (q == 0) bpart[i] = dpp_sum16(r * kd * rkc);
    }
    if (q == 0 && l15 == 0) {
#pragma unroll
      for (int i = 0; i < 4; ++i) L.bp[bsel][wave][l4 * 4 + i] = bpart[i];
    }
    L.vv[bsel][tid >> 4][tid & 15] = (float)vvr;
  };
  auto write_bonus = [&](int c) {
    if (q == 0 && tid < 16) {
      bool isctx; const int rb = chunk_rowbase(c, isctx);
      const int b2 = c & 1;
      p.bonus[((size_t)dir * MR + rb + tid) * 16 + h] = L.bp[b2][0][tid] + L.bp[b2][1][tid] + L.bp[b2][2][tid] + L.bp[b2][3][tid];
    }
  };
  __syncthreads();
  stage_load(0);
  stage_compute(0);
  __syncthreads();
  write_bonus(0);
  const int NCH = 528;
  float ykeep = 0.f;
#pragma unroll 1
  for (int c = 0; c < 16; ++c) {
    stage_load(c + 1);
    scan_steps<DIR, false>(L, c & 1, c0, myrow, l15, Sa, Sb, ykeep);
    stage_compute(c + 1);
    __syncthreads();
    write_bonus(c + 1);
  }
#pragma unroll 1
  for (int c = 16; c < NCH; ++c) {
    const int bsel = c & 1;
    if (c + 1 < NCH) stage_load(c + 1);
    scan_steps<DIR, true>(L, bsel, c0, myrow, l15, Sa, Sb, ykeep);
    L.yy[bsel][l15][myrow] = ykeep;
    if (c + 1 < NCH) stage_compute(c + 1);
    __syncthreads();
    {
      bool isctx; const int rb = chunk_rowbase(c, isctx);
      f16* Y = dir ? p.Y1 : p.Y0;
      Y[(size_t)(rb + (tid >> 4)) * DM + h * 64 + q * 16 + (tid & 15)] = (f16)(L.yy[bsel][tid >> 4][tid & 15] * 0.0625f);
    }
    if (c + 1 < NCH) write_bonus(c + 1);
  }
}

struct ScanLds2 {
  float dec[2][16][64], kd[2][16][64], nk[2][16][64], bb[2][16][64], rr[2][16][64];
  float vv[2][16][32];
  float yy[2][16][32];
  float bp[2][4][16];
};
DI float dpp_sum8(float v) {
  v += dpp_mov<0xB1>(v);
  v += dpp_mov<0x4E>(v);
  v += dpp_mov<0x141>(v);
  return v;
}
template <int DIR, bool EMIT>
DI void scan_steps2(const ScanLds2& L, int bsel, int c0, int myrow, int l7, f32x2 (&S)[4], float& ykA, float& ykB) {
  f32x4 d4[2][2], k4[2][2], n4[2][2], b4[2][2], r4[2][2];
  float vv[2];
  auto ld = [&](int slot, int s) {
#pragma unroll
    for (int hf = 0; hf < 2; ++hf) {
      d4[slot][hf] = *(const f32x4*)&L.dec[bsel][s][c0 + 4 * hf];
      k4[slot][hf] = *(const f32x4*)&L.kd[bsel][s][c0 + 4 * hf];
      n4[slot][hf] = *(const f32x4*)&L.nk[bsel][s][c0 + 4 * hf];
      b4[slot][hf] = *(const f32x4*)&L.bb[bsel][s][c0 + 4 * hf];
      if (EMIT) r4[slot][hf] = *(const f32x4*)&L.rr[bsel][s][c0 + 4 * hf];
    }
    vv[slot] = L.vv[bsel][s][myrow];
  };
  ld(0, DIR ? 15 : 0);
#pragma unroll
  for (int ss = 0; ss < 16; ++ss) {
    const int s = DIR ? 15 - ss : ss;
    const int cur = ss & 1;
    if (ss + 1 < 16) ld(cur ^ 1, DIR ? 14 - ss : ss + 1);
    f32x2 t = {0.f, 0.f};
#pragma unroll
    for (int i = 0; i < 4; ++i) { const f32x2 nn = {n4[cur][i >> 1][(i & 1) * 2], n4[cur][i >> 1][(i & 1) * 2 + 1]}; t += S[i] * nn; }
    const float sa = dpp_sum8(t[0] + t[1]);
    const f32x2 sa2 = {sa, sa}, v2 = {vv[cur], vv[cur]};
#pragma unroll
    for (int i = 0; i < 4; ++i) {
      const f32x2 dd = {d4[cur][i >> 1][(i & 1) * 2], d4[cur][i >> 1][(i & 1) * 2 + 1]};
      const f32x2 kk = {k4[cur][i >> 1][(i & 1) * 2], k4[cur][i >> 1][(i & 1) * 2 + 1]};
      const f32x2 bb = {b4[cur][i >> 1][(i & 1) * 2], b4[cur][i >> 1][(i & 1) * 2 + 1]};
      S[i] = S[i] * dd + (sa2 * bb + v2 * kk);
    }
    if (EMIT) {
      f32x2 u = {0.f, 0.f};
#pragma unroll
      for (int i = 0; i < 4; ++i) { const f32x2 rr = {r4[cur][i >> 1][(i & 1) * 2], r4[cur][i >> 1][(i & 1) * 2 + 1]}; u += S[i] * rr; }
      const float y = dpp_sum8(u[0] + u[1]);
      if (s < 8) ykA = (l7 == s) ? y : ykA; else ykB = (l7 == s - 8) ? y : ykB;
    }
  }
}
template <int DIR>
DI void scan_item2(const Params& p, ScanLds2& L, int b, int h, int hf) {
  constexpr int dir = DIR;
  const int tid = threadIdx.x, lane = tid & 63, wave = tid >> 6;
  const int l15 = lane & 15, l4 = lane >> 4;
  const int colw = h * 64 + wave * 16 + l15;
  const int chd = wave * 16 + l15;
  bf16x8 w2f[2], a2f[2];
#pragma unroll
  for (int ks = 0; ks < 2; ++ks) {
    w2f[ks] = *(const bf16x8*)(p.w2_t + ((size_t)(dir * 1024 + colw) * 64 + ks * 32 + l4 * 8));
    a2f[ks] = *(const bf16x8*)(p.a2_t + ((size_t)(dir * 1024 + colw) * 64 + ks * 32 + l4 * 8));
  }
  const float w0c = p.dw0[dir * 1024 + colw], a0c = p.a0[dir * 1024 + colw], kac = p.k_a[colw], rkc = p.r_k[colw];
  f32x2 S[4];
#pragma unroll
  for (int i = 0; i < 4; ++i) { S[i][0] = 0.f; S[i][1] = 0.f; }
  const int l7 = lane & 7;
  const int myrow = wave * 8 + (lane >> 3);
  const int c0 = l7 * 8;
  bf16x8 lwf[2], laf[2];
  f16 kv[4], kkv[4], rv[4];
  f16 vvr[2];
  auto chunk_rowbase = [&](int c, bool& isctx) -> int {
    if (c < 16) { isctx = true; const int cc = dir ? 15 - c : c; return TL + b * 256 + cc * 16; }
    isctx = false; const int cc = dir ? 511 - (c - 16) : (c - 16); return b * 8192 + cc * 16;
  };
  auto stage_load = [&](int c) {
    bool isctx; const int rb = chunk_rowbase(c, isctx);
#pragma unroll
    for (int ks = 0; ks < 2; ++ks) {
      lwf[ks] = *(const bf16x8*)(p.LW + ((size_t)(rb + l15) * 128 + dir * 64 + ks * 32 + l4 * 8));
      laf[ks] = *(const bf16x8*)(p.LA + ((size_t)(rb + l15) * 128 + dir * 64 + ks * 32 + l4 * 8));
    }
#pragma unroll
    for (int i = 0; i < 4; ++i) {
      const size_t off = (size_t)(rb + l4 * 4 + i) * DM + colw;
      kv[i] = p.K16[off]; kkv[i] = p.KK16[off];
      rv[i] = isctx ? (f16)0.f : p.R16[off];
    }
#pragma unroll
    for (int j = 0; j < 2; ++j) { const int e = tid + 256 * j; vvr[j] = p.V16[(size_t)(rb + (e >> 5)) * DM + h * 64 + hf * 32 + (e & 31)]; }
  };
  auto stage_compute = [&](int c) {
    const int bsel = c & 1;
    f32x4 wacc = {0.f, 0.f, 0.f, 0.f}, aacc = {0.f, 0.f, 0.f, 0.f};
    wacc = __builtin_amdgcn_mfma_f32_16x16x32_bf16(lwf[0], w2f[0], wacc, 0, 0, 0);
    wacc = __builtin_amdgcn_mfma_f32_16x16x32_bf16(lwf[1], w2f[1], wacc, 0, 0, 0);
    aacc = __builtin_amdgcn_mfma_f32_16x16x32_bf16(laf[0], a2f[0], aacc, 0, 0, 0);
    aacc = __builtin_amdgcn_mfma_f32_16x16x32_bf16(laf[1], a2f[1], aacc, 0, 0, 0);
    float bpart[4];
#pragma unroll
    for (int i = 0; i < 4; ++i) {
      const int s = l4 * 4 + i;
      const float sg = sigmoid_fast(w0c + wacc[i]);
      const float dec = __expf(-0.6065306597126334f * sg);
      const float a = sigmoid_fast(a0c + aacc[i]);
      const float k = (float)kv[i], kk = (float)kkv[i], r = (float)rv[i];
      const float kd = k * (1.f + (a - 1.f) * kac);
      L.dec[bsel][s][chd] = dec;
      L.kd[bsel][s][chd] = kd;
      L.nk[bsel][s][chd] = -kk;
      L.bb[bsel][s][chd] = kk * a;
      L.rr[bsel][s][chd] = r;
      if (hf == 0) bpart[i] = dpp_sum16(r * kd * rkc);
    }
    if (hf == 0 && l15 == 0) {
#pragma unroll
      for (int i = 0; i < 4; ++i) L.bp[bsel][wave][l4 * 4 + i] = bpart[i];
    }
#pragma unroll
    for (int j = 0; j < 2; ++j) { const int e = tid + 256 * j; L.vv[bsel][e >> 5][e & 31] = (float)vvr[j]; }
  };
  auto write_bonus = [&](int c) {
    if (hf == 0 && tid < 16) {
      bool isctx; const int rb = chunk_rowbase(c, isctx);
      const int b2 = c & 1;
      p.bonus[((size_t)dir * MR + rb + tid) * 16 + h] = L.bp[b2][0][tid] + L.bp[b2][1][tid] + L.bp[b2][2][tid] + L.bp[b2][3][tid];
    }
  };
  __syncthreads();
  stage_load(0);
  stage_compute(0);
  __syncthreads();
  write_bonus(0);
  const int NCH = 528;
  float ykA = 0.f, ykB = 0.f;
#pragma unroll 1
  for (int c = 0; c < 16; ++c) {
    stage_load(c + 1);
    scan_steps2<DIR, false>(L, c & 1, c0, myrow, l7, S, ykA, ykB);
    stage_compute(c + 1);
    __syncthreads();
    write_bonus(c + 1);
  }
#pragma unroll 1
  for (int c = 16; c < NCH; ++c) {
    const int bsel = c & 1;
    if (c + 1 < NCH) stage_load(c + 1);
    scan_steps2<DIR, true>(L, bsel, c0, myrow, l7, S, ykA, ykB);
    L.yy[bsel][l7][myrow] = ykA;
    L.yy[bsel][8 + l7][myrow] = ykB;
    if (c + 1 < NCH) stage_compute(c + 1);
    __syncthreads();
    {
      bool isctx; const int rb = chunk_rowbase(c, isctx);
      f16* Y = dir ? p.Y1 : p.Y0;
#pragma unroll
      for (int j = 0; j < 2; ++j) {
        const int e = tid + 256 * j;
        Y[(size_t)(rb + (e >> 5)) * DM + h * 64 + hf * 32 + (e & 31)] = (f16)(L.yy[bsel][e >> 5][e & 31] * 0.0625f);
      }
    }
    if (c + 1 < NCH) write_bonus(c + 1);
  }
}
DI void phase_scan2(const Params& p, char* smem) {
  ScanLds2& L = *(ScanLds2*)smem;
  const unsigned info = p.blkinfo[blockIdx.x];
  const unsigned rank = info >> 16, ticket = info & 0xffffu;
  const unsigned n0 = xb_ld(&p.bar[XB_N0]);
  const unsigned item = rank == 0u ? ticket : n0 + ticket;
  if (item < 256u) {
    const int sc = item >> 1, hf = item & 1;
    const int dir = sc & 1, bh = sc >> 1, b = bh >> 4, h = bh & 15;
    if (dir) scan_item2<1>(p, L, b, h, hf); else scan_item2<0>(p, L, b, h, hf);
  }
}

DI void phase_scan(const Params& p, char* smem) {
  ScanLds& L = *(ScanLds*)smem;
  for (int item = blockIdx.x; item < 512; item += gridDim.x) {
    int sc, q;
    if (gridDim.x == 512) { const int xcd = item & 7, slot = item >> 3; sc = xcd * 16 + (slot >> 2); q = slot & 3; }
    else { sc = item >> 2; q = item & 3; }
    const int dir = sc & 1, bh = sc >> 1, b = bh >> 4, h = bh & 15;
    if (dir) scan_item<1>(p, L, b, h, q); else scan_item<0>(p, L, b, h, q);
  }
}

DI void phase_readout(const Params& p, char* smem) {
  float* Cs = (float*)smem;
  const int tid = threadIdx.x;
  int g0, gend, gstep; work_range(256 * 8, g0, gend, gstep);
  for (int tile = g0; tile < gend; tile += gstep) {
    int mt, nt; band_decode(tile, 256, 8, mt, nt);
    const int m0 = mt * 128;
    f32x4 acc[4][4];
    gemm_mainloop(smem, 1, 192,
                  [&](int r, int) { return (const u16*)(p.LG + (size_t)(m0 + r) * 192); },
                  [&](int c) { return (const u16*)(p.g2_t + (size_t)(nt * 128 + c) * 192); }, acc);
    acc_to_lds(Cs, acc);
    const int lane = tid & 63, wave = tid >> 6;
    const int head = nt * 2 + (lane >> 5);
    const int col = nt * 128 + 2 * lane;
    const float gw0 = p.gn_w[col], gw1 = p.gn_w[col + 1], gb0 = p.gn_b[col], gb1 = p.gn_b[col + 1];
#pragma unroll 2
    for (int rr = 0; rr < 32; ++rr) {
      const int r = wave * 32 + rr;
      const int row = m0 + r;
      const unsigned ua = *(const unsigned*)(p.Y0 + (size_t)row * DM + col), ub = *(const unsigned*)(p.Y1 + (size_t)row * DM + col);
      const unsigned uv = *(const unsigned*)(p.V16 + (size_t)row * DM + col);
      const f16* fa = (const f16*)&ua; const f16* fb = (const f16*)&ub; const f16* fv = (const f16*)&uv;
      const float y0 = ((float)fa[0] + (float)fb[0]) * 16.f, y1 = ((float)fa[1] + (float)fb[1]) * 16.f;
      float sm = y0 + y1;
      sm = sum32(sm);
      const float mean = sm * (1.f / 64.f);
      const float d0 = y0 - mean, d1 = y1 - mean;
      float vs = d0 * d0 + d1 * d1;
      vs = sum32(vs);
      const float rstd = rsqrtf(vs * (1.f / 64.f) + 64e-5f);
      const float bon = p.bonus[((size_t)0 * MR + row) * 16 + head] + p.bonus[((size_t)1 * MR + row) * 16 + head];
      const float2 g = *(const float2*)&CS(r, 2 * lane);
      const float z0 = (d0 * rstd * gw0 + gb0 + bon * (float)fv[0]) * g.x;
      const float z1 = (d1 * rstd * gw1 + gb1 + bon * (float)fv[1]) * g.y;
      *(unsigned*)(p.Z + (size_t)row * DM + col) = pack2(z0, z1);
    }
  }
}

DI void phase_final(const Params& p) {
  const int lane = threadIdx.x & 63;
  const int gw = blockIdx.x * 4 + (threadIdx.x >> 6), nw = gridDim.x * 4;
  float4 g[4];
#pragma unroll
  for (int i = 0; i < 4; ++i) g[i] = *(const float4*)(p.final_gain + i * 256 + lane * 4);
  float4 v[4], vn[4];
  int row = gw;
  if (row < TL) {
#pragma unroll
    for (int i = 0; i < 4; ++i) v[i] = *(const float4*)(p.out + (size_t)row * DM + i * 256 + lane * 4);
  }
  for (; row < TL; row += nw) {
    const int nxt = row + nw;
    if (nxt < TL) {
#pragma unroll
      for (int i = 0; i < 4; ++i) vn[i] = *(const float4*)(p.out + (size_t)nxt * DM + i * 256 + lane * 4);
    }
    float* src = p.out + (size_t)row * DM;
    float ss = 0.f;
#pragma unroll
    for (int i = 0; i < 4; ++i) ss += v[i].x * v[i].x + v[i].y * v[i].y + v[i].z * v[i].z + v[i].w * v[i].w;
    ss = wave_sum(ss);
    const float rinv = rsqrtf(ss * (1.f / 1024.f) + 1e-6f);
#pragma unroll
    for (int i = 0; i < 4; ++i) {
      float4 o;
      o.x = v[i].x * rinv * g[i].x; o.y = v[i].y * rinv * g[i].y; o.z = v[i].z * rinv * g[i].z; o.w = v[i].w * rinv * g[i].w;
      *(float4*)(src + i * 256 + lane * 4) = o;
    }
#pragma unroll
    for (int i = 0; i < 4; ++i) v[i] = vn[i];
  }
}

__global__ void __launch_bounds__(256, 2) mega(Params p) {
  __shared__ __attribute__((aligned(16))) char smem[65536];
  cg::grid_group grid = cg::this_grid();
  XbState xst; xst.x = xb_xcc_id(); xst.nloc = 0u; xst.nx = 0u;
  if (threadIdx.x == 0) {
    (void)xb_add(&p.bar[XB_XCNT(xst.x)], 1u);
    const unsigned hwid = (unsigned)__builtin_amdgcn_s_getreg((7 << 11) | (8 << 6) | 4) & 0xffu;
    const unsigned rank = xb_add(&p.bar[XB_CU((xst.x << 8) | hwid)], 1u);
    const unsigned ticket = xb_add(&p.bar[rank == 0u ? XB_N0 : XB_N1], 1u);
    p.blkinfo[blockIdx.x] = ((rank > 0u ? 1u : 0u) << 16) | (ticket & 0xffffu);
  }
  if (gridDim.x == 0x7fffffffu) grid.sync();
  phase_prep(p, smem); grid_barrier(p.bar, xst);
  phase_modreduce(p); grid_barrier(p.bar, xst);
  phase_modulate<true>(p, 0, 0, MR); grid_barrier(p.bar, xst);
  phase_qkv(p, smem); grid_barrier(p.bar, xst);
  phase_attn(p, smem); grid_barrier(p.bar, xst);
  phase_proj_res<true>(p, smem, p.H, 1024, 1024, p.wo_t, 0, 2, 264); grid_barrier(p.bar, xst);
  phase_modulate<false>(p, 0, 1, MR); grid_barrier(p.bar, xst);
  phase_ffn_up(p, smem, 0, true, p.ACT0); grid_barrier(p.bar, xst);
  phase_proj_res<false>(p, smem, p.ACT0, DFF, DFF, p.down_t, 0, 5, 264); grid_barrier(p.bar, xst);
  phase_rwkv_shift(p); grid_barrier(p.bar, xst);
  phase_rwkv_gemms(p, smem); grid_barrier(p.bar, xst);
  phase_scan2(p, smem); grid_barrier(p.bar, xst);
  phase_readout(p, smem); grid_barrier(p.bar, xst);
  phase_proj_res<false>(p, smem, p.Z, 1024, 1024, p.ro_t, 1, 2, 256); grid_barrier(p.bar, xst);
  phase_modulate<false>(p, 1, 1, TL); grid_barrier(p.bar, xst);
  phase_ffn_up(p, smem, 1, false, p.ACT1); grid_barrier(p.bar, xst);
  phase_proj_res<false>(p, smem, p.ACT1, DFF, DFF, p.down_t + (size_t)1024 * 2816, 1, 5, 256); grid_barrier(p.bar, xst);
  phase_final(p);
}

extern "C" void kernel_launch(void* const* d_in, const int* in_sizes, int n_in, void* d_out, int out_size, void* d_ws, size_t ws_size,
                              hipStream_t stream) {
  static int grid_blocks = 0;
  if (!grid_blocks) {
    int dev = 0, cus = 0, per_cu = 0;
    hipGetDevice(&dev);
    hipDeviceGetAttribute(&cus, hipDeviceAttributeMultiprocessorCount, dev);
    hipOccupancyMaxActiveBlocksPerMultiprocessor(&per_cu, mega, 256, 0);
    if (per_cu > 2) per_cu = 2;
    if (per_cu < 1) per_cu = 1;
    grid_blocks = cus * per_cu;
  }
  Params p{};
  const float* const* in = (const float* const*)d_in;
  p.x = in[0]; p.c = in[1]; p.ctx = in[2]; p.c_ctx = in[3]; p.ada_w = in[4]; p.ada_b = in[5]; p.w_qkv = in[6]; p.q_gain = in[7];
  p.k_gain = in[8]; p.w_o = in[9]; p.mu = in[10]; p.rw_r = in[11]; p.rw_k = in[12]; p.rw_v = in[13]; p.rw_o = in[14]; p.dw0 = in[15];
  p.dw1 = in[16]; p.dw2 = in[17]; p.a0 = in[18]; p.a1 = in[19]; p.a2 = in[20]; p.g1 = in[21]; p.g2 = in[22]; p.k_k = in[23];
  p.k_a = in[24]; p.r_k = in[25]; p.gn_w = in[26]; p.gn_b = in[27]; p.f_up = in[28]; p.f_cw = in[29]; p.f_cb = in[30];
  p.f_down = in[31]; p.final_gain = in[32];
  p.out = (float*)d_out;
  char* w = (char*)d_ws;
  size_t off = 0;
  auto take = [&](size_t bytes) { char* r = w + off; off += (bytes + 255) & ~(size_t)255; return r; };
  p.qkv_t = (u16*)take((size_t)1536 * 1024 * 2);
  p.wo_t = (u16*)take((size_t)1024 * 1024 * 2);
  p.up_t = (u16*)take((size_t)2 * 5632 * 1024 * 2);
  p.down_t = (u16*)take((size_t)2 * 1024 * 2816 * 2);
  p.rr_t = (u16*)take((size_t)1024 * 2048 * 2);
  p.rk_t = (u16*)take((size_t)1024 * 2048 * 2);
  p.rv_t = (u16*)take((size_t)1024 * 2048 * 2);
  p.ro_t = (u16*)take((size_t)1024 * 1024 * 2);
  p.w1_t = (u16*)take((size_t)128 * 2048 * 2);
  p.a1_t = (u16*)take((size_t)128 * 2048 * 2);
  p.g1_t = (u16*)take((size_t)256 * 2048 * 2);
  p.w2_t = (u16*)take((size_t)2 * 1024 * 64 * 2);
  p.a2_t = (u16*)take((size_t)2 * 1024 * 64 * 2);
  p.g2_t = (u16*)take((size_t)1024 * 192 * 2);
  p.modpart = (float*)take((size_t)2 * 8 * 5 * 6144 * 4);
  p.modv = (float*)take((size_t)2 * 5 * 6144 * 4);
  p.rope = (float*)take((size_t)8192 * 32 * 2 * 4);
  p.XC = (float*)take((size_t)TCX * DM * 4);
  p.bonus = (float*)take((size_t)2 * MR * 16 * 4);
  p.zero = (u16*)take(8192);
  p.bar = (unsigned*)take(65536);
  p.blkinfo = (unsigned*)take(4096 * 4);
  const size_t pb = off;
  p.H = (u16*)take((size_t)MR * DM * 2);
  const size_t after_h = off;
  p.Q = (u16*)take((size_t)TL * DM * 2);
  p.QC = (u16*)take((size_t)TCX * DM * 2);
  p.Kb = (u16*)take((size_t)16 * NKEY * 64 * 2);
  p.Vt = (u16*)take((size_t)16 * NKEY * 64 * 2);
  p.ACT0 = (u16*)take((size_t)MR * DFF * 2);
  const size_t end0 = off;
  off = after_h;
  p.XX = (u16*)take((size_t)MR * DM * 2);
  p.R16 = (f16*)take((size_t)TL * DM * 2);
  p.K16 = (f16*)take((size_t)MR * DM * 2);
  p.V16 = (f16*)take((size_t)MR * DM * 2);
  p.KK16 = (f16*)take((size_t)MR * DM * 2);
  p.LW = (u16*)take((size_t)MR * 128 * 2);
  p.LA = (u16*)take((size_t)MR * 128 * 2);
  p.LG = (u16*)take((size_t)TL * 192 * 2);
  const size_t end1 = off;
  p.Y0 = (f16*)p.H;
  p.Y1 = (f16*)p.XX;
  p.Z = (u16*)p.R16;
  p.ACT1 = (u16*)p.K16;
  (void)pb;
  const size_t need = end0 > end1 ? end0 : end1;
  if (need > ws_size) { fprintf(stderr, "workspace too small: need %zu have %zu\n", need, ws_size); return; }
  hipMemsetAsync(p.bar, 0, 65536, stream);
  void* args[] = {&p};
  hipError_t e = hipLaunchCooperativeKernel((void*)mega, dim3(grid_blocks), dim3(256), args, 0, stream);
  if (e != hipSuccess) fprintf(stderr, "cooperative launch failed: %s (grid %d)\n", hipGetErrorString(e), grid_blocks);
}
```

```cpp
#include <hip/hip_runtime.h>
#include <hip/hip_cooperative_groups.h>
#include <cstdio>
#include <cstdint>
namespace cg = cooperative_groups;

typedef unsigned short u16;
typedef _Float16 f16;
using bf16x8 = __attribute__((ext_vector_type(8))) short;
using f32x16 = __attribute__((ext_vector_type(16))) float;
using f32x4 = __attribute__((ext_vector_type(4))) float;
using u32x4 = __attribute__((ext_vector_type(4))) unsigned;
#define DI __device__ __forceinline__
DI u32x4 mk4(unsigned a, unsigned b, unsigned c, unsigned d) { u32x4 r; r[0] = a; r[1] = b; r[2] = c; r[3] = d; return r; }

constexpr int TL = 32768;
constexpr int TCX = 1024;
constexpr int MR = 33792;
constexpr int DM = 1024;
constexpr int DFF = 2816;
constexpr int NKEY = 8448;
constexpr int NPHASE = 18;
#define XB_CU(j)    (4096 + (j))
#define XB_N0       8192
#define XB_N1       8256

struct Params {
  const float *x, *c, *ctx, *c_ctx, *ada_w, *ada_b, *w_qkv, *q_gain, *k_gain, *w_o;
  const float *mu, *rw_r, *rw_k, *rw_v, *rw_o, *dw0, *dw1, *dw2, *a0, *a1, *a2, *g1, *g2, *k_k, *k_a, *r_k, *gn_w, *gn_b;
  const float *f_up, *f_cw, *f_cb, *f_down, *final_gain;
  float* out;
  u16 *qkv_t, *wo_t, *up_t, *down_t, *rr_t, *rk_t, *rv_t, *ro_t, *w1_t, *a1_t, *g1_t, *w2_t, *a2_t, *g2_t;
  float *modpart, *modv, *rope, *XC, *bonus;
  u16* zero;
  unsigned* bar;
  unsigned* blkinfo;
  u16 *H, *XX, *Q, *QC, *Kb, *Vt, *ACT0, *ACT1;
  f16 *R16, *K16, *V16, *KK16, *Y0, *Y1;
  u16 *LW, *LA, *LG, *Z;
  int phase_lo, phase_hi;
};

typedef __bf16 bf16x2_t __attribute__((ext_vector_type(2)));
typedef float f32x2 __attribute__((ext_vector_type(2)));
DI unsigned pack2(float a, float b) { f32x2 f = {a, b}; return __builtin_bit_cast(unsigned, __builtin_convertvector(f, bf16x2_t)); }
DI u16 f2bf(float x) { return (u16)(pack2(x, 0.f) & 0xffffu); }
DI float bf2f(u16 h) { return __uint_as_float(((unsigned)h) << 16); }
DI float wave_sum(float v) {
#pragma unroll
  for (int o = 32; o > 0; o >>= 1) v += __shfl_xor(v, o, 64);
  return v;
}
template <int CTRL> DI float dpp_mov(float v) { return __builtin_bit_cast(float, __builtin_amdgcn_update_dpp(0, __builtin_bit_cast(int, v), CTRL, 0xF, 0xF, false)); }
DI float dpp_sum16(float v) {
  v += dpp_mov<0x128>(v);
  v += dpp_mov<0x124>(v);
  v += dpp_mov<0x122>(v);
  v += dpp_mov<0x121>(v);
  return v;
}
DI float sum32(float v) { v = dpp_sum16(v); v += __shfl_xor(v, 16, 64); return v; }
DI float sigmoidf_(float x) { return 1.f / (1.f + __expf(-x)); }
DI float sigmoid_fast(float x) { return __builtin_amdgcn_rcpf(1.f + __expf(-x)); }
DI int midx_of(int row) { return row < TL ? (row >> 13) : 4; }
DI float* resid_ptr(const Params& p, int row) { return row < TL ? p.out + (size_t)row * DM : p.XC + (size_t)(row - TL) * DM; }
DI const float* xin_ptr(const Params& p, int row) { return row < TL ? p.x + (size_t)row * DM : p.ctx + (size_t)(row - TL) * DM; }

DI void work_range(int total, int& g0, int& gend, int& step) {
  if ((gridDim.x & 7) == 0) {
    const int x = blockIdx.x & 7, li = blockIdx.x >> 3, nl = gridDim.x >> 3;
    const int lo = (int)(((long long)total * x) >> 3), hi = (int)(((long long)total * (x + 1)) >> 3);
    g0 = lo + li; gend = hi; step = nl;
  } else { g0 = blockIdx.x; gend = total; step = gridDim.x; }
}
DI void band_decode(int g, int MT, int NT, int& mt, int& nt) {
  const int per = 8 * NT;
  const int band = g / per, r = g - band * per;
  int hb = MT - band * 8; if (hb > 8) hb = 8;
  nt = r / hb; mt = band * 8 + (r - nt * hb);
}

using GAcc = f32x4[4][4];
template <class AF, class BF>
DI void gemm_mainloop(char* smem, int nparts, int kpart, AF arow, BF brow, f32x4 (&acc)[4][4]) {
  const int tid = threadIdx.x, lane = tid & 63, wave = tid >> 6;
  const int wm = wave >> 1, wn = wave & 1;
  const int lr = tid >> 3, lc = tid & 7;
#pragma unroll
  for (int i = 0; i < 4; ++i)
#pragma unroll
    for (int j = 0; j < 4; ++j)
#pragma unroll
      for (int e = 0; e < 4; ++e) acc[i][j][e] = 0.f;
  const int csrc = (lc ^ ((lr >> 1) & 7)) * 8;
  const u16* bp[4];
  const u16* ap[4];
#pragma unroll
  for (int q = 0; q < 4; ++q) { bp[q] = brow(lr + 32 * q) + csrc; ap[q] = arow(lr + 32 * q, 0) + csrc; }
  const int nk = kpart >> 6;
  const int total = nparts * nk;
  const int sw = (lane >> 1) & 7;
  const int kq = lane >> 4;
  char* const wbase = smem + wave * 1024;
  auto stage = [&](int buf, int kk, int boff) {
#pragma unroll
    for (int q = 0; q < 4; ++q) {
      __builtin_amdgcn_global_load_lds((const unsigned*)(ap[q] + kk), (unsigned*)(wbase + buf * 32768 + q * 4096), 16, 0, 0);
      __builtin_amdgcn_global_load_lds((const unsigned*)(bp[q] + boff), (unsigned*)(wbase + buf * 32768 + 16384 + q * 4096), 16, 0, 0);
    }
  };
  __syncthreads();
  stage(0, 0, 0);
  asm volatile("s_waitcnt vmcnt(0)" ::: "memory");
  __syncthreads();
  int part = 0, kk = 0, buf = 0;
#pragma unroll 1
  for (int it = 0; it < total; ++it) {
    kk += 64;
    if (kk == kpart) {
      kk = 0; ++part;
      if (part < nparts) {
#pragma unroll
        for (int q = 0; q < 4; ++q) ap[q] = arow(lr + 32 * q, part) + csrc;
      }
    }
    if (it + 1 < total) stage(buf ^ 1, kk, part * kpart + kk);
    const u16* As = (const u16*)(smem + buf * 32768);
    const u16* Bs = As + 128 * 64;
    const u16* Ar = As + (wm * 64 + (lane & 15)) * 64;
    const u16* Br = Bs + (wn * 64 + (lane & 15)) * 64;
    bf16x8 af[2][4], bf[2][4];
    {
      const int pc = (kq ^ sw) * 8;
#pragma unroll
      for (int i = 0; i < 4; ++i) { af[0][i] = *(const bf16x8*)(Ar + i * 1024 + pc); bf[0][i] = *(const bf16x8*)(Br + i * 1024 + pc); }
    }
#pragma unroll
    for (int ks = 0; ks < 2; ++ks) {
      const int cur = ks & 1;
      if (ks + 1 < 2) {
        const int pc = ((4 + kq) ^ sw) * 8;
#pragma unroll
        for (int i = 0; i < 4; ++i) { af[1][i] = *(const bf16x8*)(Ar + i * 1024 + pc); bf[1][i] = *(const bf16x8*)(Br + i * 1024 + pc); }
      }
#pragma unroll
      for (int i = 0; i < 4; ++i)
#pragma unroll
        for (int j = 0; j < 4; ++j) acc[i][j] = __builtin_amdgcn_mfma_f32_16x16x32_bf16(af[cur][i], bf[cur][j], acc[i][j], 0, 0, 0);
      __builtin_amdgcn_sched_barrier(0);
    }
    asm volatile("s_waitcnt vmcnt(0)" ::: "memory");
    __syncthreads();
    buf ^= 1;
  }
}

template <class F>
DI void epi_direct(const f32x4 (&acc)[4][4], F f) {
  const int lane = threadIdx.x & 63, wave = threadIdx.x >> 6;
  const int wm = wave >> 1, wn = wave & 1, g = lane >> 4;
#pragma unroll
  for (int i = 0; i < 4; ++i)
#pragma unroll
    for (int j = 0; j < 4; ++j)
#pragma unroll
      for (int e = 0; e < 4; ++e) {
        const int row = wm * 64 + i * 16 + g * 4 + e;
        const int col = wn * 64 + j * 16 + (lane & 15);
        f(row, col, acc[i][j][e]);
      }
}
#define CS(r, c) Cs[(r) * 128 + (c)]
DI void acc_to_lds(float* Cs, const f32x4 (&acc)[4][4]) {
  __syncthreads();
  epi_direct(acc, [&](int r, int c, float v) { CS(r, c) = v; });
  __syncthreads();
}

struct TJob { const float* src; int srcK, srcN; u16* dst; int ld, koff; const float* mu; int Kpad, Npad; };
DI TJob get_job(const Params& p, int j) {
  TJob t; t.mu = nullptr; t.koff = 0;
  auto set = [&](const float* s, int K, int N, u16* d, int ld) { t.src = s; t.srcK = K; t.srcN = N; t.dst = d; t.ld = ld; t.Kpad = K; t.Npad = N; };
  switch (j) {
    case 4: set(p.w_qkv, 1024, 1536, p.qkv_t, 1024); break;
    case 5: set(p.w_o, 1024, 1024, p.wo_t, 1024); break;
    case 0: set(p.f_up, 1024, 5632, p.up_t, 1024); break;
    case 1: set(p.f_up + (size_t)1024 * 5632, 1024, 5632, p.up_t + (size_t)5632 * 1024, 1024); break;
    case 2: set(p.f_down, 2816, 1024, p.down_t, 2816); break;
    case 3: set(p.f_down + (size_t)2816 * 1024, 2816, 1024, p.down_t + (size_t)1024 * 2816, 2816); break;
    case 6: set(p.rw_r, 1024, 1024, p.rr_t, 2048); break;
    case 7: set(p.rw_r, 1024, 1024, p.rr_t, 2048); t.mu = p.mu + 0 * 1024; t.koff = 1024; break;
    case 8: set(p.rw_k, 1024, 1024, p.rk_t, 2048); break;
    case 9: set(p.rw_k, 1024, 1024, p.rk_t, 2048); t.mu = p.mu + 2 * 1024; t.koff = 1024; break;
    case 10: set(p.rw_v, 1024, 1024, p.rv_t, 2048); break;
    case 11: set(p.rw_v, 1024, 1024, p.rv_t, 2048); t.mu = p.mu + 3 * 1024; t.koff = 1024; break;
    case 12: set(p.rw_o, 1024, 1024, p.ro_t, 1024); break;
    case 13: set(p.dw1, 1024, 64, p.w1_t, 2048); break;
    case 14: set(p.dw1, 1024, 64, p.w1_t, 2048); t.mu = p.mu + 1 * 1024; t.koff = 1024; break;
    case 15: set(p.dw1 + 1024 * 64, 1024, 64, p.w1_t + 64 * 2048, 2048); break;
    case 16: set(p.dw1 + 1024 * 64, 1024, 64, p.w1_t + 64 * 2048, 2048); t.mu = p.mu + 1 * 1024; t.koff = 1024; break;
    case 17: set(p.a1, 1024, 64, p.a1_t, 2048); break;
    case 18: set(p.a1, 1024, 64, p.a1_t, 2048); t.mu = p.mu + 4 * 1024; t.koff = 1024; break;
    case 19: set(p.a1 + 1024 * 64, 1024, 64, p.a1_t + 64 * 2048, 2048); break;
    case 20: set(p.a1 + 1024 * 64, 1024, 64, p.a1_t + 64 * 2048, 2048); t.mu = p.mu + 4 * 1024; t.koff = 1024; break;
    case 21: set(p.g1, 1024, 160, p.g1_t, 2048); t.Npad = 256; break;
    case 22: set(p.g1, 1024, 160, p.g1_t, 2048); t.Npad = 256; t.mu = p.mu + 5 * 1024; t.koff = 1024; break;
    case 23: set(p.dw2, 64, 1024, p.w2_t, 64); break;
    case 24: set(p.dw2 + 64 * 1024, 64, 1024, p.w2_t + 1024 * 64, 64); break;
    case 25: set(p.a2, 64, 1024, p.a2_t, 64); break;
    case 26: set(p.a2 + 64 * 1024, 64, 1024, p.a2_t + 1024 * 64, 64); break;
    default: set(p.g2, 160, 1024, p.g2_t, 192); t.Kpad = 192; break;
  }
  return t;
}
constexpr int NJOBS = 28;
DI int job_tiles(const TJob& t) { return ((t.Kpad + 63) >> 6) * ((t.Npad + 63) >> 6); }

DI void phase_prep(const Params& p, char* smem) {
  const int tid = threadIdx.x;
  const int ttiles = 7024;
  const int n_mod = 2 * 24 * 8;
  const int n_rope = 1024;
  const int total = ttiles + n_mod + n_rope;
  float* tile = (float*)smem;
  if (blockIdx.x == 0) for (int e = tid; e < 4096; e += 256) p.zero[e] = 0;
  {
    auto decode = [&](int item, TJob& t, int& kt, int& nt) {
      int rem = item, j = 0;
      t = get_job(p, 0);
      while (true) { int n = job_tiles(t); if (rem < n) break; rem -= n; ++j; t = get_job(p, j); }
      const int ntn = (t.Npad + 63) >> 6;
      kt = rem / ntn; nt = rem % ntn;
    };
    auto load_tile = [&](const TJob& t, int kt, int nt, float (&v)[16]) {
#pragma unroll
      for (int i = 0; i < 16; ++i) {
        const int kl = i * 4 + (tid >> 6), nl = tid & 63;
        const int k = kt * 64 + kl, n = nt * 64 + nl;
        float x = 0.f;
        if (k < t.srcK && n < t.srcN) { x = t.src[(size_t)k * t.srcN + n]; if (t.mu) x *= t.mu[k]; }
        v[i] = x;
      }
    };
    TJob tc, tn; int ktc = 0, ntc = 0, ktn = 0, ntn_ = 0;
    float vc[16], vn[16];
    int item = blockIdx.x;
    if (item < ttiles) { decode(item, tc, ktc, ntc); load_tile(tc, ktc, ntc, vc); }
    for (; item < ttiles; item += gridDim.x) {
      const int nxt = item + gridDim.x;
      if (nxt < ttiles) { decode(nxt, tn, ktn, ntn_); load_tile(tn, ktn, ntn_, vn); }
      __syncthreads();
#pragma unroll
      for (int i = 0; i < 16; ++i) tile[(i * 4 + (tid >> 6)) * 65 + (tid & 63)] = vc[i];
      __syncthreads();
#pragma unroll
      for (int i = 0; i < 16; ++i) {
        const int nl = i * 4 + (tid >> 6), kl = tid & 63;
        const int k = ktc * 64 + kl, n = ntc * 64 + nl;
        if (k < tc.Kpad && n < tc.Npad) tc.dst[(size_t)n * tc.ld + tc.koff + k] = f2bf(tile[kl * 65 + nl]);
      }
      if (nxt < ttiles) {
        tc = tn; ktc = ktn; ntc = ntn_;
#pragma unroll
        for (int i = 0; i < 16; ++i) vc[i] = vn[i];
      }
    }
  }
  int first_other = ttiles + (int)blockIdx.x;
  for (int item = first_other; item < total; item += gridDim.x) {
    if (false) {
    } else if (item < ttiles + n_mod) {
      const int it = item - ttiles;
      const int layer = it / 192, cc = (it % 192) / 8, kc = it % 8;
      float* sil = (float*)smem;
      __syncthreads();
      for (int e = tid; e < 640; e += 256) {
        const int j = e >> 7, k = kc * 128 + (e & 127);
        const float v = j < 4 ? p.c[j * 1024 + k] : p.c_ctx[k];
        sil[e] = v / (1.f + __expf(-v));
      }
      __syncthreads();
      const int col = cc * 256 + tid;
      float a0 = 0, a1 = 0, a2 = 0, a3 = 0, a4 = 0;
      const float* w = p.ada_w + ((size_t)layer * 1024 + kc * 128) * 6144 + col;
#pragma unroll 16
      for (int k = 0; k < 128; ++k) {
        const float wv = w[(size_t)k * 6144];
        a0 += sil[k] * wv; a1 += sil[128 + k] * wv; a2 += sil[256 + k] * wv; a3 += sil[384 + k] * wv; a4 += sil[512 + k] * wv;
      }
      float* mp = p.modpart + ((size_t)(layer * 8 + kc) * 5) * 6144 + col;
      mp[0] = a0; mp[6144] = a1; mp[2 * 6144] = a2; mp[3 * 6144] = a3; mp[4 * 6144] = a4;
    } else {
      const int e = (item - ttiles - n_mod) * 256 + tid;
      const int s = e >> 5, pr = e & 31;
      const int f = pr & 15;
      const float inv_freq = powf(10000.f, -(float)f / 16.f);
      const float pos = (pr < 16) ? (float)(s >> 6) : (float)(s & 63);
      const float ang = pos * inv_freq;
      float sn, cs;
      sincosf(ang, &sn, &cs);
      p.rope[e * 2] = cs; p.rope[e * 2 + 1] = sn;
    }
  }
}

DI void phase_modreduce(const Params& p) {
  const int n = 2 * 5 * 6144;
  for (int e = blockIdx.x * 256 + threadIdx.x; e < n; e += gridDim.x * 256) {
    const int layer = e / (5 * 6144), r = e % (5 * 6144), col = r % 6144;
    float s = p.ada_b[layer * 6144 + col];
    for (int kc = 0; kc < 8; ++kc) s += p.modpart[(size_t)(layer * 8 + kc) * 5 * 6144 + r];
    p.modv[e] = s;
  }
}

template <bool FROM_INPUT>
DI void phase_modulate(const Params& p, int layer, int which, int nrows) {
  const int lane = threadIdx.x & 63;
  const int gw = blockIdx.x * 4 + (threadIdx.x >> 6), nw = gridDim.x * 4;
  auto load_row = [&](int row, float4 (&v)[4]) {
    const float* src = FROM_INPUT ? xin_ptr(p, row) : resid_ptr(p, row);
#pragma unroll
    for (int i = 0; i < 4; ++i) v[i] = *(const float4*)(src + i * 256 + lane * 4);
  };
  float4 v[4], vn[4];
  int row = gw;
  if (row < nrows) load_row(row, v);
  for (; row < nrows; row += nw) {
    const int nxt = row + nw;
    if (nxt < nrows) load_row(nxt, vn);
    const float* mv = p.modv + ((size_t)layer * 5 + midx_of(row)) * 6144 + which * 3072;
    float ss = 0.f;
#pragma unroll
    for (int i = 0; i < 4; ++i) ss += v[i].x * v[i].x + v[i].y * v[i].y + v[i].z * v[i].z + v[i].w * v[i].w;
    ss = wave_sum(ss);
    const float rinv = rsqrtf(ss * (1.f / 1024.f) + 1e-6f);
#pragma unroll
    for (int i = 0; i < 4; ++i) {
      const int col = i * 256 + lane * 4;
      const float4 sh = *(const float4*)(mv + col);
      const float4 sc = *(const float4*)(mv + 1024 + col);
      uint2 o;
      o.x = pack2(v[i].x * rinv * (1.f + sc.x) + sh.x, v[i].y * rinv * (1.f + sc.y) + sh.y);
      o.y = pack2(v[i].z * rinv * (1.f + sc.z) + sh.z, v[i].w * rinv * (1.f + sc.w) + sh.w);
      *(uint2*)(p.H + (size_t)row * DM + col) = o;
    }
#pragma unroll
    for (int i = 0; i < 4; ++i) v[i] = vn[i];
  }
}

DI void modrow(const Params& p, int row, bool valid, int lane, float (&h)[16]) {
  if (!valid) {
#pragma unroll
    for (int i = 0; i < 16; ++i) h[i] = 0.f;
    return;
  }
  const float* src = resid_ptr(p, row);
  const float* mv = p.modv + ((size_t)1 * 5 + midx_of(row)) * 6144;
  float ss = 0.f;
#pragma unroll
  for (int i = 0; i < 4; ++i) {
    const float4 v = *(const float4*)(src + i * 256 + lane * 4);
    h[i * 4 + 0] = v.x; h[i * 4 + 1] = v.y; h[i * 4 + 2] = v.z; h[i * 4 + 3] = v.w;
    ss += v.x * v.x + v.y * v.y + v.z * v.z + v.w * v.w;
  }
  ss = wave_sum(ss);
  const float rinv = rsqrtf(ss * (1.f / 1024.f) + 1e-6f);
#pragma unroll
  for (int i = 0; i < 4; ++i) {
    const int col = i * 256 + lane * 4;
    const float4 sh = *(const float4*)(mv + col);
    const float4 sc = *(const float4*)(mv + 1024 + col);
    h[i * 4 + 0] = h[i * 4 + 0] * rinv * (1.f + sc.x) + sh.x;
    h[i * 4 + 1] = h[i * 4 + 1] * rinv * (1.f + sc.y) + sh.y;
    h[i * 4 + 2] = h[i * 4 + 2] * rinv * (1.f + sc.z) + sh.z;
    h[i * 4 + 3] = h[i * 4 + 3] * rinv * (1.f + sc.w) + sh.w;
  }
}
DI void phase_rwkv_shift(const Params& p) {
  const int lane = threadIdx.x & 63;
  const int gw = blockIdx.x * 4 + (threadIdx.x >> 6), nw = gridDim.x * 4;
  const int nitems = MR / 8;
  for (int item = gw; item < nitems; item += nw) {
    const int r0 = item * 8;
    int sb, T;
    if (r0 < TL) { sb = r0 & ~8191; T = 8192; } else { sb = TL + ((r0 - TL) & ~255); T = 256; }
    float hm[16], hc[16], hn[16];
    modrow(p, r0 - 1, r0 - 1 >= sb, lane, hm);
    modrow(p, r0, true, lane, hc);
    for (int j = 0; j < 8; ++j) {
      const int row = r0 + j;
      modrow(p, row + 1, row + 1 < sb + T, lane, hn);
#pragma unroll
      for (int i = 0; i < 4; ++i) {
        const int col = i * 256 + lane * 4;
        float xx[4];
#pragma unroll
        for (int e = 0; e < 4; ++e) xx[e] = 0.5f * (hm[i * 4 + e] + hn[i * 4 + e]) - hc[i * 4 + e];
        uint2 o, o2;
        o.x = pack2(hc[i * 4 + 0], hc[i * 4 + 1]); o.y = pack2(hc[i * 4 + 2], hc[i * 4 + 3]);
        o2.x = pack2(xx[0], xx[1]); o2.y = pack2(xx[2], xx[3]);
        *(uint2*)(p.H + (size_t)row * DM + col) = o;
        *(uint2*)(p.XX + (size_t)row * DM + col) = o2;
      }
#pragma unroll
      for (int i = 0; i < 16; ++i) { hm[i] = hc[i]; hc[i] = hn[i]; }
    }
  }
}

DI void phase_qkv(const Params& p, char* smem) {
  float* Cs = (float*)smem;
  const int tid = threadIdx.x;
  int g0, gend, gstep; work_range(264 * 12, g0, gend, gstep);
  for (int tile = g0; tile < gend; tile += gstep) {
    int mt, nt; band_decode(tile, 264, 12, mt, nt);
    const int m0 = mt * 128;
    f32x4 acc[4][4];
    gemm_mainloop(smem, 1, 1024,
                  [&](int r, int) { return (const u16*)(p.H + (size_t)(m0 + r) * DM); },
                  [&](int c) { return (const u16*)(p.qkv_t + (size_t)(nt * 128 + c) * 1024); }, acc);
    acc_to_lds(Cs, acc);
    const bool isctx = m0 >= TL;
    const int b = isctx ? (m0 - TL) >> 8 : m0 >> 13;
    const int t0 = isctx ? (m0 - TL) & 255 : m0 & 8191;
    if (nt < 10) {
      const int lane = tid & 63, wave = tid >> 6;
      const int hh = lane >> 5, pr = lane & 31;
      const bool isq = nt < 8;
      const float* gain = isq ? p.q_gain : p.k_gain;
      const float qs = isq ? 0.125f * 1.4426950408889634f : 1.f;
      const float g0 = gain[2 * pr] * qs, g1 = gain[2 * pr + 1] * qs;
      u16* dstb;
      size_t tstride = 64;
      if (isq) {
        const int head = nt * 2 + hh;
        dstb = isctx ? p.QC + ((size_t)(b * 16 + head) * 256 + t0) * 64 : p.Q + ((size_t)(b * 16 + head) * 8192 + t0) * 64;
      } else {
        const int kh = (nt - 8) * 2 + hh;
        dstb = p.Kb + ((size_t)(b * 4 + kh) * NKEY + (isctx ? t0 : 256 + t0)) * 64;
      }
#pragma unroll 4
      for (int rr = 0; rr < 32; ++rr) {
        const int r = wave * 32 + rr;
        const float2 v = *(const float2*)&CS(r, 2 * lane);
        float ss = v.x * v.x + v.y * v.y;
        ss = sum32(ss);
        const float rinv = rsqrtf(ss * (1.f / 64.f) + 1e-6f);
        float x0 = v.x * rinv * g0, x1 = v.y * rinv * g1;
        if (!isctx) {
          const float2 cssn = *(const float2*)(p.rope + ((size_t)(t0 + r) * 32 + pr) * 2);
          const float y0 = x0 * cssn.x - x1 * cssn.y, y1 = x0 * cssn.y + x1 * cssn.x;
          x0 = y0; x1 = y1;
        }
        *(unsigned*)(dstb + (size_t)r * tstride + 2 * pr) = pack2(x0, x1);
      }
    } else {
      const int keybase = (isctx ? t0 : 256 + t0);
      for (int j = 0; j < 4; ++j) {
        const int item = tid + 256 * j;
        const int d = item & 63, hh = (item >> 6) & 1, rg = item >> 7;
        const int kh = (nt - 10) * 2 + hh;
        float v[16];
#pragma unroll
        for (int i = 0; i < 16; ++i) v[i] = CS(rg * 16 + i, hh * 64 + d);
        u16* dst = p.Vt + ((size_t)(b * 4 + kh) * 64 + d) * NKEY + keybase + rg * 16;
        *(u32x4*)(dst) = mk4(pack2(v[0], v[1]), pack2(v[2], v[3]), pack2(v[8], v[9]), pack2(v[10], v[11]));
        *(u32x4*)(dst + 8) = mk4(pack2(v[4], v[5]), pack2(v[6], v[7]), pack2(v[12], v[13]), pack2(v[14], v[15]));
      }
    }
  }
}

DI void phase_attn(const Params& p, char* smem) {
  const int tid = threadIdx.x, lane = tid & 63, wave = tid >> 6;
  const int sw = (lane >> 1) & 7, hsel = lane >> 5;
  float mq = 0.f, mk = 0.f;
  for (int d = 0; d < 64; ++d) { mq = fmaxf(mq, fabsf(p.q_gain[d])); mk = fmaxf(mk, fabsf(p.k_gain[d])); }
  const float c0 = 0.125f * 1.4426950408889634f * 64.f * mq * mk * 1.02f + 0.5f;
  f32x16 negc;
#pragma unroll
  for (int i = 0; i < 16; ++i) negc[i] = -c0;
  int ga, gae, gs, gc, gce, gs2;
  work_range(2048, ga, gae, gs);
  work_range(64, gc, gce, gs2);
  const int n_lat = ga < gae ? (gae - ga + gs - 1) / gs : 0;
  const int n_ctx = gc < gce ? (gce - gc + gs2 - 1) / gs2 : 0;
  for (int wi = 0; wi < n_lat + n_ctx; ++wi) {
    const int item = wi < n_lat ? ga + wi * gs : 2048 + gc + (wi - n_lat) * gs2;
    int b, kvh, qb, nkt;
    const u16* qbase;
    size_t orow;
    const int head_g = wave;
    if (item < 2048) {
      b = item >> 9; kvh = (item >> 7) & 3; qb = item & 127; nkt = NKEY / 64;
      qbase = p.Q + ((size_t)(b * 16 + kvh * 4 + head_g) * 8192 + qb * 64) * 64;
      orow = (size_t)b * 8192 + qb * 64;
    } else {
      const int j = item - 2048;
      b = j >> 4; kvh = (j >> 2) & 3; qb = j & 3; nkt = 4;
      qbase = p.QC + ((size_t)(b * 16 + kvh * 4 + head_g) * 256 + qb * 64) * 64;
      orow = (size_t)TL + b * 256 + qb * 64;
    }
    const int head = kvh * 4 + head_g;
    bf16x8 qf[2][4];
#pragma unroll
    for (int qi = 0; qi < 2; ++qi)
#pragma unroll
      for (int ks = 0; ks < 4; ++ks) qf[qi][ks] = *(const bf16x8*)(qbase + (qi * 32 + (lane & 31)) * 64 + ks * 16 + hsel * 8);
    const u16* kg = p.Kb + (size_t)(b * 4 + kvh) * NKEY * 64;
    const u16* vg = p.Vt + (size_t)(b * 4 + kvh) * 64 * NKEY;
    f32x16 oacc[2][2];
#pragma unroll
    for (int i = 0; i < 16; ++i) { oacc[0][0][i] = 0.f; oacc[0][1][i] = 0.f; oacc[1][0][i] = 0.f; oacc[1][1][i] = 0.f; }
    f32x2 ls2[2] = {{0.f, 0.f}, {0.f, 0.f}};
    const int grow = wave * 8 + (lane >> 3);
    const int gsrc = ((lane & 7) ^ ((grow >> 1) & 7)) * 8;
    const u16* kgl = kg + (size_t)grow * 64 + gsrc;
    const u16* vgl = vg + (size_t)grow * NKEY + gsrc;
    char* const wb = smem + wave * 1024;
    auto stage_kv = [&](int kt, int buf) {
#pragma unroll
      for (int q = 0; q < 2; ++q) {
        __builtin_amdgcn_global_load_lds((const unsigned*)(kgl + (size_t)kt * 4096 + q * 32 * 64), (unsigned*)(wb + buf * 16384 + q * 4096), 16, 0, 0);
        __builtin_amdgcn_global_load_lds((const unsigned*)(vgl + (size_t)q * 32 * NKEY + kt * 64), (unsigned*)(wb + buf * 16384 + 8192 + q * 4096), 16, 0, 0);
      }
    };
    __syncthreads();
    stage_kv(0, 0);
    asm volatile("s_waitcnt vmcnt(0)" ::: "memory");
    __syncthreads();
    for (int kt = 0; kt < nkt; ++kt) {
      const int buf = kt & 1;
      if (kt + 1 < nkt) stage_kv(kt + 1, buf ^ 1);
      const u16* Ks = (const u16*)(smem + buf * 16384);
      const u16* Vs = Ks + 64 * 64;
      f32x16 sacc[2][2];
#pragma unroll
      for (int kb = 0; kb < 2; ++kb) {
        bf16x8 kf[4];
#pragma unroll
        for (int ks = 0; ks < 4; ++ks) kf[ks] = *(const bf16x8*)(Ks + (kb * 32 + (lane & 31)) * 64 + (((ks * 2 + hsel) ^ sw) * 8));
#pragma unroll
        for (int ks = 0; ks < 4; ++ks) {
          sacc[0][kb] = __builtin_amdgcn_mfma_f32_32x32x16_bf16(kf[ks], qf[0][ks], ks == 0 ? negc : sacc[0][kb], 0, 0, 0);
          sacc[1][kb] = __builtin_amdgcn_mfma_f32_32x32x16_bf16(kf[ks], qf[1][ks], ks == 0 ? negc : sacc[1][kb], 0, 0, 0);
        }
      }
#pragma unroll
      for (int qi = 0; qi < 2; ++qi)
#pragma unroll
        for (int kb = 0; kb < 2; ++kb)
#pragma unroll
          for (int i = 0; i < 16; i += 2) {
            const float e0 = __builtin_amdgcn_exp2f(sacc[qi][kb][i]), e1 = __builtin_amdgcn_exp2f(sacc[qi][kb][i + 1]);
            sacc[qi][kb][i] = e0; sacc[qi][kb][i + 1] = e1;
            const f32x2 e2 = {e0, e1};
            ls2[qi] += e2;
          }
#pragma unroll
      for (int kb = 0; kb < 2; ++kb)
#pragma unroll
        for (int s2 = 0; s2 < 2; ++s2) {
          bf16x8 vfr[2];
#pragma unroll
          for (int db = 0; db < 2; ++db) vfr[db] = *(const bf16x8*)(Vs + (db * 32 + (lane & 31)) * 64 + (((2 * (2 * kb + s2) + hsel) ^ sw) * 8));
#pragma unroll
          for (int qi = 0; qi < 2; ++qi) {
            unsigned w[4];
#pragma unroll
            for (int e = 0; e < 4; ++e) w[e] = pack2(sacc[qi][kb][8 * s2 + 2 * e], sacc[qi][kb][8 * s2 + 2 * e + 1]);
            u32x4 pw = mk4(w[0], w[1], w[2], w[3]);
            const bf16x8 pf = __builtin_bit_cast(bf16x8, pw);
#pragma unroll
            for (int db = 0; db < 2; ++db) oacc[qi][db] = __builtin_amdgcn_mfma_f32_32x32x16_bf16(vfr[db], pf, oacc[qi][db], 0, 0, 0);
          }
        }
      asm volatile("s_waitcnt vmcnt(0)" ::: "memory");
      __syncthreads();
    }
#pragma unroll
    for (int qi = 0; qi < 2; ++qi) {
      const float lsum = ls2[qi][0] + ls2[qi][1];
      const float l = lsum + __shfl_xor(lsum, 32, 64);
      const float inv = 1.f / l;
      u16* od = p.H + (orow + qi * 32 + (lane & 31)) * DM + head * 64;
#pragma unroll
      for (int db = 0; db < 2; ++db)
#pragma unroll
        for (int g = 0; g < 4; ++g) {
          uint2 o;
          o.x = pack2(oacc[qi][db][g * 4 + 0] * inv, oacc[qi][db][g * 4 + 1] * inv);
          o.y = pack2(oacc[qi][db][g * 4 + 2] * inv, oacc[qi][db][g * 4 + 3] * inv);
          *(uint2*)(od + db * 32 + 8 * g + 4 * hsel) = o;
        }
    }
  }
}

template <bool FROM_INPUT>
DI void phase_proj_res(const Params& p, char* smem, const u16* A, int lda, int K, const u16* Bt, int layer, int gate_idx, int mtiles) {
  int g0, gend, gstep; work_range(mtiles * 8, g0, gend, gstep);
  for (int tile = g0; tile < gend; tile += gstep) {
    int mt, nt; band_decode(tile, mtiles, 8, mt, nt);
    const int m0 = mt * 128;
    f32x4 acc[4][4];
    gemm_mainloop(smem, 1, K,
                  [&](int r, int) { return A + (size_t)(m0 + r) * lda; },
                  [&](int c) { return Bt + (size_t)(nt * 128 + c) * K; }, acc);
    const float* gate = p.modv + ((size_t)layer * 5 + midx_of(m0)) * 6144 + gate_idx * 1024 + nt * 128;
    const float* sb = (FROM_INPUT ? xin_ptr(p, m0) : (const float*)resid_ptr(p, m0)) + nt * 128;
    float* db = resid_ptr(p, m0) + nt * 128;
    epi_direct(acc, [&](int r, int c, float v) { db[r * DM + c] = sb[r * DM + c] + gate[c] * v; });
  }
}

DI void phase_ffn_up(const Params& p, char* smem, int layer, bool with_ctx, u16* ACT) {
  float* Cs = (float*)smem;
  const int tid = threadIdx.x;
  const int mtiles = with_ctx ? 276 : 264;
  int g0, gend, gstep; work_range(mtiles * 44, g0, gend, gstep);
  const u16* up = p.up_t + (size_t)layer * 5632 * 1024;
  const float* cw = p.f_cw + (size_t)layer * 3 * 5632;
  const float* cb = p.f_cb + (size_t)layer * 5632;
  for (int tile = g0; tile < gend; tile += gstep) {
    int mt, nt; band_decode(tile, mtiles, 44, mt, nt);
    int rowbase, T, j;
    if (mt < 264) { rowbase = (mt / 66) * 8192; T = 8192; j = mt % 66; }
    else { const int m2 = mt - 264; rowbase = TL + (m2 / 3) * 256; T = 256; j = m2 % 3; }
    const int tb = j * 126 - 1;
    f32x4 acc[4][4];
    gemm_mainloop(smem, 1, 1024,
                  [&](int r, int) { const int t = tb + r; return (t >= 0 && t < T) ? (const u16*)(p.H + (size_t)(rowbase + t) * DM) : (const u16*)p.zero; },
                  [&](int c) { return up + (size_t)(c < 64 ? nt * 64 + c : 2816 + nt * 64 + (c - 64)) * 1024; }, acc);
    acc_to_lds(Cs, acc);
    const int c = tid & 63, rq = tid >> 6;
    const int n = nt * 64 + c;
    const float g0 = cw[n], g1 = cw[5632 + n], g2 = cw[2 * 5632 + n], gb = cb[n];
    const float v0 = cw[2816 + n], v1 = cw[5632 + 2816 + n], v2 = cw[2 * 5632 + 2816 + n], vb = cb[2816 + n];
    const int rs = 1 + rq * 32;
    int re = rs + 32; if (re > 127) re = 127;
    float gp = CS(rs - 1, c), gc = CS(rs, c), vp = CS(rs - 1, c + 64), vc = CS(rs, c + 64);
    for (int r = rs; r < re; ++r) {
      const float gn = CS(r + 1, c), vn = CS(r + 1, c + 64);
      const int t = tb + r;
      if (t < T) {
        const float g = g0 * gp + g1 * gc + g2 * gn + gb;
        const float v = v0 * vp + v1 * vc + v2 * vn + vb;
        const float a = g * __builtin_amdgcn_rcpf(1.f + __expf(-g)) * v;
        ACT[(size_t)(rowbase + t) * DFF + n] = f2bf(a);
      }
      gp = gc; gc = gn; vp = vc; vc = vn;
    }
  }
}

DI void phase_rwkv_gemms(const Params& p, char* smem) {
  float* Cs = (float*)smem;
  const int tid = threadIdx.x;
  int g0, gend, gstep; work_range(7312, g0, gend, gstep);
  for (int tile = g0; tile < gend; tile += gstep) {
    int job, mt, nt;
    const u16* Bt;
    if (tile < 2048) { job = 0; band_decode(tile, 256, 8, mt, nt); Bt = p.rr_t; }
    else if (tile < 4160) { job = 1; band_decode(tile - 2048, 264, 8, mt, nt); Bt = p.rk_t; }
    else if (tile < 6272) { job = 2; band_decode(tile - 4160, 264, 8, mt, nt); Bt = p.rv_t; }
    else if (tile < 6536) { job = 3; mt = tile - 6272; nt = 0; Bt = p.w1_t; }
    else if (tile < 6800) { job = 4; mt = tile - 6536; nt = 0; Bt = p.a1_t; }
    else { job = 5; band_decode(tile - 6800, 256, 2, mt, nt); Bt = p.g1_t; }
    const int m0 = mt * 128;
    f32x4 acc[4][4];
    gemm_mainloop(smem, 2, 1024,
                  [&](int r, int part) { return (const u16*)((part ? p.XX : p.H) + (size_t)(m0 + r) * DM); },
                  [&](int c) { return Bt + (size_t)(nt * 128 + c) * 2048; }, acc);
    if (job == 0) {
      epi_direct(acc, [&](int r, int c, float v) { p.R16[(size_t)(m0 + r) * DM + nt * 128 + c] = (f16)v; });
    } else if (job == 2) {
      epi_direct(acc, [&](int r, int c, float v) { p.V16[(size_t)(m0 + r) * DM + nt * 128 + c] = (f16)v; });
    } else if (job == 3) {
      epi_direct(acc, [&](int r, int c, float v) { p.LW[(size_t)(m0 + r) * 128 + c] = f2bf(tanhf(v)); });
    } else if (job == 4) {
      epi_direct(acc, [&](int r, int c, float v) { p.LA[(size_t)(m0 + r) * 128 + c] = f2bf(v); });
    } else if (job == 5) {
      epi_direct(acc, [&](int r, int c, float v) {
        const int col = nt * 128 + c;
        if (col < 192) p.LG[(size_t)(m0 + r) * 192 + col] = col < 160 ? f2bf(sigmoid_fast(v)) : (u16)0;
      });
    } else {
      acc_to_lds(Cs, acc);
      const int lane = tid & 63, wave = tid >> 6;
      const int col = nt * 128 + 2 * lane;
      const float kk0 = p.k_k[col], kk1 = p.k_k[col + 1];
#pragma unroll 4
      for (int rr = 0; rr < 32; ++rr) {
        const int r = wave * 32 + rr;
        const float2 v = *(const float2*)&CS(r, 2 * lane);
        const float a0 = v.x * kk0, a1 = v.y * kk1;
        float ss = a0 * a0 + a1 * a1;
        ss = sum32(ss);
        const float inv = 1.f / fmaxf(sqrtf(ss), 1e-12f);
        f16 k2[2], n2[2];
        k2[0] = (f16)v.x; k2[1] = (f16)v.y; n2[0] = (f16)(a0 * inv); n2[1] = (f16)(a1 * inv);
        *(unsigned*)(p.K16 + (size_t)(m0 + r) * DM + col) = *(const unsigned*)k2;
        *(unsigned*)(p.KK16 + (size_t)(m0 + r) * DM + col) = *(const unsigned*)n2;
      }
    }
  }
}

#define XB_TMO      128
#define XB_XCNT(j)  (256  + 64 * (j))
#define XB_XSUB(j)  (1280 + 64 * (j))
#define XB_XGEN(j)  (2304 + 64 * (j))
#define XB_TOP      3328
#define XB_TOPGEN   3392
#define XB_SPIN_CAP (1u << 20)
DI unsigned xb_ld(unsigned* p) { return __hip_atomic_load(p, __ATOMIC_RELAXED, __HIP_MEMORY_SCOPE_AGENT); }
DI unsigned xb_add(unsigned* p, unsigned v) { return __hip_atomic_fetch_add(p, v, __ATOMIC_RELAXED, __HIP_MEMORY_SCOPE_AGENT); }
DI unsigned xb_xcc_id() { return (unsigned)__builtin_amdgcn_s_getreg((3 << 11) | 20) & 0xFu; }
#define XB_SPIN(cond, bar) do { unsigned _sp = 0; while (cond) { __builtin_amdgcn_s_sleep(1); \
    if ((++_sp & 255u) == 0u) { if (xb_ld(&(bar)[XB_TMO])) break; if (_sp > XB_SPIN_CAP) { atomicAdd(&(bar)[XB_TMO], 1u); break; } } } } while (0)
struct XbState { unsigned x, nloc, nx; };
DI void xb_census(unsigned* bar, unsigned x, unsigned& nloc, unsigned& nx) {
  const unsigned G = gridDim.x;
  unsigned sum, cnt, mine, sp = 0u;
  for (;;) {
    sum = 0u; cnt = 0u; mine = 0u;
#pragma unroll
    for (unsigned j = 0; j < 16; ++j) { const unsigned c = xb_ld(&bar[XB_XCNT(j)]); sum += c; cnt += (c > 0u) ? 1u : 0u; mine = (j == x) ? c : mine; }
    if (sum == G) break;
    __builtin_amdgcn_s_sleep(1);
    if ((++sp & 255u) == 0u) { if (xb_ld(&bar[XB_TMO])) break; if (sp > XB_SPIN_CAP) { atomicAdd(&bar[XB_TMO], 1u); break; } }
  }
  nloc = mine > 0u ? mine : 1u; nx = cnt > 0u ? cnt : 1u;
}
DI void grid_barrier(unsigned* bar, XbState& st) {
  asm volatile("s_waitcnt vmcnt(0)" ::: "memory");
  __syncthreads();
  if (threadIdx.x == 0) {
    __builtin_amdgcn_s_waitcnt(0);
    if (st.nloc == 0u) xb_census(bar, st.x, st.nloc, st.nx);
    const unsigned nloc = st.nloc, nx = st.nx;
    const unsigned old = xb_add(&bar[XB_XSUB(st.x)], 1u);
    const unsigned gen = old / nloc;
    if (old + 1u == (gen + 1u) * nloc) {
      __builtin_amdgcn_fence(__ATOMIC_RELEASE, "agent");
      asm volatile("s_waitcnt vmcnt(0)" ::: "memory");
      const unsigned og = xb_add(&bar[XB_TOP], 1u);
      const unsigned tg = og / nx;
      if (og + 1u == (tg + 1u) * nx) xb_add(&bar[XB_TOPGEN], 1u);
      else XB_SPIN(xb_ld(&bar[XB_TOPGEN]) == tg, bar);
      __builtin_amdgcn_fence(__ATOMIC_ACQUIRE, "agent");
      xb_add(&bar[XB_XGEN(st.x)], 1u);
      asm volatile("s_waitcnt vmcnt(0)" ::: "memory");
    } else {
      XB_SPIN(xb_ld(&bar[XB_XGEN(st.x)]) == gen, bar);
      __builtin_amdgcn_fence(__ATOMIC_ACQUIRE, "agent");
      asm volatile("s_waitcnt vmcnt(0)" ::: "memory");
    }
  }
  __syncthreads();
}

struct ScanLds {
  float dec[2][16][64], kd[2][16][64], nk[2][16][64], bb[2][16][64], rr[2][16][64];
  float vv[2][16][16];
  float yy[2][16][16];
  float bp[2][4][16];
};

template <int DIR, bool EMIT>
DI void scan_steps(const ScanLds& L, int bsel, int c0, int myrow, int l15, f32x2& Sa, f32x2& Sb, float& ykeep) {
  f32x4 d4[2], k4[2], n4[2], b4[2], r4[2];
  float vv[2];
  auto ld = [&](int slot, int s) {
    d4[slot] = *(const f32x4*)&L.dec[bsel][s][c0];
    k4[slot] = *(const f32x4*)&L.kd[bsel][s][c0];
    n4[slot] = *(const f32x4*)&L.nk[bsel][s][c0];
    b4[slot] = *(const f32x4*)&L.bb[bsel][s][c0];
    if (EMIT) r4[slot] = *(const f32x4*)&L.rr[bsel][s][c0];
    vv[slot] = L.vv[bsel][s][myrow];
  };
  ld(0, DIR ? 15 : 0);
#pragma unroll
  for (int ss = 0; ss < 16; ++ss) {
    const int s = DIR ? 15 - ss : ss;
    const int cur = ss & 1;
    if (ss + 1 < 16) ld(cur ^ 1, DIR ? 14 - ss : ss + 1);
    const f32x2 nlo = {n4[cur][0], n4[cur][1]}, nhi = {n4[cur][2], n4[cur][3]};
    const f32x2 dlo = {d4[cur][0], d4[cur][1]}, dhi = {d4[cur][2], d4[cur][3]};
    const f32x2 klo = {k4[cur][0], k4[cur][1]}, khi = {k4[cur][2], k4[cur][3]};
    const f32x2 blo = {b4[cur][0], b4[cur][1]}, bhi = {b4[cur][2], b4[cur][3]};
    f32x2 t = Sa * nlo + Sb * nhi;
    float sa = dpp_sum16(t[0] + t[1]);
    const f32x2 sa2 = {sa, sa}, v2 = {vv[cur], vv[cur]};
    Sa = Sa * dlo + (sa2 * blo + v2 * klo);
    Sb = Sb * dhi + (sa2 * bhi + v2 * khi);
    if (EMIT) {
      const f32x2 rlo = {r4[cur][0], r4[cur][1]}, rhi = {r4[cur][2], r4[cur][3]};
      const f32x2 u = Sa * rlo + Sb * rhi;
      const float y = dpp_sum16(u[0] + u[1]);
      ykeep = (l15 == s) ? y : ykeep;
    }
  }
}

template <int DIR>
DI void scan_item(const Params& p, ScanLds& L, int b, int h, int q) {
  constexpr int dir = DIR;
  const int tid = threadIdx.x, lane = tid & 63, wave = tid >> 6;
  const int l15 = lane & 15, l4 = lane >> 4;
  const int colw = h * 64 + wave * 16 + l15;
  const int chd = wave * 16 + l15;
  bf16x8 w2f[2], a2f[2];
#pragma unroll
  for (int ks = 0; ks < 2; ++ks) {
    w2f[ks] = *(const bf16x8*)(p.w2_t + ((size_t)(dir * 1024 + colw) * 64 + ks * 32 + l4 * 8));
    a2f[ks] = *(const bf16x8*)(p.a2_t + ((size_t)(dir * 1024 + colw) * 64 + ks * 32 + l4 * 8));
  }
  const float w0c = p.dw0[dir * 1024 + colw], a0c = p.a0[dir * 1024 + colw], kac = p.k_a[colw], rkc = p.r_k[colw];
  f32x2 Sa = {0.f, 0.f}, Sb = {0.f, 0.f};
  const int myrow = wave * 4 + l4;
  const int c0 = l15 * 4;
  bf16x8 lwf[2], laf[2];
  f16 kv[4], kkv[4], rv[4];
  f16 vvr;
  auto chunk_rowbase = [&](int c, bool& isctx) -> int {
    if (c < 16) { isctx = true; const int cc = dir ? 15 - c : c; return TL + b * 256 + cc * 16; }
    isctx = false; const int cc = dir ? 511 - (c - 16) : (c - 16); return b * 8192 + cc * 16;
  };
  auto stage_load = [&](int c) {
    bool isctx; const int rb = chunk_rowbase(c, isctx);
#pragma unroll
    for (int ks = 0; ks < 2; ++ks) {
      lwf[ks] = *(const bf16x8*)(p.LW + ((size_t)(rb + l15) * 128 + dir * 64 + ks * 32 + l4 * 8));
      laf[ks] = *(const bf16x8*)(p.LA + ((size_t)(rb + l15) * 128 + dir * 64 + ks * 32 + l4 * 8));
    }
#pragma unroll
    for (int i = 0; i < 4; ++i) {
      const size_t off = (size_t)(rb + l4 * 4 + i) * DM + colw;
      kv[i] = p.K16[off]; kkv[i] = p.KK16[off];
      rv[i] = isctx ? (f16)0.f : p.R16[off];
    }
    vvr = p.V16[(size_t)(rb + (tid >> 4)) * DM + h * 64 + q * 16 + (tid & 15)];
  };
  auto stage_compute = [&](int c) {
    const int bsel = c & 1;
    f32x4 wacc = {0.f, 0.f, 0.f, 0.f}, aacc = {0.f, 0.f, 0.f, 0.f};
    wacc = __builtin_amdgcn_mfma_f32_16x16x32_bf16(lwf[0], w2f[0], wacc, 0, 0, 0);
    wacc = __builtin_amdgcn_mfma_f32_16x16x32_bf16(lwf[1], w2f[1], wacc, 0, 0, 0);
    aacc = __builtin_amdgcn_mfma_f32_16x16x32_bf16(laf[0], a2f[0], aacc, 0, 0, 0);
    aacc = __builtin_amdgcn_mfma_f32_16x16x32_bf16(laf[1], a2f[1], aacc, 0, 0, 0);
    float bpart[4];
#pragma unroll
    for (int i = 0; i < 4; ++i) {
      const int s = l4 * 4 + i;
      const float sg = sigmoid_fast(w0c + wacc[i]);
      const float dec = __expf(-0.6065306597126334f * sg);
      const float a = sigmoid_fast(a0c + aacc[i]);
      const float k = (float)kv[i], kk = (float)kkv[i], r = (float)rv[i];
      const float kd = k * (1.f + (a - 1.f) * kac);
      L.dec[bsel][s][chd] = dec;
      L.kd[bsel][s][chd] = kd;
      L.nk[bsel][s][chd] = -kk;
      L.bb[bsel][s][chd] = kk * a;
      L.rr[bsel][s][chd] = r;
      if (q == 0) bpart[i] = dpp_sum16(r * kd * rkc);
    }
    if (q == 0 && l15 == 0) {
#pragma unroll
      for (int i = 0; i < 4; ++i) L.bp[bsel][wave][l4 * 4 + i] = bpart[i];
    }
    L.vv[bsel][tid >> 4][tid & 15] = (float)vvr;
  };
  auto write_bonus = [&](int c) {
    if (q == 0 && tid < 16) {
      bool isctx; const int rb = chunk_rowbase(c, isctx);
      const int b2 = c & 1;
      p.bonus[((size_t)dir * MR + rb + tid) * 16 + h] = L.bp[b2][0][tid] + L.bp[b2][1][tid] + L.bp[b2][2][tid] + L.bp[b2][3][tid];
    }
  };
  __syncthreads();
  stage_load(0);
  stage_compute(0);
  __syncthreads();
  write_bonus(0);
  const int NCH = 528;
  float ykeep = 0.f;
#pragma unroll 1
  for (int c = 0; c < 16; ++c) {
    stage_load(c + 1);
    scan_steps<DIR, false>(L, c & 1, c0, myrow, l15, Sa, Sb, ykeep);
    stage_compute(c + 1);
    __syncthreads();
    write_bonus(c + 1);
  }
#pragma unroll 1
  for (int c = 16; c < NCH; ++c) {
    const int bsel = c & 1;
    if (c + 1 < NCH) stage_load(c + 1);
    scan_steps<DIR, true>(L, bsel, c0, myrow, l15, Sa, Sb, ykeep);
    L.yy[bsel][l15][myrow] = ykeep;
    if (c + 1 < NCH) stage_compute(c + 1);
    __syncthreads();
    {
      bool isctx; const int rb = chunk_rowbase(c, isctx);
      f16* Y = dir ? p.Y1 : p.Y0;
      Y[(size_t)(rb + (tid >> 4)) * DM + h * 64 + q * 16 + (tid & 15)] = (f16)(L.yy[bsel][tid >> 4][tid & 15] * 0.0625f);
    }
    if (c + 1 < NCH) write_bonus(c + 1);
  }
}

struct ScanLds2 {
  float dec[2][16][64], kd[2][16][64], nk[2][16][64], bb[2][16][64], rr[2][16][64];
  float vv[2][16][32];
  float yy[2][16][32];
  float bp[2][4][16];
};
DI float dpp_sum8(float v) {
  v += dpp_mov<0xB1>(v);
  v += dpp_mov<0x4E>(v);
  v += dpp_mov<0x141>(v);
  return v;
}
template <int DIR, bool EMIT>
DI void scan_steps2(const ScanLds2& L, int bsel, int c0, int myrow, int l7, f32x2 (&S)[4], float& ykA, float& ykB) {
  f32x4 d4[2][2], k4[2][2], n4[2][2], b4[2][2], r4[2][2];
  float vv[2];
  auto ld = [&](int slot, int s) {
#pragma unroll
    for (int hf = 0; hf < 2; ++hf) {
      d4[slot][hf] = *(const f32x4*)&L.dec[bsel][s][c0 + 4 * hf];
      k4[slot][hf] = *(const f32x4*)&L.kd[bsel][s][c0 + 4 * hf];
      n4[slot][hf] = *(const f32x4*)&L.nk[bsel][s][c0 + 4 * hf];
      b4[slot][hf] = *(const f32x4*)&L.bb[bsel][s][c0 + 4 * hf];
      if (EMIT) r4[slot][hf] = *(const f32x4*)&L.rr[bsel][s][c0 + 4 * hf];
    }
    vv[slot] = L.vv[bsel][s][myrow];
  };
  ld(0, DIR ? 15 : 0);
#pragma unroll
  for (int ss = 0; ss < 16; ++ss) {
    const int s = DIR ? 15 - ss : ss;
    const int cur = ss & 1;
    if (ss + 1 < 16) ld(cur ^ 1, DIR ? 14 - ss : ss + 1);
    f32x2 t = {0.f, 0.f};
#pragma unroll
    for (int i = 0; i < 4; ++i) { const f32x2 nn = {n4[cur][i >> 1][(i & 1) * 2], n4[cur][i >> 1][(i & 1) * 2 + 1]}; t += S[i] * nn; }
    const float sa = dpp_sum8(t[0] + t[1]);
    const f32x2 sa2 = {sa, sa}, v2 = {vv[cur], vv[cur]};
#pragma unroll
    for (int i = 0; i < 4; ++i) {
      const f32x2 dd = {d4[cur][i >> 1][(i & 1) * 2], d4[cur][i >> 1][(i & 1) * 2 + 1]};
      const f32x2 kk = {k4[cur][i >> 1][(i & 1) * 2], k4[cur][i >> 1][(i & 1) * 2 + 1]};
      const f32x2 bb = {b4[cur][i >> 1][(i & 1) * 2], b4[cur][i >> 1][(i & 1) * 2 + 1]};
      S[i] = S[i] * dd + (sa2 * bb + v2 * kk);
    }
    if (EMIT) {
      f32x2 u = {0.f, 0.f};
#pragma unroll
      for (int i = 0; i < 4; ++i) { const f32x2 rr = {r4[cur][i >> 1][(i & 1) * 2], r4[cur][i >> 1][(i & 1) * 2 + 1]}; u += S[i] * rr; }
      const float y = dpp_sum8(u[0] + u[1]);
      if (s < 8) ykA = (l7 == s) ? y : ykA; else ykB = (l7 == s - 8) ? y : ykB;
    }
  }
}
template <int DIR>
DI void scan_item2(const Params& p, ScanLds2& L, int b, int h, int hf) {
  constexpr int dir = DIR;
  const int tid = threadIdx.x, lane = tid & 63, wave = tid >> 6;
  const int l15 = lane & 15, l4 = lane >> 4;
  const int colw = h * 64 + wave * 16 + l15;
  const int chd = wave * 16 + l15;
  bf16x8 w2f[2], a2f[2];
#pragma unroll
  for (int ks = 0; ks < 2; ++ks) {
    w2f[ks] = *(const bf16x8*)(p.w2_t + ((size_t)(dir * 1024 + colw) * 64 + ks * 32 + l4 * 8));
    a2f[ks] = *(const bf16x8*)(p.a2_t + ((size_t)(dir * 1024 + colw) * 64 + ks * 32 + l4 * 8));
  }
  const float w0c = p.dw0[dir * 1024 + colw], a0c = p.a0[dir * 1024 + colw], kac = p.k_a[colw], rkc = p.r_k[colw];
  f32x2 S[4];
#pragma unroll
  for (int i = 0; i < 4; ++i) { S[i][0] = 0.f; S[i][1] = 0.f; }
  const int l7 = lane & 7;
  const int myrow = wave * 8 + (lane >> 3);
  const int c0 = l7 * 8;
  bf16x8 lwf[2], laf[2];
  f16 kv[4], kkv[4], rv[4];
  f16 vvr[2];
  auto chunk_rowbase = [&](int c, bool& isctx) -> int {
    if (c < 16) { isctx = true; const int cc = dir ? 15 - c : c; return TL + b * 256 + cc * 16; }
    isctx = false; const int cc = dir ? 511 - (c - 16) : (c - 16); return b * 8192 + cc * 16;
  };
  auto stage_load = [&](int c) {
    bool isctx; const int rb = chunk_rowbase(c, isctx);
#pragma unroll
    for (int ks = 0; ks < 2; ++ks) {
      lwf[ks] = *(const bf16x8*)(p.LW + ((size_t)(rb + l15) * 128 + dir * 64 + ks * 32 + l4 * 8));
      laf[ks] = *(const bf16x8*)(p.LA + ((size_t)(rb + l15) * 128 + dir * 64 + ks * 32 + l4 * 8));
    }
#pragma unroll
    for (int i = 0; i < 4; ++i) {
      const size_t off = (size_t)(rb + l4 * 4 + i) * DM + colw;
      kv[i] = p.K16[off]; kkv[i] = p.KK16[off];
      rv[i] = isctx ? (f16)0.f : p.R16[off];
    }
#pragma unroll
    for (int j = 0; j < 2; ++j) { const int e = tid + 256 * j; vvr[j] = p.V16[(size_t)(rb + (e >> 5)) * DM + h * 64 + hf * 32 + (e & 31)]; }
  };
  auto stage_compute = [&](int c) {
    const int bsel = c & 1;
    f32x4 wacc = {0.f, 0.f, 0.f, 0.f}, aacc = {0.f, 0.f, 0.f, 0.f};
    wacc = __builtin_amdgcn_mfma_f32_16x16x32_bf16(lwf[0], w2f[0], wacc, 0, 0, 0);
    wacc = __builtin_amdgcn_mfma_f32_16x16x32_bf16(lwf[1], w2f[1], wacc, 0, 0, 0);
    aacc = __builtin_amdgcn_mfma_f32_16x16x32_bf16(laf[0], a2f[0], aacc, 0, 0, 0);
    aacc = __builtin_amdgcn_mfma_f32_16x16x32_bf16(laf[1], a2f[1], aacc, 0, 0, 0);
    float bpart[4];
#pragma unroll
    for (int i = 0; i < 4; ++i) {
      const int s = l4 * 4 + i;
      const float sg = sigmoid_fast(w0c + wacc[i]);
      const float dec = __expf(-0.6065306597126334f * sg);
      const float a = sigmoid_fast(a0c + aacc[i]);
      const float k = (float)kv[i], kk = (float)kkv[i], r = (float)rv[i];
      const float kd = k * (1.f + (a - 1.f) * kac);
      L.dec[bsel][s][chd] = dec;
      L.kd[bsel][s][chd] = kd;
      L.nk[bsel][s][chd] = -kk;
      L.bb[bsel][s][chd] = kk * a;
      L.rr[bsel][s][chd] = r;
      if (hf == 0) bpart[i] = dpp_sum16(r * kd * rkc);
    }
    if (hf == 0 && l15 == 0) {
#pragma unroll
      for (int i = 0; i < 4; ++i) L.bp[bsel][wave][l4 * 4 + i] = bpart[i];
    }
#pragma unroll
    for (int j = 0; j < 2; ++j) { const int e = tid + 256 * j; L.vv[bsel][e >> 5][e & 31] = (float)vvr[j]; }
  };
  auto write_bonus = [&](int c) {
    if (hf == 0 && tid < 16) {
      bool isctx; const int rb = chunk_rowbase(c, isctx);
      const int b2 = c & 1;
      p.bonus[((size_t)dir * MR + rb + tid) * 16 + h] = L.bp[b2][0][tid] + L.bp[b2][1][tid] + L.bp[b2][2][tid] + L.bp[b2][3][tid];
    }
  };
  __syncthreads();
  stage_load(0);
  stage_compute(0);
  __syncthreads();
  write_bonus(0);
  const int NCH = 528;
  float ykA = 0.f, ykB = 0.f;
#pragma unroll 1
  for (int c = 0; c < 16; ++c) {
    stage_load(c + 1);
    scan_steps2<DIR, false>(L, c & 1, c0, myrow, l7, S, ykA, ykB);
    stage_compute(c + 1);
    __syncthreads();
    write_bonus(c + 1);
  }
#pragma unroll 1
  for (int c = 16; c < NCH; ++c) {
    const int bsel = c & 1;
    if (c + 1 < NCH) stage_load(c + 1);
    scan_steps2<DIR, true>(L, bsel, c0, myrow, l7, S, ykA, ykB);
    L.yy[bsel][l7][myrow] = ykA;
    L.yy[bsel][8 + l7][myrow] = ykB;
    if (c + 1 < NCH) stage_compute(c + 1);
    __syncthreads();
    {
      bool isctx; const int rb = chunk_rowbase(c, isctx);
      f16* Y = dir ? p.Y1 : p.Y0;
#pragma unroll
      for (int j = 0; j < 2; ++j) {
        const int e = tid + 256 * j;
        Y[(size_t)(rb + (e >> 5)) * DM + h * 64 + hf * 32 + (e & 31)] = (f16)(L.yy[bsel][e >> 5][e & 31] * 0.0625f);
      }
    }
    if (c + 1 < NCH) write_bonus(c + 1);
  }
}
DI void phase_scan2(const Params& p, char* smem) {
  ScanLds2& L = *(ScanLds2*)smem;
  const unsigned info = p.blkinfo[blockIdx.x];
  const unsigned rank = info >> 16, ticket = info & 0xffffu;
  const unsigned n0 = xb_ld(&p.bar[XB_N0]);
  const unsigned item = rank == 0u ? ticket : n0 + ticket;
  if (item < 256u) {
    const int sc = item >> 1, hf = item & 1;
    const int dir = sc & 1, bh = sc >> 1, b = bh >> 4, h = bh & 15;
    if (dir) scan_item2<1>(p, L, b, h, hf); else scan_item2<0>(p, L, b, h, hf);
  }
}

DI void phase_scan(const Params& p, char* smem) {
  ScanLds& L = *(ScanLds*)smem;
  for (int item = blockIdx.x; item < 512; item += gridDim.x) {
    int sc, q;
    if (gridDim.x == 512) { const int xcd = item & 7, slot = item >> 3; sc = xcd * 16 + (slot >> 2); q = slot & 3; }
    else { sc = item >> 2; q = item & 3; }
    const int dir = sc & 1, bh = sc >> 1, b = bh >> 4, h = bh & 15;
    if (dir) scan_item<1>(p, L, b, h, q); else scan_item<0>(p, L, b, h, q);
  }
}

DI void phase_readout(const Params& p, char* smem) {
  float* Cs = (float*)smem;
  const int tid = threadIdx.x;
  int g0, gend, gstep; work_range(256 * 8, g0, gend, gstep);
  for (int tile = g0; tile < gend; tile += gstep) {
    int mt, nt; band_decode(tile, 256, 8, mt, nt);
    const int m0 = mt * 128;
    f32x4 acc[4][4];
    gemm_mainloop(smem, 1, 192,
                  [&](int r, int) { return (const u16*)(p.LG + (size_t)(m0 + r) * 192); },
                  [&](int c) { return (const u16*)(p.g2_t + (size_t)(nt * 128 + c) * 192); }, acc);
    acc_to_lds(Cs, acc);
    const int lane = tid & 63, wave = tid >> 6;
    const int head = nt * 2 + (lane >> 5);
    const int col = nt * 128 + 2 * lane;
    const float gw0 = p.gn_w[col], gw1 = p.gn_w[col + 1], gb0 = p.gn_b[col], gb1 = p.gn_b[col + 1];
#pragma unroll 2
    for (int rr = 0; rr < 32; ++rr) {
      const int r = wave * 32 + rr;
      const int row = m0 + r;
      const unsigned ua = *(const unsigned*)(p.Y0 + (size_t)row * DM + col), ub = *(const unsigned*)(p.Y1 + (size_t)row * DM + col);
      const unsigned uv = *(const unsigned*)(p.V16 + (size_t)row * DM + col);
      const f16* fa = (const f16*)&ua; const f16* fb = (const f16*)&ub; const f16* fv = (const f16*)&uv;
      const float y0 = ((float)fa[0] + (float)fb[0]) * 16.f, y1 = ((float)fa[1] + (float)fb[1]) * 16.f;
      float sm = y0 + y1;
      sm = sum32(sm);
      const float mean = sm * (1.f / 64.f);
      const float d0 = y0 - mean, d1 = y1 - mean;
      float vs = d0 * d0 + d1 * d1;
      vs = sum32(vs);
      const float rstd = rsqrtf(vs * (1.f / 64.f) + 64e-5f);
      const float bon = p.bonus[((size_t)0 * MR + row) * 16 + head] + p.bonus[((size_t)1 * MR + row) * 16 + head];
      const float2 g = *(const float2*)&CS(r, 2 * lane);
      const float z0 = (d0 * rstd * gw0 + gb0 + bon * (float)fv[0]) * g.x;
      const float z1 = (d1 * rstd * gw1 + gb1 + bon * (float)fv[1]) * g.y;
      *(unsigned*)(p.Z + (size_t)row * DM + col) = pack2(z0, z1);
    }
  }
}

DI void phase_final(const Params& p) {
  const int lane = threadIdx.x & 63;
  const int gw = blockIdx.x * 4 + (threadIdx.x >> 6), nw = gridDim.x * 4;
  float4 g[4];
#pragma unroll
  for (int i = 0; i < 4; ++i) g[i] = *(const float4*)(p.final_gain + i * 256 + lane * 4);
  float4 v[4], vn[4];
  int row = gw;
  if (row < TL) {
#pragma unroll
    for (int i = 0; i < 4; ++i) v[i] = *(const float4*)(p.out + (size_t)row * DM + i * 256 + lane * 4);
  }
  for (; row < TL; row += nw) {
    const int nxt = row + nw;
    if (nxt < TL) {
#pragma unroll
      for (int i = 0; i < 4; ++i) vn[i] = *(const float4*)(p.out + (size_t)nxt * DM + i * 256 + lane * 4);
    }
    float* src = p.out + (size_t)row * DM;
    float ss = 0.f;
#pragma unroll
    for (int i = 0; i < 4; ++i) ss += v[i].x * v[i].x + v[i].y * v[i].y + v[i].z * v[i].z + v[i].w * v[i].w;
    ss = wave_sum(ss);
    const float rinv = rsqrtf(ss * (1.f / 1024.f) + 1e-6f);
#pragma unroll
    for (int i = 0; i < 4; ++i) {
      float4 o;
      o.x = v[i].x * rinv * g[i].x; o.y = v[i].y * rinv * g[i].y; o.z = v[i].z * rinv * g[i].z; o.w = v[i].w * rinv * g[i].w;
      *(float4*)(src + i * 256 + lane * 4) = o;
    }
#pragma unroll
    for (int i = 0; i < 4; ++i) v[i] = vn[i];
  }
}

__global__ void __launch_bounds__(256, 2) mega(Params p) {
  __shared__ __attribute__((aligned(16))) char smem[65536];
  cg::grid_group grid = cg::this_grid();
  XbState xst; xst.x = xb_xcc_id(); xst.nloc = 0u; xst.nx = 0u;
  if (threadIdx.x == 0) {
    (void)xb_add(&p.bar[XB_XCNT(xst.x)], 1u);
    const unsigned hwid = (unsigned)__builtin_amdgcn_s_getreg((7 << 11) | (8 << 6) | 4) & 0xffu;
    const unsigned rank = xb_add(&p.bar[XB_CU((xst.x << 8) | hwid)], 1u);
    const unsigned ticket = xb_add(&p.bar[rank == 0u ? XB_N0 : XB_N1], 1u);
    p.blkinfo[blockIdx.x] = ((rank > 0u ? 1u : 0u) << 16) | (ticket & 0xffffu);
  }
  if (gridDim.x == 0x7fffffffu) grid.sync();
  phase_prep(p, smem); grid_barrier(p.bar, xst);
  phase_modreduce(p); grid_barrier(p.bar, xst);
  phase_modulate<true>(p, 0, 0, MR); grid_barrier(p.bar, xst);
  phase_qkv(p, smem); grid_barrier(p.bar, xst);
  phase_attn(p, smem); grid_barrier(p.bar, xst);
  phase_proj_res<true>(p, smem, p.H, 1024, 1024, p.wo_t, 0, 2, 264); grid_barrier(p.bar, xst);
  phase_modulate<false>(p, 0, 1, MR); grid_barrier(p.bar, xst);
  phase_ffn_up(p, smem, 0, true, p.ACT0); grid_barrier(p.bar, xst);
  phase_proj_res<false>(p, smem, p.ACT0, DFF, DFF, p.down_t, 0, 5, 264); grid_barrier(p.bar, xst);
  phase_rwkv_shift(p); grid_barrier(p.bar, xst);
  phase_rwkv_gemms(p, smem); grid_barrier(p.bar, xst);
  phase_scan2(p, smem); grid_barrier(p.bar, xst);
  phase_readout(p, smem); grid_barrier(p.bar, xst);
  phase_proj_res<false>(p, smem, p.Z, 1024, 1024, p.ro_t, 1, 2, 256); grid_barrier(p.bar, xst);
  phase_modulate<false>(p, 1, 1, TL); grid_barrier(p.bar, xst);
  phase_ffn_up(p, smem, 1, false, p.ACT1); grid_barrier(p.bar, xst);
  phase_proj_res<false>(p, smem, p.ACT1, DFF, DFF, p.down_t + (size_t)1024 * 2816, 1, 5, 256); grid_barrier(p.bar, xst);
  phase_final(p);
}

extern "C" void kernel_launch(void* const* d_in, const int* in_sizes, int n_in, void* d_out, int out_size, void* d_ws, size_t ws_size,
                              hipStream_t stream) {
  static int grid_blocks = 0;
  if (!grid_blocks) {
    int dev = 0, cus = 0, per_cu = 0;
    hipGetDevice(&dev);
    hipDeviceGetAttribute(&cus, hipDeviceAttributeMultiprocessorCount, dev);
    hipOccupancyMaxActiveBlocksPerMultiprocessor(&per_cu, mega, 256, 0);
    if (per_cu > 2) per_cu = 2;
    if (per_cu < 1) per_cu = 1;
    grid_blocks = cus * per_cu;
  }
  Params p{};
  const float* const* in = (const float* const*)d_in;
  p.x = in[0]; p.c = in[1]; p.ctx = in[2]; p.c_ctx = in[3]; p.ada_w = in[4]; p.ada_b = in[5]; p.w_qkv = in[6]; p.q_gain = in[7];
  p.k_gain = in[8]; p.w_o = in[9]; p.mu = in[10]; p.rw_r = in[11]; p.rw_k = in[12]; p.rw_v = in[13]; p.rw_o = in[14]; p.dw0 = in[15];
  p.dw1 = in[16]; p.dw2 = in[17]; p.a0 = in[18]; p.a1 = in[19]; p.a2 = in[20]; p.g1 = in[21]; p.g2 = in[22]; p.k_k = in[23];
  p.k_a = in[24]; p.r_k = in[25]; p.gn_w = in[26]; p.gn_b = in[27]; p.f_up = in[28]; p.f_cw = in[29]; p.f_cb = in[30];
  p.f_down = in[31]; p.final_gain = in[32];
  p.out = (float*)d_out;
  char* w = (char*)d_ws;
  size_t off = 0;
  auto take = [&](size_t bytes) { char* r = w + off; off += (bytes + 255) & ~(size_t)255; return r; };
  p.qkv_t = (u16*)take((size_t)1536 * 1024 * 2);
  p.wo_t = (u16*)take((size_t)1024 * 1024 * 2);
  p.up_t = (u16*)take((size_t)2 * 5632 * 1024 * 2);
  p.down_t = (u16*)take((size_t)2 * 1024 * 2816 * 2);
  p.rr_t = (u16*)take((size_t)1024 * 2048 * 2);
  p.rk_t = (u16*)take((size_t)1024 * 2048 * 2);
  p.rv_t = (u16*)take((size_t)1024 * 2048 * 2);
  p.ro_t = (u16*)take((size_t)1024 * 1024 * 2);
  p.w1_t = (u16*)take((size_t)128 * 2048 * 2);
  p.a1_t = (u16*)take((size_t)128 * 2048 * 2);
  p.g1_t = (u16*)take((size_t)256 * 2048 * 2);
  p.w2_t = (u16*)take((size_t)2 * 1024 * 64 * 2);
  p.a2_t = (u16*)take((size_t)2 * 1024 * 64 * 2);
  p.g2_t = (u16*)take((size_t)1024 * 192 * 2);
  p.modpart = (float*)take((size_t)2 * 8 * 5 * 6144 * 4);
  p.modv = (float*)take((size_t)2 * 5 * 6144 * 4);
  p.rope = (float*)take((size_t)8192 * 32 * 2 * 4);
  p.XC = (float*)take((size_t)TCX * DM * 4);
  p.bonus = (float*)take((size_t)2 * MR * 16 * 4);
  p.zero = (u16*)take(8192);
  p.bar = (unsigned*)take(65536);
  p.blkinfo = (unsigned*)take(4096 * 4);
  const size_t pb = off;
  p.H = (u16*)take((size_t)MR * DM * 2);
  const size_t after_h = off;
  p.Q = (u16*)take((size_t)TL * DM * 2);
  p.QC = (u16*)take((size_t)TCX * DM * 2);
  p.Kb = (u16*)take((size_t)16 * NKEY * 64 * 2);
  p.Vt = (u16*)take((size_t)16 * NKEY * 64 * 2);
  p.ACT0 = (u16*)take((size_t)MR * DFF * 2);
  const size_t end0 = off;
  off = after_h;
  p.XX = (u16*)take((size_t)MR * DM * 2);
  p.R16 = (f16*)take((size_t)TL * DM * 2);
  p.K16 = (f16*)take((size_t)MR * DM * 2);
  p.V16 = (f16*)take((size_t)MR * DM * 2);
  p.KK16 = (f16*)take((size_t)MR * DM * 2);
  p.LW = (u16*)take((size_t)MR * 128 * 2);
  p.LA = (u16*)take((size_t)MR * 128 * 2);
  p.LG = (u16*)take((size_t)TL * 192 * 2);
  const size_t end1 = off;
  p.Y0 = (f16*)p.H;
  p.Y1 = (f16*)p.XX;
  p.Z = (u16*)p.R16;
  p.ACT1 = (u16*)p.K16;
  (void)pb;
  const size_t need = end0 > end1 ? end0 : end1;
  if (need > ws_size) { fprintf(stderr, "workspace too small: need %zu have %zu\n", need, ws_size); return; }
  hipMemsetAsync(p.bar, 0, 65536, stream);
  void* args[] = {&p};
  hipError_t e = hipLaunchCooperativeKernel((void*)mega, dim3(grid_blocks), dim3(256), args, 0, stream);
  if (e != hipSuccess) fprintf(stderr, "cooperative launch failed: %s (grid %d)\n", hipGetErrorString(e), grid_blocks);
}
```

```cpp
#include <hip/hip_runtime.h>
#include <hip/hip_cooperative_groups.h>
#include <cstdio>
#include <cstdint>
namespace cg = cooperative_groups;

typedef unsigned short u16;
typedef _Float16 f16;
using bf16x8 = __attribute__((ext_vector_type(8))) short;
using f32x16 = __attribute__((ext_vector_type(16))) float;
using f32x4 = __attribute__((ext_vector_type(4))) float;
using u32x4 = __attribute__((ext_vector_type(4))) unsigned;
#define DI __device__ __forceinline__
DI u32x4 mk4(unsigned a, unsigned b, unsigned c, unsigned d) { u32x4 r; r[0] = a; r[1] = b; r[2] = c; r[3] = d; return r; }

constexpr int TL = 32768;
constexpr int TCX = 1024;
constexpr int MR = 33792;
constexpr int DM = 1024;
constexpr int DFF = 2816;
constexpr int NKEY = 8448;
constexpr int NPHASE = 18;
#define XB_CU(j)    (4096 + (j))
#define XB_N0       8192
#define XB_N1       8256

struct Params {
  const float *x, *c, *ctx, *c_ctx, *ada_w, *ada_b, *w_qkv, *q_gain, *k_gain, *w_o;
  const float *mu, *rw_r, *rw_k, *rw_v, *rw_o, *dw0, *dw1, *dw2, *a0, *a1, *a2, *g1, *g2, *k_k, *k_a, *r_k, *gn_w, *gn_b;
  const float *f_up, *f_cw, *f_cb, *f_down, *final_gain;
  float* out;
  u16 *qkv_t, *wo_t, *up_t, *down_t, *rr_t, *rk_t, *rv_t, *ro_t, *w1_t, *a1_t, *g1_t, *w2_t, *a2_t, *g2_t;
  float *modpart, *modv, *rope, *XC, *bonus;
  u16* zero;
  unsigned* bar;
  unsigned* blkinfo;
  u16 *H, *XX, *Q, *QC, *Kb, *Vt, *ACT0, *ACT1;
  f16 *R16, *K16, *V16, *KK16, *Y0, *Y1;
  u16 *LW, *LA, *LG, *Z;
  int phase_lo, phase_hi;
};

typedef __bf16 bf16x2_t __attribute__((ext_vector_type(2)));
typedef float f32x2 __attribute__((ext_vector_type(2)));
DI unsigned pack2(float a, float b) { f32x2 f = {a, b}; return __builtin_bit_cast(unsigned, __builtin_convertvector(f, bf16x2_t)); }
DI u16 f2bf(float x) { return (u16)(pack2(x, 0.f) & 0xffffu); }
DI float bf2f(u16 h) { return __uint_as_float(((unsigned)h) << 16); }
DI float wave_sum(float v) {
#pragma unroll
  for (int o = 32; o > 0; o >>= 1) v += __shfl_xor(v, o, 64);
  return v;
}
template <int CTRL> DI float dpp_mov(float v) { return __builtin_bit_cast(float, __builtin_amdgcn_update_dpp(0, __builtin_bit_cast(int, v), CTRL, 0xF, 0xF, true)); }
DI float dpp_sum16(float v) {
  v += dpp_mov<0x128>(v);
  v += dpp_mov<0x124>(v);
  v += dpp_mov<0x122>(v);
  v += dpp_mov<0x121>(v);
  return v;
}
DI float sum32(float v) { v = dpp_sum16(v); v += __shfl_xor(v, 16, 64); return v; }
DI float sigmoidf_(float x) { return 1.f / (1.f + __expf(-x)); }
DI float sigmoid_fast(float x) { return __builtin_amdgcn_rcpf(1.f + __expf(-x)); }
DI int midx_of(int row) { return row < TL ? (row >> 13) : 4; }
DI float* resid_ptr(const Params& p, int row) { return row < TL ? p.out + (size_t)row * DM : p.XC + (size_t)(row - TL) * DM; }
DI const float* xin_ptr(const Params& p, int row) { return row < TL ? p.x + (size_t)row * DM : p.ctx + (size_t)(row - TL) * DM; }

DI void work_range(int total, int& g0, int& gend, int& step) {
  if ((gridDim.x & 7) == 0) {
    const int x = blockIdx.x & 7, li = blockIdx.x >> 3, nl = gridDim.x >> 3;
    const int lo = (int)(((long long)total * x) >> 3), hi = (int)(((long long)total * (x + 1)) >> 3);
    g0 = lo + li; gend = hi; step = nl;
  } else { g0 = blockIdx.x; gend = total; step = gridDim.x; }
}
DI void band_decode(int g, int MT, int NT, int& mt, int& nt) {
  const int per = 8 * NT;
  const int band = g / per, r = g - band * per;
  int hb = MT - band * 8; if (hb > 8) hb = 8;
  nt = r / hb; mt = band * 8 + (r - nt * hb);
}

using GAcc = f32x4[4][4];
template <class AF, class BF>
DI void gemm_mainloop(char* smem, int nparts, int kpart, AF arow, BF brow, f32x4 (&acc)[4][4]) {
  const int tid = threadIdx.x, lane = tid & 63, wave = tid >> 6;
  const int wm = wave >> 1, wn = wave & 1;
  const int lr = tid >> 3, lc = tid & 7;
#pragma unroll
  for (int i = 0; i < 4; ++i)
#pragma unroll
    for (int j = 0; j < 4; ++j)
#pragma unroll
      for (int e = 0; e < 4; ++e) acc[i][j][e] = 0.f;
  const int csrc = (lc ^ ((lr >> 1) & 7)) * 8;
  const u16* bp[4];
  const u16* ap[4];
#pragma unroll
  for (int q = 0; q < 4; ++q) { bp[q] = brow(lr + 32 * q) + csrc; ap[q] = arow(lr + 32 * q, 0) + csrc; }
  const int nk = kpart >> 6;
  const int total = nparts * nk;
  const int sw = (lane >> 1) & 7;
  const int kq = lane >> 4;
  char* const wbase = smem + wave * 1024;
  auto stage = [&](int buf, int kk, int boff) {
#pragma unroll
    for (int q = 0; q < 4; ++q) {
      __builtin_amdgcn_global_load_lds((const unsigned*)(ap[q] + kk), (unsigned*)(wbase + buf * 32768 + q * 4096), 16, 0, 0);
      __builtin_amdgcn_global_load_lds((const unsigned*)(bp[q] + boff), (unsigned*)(wbase + buf * 32768 + 16384 + q * 4096), 16, 0, 0);
    }
  };
  __syncthreads();
  stage(0, 0, 0);
  asm volatile("s_waitcnt vmcnt(0)" ::: "memory");
  __syncthreads();
  int part = 0, kk = 0, buf = 0;
#pragma unroll 1
  for (int it = 0; it < total; ++it) {
    kk += 64;
    if (kk == kpart) {
      kk = 0; ++part;
      if (part < nparts) {
#pragma unroll
        for (int q = 0; q < 4; ++q) ap[q] = arow(lr + 32 * q, part) + csrc;
      }
    }
    if (it + 1 < total) stage(buf ^ 1, kk, part * kpart + kk);
    const u16* As = (const u16*)(smem + buf * 32768);
    const u16* Bs = As + 128 * 64;
    const u16* Ar = As + (wm * 64 + (lane & 15)) * 64;
    const u16* Br = Bs + (wn * 64 + (lane & 15)) * 64;
    bf16x8 af[2][4], bf[2][4];
    {
      const int pc = (kq ^ sw) * 8;
#pragma unroll
      for (int i = 0; i < 4; ++i) { af[0][i] = *(const bf16x8*)(Ar + i * 1024 + pc); bf[0][i] = *(const bf16x8*)(Br + i * 1024 + pc); }
    }
#pragma unroll
    for (int ks = 0; ks < 2; ++ks) {
      const int cur = ks & 1;
      if (ks + 1 < 2) {
        const int pc = ((4 + kq) ^ sw) * 8;
#pragma unroll
        for (int i = 0; i < 4; ++i) { af[1][i] = *(const bf16x8*)(Ar + i * 1024 + pc); bf[1][i] = *(const bf16x8*)(Br + i * 1024 + pc); }
      }
#pragma unroll
      for (int i = 0; i < 4; ++i)
#pragma unroll
        for (int j = 0; j < 4; ++j) acc[i][j] = __builtin_amdgcn_mfma_f32_16x16x32_bf16(af[cur][i], bf[cur][j], acc[i][j], 0, 0, 0);
      __builtin_amdgcn_sched_barrier(0);
    }
    asm volatile("s_waitcnt vmcnt(0)" ::: "memory");
    __syncthreads();
    buf ^= 1;
  }
}

template <class F>
DI void epi_direct(const f32x4 (&acc)[4][4], F f) {
  const int lane = threadIdx.x & 63, wave = threadIdx.x >> 6;
  const int wm = wave >> 1, wn = wave & 1, g = lane >> 4;
#pragma unroll
  for (int i = 0; i < 4; ++i)
#pragma unroll
    for (int j = 0; j < 4; ++j)
#pragma unroll
      for (int e = 0; e < 4; ++e) {
        const int row = wm * 64 + i * 16 + g * 4 + e;
        const int col = wn * 64 + j * 16 + (lane & 15);
        f(row, col, acc[i][j][e]);
      }
}
#define CS(r, c) Cs[(r) * 128 + (c)]
DI void acc_to_lds(float* Cs, const f32x4 (&acc)[4][4]) {
  __syncthreads();
  epi_direct(acc, [&](int r, int c, float v) { CS(r, c) = v; });
  __syncthreads();
}

struct TJob { const float* src; int srcK, srcN; u16* dst; int ld, koff; const float* mu; int Kpad, Npad; };
DI TJob get_job(const Params& p, int j) {
  TJob t; t.mu = nullptr; t.koff = 0;
  auto set = [&](const float* s, int K, int N, u16* d, int ld) { t.src = s; t.srcK = K; t.srcN = N; t.dst = d; t.ld = ld; t.Kpad = K; t.Npad = N; };
  switch (j) {
    case 4: set(p.w_qkv, 1024, 1536, p.qkv_t, 1024); break;
    case 5: set(p.w_o, 1024, 1024, p.wo_t, 1024); break;
    case 0: set(p.f_up, 1024, 5632, p.up_t, 1024); break;
    case 1: set(p.f_up + (size_t)1024 * 5632, 1024, 5632, p.up_t + (size_t)5632 * 1024, 1024); break;
    case 2: set(p.f_down, 2816, 1024, p.down_t, 2816); break;
    case 3: set(p.f_down + (size_t)2816 * 1024, 2816, 1024, p.down_t + (size_t)1024 * 2816, 2816); break;
    case 6: set(p.rw_r, 1024, 1024, p.rr_t, 2048); break;
    case 7: set(p.rw_r, 1024, 1024, p.rr_t, 2048); t.mu = p.mu + 0 * 1024; t.koff = 1024; break;
    case 8: set(p.rw_k, 1024, 1024, p.rk_t, 2048); break;
    case 9: set(p.rw_k, 1024, 1024, p.rk_t, 2048); t.mu = p.mu + 2 * 1024; t.koff = 1024; break;
    case 10: set(p.rw_v, 1024, 1024, p.rv_t, 2048); break;
    case 11: set(p.rw_v, 1024, 1024, p.rv_t, 2048); t.mu = p.mu + 3 * 1024; t.koff = 1024; break;
    case 12: set(p.rw_o, 1024, 1024, p.ro_t, 1024); break;
    case 13: set(p.dw1, 1024, 64, p.w1_t, 2048); break;
    case 14: set(p.dw1, 1024, 64, p.w1_t, 2048); t.mu = p.mu + 1 * 1024; t.koff = 1024; break;
    case 15: set(p.dw1 + 1024 * 64, 1024, 64, p.w1_t + 64 * 2048, 2048); break;
    case 16: set(p.dw1 + 1024 * 64, 1024, 64, p.w1_t + 64 * 2048, 2048); t.mu = p.mu + 1 * 1024; t.koff = 1024; break;
    case 17: set(p.a1, 1024, 64, p.a1_t, 2048); break;
    case 18: set(p.a1, 1024, 64, p.a1_t, 2048); t.mu = p.mu + 4 * 1024; t.koff = 1024; break;
    case 19: set(p.a1 + 1024 * 64, 1024, 64, p.a1_t + 64 * 2048, 2048); break;
    case 20: set(p.a1 + 1024 * 64, 1024, 64, p.a1_t + 64 * 2048, 2048); t.mu = p.mu + 4 * 1024; t.koff = 1024; break;
    case 21: set(p.g1, 1024, 160, p.g1_t, 2048); t.Npad = 256; break;
    case 22: set(p.g1, 1024, 160, p.g1_t, 2048); t.Npad = 256; t.mu = p.mu + 5 * 1024; t.koff = 1024; break;
    case 23: set(p.dw2, 64, 1024, p.w2_t, 64); break;
    case 24: set(p.dw2 + 64 * 1024, 64, 1024, p.w2_t + 1024 * 64, 64); break;
    case 25: set(p.a2, 64, 1024, p.a2_t, 64); break;
    case 26: set(p.a2 + 64 * 1024, 64, 1024, p.a2_t + 1024 * 64, 64); break;
    default: set(p.g2, 160, 1024, p.g2_t, 192); t.Kpad = 192; break;
  }
  return t;
}
constexpr int NJOBS = 28;
DI int job_tiles(const TJob& t) { return ((t.Kpad + 63) >> 6) * ((t.Npad + 63) >> 6); }

DI void phase_prep(const Params& p, char* smem) {
  const int tid = threadIdx.x;
  const int ttiles = 7024;
  const int n_mod = 2 * 24 * 8;
  const int n_rope = 1024;
  const int total = ttiles + n_mod + n_rope;
  float* tile = (float*)smem;
  if (blockIdx.x == 0) for (int e = tid; e < 4096; e += 256) p.zero[e] = 0;
  {
    auto decode = [&](int item, TJob& t, int& kt, int& nt) {
      int rem = item, j = 0;
      t = get_job(p, 0);
      while (true) { int n = job_tiles(t); if (rem < n) break; rem -= n; ++j; t = get_job(p, j); }
      const int ntn = (t.Npad + 63) >> 6;
      kt = rem / ntn; nt = rem % ntn;
    };
    auto load_tile = [&](const TJob& t, int kt, int nt, float (&v)[16]) {
#pragma unroll
      for (int i = 0; i < 16; ++i) {
        const int kl = i * 4 + (tid >> 6), nl = tid & 63;
        const int k = kt * 64 + kl, n = nt * 64 + nl;
        float x = 0.f;
        if (k < t.srcK && n < t.srcN) { x = t.src[(size_t)k * t.srcN + n]; if (t.mu) x *= t.mu[k]; }
        v[i] = x;
      }
    };
    TJob tc, tn; int ktc = 0, ntc = 0, ktn = 0, ntn_ = 0;
    float vc[16], vn[16];
    int item = blockIdx.x;
    if (item < ttiles) { decode(item, tc, ktc, ntc); load_tile(tc, ktc, ntc, vc); }
    for (; item < ttiles; item += gridDim.x) {
      const int nxt = item + gridDim.x;
      if (nxt < ttiles) { decode(nxt, tn, ktn, ntn_); load_tile(tn, ktn, ntn_, vn); }
      __syncthreads();
#pragma unroll
      for (int i = 0; i < 16; ++i) tile[(i * 4 + (tid >> 6)) * 65 + (tid & 63)] = vc[i];
      __syncthreads();
#pragma unroll
      for (int i = 0; i < 16; ++i) {
        const int nl = i * 4 + (tid >> 6), kl = tid & 63;
        const int k = ktc * 64 + kl, n = ntc * 64 + nl;
        if (k < tc.Kpad && n < tc.Npad) tc.dst[(size_t)n * tc.ld + tc.koff + k] = f2bf(tile[kl * 65 + nl]);
      }
      if (nxt < ttiles) {
        tc = tn; ktc = ktn; ntc = ntn_;
#pragma unroll
        for (int i = 0; i < 16; ++i) vc[i] = vn[i];
      }
    }
  }
  int first_other = ttiles + (int)blockIdx.x;
  for (int item = first_other; item < total; item += gridDim.x) {
    if (false) {
    } else if (item < ttiles + n_mod) {
      const int it = item - ttiles;
      const int layer = it / 192, cc = (it % 192) / 8, kc = it % 8;
      float* sil = (float*)smem;
      __syncthreads();
      for (int e = tid; e < 640; e += 256) {
        const int j = e >> 7, k = kc * 128 + (e & 127);
        const float v = j < 4 ? p.c[j * 1024 + k] : p.c_ctx[k];
        sil[e] = v / (1.f + __expf(-v));
      }
      __syncthreads();
      const int col = cc * 256 + tid;
      float a0 = 0, a1 = 0, a2 = 0, a3 = 0, a4 = 0;
      const float* w = p.ada_w + ((size_t)layer * 1024 + kc * 128) * 6144 + col;
#pragma unroll 16
      for (int k = 0; k < 128; ++k) {
        const float wv = w[(size_t)k * 6144];
        a0 += sil[k] * wv; a1 += sil[128 + k] * wv; a2 += sil[256 + k] * wv; a3 += sil[384 + k] * wv; a4 += sil[512 + k] * wv;
      }
      float* mp = p.modpart + ((size_t)(layer * 8 + kc) * 5) * 6144 + col;
      mp[0] = a0; mp[6144] = a1; mp[2 * 6144] = a2; mp[3 * 6144] = a3; mp[4 * 6144] = a4;
    } else {
      const int e = (item - ttiles - n_mod) * 256 + tid;
      const int s = e >> 5, pr = e & 31;
      const int f = pr & 15;
      const float inv_freq = powf(10000.f, -(float)f / 16.f);
      const float pos = (pr < 16) ? (float)(s >> 6) : (float)(s & 63);
      const float ang = pos * inv_freq;
      float sn, cs;
      sincosf(ang, &sn, &cs);
      p.rope[e * 2] = cs; p.rope[e * 2 + 1] = sn;
    }
  }
}

DI void phase_modreduce(const Params& p) {
  const int n = 2 * 5 * 6144;
  for (int e = blockIdx.x * 256 + threadIdx.x; e < n; e += gridDim.x * 256) {
    const int layer = e / (5 * 6144), r = e % (5 * 6144), col = r % 6144;
    float s = p.ada_b[layer * 6144 + col];
    for (int kc = 0; kc < 8; ++kc) s += p.modpart[(size_t)(layer * 8 + kc) * 5 * 6144 + r];
    p.modv[e] = s;
  }
}

template <bool FROM_INPUT>
DI void phase_modulate(const Params& p, int layer, int which, int nrows) {
  const int lane = threadIdx.x & 63;
  const int gw = blockIdx.x * 4 + (threadIdx.x >> 6), nw = gridDim.x * 4;
  auto load_row = [&](int row, float4 (&v)[4]) {
    const float* src = FROM_INPUT ? xin_ptr(p, row) : resid_ptr(p, row);
#pragma unroll
    for (int i = 0; i < 4; ++i) v[i] = *(const float4*)(src + i * 256 + lane * 4);
  };
  float4 v[4], vn[4];
  int row = gw;
  if (row < nrows) load_row(row, v);
  for (; row < nrows; row += nw) {
    const int nxt = row + nw;
    if (nxt < nrows) load_row(nxt, vn);
    const float* mv = p.modv + ((size_t)layer * 5 + midx_of(row)) * 6144 + which * 3072;
    float ss = 0.f;
#pragma unroll
    for (int i = 0; i < 4; ++i) ss += v[i].x * v[i].x + v[i].y * v[i].y + v[i].z * v[i].z + v[i].w * v[i].w;
    ss = wave_sum(ss);
    const float rinv = rsqrtf(ss * (1.f / 1024.f) + 1e-6f);
#pragma unroll
    for (int i = 0; i < 4; ++i) {
      const int col = i * 256 + lane * 4;
      const float4 sh = *(const float4*)(mv + col);
      const float4 sc = *(const float4*)(mv + 1024 + col);
      uint2 o;
      o.x = pack2(v[i].x * rinv * (1.f + sc.x) + sh.x, v[i].y * rinv * (1.f + sc.y) + sh.y);
      o.y = pack2(v[i].z * rinv * (1.f + sc.z) + sh.z, v[i].w * rinv * (1.f + sc.w) + sh.w);
      *(uint2*)(p.H + (size_t)row * DM + col) = o;
    }
#pragma unroll
    for (int i = 0; i < 4; ++i) v[i] = vn[i];
  }
}

DI void shift_load(const Params& p, int row, bool valid, int lane, f32x4 (&raw)[4]) {
  if (valid) {
    const float* src = resid_ptr(p, row);
#pragma unroll
    for (int i = 0; i < 4; ++i) raw[i] = *(const f32x4*)(src + i * 256 + lane * 4);
  }
}
DI void shift_finish(const Params& p, int row, bool valid, int lane, const f32x4 (&raw)[4], float (&h)[16]) {
  if (!valid) {
#pragma unroll
    for (int i = 0; i < 16; ++i) h[i] = 0.f;
    return;
  }
  const float* mv = p.modv + ((size_t)1 * 5 + midx_of(row)) * 6144;
  float ss = 0.f;
#pragma unroll
  for (int i = 0; i < 4; ++i) ss += raw[i][0] * raw[i][0] + raw[i][1] * raw[i][1] + raw[i][2] * raw[i][2] + raw[i][3] * raw[i][3];
  ss = wave_sum(ss);
  const float rinv = rsqrtf(ss * (1.f / 1024.f) + 1e-6f);
#pragma unroll
  for (int i = 0; i < 4; ++i) {
    const int col = i * 256 + lane * 4;
    const float4 sh = *(const float4*)(mv + col);
    const float4 sc = *(const float4*)(mv + 1024 + col);
    h[i * 4 + 0] = raw[i][0] * rinv * (1.f + sc.x) + sh.x;
    h[i * 4 + 1] = raw[i][1] * rinv * (1.f + sc.y) + sh.y;
    h[i * 4 + 2] = raw[i][2] * rinv * (1.f + sc.z) + sh.z;
    h[i * 4 + 3] = raw[i][3] * rinv * (1.f + sc.w) + sh.w;
  }
}
DI void phase_rwkv_shift(const Params& p) {
  const int lane = threadIdx.x & 63;
  const int gw = blockIdx.x * 4 + (threadIdx.x >> 6), nw = gridDim.x * 4;
  const int nitems = MR / 8;
  for (int item = gw; item < nitems; item += nw) {
    const int r0 = item * 8;
    int sb, T;
    if (r0 < TL) { sb = r0 & ~8191; T = 8192; } else { sb = TL + ((r0 - TL) & ~255); T = 256; }
    const int send = sb + T;
    float hm[16], hc[16], hn[16];
    f32x4 raw[2][4];
    shift_load(p, r0 - 1, r0 - 1 >= sb, lane, raw[0]);
    shift_load(p, r0, true, lane, raw[1]);
    shift_finish(p, r0 - 1, r0 - 1 >= sb, lane, raw[0], hm);
    shift_load(p, r0 + 1, r0 + 1 < send, lane, raw[0]);
    shift_finish(p, r0, true, lane, raw[1], hc);
#pragma unroll
    for (int j = 0; j < 8; ++j) {
      const int row = r0 + j;
      if (j < 7) shift_load(p, row + 2, row + 2 < send, lane, raw[(j & 1) ^ 1]);
      shift_finish(p, row + 1, row + 1 < send, lane, raw[j & 1], hn);
#pragma unroll
      for (int i = 0; i < 4; ++i) {
        const int col = i * 256 + lane * 4;
        float xx[4];
#pragma unroll
        for (int e = 0; e < 4; ++e) xx[e] = 0.5f * (hm[i * 4 + e] + hn[i * 4 + e]) - hc[i * 4 + e];
        uint2 o, o2;
        o.x = pack2(hc[i * 4 + 0], hc[i * 4 + 1]); o.y = pack2(hc[i * 4 + 2], hc[i * 4 + 3]);
        o2.x = pack2(xx[0], xx[1]); o2.y = pack2(xx[2], xx[3]);
        *(uint2*)(p.H + (size_t)row * DM + col) = o;
        *(uint2*)(p.XX + (size_t)row * DM + col) = o2;
      }
#pragma unroll
      for (int i = 0; i < 16; ++i) { hm[i] = hc[i]; hc[i] = hn[i]; }
    }
  }
}

DI void phase_qkv(const Params& p, char* smem) {
  float* Cs = (float*)smem;
  const int tid = threadIdx.x;
  int g0, gend, gstep; work_range(264 * 12, g0, gend, gstep);
  for (int tile = g0; tile < gend; tile += gstep) {
    int mt, nt; band_decode(tile, 264, 12, mt, nt);
    const int m0 = mt * 128;
    f32x4 acc[4][4];
    gemm_mainloop(smem, 1, 1024,
                  [&](int r, int) { return (const u16*)(p.H + (size_t)(m0 + r) * DM); },
                  [&](int c) { return (const u16*)(p.qkv_t + (size_t)(nt * 128 + c) * 1024); }, acc);
    acc_to_lds(Cs, acc);
    const bool isctx = m0 >= TL;
    const int b = isctx ? (m0 - TL) >> 8 : m0 >> 13;
    const int t0 = isctx ? (m0 - TL) & 255 : m0 & 8191;
    if (nt < 10) {
      const int lane = tid & 63, wave = tid >> 6;
      const int hh = lane >> 5, pr = lane & 31;
      const bool isq = nt < 8;
      const float* gain = isq ? p.q_gain : p.k_gain;
      const float qs = isq ? 0.125f * 1.4426950408889634f : 1.f;
      const float g0 = gain[2 * pr] * qs, g1 = gain[2 * pr + 1] * qs;
      u16* dstb;
      size_t tstride = 64;
      if (isq) {
        const int head = nt * 2 + hh;
        dstb = isctx ? p.QC + ((size_t)(b * 16 + head) * 256 + t0) * 64 : p.Q + ((size_t)(b * 16 + head) * 8192 + t0) * 64;
      } else {
        const int kh = (nt - 8) * 2 + hh;
        dstb = p.Kb + ((size_t)(b * 4 + kh) * NKEY + (isctx ? t0 : 256 + t0)) * 64;
      }
#pragma unroll 4
      for (int rr = 0; rr < 32; ++rr) {
        const int r = wave * 32 + rr;
        const float2 v = *(const float2*)&CS(r, 2 * lane);
        float ss = v.x * v.x + v.y * v.y;
        ss = sum32(ss);
        const float rinv = rsqrtf(ss * (1.f / 64.f) + 1e-6f);
        float x0 = v.x * rinv * g0, x1 = v.y * rinv * g1;
        if (!isctx) {
          const float2 cssn = *(const float2*)(p.rope + ((size_t)(t0 + r) * 32 + pr) * 2);
          const float y0 = x0 * cssn.x - x1 * cssn.y, y1 = x0 * cssn.y + x1 * cssn.x;
          x0 = y0; x1 = y1;
        }
        *(unsigned*)(dstb + (size_t)r * tstride + 2 * pr) = pack2(x0, x1);
      }
    } else {
      const int keybase = (isctx ? t0 : 256 + t0);
      for (int j = 0; j < 4; ++j) {
        const int item = tid + 256 * j;
        const int d = item & 63, hh = (item >> 6) & 1, rg = item >> 7;
        const int kh = (nt - 10) * 2 + hh;
        float v[16];
#pragma unroll
        for (int i = 0; i < 16; ++i) v[i] = CS(rg * 16 + i, hh * 64 + d);
        u16* dst = p.Vt + ((size_t)(b * 4 + kh) * 64 + d) * NKEY + keybase + rg * 16;
        *(u32x4*)(dst) = mk4(pack2(v[0], v[1]), pack2(v[2], v[3]), pack2(v[8], v[9]), pack2(v[10], v[11]));
        *(u32x4*)(dst + 8) = mk4(pack2(v[4], v[5]), pack2(v[6], v[7]), pack2(v[12], v[13]), pack2(v[14], v[15]));
      }
    }
  }
}

DI void phase_attn(const Params& p, char* smem) {
  const int tid = threadIdx.x, lane = tid & 63, wave = tid >> 6;
  const int sw = (lane >> 1) & 7, hsel = lane >> 5;
  float mq = 0.f, mk = 0.f;
  for (int d = 0; d < 64; ++d) { mq = fmaxf(mq, fabsf(p.q_gain[d])); mk = fmaxf(mk, fabsf(p.k_gain[d])); }
  const float c0 = 0.125f * 1.4426950408889634f * 64.f * mq * mk * 1.02f + 0.5f;
  f32x16 negc;
#pragma unroll
  for (int i = 0; i < 16; ++i) negc[i] = -c0;
  int ga, gae, gs, gc, gce, gs2;
  work_range(2048, ga, gae, gs);
  work_range(64, gc, gce, gs2);
  const int n_lat = ga < gae ? (gae - ga + gs - 1) / gs : 0;
  const int n_ctx = gc < gce ? (gce - gc + gs2 - 1) / gs2 : 0;
  for (int wi = 0; wi < n_lat + n_ctx; ++wi) {
    const int item = wi < n_lat ? ga + wi * gs : 2048 + gc + (wi - n_lat) * gs2;
    int b, kvh, qb, nkt;
    const u16* qbase;
    size_t orow;
    const int head_g = wave;
    if (item < 2048) {
      b = item >> 9; kvh = (item >> 7) & 3; qb = item & 127; nkt = NKEY / 64;
      qbase = p.Q + ((size_t)(b * 16 + kvh * 4 + head_g) * 8192 + qb * 64) * 64;
      orow = (size_t)b * 8192 + qb * 64;
    } else {
      const int j = item - 2048;
      b = j >> 4; kvh = (j >> 2) & 3; qb = j & 3; nkt = 4;
      qbase = p.QC + ((size_t)(b * 16 + kvh * 4 + head_g) * 256 + qb * 64) * 64;
      orow = (size_t)TL + b * 256 + qb * 64;
    }
    const int head = kvh * 4 + head_g;
    bf16x8 qf[2][4];
#pragma unroll
    for (int qi = 0; qi < 2; ++qi)
#pragma unroll
      for (int ks = 0; ks < 4; ++ks) qf[qi][ks] = *(const bf16x8*)(qbase + (qi * 32 + (lane & 31)) * 64 + ks * 16 + hsel * 8);
    const u16* kg = p.Kb + (size_t)(b * 4 + kvh) * NKEY * 64;
    const u16* vg = p.Vt + (size_t)(b * 4 + kvh) * 64 * NKEY;
    f32x16 oacc[2][2];
#pragma unroll
    for (int i = 0; i < 16; ++i) { oacc[0][0][i] = 0.f; oacc[0][1][i] = 0.f; oacc[1][0][i] = 0.f; oacc[1][1][i] = 0.f; }
    f32x2 ls2[2] = {{0.f, 0.f}, {0.f, 0.f}};
    const int grow = wave * 8 + (lane >> 3);
    const int gsrc = ((lane & 7) ^ ((grow >> 1) & 7)) * 8;
    const u16* kgl = kg + (size_t)grow * 64 + gsrc;
    const u16* vgl = vg + (size_t)grow * NKEY + gsrc;
    char* const wb = smem + wave * 1024;
    auto stage_kv = [&](int kt, int buf) {
#pragma unroll
      for (int q = 0; q < 2; ++q) {
        __builtin_amdgcn_global_load_lds((const unsigned*)(kgl + (size_t)kt * 4096 + q * 32 * 64), (unsigned*)(wb + buf * 16384 + q * 4096), 16, 0, 0);
        __builtin_amdgcn_global_load_lds((const unsigned*)(vgl + (size_t)q * 32 * NKEY + kt * 64), (unsigned*)(wb + buf * 16384 + 8192 + q * 4096), 16, 0, 0);
      }
    };
    __syncthreads();
    stage_kv(0, 0);
    asm volatile("s_waitcnt vmcnt(0)" ::: "memory");
    __syncthreads();
    for (int kt = 0; kt < nkt; ++kt) {
      const int buf = kt & 1;
      if (kt + 1 < nkt) stage_kv(kt + 1, buf ^ 1);
      const u16* Ks = (const u16*)(smem + buf * 16384);
      const u16* Vs = Ks + 64 * 64;
      f32x16 sacc[2][2];
#pragma unroll
      for (int kb = 0; kb < 2; ++kb) {
        bf16x8 kf[4];
#pragma unroll
        for (int ks = 0; ks < 4; ++ks) kf[ks] = *(const bf16x8*)(Ks + (kb * 32 + (lane & 31)) * 64 + (((ks * 2 + hsel) ^ sw) * 8));
#pragma unroll
        for (int ks = 0; ks < 4; ++ks) {
          sacc[0][kb] = __builtin_amdgcn_mfma_f32_32x32x16_bf16(kf[ks], qf[0][ks], ks == 0 ? negc : sacc[0][kb], 0, 0, 0);
          sacc[1][kb] = __builtin_amdgcn_mfma_f32_32x32x16_bf16(kf[ks], qf[1][ks], ks == 0 ? negc : sacc[1][kb], 0, 0, 0);
        }
      }
#pragma unroll
      for (int qi = 0; qi < 2; ++qi)
#pragma unroll
        for (int kb = 0; kb < 2; ++kb)
#pragma unroll
          for (int i = 0; i < 16; i += 2) {
            const float e0 = __builtin_amdgcn_exp2f(sacc[qi][kb][i]), e1 = __builtin_amdgcn_exp2f(sacc[qi][kb][i + 1]);
            sacc[qi][kb][i] = e0; sacc[qi][kb][i + 1] = e1;
            const f32x2 e2 = {e0, e1};
            ls2[qi] += e2;
          }
#pragma unroll
      for (int kb = 0; kb < 2; ++kb)
#pragma unroll
        for (int s2 = 0; s2 < 2; ++s2) {
          bf16x8 vfr[2];
#pragma unroll
          for (int db = 0; db < 2; ++db) vfr[db] = *(const bf16x8*)(Vs + (db * 32 + (lane & 31)) * 64 + (((2 * (2 * kb + s2) + hsel) ^ sw) * 8));
#pragma unroll
          for (int qi = 0; qi < 2; ++qi) {
            unsigned w[4];
#pragma unroll
            for (int e = 0; e < 4; ++e) w[e] = pack2(sacc[qi][kb][8 * s2 + 2 * e], sacc[qi][kb][8 * s2 + 2 * e + 1]);
            u32x4 pw = mk4(w[0], w[1], w[2], w[3]);
            const bf16x8 pf = __builtin_bit_cast(bf16x8, pw);
#pragma unroll
            for (int db = 0; db < 2; ++db) oacc[qi][db] = __builtin_amdgcn_mfma_f32_32x32x16_bf16(vfr[db], pf, oacc[qi][db], 0, 0, 0);
          }
        }
      asm volatile("s_waitcnt vmcnt(0)" ::: "memory");
      __syncthreads();
    }
#pragma unroll
    for (int qi = 0; qi < 2; ++qi) {
      const float lsum = ls2[qi][0] + ls2[qi][1];
      const float l = lsum + __shfl_xor(lsum, 32, 64);
      const float inv = 1.f / l;
      u16* od = p.H + (orow + qi * 32 + (lane & 31)) * DM + head * 64;
#pragma unroll
      for (int db = 0; db < 2; ++db)
#pragma unroll
        for (int g = 0; g < 4; ++g) {
          uint2 o;
          o.x = pack2(oacc[qi][db][g * 4 + 0] * inv, oacc[qi][db][g * 4 + 1] * inv);
          o.y = pack2(oacc[qi][db][g * 4 + 2] * inv, oacc[qi][db][g * 4 + 3] * inv);
          *(uint2*)(od + db * 32 + 8 * g + 4 * hsel) = o;
        }
    }
  }
}

template <bool FROM_INPUT>
DI void phase_proj_res(const Params& p, char* smem, const u16* A, int lda, int K, const u16* Bt, int layer, int gate_idx, int mtiles) {
  int g0, gend, gstep; work_range(mtiles * 8, g0, gend, gstep);
  for (int tile = g0; tile < gend; tile += gstep) {
    int mt, nt; band_decode(tile, mtiles, 8, mt, nt);
    const int m0 = mt * 128;
    f32x4 acc[4][4];
    gemm_mainloop(smem, 1, K,
                  [&](int r, int) { return A + (size_t)(m0 + r) * lda; },
                  [&](int c) { return Bt + (size_t)(nt * 128 + c) * K; }, acc);
    const float* gate = p.modv + ((size_t)layer * 5 + midx_of(m0)) * 6144 + gate_idx * 1024 + nt * 128;
    const float* sb = (FROM_INPUT ? xin_ptr(p, m0) : (const float*)resid_ptr(p, m0)) + nt * 128;
    float* db = resid_ptr(p, m0) + nt * 128;
    epi_direct(acc, [&](int r, int c, float v) { db[r * DM + c] = sb[r * DM + c] + gate[c] * v; });
  }
}

DI void phase_ffn_up(const Params& p, char* smem, int layer, bool with_ctx, u16* ACT) {
  float* Cs = (float*)smem;
  const int tid = threadIdx.x;
  const int mtiles = with_ctx ? 276 : 264;
  int g0, gend, gstep; work_range(mtiles * 44, g0, gend, gstep);
  const u16* up = p.up_t + (size_t)layer * 5632 * 1024;
  const float* cw = p.f_cw + (size_t)layer * 3 * 5632;
  const float* cb = p.f_cb + (size_t)layer * 5632;
  for (int tile = g0; tile < gend; tile += gstep) {
    int mt, nt; band_decode(tile, mtiles, 44, mt, nt);
    int rowbase, T, j;
    if (mt < 264) { rowbase = (mt / 66) * 8192; T = 8192; j = mt % 66; }
    else { const int m2 = mt - 264; rowbase = TL + (m2 / 3) * 256; T = 256; j = m2 % 3; }
    const int tb = j * 126 - 1;
    f32x4 acc[4][4];
    gemm_mainloop(smem, 1, 1024,
                  [&](int r, int) { const int t = tb + r; return (t >= 0 && t < T) ? (const u16*)(p.H + (size_t)(rowbase + t) * DM) : (const u16*)p.zero; },
                  [&](int c) { return up + (size_t)(c < 64 ? nt * 64 + c : 2816 + nt * 64 + (c - 64)) * 1024; }, acc);
    acc_to_lds(Cs, acc);
    const int c = tid & 63, rq = tid >> 6;
    const int n = nt * 64 + c;
    const float g0 = cw[n], g1 = cw[5632 + n], g2 = cw[2 * 5632 + n], gb = cb[n];
    const float v0 = cw[2816 + n], v1 = cw[5632 + 2816 + n], v2 = cw[2 * 5632 + 2816 + n], vb = cb[2816 + n];
    const int rs = 1 + rq * 32;
    int re = rs + 32; if (re > 127) re = 127;
    float gp = CS(rs - 1, c), gc = CS(rs, c), vp = CS(rs - 1, c + 64), vc = CS(rs, c + 64);
    for (int r = rs; r < re; ++r) {
      const float gn = CS(r + 1, c), vn = CS(r + 1, c + 64);
      const int t = tb + r;
      if (t < T) {
        const float g = g0 * gp + g1 * gc + g2 * gn + gb;
        const float v = v0 * vp + v1 * vc + v2 * vn + vb;
        const float a = g * __builtin_amdgcn_rcpf(1.f + __expf(-g)) * v;
        ACT[(size_t)(rowbase + t) * DFF + n] = f2bf(a);
      }
      gp = gc; gc = gn; vp = vc; vc = vn;
    }
  }
}

DI void phase_rwkv_gemms(const Params& p, char* smem) {
  float* Cs = (float*)smem;
  const int tid = threadIdx.x;
  int g0, gend, gstep; work_range(7312, g0, gend, gstep);
  for (int tile = g0; tile < gend; tile += gstep) {
    int job, mt, nt;
    const u16* Bt;
    if (tile < 2048) { job = 0; band_decode(tile, 256, 8, mt, nt); Bt = p.rr_t; }
    else if (tile < 4160) { job = 1; band_decode(tile - 2048, 264, 8, mt, nt); Bt = p.rk_t; }
    else if (tile < 6272) { job = 2; band_decode(tile - 4160, 264, 8, mt, nt); Bt = p.rv_t; }
    else if (tile < 6536) { job = 3; mt = tile - 6272; nt = 0; Bt = p.w1_t; }
    else if (tile < 6800) { job = 4; mt = tile - 6536; nt = 0; Bt = p.a1_t; }
    else { job = 5; band_decode(tile - 6800, 256, 2, mt, nt); Bt = p.g1_t; }
    const int m0 = mt * 128;
    f32x4 acc[4][4];
    gemm_mainloop(smem, 2, 1024,
                  [&](int r, int part) { return (const u16*)((part ? p.XX : p.H) + (size_t)(m0 + r) * DM); },
                  [&](int c) { return Bt + (size_t)(nt * 128 + c) * 2048; }, acc);
    if (job == 0) {
      epi_direct(acc, [&](int r, int c, float v) { p.R16[(size_t)(m0 + r) * DM + nt * 128 + c] = (f16)v; });
    } else if (job == 2) {
      epi_direct(acc, [&](int r, int c, float v) { p.V16[(size_t)(m0 + r) * DM + nt * 128 + c] = (f16)v; });
    } else if (job == 3) {
      epi_direct(acc, [&](int r, int c, float v) { p.LW[(size_t)(m0 + r) * 128 + c] = f2bf(tanhf(v)); });
    } else if (job == 4) {
      epi_direct(acc, [&](int r, int c, float v) { p.LA[(size_t)(m0 + r) * 128 + c] = f2bf(v); });
    } else if (job == 5) {
      epi_direct(acc, [&](int r, int c, float v) {
        const int col = nt * 128 + c;
        if (col < 192) p.LG[(size_t)(m0 + r) * 192 + col] = col < 160 ? f2bf(sigmoid_fast(v)) : (u16)0;
      });
    } else {
      acc_to_lds(Cs, acc);
      const int lane = tid & 63, wave = tid >> 6;
      const int col = nt * 128 + 2 * lane;
      const float kk0 = p.k_k[col], kk1 = p.k_k[col + 1];
#pragma unroll 4
      for (int rr = 0; rr < 32; ++rr) {
        const int r = wave * 32 + rr;
        const float2 v = *(const float2*)&CS(r, 2 * lane);
        const float a0 = v.x * kk0, a1 = v.y * kk1;
        float ss = a0 * a0 + a1 * a1;
        ss = sum32(ss);
        const float inv = 1.f / fmaxf(sqrtf(ss), 1e-12f);
        f16 k2[2], n2[2];
        k2[0] = (f16)v.x; k2[1] = (f16)v.y; n2[0] = (f16)(a0 * inv); n2[1] = (f16)(a1 * inv);
        *(unsigned*)(p.K16 + (size_t)(m0 + r) * DM + col) = *(const unsigned*)k2;
        *(unsigned*)(p.KK16 + (size_t)(m0 + r) * DM + col) = *(const unsigned*)n2;
      }
    }
  }
}

#define XB_TMO      128
#define XB_XCNT(j)  (256  + 64 * (j))
#define XB_XSUB(j)  (1280 + 64 * (j))
#define XB_XGEN(j)  (2304 + 64 * (j))
#define XB_TOP      3328
#define XB_TOPGEN   3392
#define XB_SPIN_CAP (1u << 20)
DI unsigned xb_ld(unsigned* p) { return __hip_atomic_load(p, __ATOMIC_RELAXED, __HIP_MEMORY_SCOPE_AGENT); }
DI unsigned xb_add(unsigned* p, unsigned v) { return __hip_atomic_fetch_add(p, v, __ATOMIC_RELAXED, __HIP_MEMORY_SCOPE_AGENT); }
DI unsigned xb_xcc_id() { return (unsigned)__builtin_amdgcn_s_getreg((3 << 11) | 20) & 0xFu; }
#define XB_SPIN(cond, bar) do { unsigned _sp = 0; while (cond) { __builtin_amdgcn_s_sleep(1); \
    if ((++_sp & 255u) == 0u) { if (xb_ld(&(bar)[XB_TMO])) break; if (_sp > XB_SPIN_CAP) { atomicAdd(&(bar)[XB_TMO], 1u); break; } } } } while (0)
struct XbState { unsigned x, nloc, nx; };
DI void xb_census(unsigned* bar, unsigned x, unsigned& nloc, unsigned& nx) {
  const unsigned G = gridDim.x;
  unsigned sum, cnt, mine, sp = 0u;
  for (;;) {
    sum = 0u; cnt = 0u; mine = 0u;
#pragma unroll
    for (unsigned j = 0; j < 16; ++j) { const unsigned c = xb_ld(&bar[XB_XCNT(j)]); sum += c; cnt += (c > 0u) ? 1u : 0u; mine = (j == x) ? c : mine; }
    if (sum == G) break;
    __builtin_amdgcn_s_sleep(1);
    if ((++sp & 255u) == 0u) { if (xb_ld(&bar[XB_TMO])) break; if (sp > XB_SPIN_CAP) { atomicAdd(&bar[XB_TMO], 1u); break; } }
  }
  nloc = mine > 0u ? mine : 1u; nx = cnt > 0u ? cnt : 1u;
}
DI void grid_barrier(unsigned* bar, XbState& st) {
  asm volatile("s_waitcnt vmcnt(0)" ::: "memory");
  __syncthreads();
  if (threadIdx.x == 0) {
    __builtin_amdgcn_s_waitcnt(0);
    if (st.nloc == 0u) xb_census(bar, st.x, st.nloc, st.nx);
    const unsigned nloc = st.nloc, nx = st.nx;
    const unsigned old = xb_add(&bar[XB_XSUB(st.x)], 1u);
    const unsigned gen = old / nloc;
    if (old + 1u == (gen + 1u) * nloc) {
      __builtin_amdgcn_fence(__ATOMIC_RELEASE, "agent");
      asm volatile("s_waitcnt vmcnt(0)" ::: "memory");
      const unsigned og = xb_add(&bar[XB_TOP], 1u);
      const unsigned tg = og / nx;
      if (og + 1u == (tg + 1u) * nx) xb_add(&bar[XB_TOPGEN], 1u);
      else XB_SPIN(xb_ld(&bar[XB_TOPGEN]) == tg, bar);
      __builtin_amdgcn_fence(__ATOMIC_ACQUIRE, "agent");
      xb_add(&bar[XB_XGEN(st.x)], 1u);
      asm volatile("s_waitcnt vmcnt(0)" ::: "memory");
    } else {
      XB_SPIN(xb_ld(&bar[XB_XGEN(st.x)]) == gen, bar);
      __builtin_amdgcn_fence(__ATOMIC_ACQUIRE, "agent");
      asm volatile("s_waitcnt vmcnt(0)" ::: "memory");
    }
  }
  __syncthreads();
}

struct ScanLds {
  float dec[2][16][64], kd[2][16][64], nk[2][16][64], bb[2][16][64], rr[2][16][64];
  float vv[2][16][16];
  float yy[2][16][16];
  float bp[2][4][16];
};

template <int DIR, bool EMIT>
DI void scan_steps(const ScanLds& L, int bsel, int c0, int myrow, int l15, f32x2& Sa, f32x2& Sb, float& ykeep) {
  f32x4 d4[2], k4[2], n4[2], b4[2], r4[2];
  float vv[2];
  auto ld = [&](int slot, int s) {
    d4[slot] = *(const f32x4*)&L.dec[bsel][s][c0];
    k4[slot] = *(const f32x4*)&L.kd[bsel][s][c0];
    n4[slot] = *(const f32x4*)&L.nk[bsel][s][c0];
    b4[slot] = *(const f32x4*)&L.bb[bsel][s][c0];
    if (EMIT) r4[slot] = *(const f32x4*)&L.rr[bsel][s][c0];
    vv[slot] = L.vv[bsel][s][myrow];
  };
  ld(0, DIR ? 15 : 0);
#pragma unroll
  for (int ss = 0; ss < 16; ++ss) {
    const int s = DIR ? 15 - ss : ss;
    const int cur = ss & 1;
    if (ss + 1 < 16) ld(cur ^ 1, DIR ? 14 - ss : ss + 1);
    const f32x2 nlo = {n4[cur][0], n4[cur][1]}, nhi = {n4[cur][2], n4[cur][3]};
    const f32x2 dlo = {d4[cur][0], d4[cur][1]}, dhi = {d4[cur][2], d4[cur][3]};
    const f32x2 klo = {k4[cur][0], k4[cur][1]}, khi = {k4[cur][2], k4[cur][3]};
    const f32x2 blo = {b4[cur][0], b4[cur][1]}, bhi = {b4[cur][2], b4[cur][3]};
    f32x2 t = Sa * nlo + Sb * nhi;
    float sa = dpp_sum16(t[0] + t[1]);
    const f32x2 sa2 = {sa, sa}, v2 = {vv[cur], vv[cur]};
    Sa = Sa * dlo + (sa2 * blo + v2 * klo);
    Sb = Sb * dhi + (sa2 * bhi + v2 * khi);
    if (EMIT) {
      const f32x2 rlo = {r4[cur][0], r4[cur][1]}, rhi = {r4[cur][2], r4[cur][3]};
      const f32x2 u = Sa * rlo + Sb * rhi;
      const float y = dpp_sum16(u[0] + u[1]);
      ykeep = (l15 == s) ? y : ykeep;
    }
  }
}

template <int DIR>
DI void scan_item(const Params& p, ScanLds& L, int b, int h, int q) {
  constexpr int dir = DIR;
  const int tid = threadIdx.x, lane = tid & 63, wave = tid >> 6;
  const int l15 = lane & 15, l4 = lane >> 4;
  const int colw = h * 64 + wave * 16 + l15;
  const int chd = wave * 16 + l15;
  bf16x8 w2f[2], a2f[2];
#pragma unroll
  for (int ks = 0; ks < 2; ++ks) {
    w2f[ks] = *(const bf16x8*)(p.w2_t + ((size_t)(dir * 1024 + colw) * 64 + ks * 32 + l4 * 8));
    a2f[ks] = *(const bf16x8*)(p.a2_t + ((size_t)(dir * 1024 + colw) * 64 + ks * 32 + l4 * 8));
  }
  const float w0c = p.dw0[dir * 1024 + colw], a0c = p.a0[dir * 1024 + colw], kac = p.k_a[colw], rkc = p.r_k[colw];
  f32x2 Sa = {0.f, 0.f}, Sb = {0.f, 0.f};
  const int myrow = wave * 4 + l4;
  const int c0 = l15 * 4;
  bf16x8 lwf[2], laf[2];
  f16 kv[4], kkv[4], rv[4];
  f16 vvr;
  auto chunk_rowbase = [&](int c, bool& isctx) -> int {
    if (c < 16) { isctx = true; const int cc = dir ? 15 - c : c; return TL + b * 256 + cc * 16; }
    isctx = false; const int cc = dir ? 511 - (c - 16) : (c - 16); return b * 8192 + cc * 16;
  };
  auto stage_load = [&](int c) {
    bool isctx; const int rb = chunk_rowbase(c, isctx);
#pragma unroll
    for (int ks = 0; ks < 2; ++ks) {
      lwf[ks] = *(const bf16x8*)(p.LW + ((size_t)(rb + l15) * 128 + dir * 64 + ks * 32 + l4 * 8));
      laf[ks] = *(const bf16x8*)(p.LA + ((size_t)(rb + l15) * 128 + dir * 64 + ks * 32 + l4 * 8));
    }
#pragma unroll
    for (int i = 0; i < 4; ++i) {
      const size_t off = (size_t)(rb + l4 * 4 + i) * DM + colw;
      kv[i] = p.K16[off]; kkv[i] = p.KK16[off];
      rv[i] = isctx ? (f16)0.f : p.R16[off];
    }
    vvr = p.V16[(size_t)(rb + (tid >> 4)) * DM + h * 64 + q * 16 + (tid & 15)];
  };
  auto stage_compute = [&](int c) {
    const int bsel = c & 1;
    f32x4 wacc = {0.f, 0.f, 0.f, 0.f}, aacc = {0.f, 0.f, 0.f, 0.f};
    wacc = __builtin_amdgcn_mfma_f32_16x16x32_bf16(lwf[0], w2f[0], wacc, 0, 0, 0);
    wacc = __builtin_amdgcn_mfma_f32_16x16x32_bf16(lwf[1], w2f[1], wacc, 0, 0, 0);
    aacc = __builtin_amdgcn_mfma_f32_16x16x32_bf16(laf[0], a2f[0], aacc, 0, 0, 0);
    aacc = __builtin_amdgcn_mfma_f32_16x16x32_bf16(laf[1], a2f[1], aacc, 0, 0, 0);
    float bpart[4];
#pragma unroll
    for (int i = 0; i < 4; ++i) {
      const int s = l4 * 4 + i;
      const float sg = sigmoid_fast(w0c + wacc[i]);
      const float dec = __expf(-0.6065306597126334f * sg);
      const float a = sigmoid_fast(a0c + aacc[i]);
      const float k = (float)kv[i], kk = (float)kkv[i], r = (float)rv[i];
      const float kd = k * (1.f + (a - 1.f) * kac);
      L.dec[bsel][s][chd] = dec;
      L.kd[bsel][s][chd] = kd;
      L.nk[bsel][s][chd] = -kk;
      L.bb[bsel][s][chd] = kk * a;
      L.rr[bsel][s][chd] = r;
      if (q == 0) bpart[i] = dpp_sum16(r * kd * rkc);
    }
    if (q == 0 && l15 == 0) {
#pragma unroll
      for (int i = 0; i < 4; ++i) L.bp[bsel][wave][l4 * 4 + i] = bpart[i];
    }
    L.vv[bsel][tid >> 4][tid & 15] = (float)vvr;
  };
  auto write_bonus = [&](int c) {
    if (q == 0 && tid < 16) {
      bool isctx; const int rb = chunk_rowbase(c, isctx);
      const int b2 = c & 1;
      p.bonus[((size_t)dir * MR + rb + tid) * 16 + h] = L.bp[b2][0][tid] + L.bp[b2][1][tid] + L.bp[b2][2][tid] + L.bp[b2][3][tid];
    }
  };
  __syncthreads();
  stage_load(0);
  stage_compute(0);
  __syncthreads();
  write_bonus(0);
  const int NCH = 528;
  float ykeep = 0.f;
#pragma unroll 1
  for (int c = 0; c < 16; ++c) {
    stage_load(c + 1);
    scan_steps<DIR, false>(L, c & 1, c0, myrow, l15, Sa, Sb, ykeep);
    stage_compute(c + 1);
    __syncthreads();
    write_bonus(c + 1);
  }
#pragma unroll 1
  for (int c = 16; c < NCH; ++c) {
    const int bsel = c & 1;
    if (c + 1 < NCH) stage_load(c + 1);
    scan_steps<DIR, true>(L, bsel, c0, myrow, l15, Sa, Sb, ykeep);
    L.yy[bsel][l15][myrow] = ykeep;
    if (c + 1 < NCH) stage_compute(c + 1);
    __syncthreads();
    {
      bool isctx; const int rb = chunk_rowbase(c, isctx);
      f16* Y = dir ? p.Y1 : p.Y0;
      Y[(size_t)(rb + (tid >> 4)) * DM + h * 64 + q * 16 + (tid & 15)] = (f16)(L.yy[bsel][tid >> 4][tid & 15] * 0.0625f);
    }
    if (c + 1 < NCH) write_bonus(c + 1);
  }
}

struct ScanLds2 {
  float dec[2][16][64], kd[2][16][64], nk[2][16][64], bb[2][16][64], rr[2][16][64];
  float vv[2][16][32];
  float yy[2][16][32];
  float bp[2][4][16];
};
DI float dpp_sum8(float v) {
  v += dpp_mov<0xB1>(v);
  v += dpp_mov<0x4E>(v);
  v += dpp_mov<0x141>(v);
  return v;
}
template <int DIR, bool EMIT>
DI void scan_steps2(const ScanLds2& L, int bsel, int c0, int myrow, int l7, f32x2 (&S)[4], float& ykA, float& ykB) {
  f32x4 d4[2][2], k4[2][2], n4[2][2], b4[2][2], r4[2][2];
  float vv[2];
  auto ld = [&](int slot, int s) {
#pragma unroll
    for (int hf = 0; hf < 2; ++hf) {
      d4[slot][hf] = *(const f32x4*)&L.dec[bsel][s][c0 + 4 * hf];
      k4[slot][hf] = *(const f32x4*)&L.kd[bsel][s][c0 + 4 * hf];
      n4[slot][hf] = *(const f32x4*)&L.nk[bsel][s][c0 + 4 * hf];
      b4[slot][hf] = *(const f32x4*)&L.bb[bsel][s][c0 + 4 * hf];
      if (EMIT) r4[slot][hf] = *(const f32x4*)&L.rr[bsel][s][c0 + 4 * hf];
    }
    vv[slot] = L.vv[bsel][s][myrow];
  };
  ld(0, DIR ? 15 : 0);
#pragma unroll
  for (int ss = 0; ss < 16; ++ss) {
    const int s = DIR ? 15 - ss : ss;
    const int cur = ss & 1;
    if (ss + 1 < 16) ld(cur ^ 1, DIR ? 14 - ss : ss + 1);
    f32x2 t = {0.f, 0.f};
#pragma unroll
    for (int i = 0; i < 4; ++i) { const f32x2 nn = {n4[cur][i >> 1][(i & 1) * 2], n4[cur][i >> 1][(i & 1) * 2 + 1]}; t += S[i] * nn; }
    const float sa = dpp_sum8(t[0] + t[1]);
    const f32x2 sa2 = {sa, sa}, v2 = {vv[cur], vv[cur]};
#pragma unroll
    for (int i = 0; i < 4; ++i) {
      const f32x2 dd = {d4[cur][i >> 1][(i & 1) * 2], d4[cur][i >> 1][(i & 1) * 2 + 1]};
      const f32x2 kk = {k4[cur][i >> 1][(i & 1) * 2], k4[cur][i >> 1][(i & 1) * 2 + 1]};
      const f32x2 bb = {b4[cur][i >> 1][(i & 1) * 2], b4[cur][i >> 1][(i & 1) * 2 + 1]};
      S[i] = S[i] * dd + (sa2 * bb + v2 * kk);
    }
    if (EMIT) {
      f32x2 u = {0.f, 0.f};
#pragma unroll
      for (int i = 0; i < 4; ++i) { const f32x2 rr = {r4[cur][i >> 1][(i & 1) * 2], r4[cur][i >> 1][(i & 1) * 2 + 1]}; u += S[i] * rr; }
      const float y = dpp_sum8(u[0] + u[1]);
      if (s < 8) ykA = (l7 == s) ? y : ykA; else ykB = (l7 == s - 8) ? y : ykB;
    }
  }
}
template <int DIR>
DI void scan_item2(const Params& p, ScanLds2& L, int b, int h, int hf) {
  constexpr int dir = DIR;
  const int tid = threadIdx.x, lane = tid & 63, wave = tid >> 6;
  const int l15 = lane & 15, l4 = lane >> 4;
  const int colw = h * 64 + wave * 16 + l15;
  const int chd = wave * 16 + l15;
  bf16x8 w2f[2], a2f[2];
#pragma unroll
  for (int ks = 0; ks < 2; ++ks) {
    w2f[ks] = *(const bf16x8*)(p.w2_t + ((size_t)(dir * 1024 + colw) * 64 + ks * 32 + l4 * 8));
    a2f[ks] = *(const bf16x8*)(p.a2_t + ((size_t)(dir * 1024 + colw) * 64 + ks * 32 + l4 * 8));
  }
  const float w0c = p.dw0[dir * 1024 + colw], a0c = p.a0[dir * 1024 + colw], kac = p.k_a[colw], rkc = p.r_k[colw];
  f32x2 S[4];
#pragma unroll
  for (int i = 0; i < 4; ++i) { S[i][0] = 0.f; S[i][1] = 0.f; }
  const int l7 = lane & 7;
  const int myrow = wave * 8 + (lane >> 3);
  const int c0 = l7 * 8;
  bf16x8 lwf[2], laf[2];
  f16 kv[4], kkv[4], rv[4];
  f16 vvr[2];
  auto chunk_rowbase = [&](int c, bool& isctx) -> int {
    if (c < 16) { isctx = true; const int cc = dir ? 15 - c : c; return TL + b * 256 + cc * 16; }
    isctx = false; const int cc = dir ? 511 - (c - 16) : (c - 16); return b * 8192 + cc * 16;
  };
  auto stage_load = [&](int c) {
    bool isctx; const int rb = chunk_rowbase(c, isctx);
#pragma unroll
    for (int ks = 0; ks < 2; ++ks) {
      lwf[ks] = *(const bf16x8*)(p.LW + ((size_t)(rb + l15) * 128 + dir * 64 + ks * 32 + l4 * 8));
      laf[ks] = *(const bf16x8*)(p.LA + ((size_t)(rb + l15) * 128 + dir * 64 + ks * 32 + l4 * 8));
    }
#pragma unroll
    for (int i = 0; i < 4; ++i) {
      const size_t off = (size_t)(rb + l4 * 4 + i) * DM + colw;
      kv[i] = p.K16[off]; kkv[i] = p.KK16[off];
      rv[i] = isctx ? (f16)0.f : p.R16[off];
    }
#pragma unroll
    for (int j = 0; j < 2; ++j) { const int e = tid + 256 * j; vvr[j] = p.V16[(size_t)(rb + (e >> 5)) * DM + h * 64 + hf * 32 + (e & 31)]; }
  };
  auto stage_compute = [&](int c) {
    const int bsel = c & 1;
    f32x4 wacc = {0.f, 0.f, 0.f, 0.f}, aacc = {0.f, 0.f, 0.f, 0.f};
    wacc = __builtin_amdgcn_mfma_f32_16x16x32_bf16(lwf[0], w2f[0], wacc, 0, 0, 0);
    wacc = __builtin_amdgcn_mfma_f32_16x16x32_bf16(lwf[1], w2f[1], wacc, 0, 0, 0);
    aacc = __builtin_amdgcn_mfma_f32_16x16x32_bf16(laf[0], a2f[0], aacc, 0, 0, 0);
    aacc = __builtin_amdgcn_mfma_f32_16x16x32_bf16(laf[1], a2f[1], aacc, 0, 0, 0);
    float bpart[4];
#pragma unroll
    for (int i = 0; i < 4; ++i) {
      const int s = l4 * 4 + i;
      const float sg = sigmoid_fast(w0c + wacc[i]);
      const float dec = __expf(-0.6065306597126334f * sg);
      const float a = sigmoid_fast(a0c + aacc[i]);
      const float k = (float)kv[i], kk = (float)kkv[i], r = (float)rv[i];
      const float kd = k * (1.f + (a - 1.f) * kac);
      L.dec[bsel][s][chd] = dec;
      L.kd[bsel][s][chd] = kd;
      L.nk[bsel][s][chd] = -kk;
      L.bb[bsel][s][chd] = kk * a;
      L.rr[bsel][s][chd] = r;
      if (hf == 0) bpart[i] = dpp_sum16(r * kd * rkc);
    }
    if (hf == 0 && l15 == 0) {
#pragma unroll
      for (int i = 0; i < 4; ++i) L.bp[bsel][wave][l4 * 4 + i] = bpart[i];
    }
#pragma unroll
    for (int j = 0; j < 2; ++j) { const int e = tid + 256 * j; L.vv[bsel][e >> 5][e & 31] = (float)vvr[j]; }
  };
  auto write_bonus = [&](int c) {
    if (hf == 0 && tid < 16) {
      bool isctx; const int rb = chunk_rowbase(c, isctx);
      const int b2 = c & 1;
      p.bonus[((size_t)dir * MR + rb + tid) * 16 + h] = L.bp[b2][0][tid] + L.bp[b2][1][tid] + L.bp[b2][2][tid] + L.bp[b2][3][tid];
    }
  };
  __syncthreads();
  stage_load(0);
  stage_compute(0);
  __syncthreads();
  write_bonus(0);
  const int NCH = 528;
  float ykA = 0.f, ykB = 0.f;
#pragma unroll 1
  for (int c = 0; c < 16; ++c) {
    stage_load(c + 1);
    scan_steps2<DIR, false>(L, c & 1, c0, myrow, l7, S, ykA, ykB);
    stage_compute(c + 1);
    __syncthreads();
    write_bonus(c + 1);
  }
#pragma unroll 1
  for (int c = 16; c < NCH; ++c) {
    const int bsel = c & 1;
    if (c + 1 < NCH) stage_load(c + 1);
    scan_steps2<DIR, true>(L, bsel, c0, myrow, l7, S, ykA, ykB);
    L.yy[bsel][l7][myrow] = ykA;
    L.yy[bsel][8 + l7][myrow] = ykB;
    if (c + 1 < NCH) stage_compute(c + 1);
    __syncthreads();
    {
      bool isctx; const int rb = chunk_rowbase(c, isctx);
      f16* Y = dir ? p.Y1 : p.Y0;
#pragma unroll
      for (int j = 0; j < 2; ++j) {
        const int e = tid + 256 * j;
        Y[(size_t)(rb + (e >> 5)) * DM + h * 64 + hf * 32 + (e & 31)] = (f16)(L.yy[bsel][e >> 5][e & 31] * 0.0625f);
      }
    }
    if (c + 1 < NCH) write_bonus(c + 1);
  }
}
DI void phase_scan2(const Params& p, char* smem) {
  ScanLds2& L = *(ScanLds2*)smem;
  const unsigned info = p.blkinfo[blockIdx.x];
  const unsigned rank = info >> 16, ticket = info & 0xffffu;
  const unsigned n0 = xb_ld(&p.bar[XB_N0]);
  const unsigned item = rank == 0u ? ticket : n0 + ticket;
  if (item < 256u) {
    const int sc = item >> 1, hf = item & 1;
    const int dir = sc & 1, bh = sc >> 1, b = bh >> 4, h = bh & 15;
    if (dir) scan_item2<1>(p, L, b, h, hf); else scan_item2<0>(p, L, b, h, hf);
  }
}

DI void phase_scan(const Params& p, char* smem) {
  ScanLds& L = *(ScanLds*)smem;
  for (int item = blockIdx.x; item < 512; item += gridDim.x) {
    int sc, q;
    if (gridDim.x == 512) { const int xcd = item & 7, slot = item >> 3; sc = xcd * 16 + (slot >> 2); q = slot & 3; }
    else { sc = item >> 2; q = item & 3; }
    const int dir = sc & 1, bh = sc >> 1, b = bh >> 4, h = bh & 15;
    if (dir) scan_item<1>(p, L, b, h, q); else scan_item<0>(p, L, b, h, q);
  }
}

DI void phase_readout(const Params& p, char* smem) {
  float* Cs = (float*)smem;
  const int tid = threadIdx.x;
  int g0, gend, gstep; work_range(256 * 8, g0, gend, gstep);
  for (int tile = g0; tile < gend; tile += gstep) {
    int mt, nt; band_decode(tile, 256, 8, mt, nt);
    const int m0 = mt * 128;
    f32x4 acc[4][4];
    gemm_mainloop(smem, 1, 192,
                  [&](int r, int) { return (const u16*)(p.LG + (size_t)(m0 + r) * 192); },
                  [&](int c) { return (const u16*)(p.g2_t + (size_t)(nt * 128 + c) * 192); }, acc);
    acc_to_lds(Cs, acc);
    const int lane = tid & 63, wave = tid >> 6;
    const int head = nt * 2 + (lane >> 5);
    const int col = nt * 128 + 2 * lane;
    const float gw0 = p.gn_w[col], gw1 = p.gn_w[col + 1], gb0 = p.gn_b[col], gb1 = p.gn_b[col + 1];
#pragma unroll 2
    for (int rr = 0; rr < 32; ++rr) {
      const int r = wave * 32 + rr;
      const int row = m0 + r;
      const unsigned ua = *(const unsigned*)(p.Y0 + (size_t)row * DM + col), ub = *(const unsigned*)(p.Y1 + (size_t)row * DM + col);
      const unsigned uv = *(const unsigned*)(p.V16 + (size_t)row * DM + col);
      const f16* fa = (const f16*)&ua; const f16* fb = (const f16*)&ub; const f16* fv = (const f16*)&uv;
      const float y0 = ((float)fa[0] + (float)fb[0]) * 16.f, y1 = ((float)fa[1] + (float)fb[1]) * 16.f;
      float sm = y0 + y1;
      sm = sum32(sm);
      const float mean = sm * (1.f / 64.f);
      const float d0 = y0 - mean, d1 = y1 - mean;
      float vs = d0 * d0 + d1 * d1;
      vs = sum32(vs);
      const float rstd = rsqrtf(vs * (1.f / 64.f) + 64e-5f);
      const float bon = p.bonus[((size_t)0 * MR + row) * 16 + head] + p.bonus[((size_t)1 * MR + row) * 16 + head];
      const float2 g = *(const float2*)&CS(r, 2 * lane);
      const float z0 = (d0 * rstd * gw0 + gb0 + bon * (float)fv[0]) * g.x;
      const float z1 = (d1 * rstd * gw1 + gb1 + bon * (float)fv[1]) * g.y;
      *(unsigned*)(p.Z + (size_t)row * DM + col) = pack2(z0, z1);
    }
  }
}

DI void phase_final(const Params& p) {
  const int lane = threadIdx.x & 63;
  const int gw = blockIdx.x * 4 + (threadIdx.x >> 6), nw = gridDim.x * 4;
  float4 g[4];
#pragma unroll
  for (int i = 0; i < 4; ++i) g[i] = *(const float4*)(p.final_gain + i * 256 + lane * 4);
  float4 v[4], vn[4];
  int row = gw;
  if (row < TL) {
#pragma unroll
    for (int i = 0; i < 4; ++i) v[i] = *(const float4*)(p.out + (size_t)row * DM + i * 256 + lane * 4);
  }
  for (; row < TL; row += nw) {
    const int nxt = row + nw;
    if (nxt < TL) {
#pragma unroll
      for (int i = 0; i < 4; ++i) vn[i] = *(const float4*)(p.out + (size_t)nxt * DM + i * 256 + lane * 4);
    }
    float* src = p.out + (size_t)row * DM;
    float ss = 0.f;
#pragma unroll
    for (int i = 0; i < 4; ++i) ss += v[i].x * v[i].x + v[i].y * v[i].y + v[i].z * v[i].z + v[i].w * v[i].w;
    ss = wave_sum(ss);
    const float rinv = rsqrtf(ss * (1.f / 1024.f) + 1e-6f);
#pragma unroll
    for (int i = 0; i < 4; ++i) {
      float4 o;
      o.x = v[i].x * rinv * g[i].x; o.y = v[i].y * rinv * g[i].y; o.z = v[i].z * rinv * g[i].z; o.w = v[i].w * rinv * g[i].w;
      *(float4*)(src + i * 256 + lane * 4) = o;
    }
#pragma unroll
    for (int i = 0; i < 4; ++i) v[i] = vn[i];
  }
}

__global__ void __launch_bounds__(256, 2) mega(Params p) {
  __shared__ __attribute__((aligned(16))) char smem[65536];
  cg::grid_group grid = cg::this_grid();
  XbState xst; xst.x = xb_xcc_id(); xst.nloc = 0u; xst.nx = 0u;
  if (threadIdx.x == 0) {
    (void)xb_add(&p.bar[XB_XCNT(xst.x)], 1u);
    const unsigned hwid = (unsigned)__builtin_amdgcn_s_getreg((7 << 11) | (8 << 6) | 4) & 0xffu;
    const unsigned rank = xb_add(&p.bar[XB_CU((xst.x << 8) | hwid)], 1u);
    const unsigned ticket = xb_add(&p.bar[rank == 0u ? XB_N0 : XB_N1], 1u);
    p.blkinfo[blockIdx.x] = ((rank > 0u ? 1u : 0u) << 16) | (ticket & 0xffffu);
  }
  if (gridDim.x == 0x7fffffffu) grid.sync();
  phase_prep(p, smem); grid_barrier(p.bar, xst);
  phase_modreduce(p); grid_barrier(p.bar, xst);
  phase_modulate<true>(p, 0, 0, MR); grid_barrier(p.bar, xst);
  phase_qkv(p, smem); grid_barrier(p.bar, xst);
  phase_attn(p, smem); grid_barrier(p.bar, xst);
  phase_proj_res<true>(p, smem, p.H, 1024, 1024, p.wo_t, 0, 2, 264); grid_barrier(p.bar, xst);
  phase_modulate<false>(p, 0, 1, MR); grid_barrier(p.bar, xst);
  phase_ffn_up(p, smem, 0, true, p.ACT0); grid_barrier(p.bar, xst);
  phase_proj_res<false>(p, smem, p.ACT0, DFF, DFF, p.down_t, 0, 5, 264); grid_barrier(p.bar, xst);
  phase_rwkv_shift(p); grid_barrier(p.bar, xst);
  phase_rwkv_gemms(p, smem); grid_barrier(p.bar, xst);
  phase_scan2(p, smem); grid_barrier(p.bar, xst);
  phase_readout(p, smem); grid_barrier(p.bar, xst);
  phase_proj_res<false>(p, smem, p.Z, 1024, 1024, p.ro_t, 1, 2, 256); grid_barrier(p.bar, xst);
  phase_modulate<false>(p, 1, 1, TL); grid_barrier(p.bar, xst);
  phase_ffn_up(p, smem, 1, false, p.ACT1); grid_barrier(p.bar, xst);
  phase_proj_res<false>(p, smem, p.ACT1, DFF, DFF, p.down_t + (size_t)1024 * 2816, 1, 5, 256); grid_barrier(p.bar, xst);
  phase_final(p);
}

extern "C" void kernel_launch(void* const* d_in, const int* in_sizes, int n_in, void* d_out, int out_size, void* d_ws, size_t ws_size,
                              hipStream_t stream) {
  static int grid_blocks = 0;
  if (!grid_blocks) {
    int dev = 0, cus = 0, per_cu = 0;
    hipGetDevice(&dev);
    hipDeviceGetAttribute(&cus, hipDeviceAttributeMultiprocessorCount, dev);
    hipOccupancyMaxActiveBlocksPerMultiprocessor(&per_cu, mega, 256, 0);
    if (per_cu > 2) per_cu = 2;
    if (per_cu < 1) per_cu = 1;
    grid_blocks = cus * per_cu;
  }
  Params p{};
  const float* const* in = (const float* const*)d_in;
  p.x = in[0]; p.c = in[1]; p.ctx = in[2]; p.c_ctx = in[3]; p.ada_w = in[4]; p.ada_b = in[5]; p.w_qkv = in[6]; p.q_gain = in[7];
  p.k_gain = in[8]; p.w_o = in[9]; p.mu = in[10]; p.rw_r = in[11]; p.rw_k = in[12]; p.rw_v = in[13]; p.rw_o = in[14]; p.dw0 = in[15];
  p.dw1 = in[16]; p.dw2 = in[17]; p.a0 = in[18]; p.a1 = in[19]; p.a2 = in[20]; p.g1 = in[21]; p.g2 = in[22]; p.k_k = in[23];
  p.k_a = in[24]; p.r_k = in[25]; p.gn_w = in[26]; p.gn_b = in[27]; p.f_up = in[28]; p.f_cw = in[29]; p.f_cb = in[30];
  p.f_down = in[31]; p.final_gain = in[32];
  p.out = (float*)d_out;
  char* w = (char*)d_ws;
  size_t off = 0;
  auto take = [&](size_t bytes) { char* r = w + off; off += (bytes + 255) & ~(size_t)255; return r; };
  p.qkv_t = (u16*)take((size_t)1536 * 1024 * 2);
  p.wo_t = (u16*)take((size_t)1024 * 1024 * 2);
  p.up_t = (u16*)take((size_t)2 * 5632 * 1024 * 2);
  p.down_t = (u16*)take((size_t)2 * 1024 * 2816 * 2);
  p.rr_t = (u16*)take((size_t)1024 * 2048 * 2);
  p.rk_t = (u16*)take((size_t)1024 * 2048 * 2);
  p.rv_t = (u16*)take((size_t)1024 * 2048 * 2);
  p.ro_t = (u16*)take((size_t)1024 * 1024 * 2);
  p.w1_t = (u16*)take((size_t)128 * 2048 * 2);
  p.a1_t = (u16*)take((size_t)128 * 2048 * 2);
  p.g1_t = (u16*)take((size_t)256 * 2048 * 2);
  p.w2_t = (u16*)take((size_t)2 * 1024 * 64 * 2);
  p.a2_t = (u16*)take((size_t)2 * 1024 * 64 * 2);
  p.g2_t = (u16*)take((size_t)1024 * 192 * 2);
  p.modpart = (float*)take((size_t)2 * 8 * 5 * 6144 * 4);
  p.modv = (float*)take((size_t)2 * 5 * 6144 * 4);
  p.rope = (float*)take((size_t)8192 * 32 * 2 * 4);
  p.XC = (float*)take((size_t)TCX * DM * 4);
  p.bonus = (float*)take((size_t)2 * MR * 16 * 4);
  p.zero = (u16*)take(8192);
  p.bar = (unsigned*)take(65536);
  p.blkinfo = (unsigned*)take(4096 * 4);
  const size_t pb = off;
  p.H = (u16*)take((size_t)MR * DM * 2);
  const size_t after_h = off;
  p.Q = (u16*)take((size_t)TL * DM * 2);
  p.QC = (u16*)take((size_t)TCX * DM * 2);
  p.Kb = (u16*)take((size_t)16 * NKEY * 64 * 2);
  p.Vt = (u16*)take((size_t)16 * NKEY * 64 * 2);
  p.ACT0 = (u16*)take((size_t)MR * DFF * 2);
  const size_t end0 = off;
  off = after_h;
  p.XX = (u16*)take((size_t)MR * DM * 2);
  p.R16 = (f16*)take((size_t)TL * DM * 2);
  p.K16 = (f16*)take((size_t)MR * DM * 2);
  p.V16 = (f16*)take((size_t)MR * DM * 2);
  p.KK16 = (f16*)take((size_t)MR * DM * 2);
  p.LW = (u16*)take((size_t)MR * 128 * 2);
  p.LA = (u16*)take((size_t)MR * 128 * 2);
  p.LG = (u16*)take((size_t)TL * 192 * 2);
  const size_t end1 = off;
  p.Y0 = (f16*)p.H;
  p.Y1 = (f16*)p.XX;
  p.Z = (u16*)p.R16;
  p.ACT1 = (u16*)p.K16;
  (void)pb;
  const size_t need = end0 > end1 ? end0 : end1;
  if (need > ws_size) { fprintf(stderr, "workspace too small: need %zu have %zu\n", need, ws_size); return; }
  hipMemsetAsync(p.bar, 0, 65536, stream);
  void* args[] = {&p};
  hipError_t e = hipLaunchCooperativeKernel((void*)mega, dim3(grid_blocks), dim3(256), args, 0, stream);
  if (e != hipSuccess) fprintf(stderr, "cooperative launch failed: %s (grid %d)\n", hipGetErrorString(e), grid_blocks);
}
```

```cpp
#include <hip/hip_runtime.h>
#include <hip/hip_cooperative_groups.h>
#include <cstdio>
#include <cstdint>
namespace cg = cooperative_groups;

typedef unsigned short u16;
typedef _Float16 f16;
using bf16x8 = __attribute__((ext_vector_type(8))) short;
using f32x16 = __attribute__((ext_vector_type(16))) float;
using f32x4 = __attribute__((ext_vector_type(4))) float;
using u32x4 = __attribute__((ext_vector_type(4))) unsigned;
#define DI __device__ __forceinline__
DI u32x4 mk4(unsigned a, unsigned b, unsigned c, unsigned d) { u32x4 r; r[0] = a; r[1] = b; r[2] = c; r[3] = d; return r; }

constexpr int TL = 32768;
constexpr int TCX = 1024;
constexpr int MR = 33792;
constexpr int DM = 1024;
constexpr int DFF = 2816;
constexpr int NKEY = 8448;
constexpr int NPHASE = 18;
#define XB_CU(j)    (4096 + (j))
#define XB_N0       8192
#define XB_N1       8256

struct Params {
  const float *x, *c, *ctx, *c_ctx, *ada_w, *ada_b, *w_qkv, *q_gain, *k_gain, *w_o;
  const float *mu, *rw_r, *rw_k, *rw_v, *rw_o, *dw0, *dw1, *dw2, *a0, *a1, *a2, *g1, *g2, *k_k, *k_a, *r_k, *gn_w, *gn_b;
  const float *f_up, *f_cw, *f_cb, *f_down, *final_gain;
  float* out;
  u16 *qkv_t, *wo_t, *up_t, *down_t, *rr_t, *rk_t, *rv_t, *ro_t, *w1_t, *a1_t, *g1_t, *w2_t, *a2_t, *g2_t;
  float *modpart, *modv, *rope, *XC, *bonus;
  u16* zero;
  unsigned* bar;
  unsigned* blkinfo;
  u16 *H, *XX, *Q, *QC, *Kb, *Vt, *ACT0, *ACT1;
  f16 *R16, *K16, *V16, *KK16, *Y0, *Y1;
  u16 *LW, *LA, *LG, *Z;
  int phase_lo, phase_hi;
};

typedef __bf16 bf16x2_t __attribute__((ext_vector_type(2)));
typedef float f32x2 __attribute__((ext_vector_type(2)));
DI unsigned pack2(float a, float b) { f32x2 f = {a, b}; return __builtin_bit_cast(unsigned, __builtin_convertvector(f, bf16x2_t)); }
DI u16 f2bf(float x) { return (u16)(pack2(x, 0.f) & 0xffffu); }
DI float bf2f(u16 h) { return __uint_as_float(((unsigned)h) << 16); }
DI float wave_sum(float v) {
#pragma unroll
  for (int o = 32; o > 0; o >>= 1) v += __shfl_xor(v, o, 64);
  return v;
}
template <int CTRL> DI float dpp_mov(float v) { return __builtin_bit_cast(float, __builtin_amdgcn_update_dpp(0, __builtin_bit_cast(int, v), CTRL, 0xF, 0xF, true)); }
DI float dpp_sum16(float v) {
  v += dpp_mov<0x128>(v);
  v += dpp_mov<0x124>(v);
  v += dpp_mov<0x122>(v);
  v += dpp_mov<0x121>(v);
  return v;
}
DI float sum32(float v) { v = dpp_sum16(v); v += __shfl_xor(v, 16, 64); return v; }
DI float sigmoidf_(float x) { return 1.f / (1.f + __expf(-x)); }
DI float sigmoid_fast(float x) { return __builtin_amdgcn_rcpf(1.f + __expf(-x)); }
DI int midx_of(int row) { return row < TL ? (row >> 13) : 4; }
DI float* resid_ptr(const Params& p, int row) { return row < TL ? p.out + (size_t)row * DM : p.XC + (size_t)(row - TL) * DM; }
DI const float* xin_ptr(const Params& p, int row) { return row < TL ? p.x + (size_t)row * DM : p.ctx + (size_t)(row - TL) * DM; }

DI void work_range(int total, int& g0, int& gend, int& step) {
  if ((gridDim.x & 7) == 0) {
    const int x = blockIdx.x & 7, li = blockIdx.x >> 3, nl = gridDim.x >> 3;
    const int lo = (int)(((long long)total * x) >> 3), hi = (int)(((long long)total * (x + 1)) >> 3);
    g0 = lo + li; gend = hi; step = nl;
  } else { g0 = blockIdx.x; gend = total; step = gridDim.x; }
}
DI void band_decode(int g, int MT, int NT, int& mt, int& nt) {
  const int per = 8 * NT;
  const int band = g / per, r = g - band * per;
  int hb = MT - band * 8; if (hb > 8) hb = 8;
  nt = r / hb; mt = band * 8 + (r - nt * hb);
}

using GAcc = f32x4[4][4];
template <class AF, class BF>
DI void gemm_mainloop(char* smem, int nparts, int kpart, AF arow, BF brow, f32x4 (&acc)[4][4]) {
  const int tid = threadIdx.x, lane = tid & 63, wave = tid >> 6;
  const int wm = wave >> 1, wn = wave & 1;
  const int lr = tid >> 3, lc = tid & 7;
#pragma unroll
  for (int i = 0; i < 4; ++i)
#pragma unroll
    for (int j = 0; j < 4; ++j)
#pragma unroll
      for (int e = 0; e < 4; ++e) acc[i][j][e] = 0.f;
  const int csrc = (lc ^ ((lr >> 1) & 7)) * 8;
  const u16* bp[4];
  const u16* ap[4];
#pragma unroll
  for (int q = 0; q < 4; ++q) { bp[q] = brow(lr + 32 * q) + csrc; ap[q] = arow(lr + 32 * q, 0) + csrc; }
  const int nk = kpart >> 6;
  const int total = nparts * nk;
  const int sw = (lane >> 1) & 7;
  const int kq = lane >> 4;
  char* const wbase = smem + wave * 1024;
  auto stage = [&](int buf, int kk, int boff) {
#pragma unroll
    for (int q = 0; q < 4; ++q) {
      __builtin_amdgcn_global_load_lds((const unsigned*)(ap[q] + kk), (unsigned*)(wbase + buf * 32768 + q * 4096), 16, 0, 0);
      __builtin_amdgcn_global_load_lds((const unsigned*)(bp[q] + boff), (unsigned*)(wbase + buf * 32768 + 16384 + q * 4096), 16, 0, 0);
    }
  };
  __syncthreads();
  stage(0, 0, 0);
  asm volatile("s_waitcnt vmcnt(0)" ::: "memory");
  __syncthreads();
  int part = 0, kk = 0, buf = 0;
#pragma unroll 1
  for (int it = 0; it < total; ++it) {
    kk += 64;
    if (kk == kpart) {
      kk = 0; ++part;
      if (part < nparts) {
#pragma unroll
        for (int q = 0; q < 4; ++q) ap[q] = arow(lr + 32 * q, part) + csrc;
      }
    }
    if (it + 1 < total) stage(buf ^ 1, kk, part * kpart + kk);
    const u16* As = (const u16*)(smem + buf * 32768);
    const u16* Bs = As + 128 * 64;
    const u16* Ar = As + (wm * 64 + (lane & 15)) * 64;
    const u16* Br = Bs + (wn * 64 + (lane & 15)) * 64;
    bf16x8 af[2][4], bf[2][4];
    {
      const int pc = (kq ^ sw) * 8;
#pragma unroll
      for (int i = 0; i < 4; ++i) { af[0][i] = *(const bf16x8*)(Ar + i * 1024 + pc); bf[0][i] = *(const bf16x8*)(Br + i * 1024 + pc); }
    }
#pragma unroll
    for (int ks = 0; ks < 2; ++ks) {
      const int cur = ks & 1;
      if (ks + 1 < 2) {
        const int pc = ((4 + kq) ^ sw) * 8;
#pragma unroll
        for (int i = 0; i < 4; ++i) { af[1][i] = *(const bf16x8*)(Ar + i * 1024 + pc); bf[1][i] = *(const bf16x8*)(Br + i * 1024 + pc); }
      }
#pragma unroll
      for (int i = 0; i < 4; ++i)
#pragma unroll
        for (int j = 0; j < 4; ++j) acc[i][j] = __builtin_amdgcn_mfma_f32_16x16x32_bf16(af[cur][i], bf[cur][j], acc[i][j], 0, 0, 0);
      __builtin_amdgcn_sched_barrier(0);
    }
    asm volatile("s_waitcnt vmcnt(0)" ::: "memory");
    __syncthreads();
    buf ^= 1;
  }
}

template <class F>
DI void epi_direct(const f32x4 (&acc)[4][4], F f) {
  const int lane = threadIdx.x & 63, wave = threadIdx.x >> 6;
  const int wm = wave >> 1, wn = wave & 1, g = lane >> 4;
#pragma unroll
  for (int i = 0; i < 4; ++i)
#pragma unroll
    for (int j = 0; j < 4; ++j)
#pragma unroll
      for (int e = 0; e < 4; ++e) {
        const int row = wm * 64 + i * 16 + g * 4 + e;
        const int col = wn * 64 + j * 16 + (lane & 15);
        f(row, col, acc[i][j][e]);
      }
}
#define CS(r, c) Cs[(r) * 128 + (c)]
DI void acc_to_lds(float* Cs, const f32x4 (&acc)[4][4]) {
  __syncthreads();
  epi_direct(acc, [&](int r, int c, float v) { CS(r, c) = v; });
  __syncthreads();
}

struct TJob { const float* src; int srcK, srcN; u16* dst; int ld, koff; const float* mu; int Kpad, Npad; };
DI TJob get_job(const Params& p, int j) {
  TJob t; t.mu = nullptr; t.koff = 0;
  auto set = [&](const float* s, int K, int N, u16* d, int ld) { t.src = s; t.srcK = K; t.srcN = N; t.dst = d; t.ld = ld; t.Kpad = K; t.Npad = N; };
  switch (j) {
    case 4: set(p.w_qkv, 1024, 1536, p.qkv_t, 1024); break;
    case 5: set(p.w_o, 1024, 1024, p.wo_t, 1024); break;
    case 0: set(p.f_up, 1024, 5632, p.up_t, 1024); break;
    case 1: set(p.f_up + (size_t)1024 * 5632, 1024, 5632, p.up_t + (size_t)5632 * 1024, 1024); break;
    case 2: set(p.f_down, 2816, 1024, p.down_t, 2816); break;
    case 3: set(p.f_down + (size_t)2816 * 1024, 2816, 1024, p.down_t + (size_t)1024 * 2816, 2816); break;
    case 6: set(p.rw_r, 1024, 1024, p.rr_t, 2048); break;
    case 7: set(p.rw_r, 1024, 1024, p.rr_t, 2048); t.mu = p.mu + 0 * 1024; t.koff = 1024; break;
    case 8: set(p.rw_k, 1024, 1024, p.rk_t, 2048); break;
    case 9: set(p.rw_k, 1024, 1024, p.rk_t, 2048); t.mu = p.mu + 2 * 1024; t.koff = 1024; break;
    case 10: set(p.rw_v, 1024, 1024, p.rv_t, 2048); break;
    case 11: set(p.rw_v, 1024, 1024, p.rv_t, 2048); t.mu = p.mu + 3 * 1024; t.koff = 1024; break;
    case 12: set(p.rw_o, 1024, 1024, p.ro_t, 1024); break;
    case 13: set(p.dw1, 1024, 64, p.w1_t, 2048); break;
    case 14: set(p.dw1, 1024, 64, p.w1_t, 2048); t.mu = p.mu + 1 * 1024; t.koff = 1024; break;
    case 15: set(p.dw1 + 1024 * 64, 1024, 64, p.w1_t + 64 * 2048, 2048); break;
    case 16: set(p.dw1 + 1024 * 64, 1024, 64, p.w1_t + 64 * 2048, 2048); t.mu = p.mu + 1 * 1024; t.koff = 1024; break;
    case 17: set(p.a1, 1024, 64, p.a1_t, 2048); break;
    case 18: set(p.a1, 1024, 64, p.a1_t, 2048); t.mu = p.mu + 4 * 1024; t.koff = 1024; break;
    case 19: set(p.a1 + 1024 * 64, 1024, 64, p.a1_t + 64 * 2048, 2048); break;
    case 20: set(p.a1 + 1024 * 64, 1024, 64, p.a1_t + 64 * 2048, 2048); t.mu = p.mu + 4 * 1024; t.koff = 1024; break;
    case 21: set(p.g1, 1024, 160, p.g1_t, 2048); t.Npad = 256; break;
    case 22: set(p.g1, 1024, 160, p.g1_t, 2048); t.Npad = 256; t.mu = p.mu + 5 * 1024; t.koff = 1024; break;
    case 23: set(p.dw2, 64, 1024, p.w2_t, 64); break;
    case 24: set(p.dw2 + 64 * 1024, 64, 1024, p.w2_t + 1024 * 64, 64); break;
    case 25: set(p.a2, 64, 1024, p.a2_t, 64); break;
    case 26: set(p.a2 + 64 * 1024, 64, 1024, p.a2_t + 1024 * 64, 64); break;
    default: set(p.g2, 160, 1024, p.g2_t, 192); t.Kpad = 192; break;
  }
  return t;
}
constexpr int NJOBS = 28;
DI int job_tiles(const TJob& t) { return ((t.Kpad + 63) >> 6) * ((t.Npad + 63) >> 6); }

DI void phase_prep(const Params& p, char* smem) {
  const int tid = threadIdx.x;
  const int ttiles = 7024;
  const int n_mod = 2 * 24 * 8;
  const int n_rope = 1024;
  const int total = ttiles + n_mod + n_rope;
  float* tile = (float*)smem;
  if (blockIdx.x == 0) for (int e = tid; e < 4096; e += 256) p.zero[e] = 0;
  {
    auto decode = [&](int item, TJob& t, int& kt, int& nt) {
      int rem = item, j = 0;
      t = get_job(p, 0);
      while (true) { int n = job_tiles(t); if (rem < n) break; rem -= n; ++j; t = get_job(p, j); }
      const int ntn = (t.Npad + 63) >> 6;
      kt = rem / ntn; nt = rem % ntn;
    };
    auto load_tile = [&](const TJob& t, int kt, int nt, float (&v)[16]) {
#pragma unroll
      for (int i = 0; i < 16; ++i) {
        const int kl = i * 4 + (tid >> 6), nl = tid & 63;
        const int k = kt * 64 + kl, n = nt * 64 + nl;
        float x = 0.f;
        if (k < t.srcK && n < t.srcN) { x = t.src[(size_t)k * t.srcN + n]; if (t.mu) x *= t.mu[k]; }
        v[i] = x;
      }
    };
    TJob tc, tn; int ktc = 0, ntc = 0, ktn = 0, ntn_ = 0;
    float vc[16], vn[16];
    int item = blockIdx.x;
    if (item < ttiles) { decode(item, tc, ktc, ntc); load_tile(tc, ktc, ntc, vc); }
    for (; item < ttiles; item += gridDim.x) {
      const int nxt = item + gridDim.x;
      if (nxt < ttiles) { decode(nxt, tn, ktn, ntn_); load_tile(tn, ktn, ntn_, vn); }
      __syncthreads();
#pragma unroll
      for (int i = 0; i < 16; ++i) tile[(i * 4 + (tid >> 6)) * 65 + (tid & 63)] = vc[i];
      __syncthreads();
#pragma unroll
      for (int i = 0; i < 16; ++i) {
        const int nl = i * 4 + (tid >> 6), kl = tid & 63;
        const int k = ktc * 64 + kl, n = ntc * 64 + nl;
        if (k < tc.Kpad && n < tc.Npad) tc.dst[(size_t)n * tc.ld + tc.koff + k] = f2bf(tile[kl * 65 + nl]);
      }
      if (nxt < ttiles) {
        tc = tn; ktc = ktn; ntc = ntn_;
#pragma unroll
        for (int i = 0; i < 16; ++i) vc[i] = vn[i];
      }
    }
  }
  int first_other = ttiles + (int)blockIdx.x;
  for (int item = first_other; item < total; item += gridDim.x) {
    if (false) {
    } else if (item < ttiles + n_mod) {
      const int it = item - ttiles;
      const int layer = it / 192, cc = (it % 192) / 8, kc = it % 8;
      float* sil = (float*)smem;
      __syncthreads();
      for (int e = tid; e < 640; e += 256) {
        const int j = e >> 7, k = kc * 128 + (e & 127);
        const float v = j < 4 ? p.c[j * 1024 + k] : p.c_ctx[k];
        sil[e] = v / (1.f + __expf(-v));
      }
      __syncthreads();
      const int col = cc * 256 + tid;
      float a0 = 0, a1 = 0, a2 = 0, a3 = 0, a4 = 0;
      const float* w = p.ada_w + ((size_t)layer * 1024 + kc * 128) * 6144 + col;
#pragma unroll 16
      for (int k = 0; k < 128; ++k) {
        const float wv = w[(size_t)k * 6144];
        a0 += sil[k] * wv; a1 += sil[128 + k] * wv; a2 += sil[256 + k] * wv; a3 += sil[384 + k] * wv; a4 += sil[512 + k] * wv;
      }
      float* mp = p.modpart + ((size_t)(layer * 8 + kc) * 5) * 6144 + col;
      mp[0] = a0; mp[6144] = a1; mp[2 * 6144] = a2; mp[3 * 6144] = a3; mp[4 * 6144] = a4;
    } else {
      const int e = (item - ttiles - n_mod) * 256 + tid;
      const int s = e >> 5, pr = e & 31;
      const int f = pr & 15;
      const float inv_freq = powf(10000.f, -(float)f / 16.f);
      const float pos = (pr < 16) ? (float)(s >> 6) : (float)(s & 63);
      const float ang = pos * inv_freq;
      float sn, cs;
      sincosf(ang, &sn, &cs);
      p.rope[e * 2] = cs; p.rope[e * 2 + 1] = sn;
    }
  }
}

DI void phase_modreduce(const Params& p) {
  const int n = 2 * 5 * 6144;
  for (int e = blockIdx.x * 256 + threadIdx.x; e < n; e += gridDim.x * 256) {
    const int layer = e / (5 * 6144), r = e % (5 * 6144), col = r % 6144;
    float s = p.ada_b[layer * 6144 + col];
    for (int kc = 0; kc < 8; ++kc) s += p.modpart[(size_t)(layer * 8 + kc) * 5 * 6144 + r];
    p.modv[e] = s;
  }
}

template <bool FROM_INPUT>
DI void phase_modulate(const Params& p, int layer, int which, int nrows) {
  const int lane = threadIdx.x & 63;
  const int gw = blockIdx.x * 4 + (threadIdx.x >> 6), nw = gridDim.x * 4;
  auto load_row = [&](int row, float4 (&v)[4]) {
    const float* src = FROM_INPUT ? xin_ptr(p, row) : resid_ptr(p, row);
#pragma unroll
    for (int i = 0; i < 4; ++i) v[i] = *(const float4*)(src + i * 256 + lane * 4);
  };
  float4 v[4], vn[4];
  int row = gw;
  if (row < nrows) load_row(row, v);
  for (; row < nrows; row += nw) {
    const int nxt = row + nw;
    if (nxt < nrows) load_row(nxt, vn);
    const float* mv = p.modv + ((size_t)layer * 5 + midx_of(row)) * 6144 + which * 3072;
    float ss = 0.f;
#pragma unroll
    for (int i = 0; i < 4; ++i) ss += v[i].x * v[i].x + v[i].y * v[i].y + v[i].z * v[i].z + v[i].w * v[i].w;
    ss = wave_sum(ss);
    const float rinv = rsqrtf(ss * (1.f / 1024.f) + 1e-6f);
#pragma unroll
    for (int i = 0; i < 4; ++i) {
      const int col = i * 256 + lane * 4;
      const float4 sh = *(const float4*)(mv + col);
      const float4 sc = *(const float4*)(mv + 1024 + col);
      uint2 o;
      o.x = pack2(v[i].x * rinv * (1.f + sc.x) + sh.x, v[i].y * rinv * (1.f + sc.y) + sh.y);
      o.y = pack2(v[i].z * rinv * (1.f + sc.z) + sh.z, v[i].w * rinv * (1.f + sc.w) + sh.w);
      *(uint2*)(p.H + (size_t)row * DM + col) = o;
    }
#pragma unroll
    for (int i = 0; i < 4; ++i) v[i] = vn[i];
  }
}

DI void shift_load(const Params& p, int row, bool valid, int lane, f32x4 (&raw)[4]) {
  if (valid) {
    const float* src = resid_ptr(p, row);
#pragma unroll
    for (int i = 0; i < 4; ++i) raw[i] = *(const f32x4*)(src + i * 256 + lane * 4);
  }
}
DI void shift_finish(const Params& p, int row, bool valid, int lane, const f32x4 (&raw)[4], float (&h)[16]) {
  if (!valid) {
#pragma unroll
    for (int i = 0; i < 16; ++i) h[i] = 0.f;
    return;
  }
  const float* mv = p.modv + ((size_t)1 * 5 + midx_of(row)) * 6144;
  float ss = 0.f;
#pragma unroll
  for (int i = 0; i < 4; ++i) ss += raw[i][0] * raw[i][0] + raw[i][1] * raw[i][1] + raw[i][2] * raw[i][2] + raw[i][3] * raw[i][3];
  ss = wave_sum(ss);
  const float rinv = rsqrtf(ss * (1.f / 1024.f) + 1e-6f);
#pragma unroll
  for (int i = 0; i < 4; ++i) {
    const int col = i * 256 + lane * 4;
    const float4 sh = *(const float4*)(mv + col);
    const float4 sc = *(const float4*)(mv + 1024 + col);
    h[i * 4 + 0] = raw[i][0] * rinv * (1.f + sc.x) + sh.x;
    h[i * 4 + 1] = raw[i][1] * rinv * (1.f + sc.y) + sh.y;
    h[i * 4 + 2] = raw[i][2] * rinv * (1.f + sc.z) + sh.z;
    h[i * 4 + 3] = raw[i][3] * rinv * (1.f + sc.w) + sh.w;
  }
}
DI void phase_rwkv_shift(const Params& p) {
  const int lane = threadIdx.x & 63;
  const int gw = blockIdx.x * 4 + (threadIdx.x >> 6), nw = gridDim.x * 4;
  const int nitems = MR / 8;
  for (int item = gw; item < nitems; item += nw) {
    const int r0 = item * 8;
    int sb, T;
    if (r0 < TL) { sb = r0 & ~8191; T = 8192; } else { sb = TL + ((r0 - TL) & ~255); T = 256; }
    const int send = sb + T;
    float hm[16], hc[16], hn[16];
    f32x4 raw[2][4];
    shift_load(p, r0 - 1, r0 - 1 >= sb, lane, raw[0]);
    shift_load(p, r0, true, lane, raw[1]);
    shift_finish(p, r0 - 1, r0 - 1 >= sb, lane, raw[0], hm);
    shift_load(p, r0 + 1, r0 + 1 < send, lane, raw[0]);
    shift_finish(p, r0, true, lane, raw[1], hc);
#pragma unroll
    for (int j = 0; j < 8; ++j) {
      const int row = r0 + j;
      if (j < 7) shift_load(p, row + 2, row + 2 < send, lane, raw[(j & 1) ^ 1]);
      shift_finish(p, row + 1, row + 1 < send, lane, raw[j & 1], hn);
#pragma unroll
      for (int i = 0; i < 4; ++i) {
        const int col = i * 256 + lane * 4;
        float xx[4];
#pragma unroll
        for (int e = 0; e < 4; ++e) xx[e] = 0.5f * (hm[i * 4 + e] + hn[i * 4 + e]) - hc[i * 4 + e];
        uint2 o, o2;
        o.x = pack2(hc[i * 4 + 0], hc[i * 4 + 1]); o.y = pack2(hc[i * 4 + 2], hc[i * 4 + 3]);
        o2.x = pack2(xx[0], xx[1]); o2.y = pack2(xx[2], xx[3]);
        *(uint2*)(p.H + (size_t)row * DM + col) = o;
        *(uint2*)(p.XX + (size_t)row * DM + col) = o2;
      }
#pragma unroll
      for (int i = 0; i < 16; ++i) { hm[i] = hc[i]; hc[i] = hn[i]; }
    }
  }
}

DI void phase_qkv(const Params& p, char* smem) {
  float* Cs = (float*)smem;
  const int tid = threadIdx.x;
  int g0, gend, gstep; work_range(264 * 12, g0, gend, gstep);
  for (int tile = g0; tile < gend; tile += gstep) {
    int mt, nt; band_decode(tile, 264, 12, mt, nt);
    const int m0 = mt * 128;
    f32x4 acc[4][4];
    gemm_mainloop(smem, 1, 1024,
                  [&](int r, int) { return (const u16*)(p.H + (size_t)(m0 + r) * DM); },
                  [&](int c) { return (const u16*)(p.qkv_t + (size_t)(nt * 128 + c) * 1024); }, acc);
    acc_to_lds(Cs, acc);
    const bool isctx = m0 >= TL;
    const int b = isctx ? (m0 - TL) >> 8 : m0 >> 13;
    const int t0 = isctx ? (m0 - TL) & 255 : m0 & 8191;
    if (nt < 10) {
      const int lane = tid & 63, wave = tid >> 6;
      const int hh = lane >> 5, pr = lane & 31;
      const bool isq = nt < 8;
      const float* gain = isq ? p.q_gain : p.k_gain;
      const float qs = isq ? 0.125f * 1.4426950408889634f : 1.f;
      const float g0 = gain[2 * pr] * qs, g1 = gain[2 * pr + 1] * qs;
      u16* dstb;
      size_t tstride = 64;
      if (isq) {
        const int head = nt * 2 + hh;
        dstb = isctx ? p.QC + ((size_t)(b * 16 + head) * 256 + t0) * 64 : p.Q + ((size_t)(b * 16 + head) * 8192 + t0) * 64;
      } else {
        const int kh = (nt - 8) * 2 + hh;
        dstb = p.Kb + ((size_t)(b * 4 + kh) * NKEY + (isctx ? t0 : 256 + t0)) * 64;
      }
#pragma unroll 8
      for (int rr = 0; rr < 32; ++rr) {
        const int r = wave * 32 + rr;
        const float2 v = *(const float2*)&CS(r, 2 * lane);
        float ss = v.x * v.x + v.y * v.y;
        ss = sum32(ss);
        const float rinv = rsqrtf(ss * (1.f / 64.f) + 1e-6f);
        float x0 = v.x * rinv * g0, x1 = v.y * rinv * g1;
        if (!isctx) {
          const float2 cssn = *(const float2*)(p.rope + ((size_t)(t0 + r) * 32 + pr) * 2);
          const float y0 = x0 * cssn.x - x1 * cssn.y, y1 = x0 * cssn.y + x1 * cssn.x;
          x0 = y0; x1 = y1;
        }
        *(unsigned*)(dstb + (size_t)r * tstride + 2 * pr) = pack2(x0, x1);
      }
    } else {
      const int keybase = (isctx ? t0 : 256 + t0);
      for (int j = 0; j < 4; ++j) {
        const int item = tid + 256 * j;
        const int d = item & 63, hh = (item >> 6) & 1, rg = item >> 7;
        const int kh = (nt - 10) * 2 + hh;
        float v[16];
#pragma unroll
        for (int i = 0; i < 16; ++i) v[i] = CS(rg * 16 + i, hh * 64 + d);
        u16* dst = p.Vt + ((size_t)(b * 4 + kh) * 64 + d) * NKEY + keybase + rg * 16;
        *(u32x4*)(dst) = mk4(pack2(v[0], v[1]), pack2(v[2], v[3]), pack2(v[8], v[9]), pack2(v[10], v[11]));
        *(u32x4*)(dst + 8) = mk4(pack2(v[4], v[5]), pack2(v[6], v[7]), pack2(v[12], v[13]), pack2(v[14], v[15]));
      }
    }
  }
}

DI void phase_attn(const Params& p, char* smem) {
  const int tid = threadIdx.x, lane = tid & 63, wave = tid >> 6;
  const int sw = (lane >> 1) & 7, hsel = lane >> 5;
  float mq = 0.f, mk = 0.f;
  for (int d = 0; d < 64; ++d) { mq = fmaxf(mq, fabsf(p.q_gain[d])); mk = fmaxf(mk, fabsf(p.k_gain[d])); }
  const float c0 = 0.125f * 1.4426950408889634f * 64.f * mq * mk * 1.02f + 0.5f;
  f32x16 negc;
#pragma unroll
  for (int i = 0; i < 16; ++i) negc[i] = -c0;
  int ga, gae, gs, gc, gce, gs2;
  work_range(2048, ga, gae, gs);
  work_range(64, gc, gce, gs2);
  const int n_lat = ga < gae ? (gae - ga + gs - 1) / gs : 0;
  const int n_ctx = gc < gce ? (gce - gc + gs2 - 1) / gs2 : 0;
  for (int wi = 0; wi < n_lat + n_ctx; ++wi) {
    const int item = wi < n_lat ? ga + wi * gs : 2048 + gc + (wi - n_lat) * gs2;
    int b, kvh, qb, nkt;
    const u16* qbase;
    size_t orow;
    const int head_g = wave;
    if (item < 2048) {
      b = item >> 9; kvh = (item >> 7) & 3; qb = item & 127; nkt = NKEY / 64;
      qbase = p.Q + ((size_t)(b * 16 + kvh * 4 + head_g) * 8192 + qb * 64) * 64;
      orow = (size_t)b * 8192 + qb * 64;
    } else {
      const int j = item - 2048;
      b = j >> 4; kvh = (j >> 2) & 3; qb = j & 3; nkt = 4;
      qbase = p.QC + ((size_t)(b * 16 + kvh * 4 + head_g) * 256 + qb * 64) * 64;
      orow = (size_t)TL + b * 256 + qb * 64;
    }
    const int head = kvh * 4 + head_g;
    bf16x8 qf[2][4];
#pragma unroll
    for (int qi = 0; qi < 2; ++qi)
#pragma unroll
      for (int ks = 0; ks < 4; ++ks) qf[qi][ks] = *(const bf16x8*)(qbase + (qi * 32 + (lane & 31)) * 64 + ks * 16 + hsel * 8);
    const u16* kg = p.Kb + (size_t)(b * 4 + kvh) * NKEY * 64;
    const u16* vg = p.Vt + (size_t)(b * 4 + kvh) * 64 * NKEY;
    f32x16 oacc[2][2];
#pragma unroll
    for (int i = 0; i < 16; ++i) { oacc[0][0][i] = 0.f; oacc[0][1][i] = 0.f; oacc[1][0][i] = 0.f; oacc[1][1][i] = 0.f; }
    f32x2 ls2[2] = {{0.f, 0.f}, {0.f, 0.f}};
    const int grow = wave * 8 + (lane >> 3);
    const int gsrc = ((lane & 7) ^ ((grow >> 1) & 7)) * 8;
    const u16* kgl = kg + (size_t)grow * 64 + gsrc;
    const u16* vgl = vg + (size_t)grow * NKEY + gsrc;
    char* const wb = smem + wave * 1024;
    auto stage_kv = [&](int kt, int buf) {
#pragma unroll
      for (int q = 0; q < 2; ++q) {
        __builtin_amdgcn_global_load_lds((const unsigned*)(kgl + (size_t)kt * 4096 + q * 32 * 64), (unsigned*)(wb + buf * 16384 + q * 4096), 16, 0, 0);
        __builtin_amdgcn_global_load_lds((const unsigned*)(vgl + (size_t)q * 32 * NKEY + kt * 64), (unsigned*)(wb + buf * 16384 + 8192 + q * 4096), 16, 0, 0);
      }
    };
    __syncthreads();
    stage_kv(0, 0);
    asm volatile("s_waitcnt vmcnt(0)" ::: "memory");
    __syncthreads();
    for (int kt = 0; kt < nkt; ++kt) {
      const int buf = kt & 1;
      if (kt + 1 < nkt) stage_kv(kt + 1, buf ^ 1);
      const u16* Ks = (const u16*)(smem + buf * 16384);
      const u16* Vs = Ks + 64 * 64;
      f32x16 sacc[2][2];
#pragma unroll
      for (int kb = 0; kb < 2; ++kb) {
        bf16x8 kf[4];
#pragma unroll
        for (int ks = 0; ks < 4; ++ks) kf[ks] = *(const bf16x8*)(Ks + (kb * 32 + (lane & 31)) * 64 + (((ks * 2 + hsel) ^ sw) * 8));
#pragma unroll
        for (int ks = 0; ks < 4; ++ks) {
          sacc[0][kb] = __builtin_amdgcn_mfma_f32_32x32x16_bf16(kf[ks], qf[0][ks], ks == 0 ? negc : sacc[0][kb], 0, 0, 0);
          sacc[1][kb] = __builtin_amdgcn_mfma_f32_32x32x16_bf16(kf[ks], qf[1][ks], ks == 0 ? negc : sacc[1][kb], 0, 0, 0);
        }
      }
#pragma unroll
      for (int qi = 0; qi < 2; ++qi)
#pragma unroll
        for (int kb = 0; kb < 2; ++kb)
#pragma unroll
          for (int i = 0; i < 16; i += 2) {
            const float e0 = __builtin_amdgcn_exp2f(sacc[qi][kb][i]), e1 = __builtin_amdgcn_exp2f(sacc[qi][kb][i + 1]);
            sacc[qi][kb][i] = e0; sacc[qi][kb][i + 1] = e1;
            const f32x2 e2 = {e0, e1};
            ls2[qi] += e2;
          }
#pragma unroll
      for (int kb = 0; kb < 2; ++kb)
#pragma unroll
        for (int s2 = 0; s2 < 2; ++s2) {
          bf16x8 vfr[2];
#pragma unroll
          for (int db = 0; db < 2; ++db) vfr[db] = *(const bf16x8*)(Vs + (db * 32 + (lane & 31)) * 64 + (((2 * (2 * kb + s2) + hsel) ^ sw) * 8));
#pragma unroll
          for (int qi = 0; qi < 2; ++qi) {
            unsigned w[4];
#pragma unroll
            for (int e = 0; e < 4; ++e) w[e] = pack2(sacc[qi][kb][8 * s2 + 2 * e], sacc[qi][kb][8 * s2 + 2 * e + 1]);
            u32x4 pw = mk4(w[0], w[1], w[2], w[3]);
            const bf16x8 pf = __builtin_bit_cast(bf16x8, pw);
#pragma unroll
            for (int db = 0; db < 2; ++db) oacc[qi][db] = __builtin_amdgcn_mfma_f32_32x32x16_bf16(vfr[db], pf, oacc[qi][db], 0, 0, 0);
          }
        }
      asm volatile("s_waitcnt vmcnt(0)" ::: "memory");
      __syncthreads();
    }
#pragma unroll
    for (int qi = 0; qi < 2; ++qi) {
      const float lsum = ls2[qi][0] + ls2[qi][1];
      const float l = lsum + __shfl_xor(lsum, 32, 64);
      const float inv = 1.f / l;
      u16* od = p.H + (orow + qi * 32 + (lane & 31)) * DM + head * 64;
#pragma unroll
      for (int db = 0; db < 2; ++db)
#pragma unroll
        for (int g = 0; g < 4; ++g) {
          uint2 o;
          o.x = pack2(oacc[qi][db][g * 4 + 0] * inv, oacc[qi][db][g * 4 + 1] * inv);
          o.y = pack2(oacc[qi][db][g * 4 + 2] * inv, oacc[qi][db][g * 4 + 3] * inv);
          *(uint2*)(od + db * 32 + 8 * g + 4 * hsel) = o;
        }
    }
  }
}

template <bool FROM_INPUT>
DI void phase_proj_res(const Params& p, char* smem, const u16* A, int lda, int K, const u16* Bt, int layer, int gate_idx, int mtiles) {
  int g0, gend, gstep; work_range(mtiles * 8, g0, gend, gstep);
  for (int tile = g0; tile < gend; tile += gstep) {
    int mt, nt; band_decode(tile, mtiles, 8, mt, nt);
    const int m0 = mt * 128;
    f32x4 acc[4][4];
    gemm_mainloop(smem, 1, K,
                  [&](int r, int) { return A + (size_t)(m0 + r) * lda; },
                  [&](int c) { return Bt + (size_t)(nt * 128 + c) * K; }, acc);
    const float* gate = p.modv + ((size_t)layer * 5 + midx_of(m0)) * 6144 + gate_idx * 1024 + nt * 128;
    const float* sb = (FROM_INPUT ? xin_ptr(p, m0) : (const float*)resid_ptr(p, m0)) + nt * 128;
    float* db = resid_ptr(p, m0) + nt * 128;
    epi_direct(acc, [&](int r, int c, float v) { db[r * DM + c] = sb[r * DM + c] + gate[c] * v; });
  }
}

DI void phase_ffn_up(const Params& p, char* smem, int layer, bool with_ctx, u16* ACT) {
  float* Cs = (float*)smem;
  const int tid = threadIdx.x;
  const int mtiles = with_ctx ? 276 : 264;
  int g0, gend, gstep; work_range(mtiles * 44, g0, gend, gstep);
  const u16* up = p.up_t + (size_t)layer * 5632 * 1024;
  const float* cw = p.f_cw + (size_t)layer * 3 * 5632;
  const float* cb = p.f_cb + (size_t)layer * 5632;
  for (int tile = g0; tile < gend; tile += gstep) {
    int mt, nt; band_decode(tile, mtiles, 44, mt, nt);
    int rowbase, T, j;
    if (mt < 264) { rowbase = (mt / 66) * 8192; T = 8192; j = mt % 66; }
    else { const int m2 = mt - 264; rowbase = TL + (m2 / 3) * 256; T = 256; j = m2 % 3; }
    const int tb = j * 126 - 1;
    f32x4 acc[4][4];
    gemm_mainloop(smem, 1, 1024,
                  [&](int r, int) { const int t = tb + r; return (t >= 0 && t < T) ? (const u16*)(p.H + (size_t)(rowbase + t) * DM) : (const u16*)p.zero; },
                  [&](int c) { return up + (size_t)(c < 64 ? nt * 64 + c : 2816 + nt * 64 + (c - 64)) * 1024; }, acc);
    acc_to_lds(Cs, acc);
    const int c = tid & 63, rq = tid >> 6;
    const int n = nt * 64 + c;
    const float g0 = cw[n], g1 = cw[5632 + n], g2 = cw[2 * 5632 + n], gb = cb[n];
    const float v0 = cw[2816 + n], v1 = cw[5632 + 2816 + n], v2 = cw[2 * 5632 + 2816 + n], vb = cb[2816 + n];
    const int rs = 1 + rq * 32;
    int re = rs + 32; if (re > 127) re = 127;
    float gp = CS(rs - 1, c), gc = CS(rs, c), vp = CS(rs - 1, c + 64), vc = CS(rs, c + 64);
    for (int r = rs; r < re; ++r) {
      const float gn = CS(r + 1, c), vn = CS(r + 1, c + 64);
      const int t = tb + r;
      if (t < T) {
        const float g = g0 * gp + g1 * gc + g2 * gn + gb;
        const float v = v0 * vp + v1 * vc + v2 * vn + vb;
        const float a = g * __builtin_amdgcn_rcpf(1.f + __expf(-g)) * v;
        ACT[(size_t)(rowbase + t) * DFF + n] = f2bf(a);
      }
      gp = gc; gc = gn; vp = vc; vc = vn;
    }
  }
}

DI void phase_rwkv_gemms(const Params& p, char* smem) {
  float* Cs = (float*)smem;
  const int tid = threadIdx.x;
  int g0, gend, gstep; work_range(7312, g0, gend, gstep);
  for (int tile = g0; tile < gend; tile += gstep) {
    int job, mt, nt;
    const u16* Bt;
    if (tile < 2048) { job = 0; band_decode(tile, 256, 8, mt, nt); Bt = p.rr_t; }
    else if (tile < 4160) { job = 1; band_decode(tile - 2048, 264, 8, mt, nt); Bt = p.rk_t; }
    else if (tile < 6272) { job = 2; band_decode(tile - 4160, 264, 8, mt, nt); Bt = p.rv_t; }
    else if (tile < 6536) { job = 3; mt = tile - 6272; nt = 0; Bt = p.w1_t; }
    else if (tile < 6800) { job = 4; mt = tile - 6536; nt = 0; Bt = p.a1_t; }
    else { job = 5; band_decode(tile - 6800, 256, 2, mt, nt); Bt = p.g1_t; }
    const int m0 = mt * 128;
    f32x4 acc[4][4];
    gemm_mainloop(smem, 2, 1024,
                  [&](int r, int part) { return (const u16*)((part ? p.XX : p.H) + (size_t)(m0 + r) * DM); },
                  [&](int c) { return Bt + (size_t)(nt * 128 + c) * 2048; }, acc);
    if (job == 0) {
      epi_direct(acc, [&](int r, int c, float v) { p.R16[(size_t)(m0 + r) * DM + nt * 128 + c] = (f16)v; });
    } else if (job == 2) {
      epi_direct(acc, [&](int r, int c, float v) { p.V16[(size_t)(m0 + r) * DM + nt * 128 + c] = (f16)v; });
    } else if (job == 3) {
      epi_direct(acc, [&](int r, int c, float v) { p.LW[(size_t)(m0 + r) * 128 + c] = f2bf(tanhf(v)); });
    } else if (job == 4) {
      epi_direct(acc, [&](int r, int c, float v) { p.LA[(size_t)(m0 + r) * 128 + c] = f2bf(v); });
    } else if (job == 5) {
      epi_direct(acc, [&](int r, int c, float v) {
        const int col = nt * 128 + c;
        if (col < 192) p.LG[(size_t)(m0 + r) * 192 + col] = col < 160 ? f2bf(sigmoid_fast(v)) : (u16)0;
      });
    } else {
      acc_to_lds(Cs, acc);
      const int lane = tid & 63, wave = tid >> 6;
      const int col = nt * 128 + 2 * lane;
      const float kk0 = p.k_k[col], kk1 = p.k_k[col + 1];
#pragma unroll 4
      for (int rr = 0; rr < 32; ++rr) {
        const int r = wave * 32 + rr;
        const float2 v = *(const float2*)&CS(r, 2 * lane);
        const float a0 = v.x * kk0, a1 = v.y * kk1;
        float ss = a0 * a0 + a1 * a1;
        ss = sum32(ss);
        const float inv = 1.f / fmaxf(sqrtf(ss), 1e-12f);
        f16 k2[2], n2[2];
        k2[0] = (f16)v.x; k2[1] = (f16)v.y; n2[0] = (f16)(a0 * inv); n2[1] = (f16)(a1 * inv);
        *(unsigned*)(p.K16 + (size_t)(m0 + r) * DM + col) = *(const unsigned*)k2;
        *(unsigned*)(p.KK16 + (size_t)(m0 + r) * DM + col) = *(const unsigned*)n2;
      }
    }
  }
}

#define XB_TMO      128
#define XB_XCNT(j)  (256  + 64 * (j))
#define XB_XSUB(j)  (1280 + 64 * (j))
#define XB_XGEN(j)  (2304 + 64 * (j))
#define XB_TOP      3328
#define XB_TOPGEN   3392
#define XB_SPIN_CAP (1u << 20)
DI unsigned xb_ld(unsigned* p) { return __hip_atomic_load(p, __ATOMIC_RELAXED, __HIP_MEMORY_SCOPE_AGENT); }
DI unsigned xb_add(unsigned* p, unsigned v) { return __hip_atomic_fetch_add(p, v, __ATOMIC_RELAXED, __HIP_MEMORY_SCOPE_AGENT); }
DI unsigned xb_xcc_id() { return (unsigned)__builtin_amdgcn_s_getreg((3 << 11) | 20) & 0xFu; }
#define XB_SPIN(cond, bar) do { unsigned _sp = 0; while (cond) { __builtin_amdgcn_s_sleep(1); \
    if ((++_sp & 255u) == 0u) { if (xb_ld(&(bar)[XB_TMO])) break; if (_sp > XB_SPIN_CAP) { atomicAdd(&(bar)[XB_TMO], 1u); break; } } } } while (0)
struct XbState { unsigned x, nloc, nx; };
DI void xb_census(unsigned* bar, unsigned x, unsigned& nloc, unsigned& nx) {
  const unsigned G = gridDim.x;
  unsigned sum, cnt, mine, sp = 0u;
  for (;;) {
    sum = 0u; cnt = 0u; mine = 0u;
#pragma unroll
    for (unsigned j = 0; j < 16; ++j) { const unsigned c = xb_ld(&bar[XB_XCNT(j)]); sum += c; cnt += (c > 0u) ? 1u : 0u; mine = (j == x) ? c : mine; }
    if (sum == G) break;
    __builtin_amdgcn_s_sleep(1);
    if ((++sp & 255u) == 0u) { if (xb_ld(&bar[XB_TMO])) break; if (sp > XB_SPIN_CAP) { atomicAdd(&bar[XB_TMO], 1u); break; } }
  }
  nloc = mine > 0u ? mine : 1u; nx = cnt > 0u ? cnt : 1u;
}
DI void grid_barrier(unsigned* bar, XbState& st) {
  asm volatile("s_waitcnt vmcnt(0)" ::: "memory");
  __syncthreads();
  if (threadIdx.x == 0) {
    __builtin_amdgcn_s_waitcnt(0);
    if (st.nloc == 0u) xb_census(bar, st.x, st.nloc, st.nx);
    const unsigned nloc = st.nloc, nx = st.nx;
    const unsigned old = xb_add(&bar[XB_XSUB(st.x)], 1u);
    const unsigned gen = old / nloc;
    if (old + 1u == (gen + 1u) * nloc) {
      __builtin_amdgcn_fence(__ATOMIC_RELEASE, "agent");
      asm volatile("s_waitcnt vmcnt(0)" ::: "memory");
      const unsigned og = xb_add(&bar[XB_TOP], 1u);
      const unsigned tg = og / nx;
      if (og + 1u == (tg + 1u) * nx) xb_add(&bar[XB_TOPGEN], 1u);
      else XB_SPIN(xb_ld(&bar[XB_TOPGEN]) == tg, bar);
      __builtin_amdgcn_fence(__ATOMIC_ACQUIRE, "agent");
      xb_add(&bar[XB_XGEN(st.x)], 1u);
      asm volatile("s_waitcnt vmcnt(0)" ::: "memory");
    } else {
      XB_SPIN(xb_ld(&bar[XB_XGEN(st.x)]) == gen, bar);
      __builtin_amdgcn_fence(__ATOMIC_ACQUIRE, "agent");
      asm volatile("s_waitcnt vmcnt(0)" ::: "memory");
    }
  }
  __syncthreads();
}

struct ScanLds {
  float dec[2][16][64], kd[2][16][64], nk[2][16][64], bb[2][16][64], rr[2][16][64];
  float vv[2][16][16];
  float yy[2][16][16];
  float bp[2][4][16];
};

template <int DIR, bool EMIT>
DI void scan_steps(const ScanLds& L, int bsel, int c0, int myrow, int l15, f32x2& Sa, f32x2& Sb, float& ykeep) {
  f32x4 d4[2], k4[2], n4[2], b4[2], r4[2];
  float vv[2];
  auto ld = [&](int slot, int s) {
    d4[slot] = *(const f32x4*)&L.dec[bsel][s][c0];
    k4[slot] = *(const f32x4*)&L.kd[bsel][s][c0];
    n4[slot] = *(const f32x4*)&L.nk[bsel][s][c0];
    b4[slot] = *(const f32x4*)&L.bb[bsel][s][c0];
    if (EMIT) r4[slot] = *(const f32x4*)&L.rr[bsel][s][c0];
    vv[slot] = L.vv[bsel][s][myrow];
  };
  ld(0, DIR ? 15 : 0);
#pragma unroll
  for (int ss = 0; ss < 16; ++ss) {
    const int s = DIR ? 15 - ss : ss;
    const int cur = ss & 1;
    if (ss + 1 < 16) ld(cur ^ 1, DIR ? 14 - ss : ss + 1);
    const f32x2 nlo = {n4[cur][0], n4[cur][1]}, nhi = {n4[cur][2], n4[cur][3]};
    const f32x2 dlo = {d4[cur][0], d4[cur][1]}, dhi = {d4[cur][2], d4[cur][3]};
    const f32x2 klo = {k4[cur][0], k4[cur][1]}, khi = {k4[cur][2], k4[cur][3]};
    const f32x2 blo = {b4[cur][0], b4[cur][1]}, bhi = {b4[cur][2], b4[cur][3]};
    f32x2 t = Sa * nlo + Sb * nhi;
    float sa = dpp_sum16(t[0] + t[1]);
    const f32x2 sa2 = {sa, sa}, v2 = {vv[cur], vv[cur]};
    Sa = Sa * dlo + (sa2 * blo + v2 * klo);
    Sb = Sb * dhi + (sa2 * bhi + v2 * khi);
    if (EMIT) {
      const f32x2 rlo = {r4[cur][0], r4[cur][1]}, rhi = {r4[cur][2], r4[cur][3]};
      const f32x2 u = Sa * rlo + Sb * rhi;
      const float y = dpp_sum16(u[0] + u[1]);
      ykeep = (l15 == s) ? y : ykeep;
    }
  }
}

template <int DIR>
DI void scan_item(const Params& p, ScanLds& L, int b, int h, int q) {
  constexpr int dir = DIR;
  const int tid = threadIdx.x, lane = tid & 63, wave = tid >> 6;
  const int l15 = lane & 15, l4 = lane >> 4;
  const int colw = h * 64 + wave * 16 + l15;
  const int chd = wave * 16 + l15;
  bf16x8 w2f[2], a2f[2];
#pragma unroll
  for (int ks = 0; ks < 2; ++ks) {
    w2f[ks] = *(const bf16x8*)(p.w2_t + ((size_t)(dir * 1024 + colw) * 64 + ks * 32 + l4 * 8));
    a2f[ks] = *(const bf16x8*)(p.a2_t + ((size_t)(dir * 1024 + colw) * 64 + ks * 32 + l4 * 8));
  }
  const float w0c = p.dw0[dir * 1024 + colw], a0c = p.a0[dir * 1024 + colw], kac = p.k_a[colw], rkc = p.r_k[colw];
  f32x2 Sa = {0.f, 0.f}, Sb = {0.f, 0.f};
  const int myrow = wave * 4 + l4;
  const int c0 = l15 * 4;
  bf16x8 lwf[2], laf[2];
  f16 kv[4], kkv[4], rv[4];
  f16 vvr;
  auto chunk_rowbase = [&](int c, bool& isctx) -> int {
    if (c < 16) { isctx = true; const int cc = dir ? 15 - c : c; return TL + b * 256 + cc * 16; }
    isctx = false; const int cc = dir ? 511 - (c - 16) : (c - 16); return b * 8192 + cc * 16;
  };
  auto stage_load = [&](int c) {
    bool isctx; const int rb = chunk_rowbase(c, isctx);
#pragma unroll
    for (int ks = 0; ks < 2; ++ks) {
      lwf[ks] = *(const bf16x8*)(p.LW + ((size_t)(rb + l15) * 128 + dir * 64 + ks * 32 + l4 * 8));
      laf[ks] = *(const bf16x8*)(p.LA + ((size_t)(rb + l15) * 128 + dir * 64 + ks * 32 + l4 * 8));
    }
#pragma unroll
    for (int i = 0; i < 4; ++i) {
      const size_t off = (size_t)(rb + l4 * 4 + i) * DM + colw;
      kv[i] = p.K16[off]; kkv[i] = p.KK16[off];
      rv[i] = isctx ? (f16)0.f : p.R16[off];
    }
    vvr = p.V16[(size_t)(rb + (tid >> 4)) * DM + h * 64 + q * 16 + (tid & 15)];
  };
  auto stage_compute = [&](int c) {
    const int bsel = c & 1;
    f32x4 wacc = {0.f, 0.f, 0.f, 0.f}, aacc = {0.f, 0.f, 0.f, 0.f};
    wacc = __builtin_amdgcn_mfma_f32_16x16x32_bf16(lwf[0], w2f[0], wacc, 0, 0, 0);
    wacc = __builtin_amdgcn_mfma_f32_16x16x32_bf16(lwf[1], w2f[1], wacc, 0, 0, 0);
    aacc = __builtin_amdgcn_mfma_f32_16x16x32_bf16(laf[0], a2f[0], aacc, 0, 0, 0);
    aacc = __builtin_amdgcn_mfma_f32_16x16x32_bf16(laf[1], a2f[1], aacc, 0, 0, 0);
    float bpart[4];
#pragma unroll
    for (int i = 0; i < 4; ++i) {
      const int s = l4 * 4 + i;
      const float sg = sigmoid_fast(w0c + wacc[i]);
      const float dec = __expf(-0.6065306597126334f * sg);
      const float a = sigmoid_fast(a0c + aacc[i]);
      const float k = (float)kv[i], kk = (float)kkv[i], r = (float)rv[i];
      const float kd = k * (1.f + (a - 1.f) * kac);
      L.dec[bsel][s][chd] = dec;
      L.kd[bsel][s][chd] = kd;
      L.nk[bsel][s][chd] = -kk;
      L.bb[bsel][s][chd] = kk * a;
      L.rr[bsel][s][chd] = r;
      if (q == 0) bpart[i] = dpp_sum16(r * kd * rkc);
    }
    if (q == 0 && l15 == 0) {
#pragma unroll
      for (int i = 0; i < 4; ++i) L.bp[bsel][wave][l4 * 4 + i] = bpart[i];
    }
    L.vv[bsel][tid >> 4][tid & 15] = (float)vvr;
  };
  auto write_bonus = [&](int c) {
    if (q == 0 && tid < 16) {
      bool isctx; const int rb = chunk_rowbase(c, isctx);
      const int b2 = c & 1;
      p.bonus[((size_t)dir * MR + rb + tid) * 16 + h] = L.bp[b2][0][tid] + L.bp[b2][1][tid] + L.bp[b2][2][tid] + L.bp[b2][3][tid];
    }
  };
  __syncthreads();
  stage_load(0);
  stage_compute(0);
  __syncthreads();
  write_bonus(0);
  const int NCH = 528;
  float ykeep = 0.f;
#pragma unroll 1
  for (int c = 0; c < 16; ++c) {
    stage_load(c + 1);
    scan_steps<DIR, false>(L, c & 1, c0, myrow, l15, Sa, Sb, ykeep);
    stage_compute(c + 1);
    __syncthreads();
    write_bonus(c + 1);
  }
#pragma unroll 1
  for (int c = 16; c < NCH; ++c) {
    const int bsel = c & 1;
    if (c + 1 < NCH) stage_load(c + 1);
    scan_steps<DIR, true>(L, bsel, c0, myrow, l15, Sa, Sb, ykeep);
    L.yy[bsel][l15][myrow] = ykeep;
    if (c + 1 < NCH) stage_compute(c + 1);
    __syncthreads();
    {
      bool isctx; const int rb = chunk_rowbase(c, isctx);
      f16* Y = dir ? p.Y1 : p.Y0;
      Y[(size_t)(rb + (tid >> 4)) * DM + h * 64 + q * 16 + (tid & 15)] = (f16)(L.yy[bsel][tid >> 4][tid & 15] * 0.0625f);
    }
    if (c + 1 < NCH) write_bonus(c + 1);
  }
}

struct ScanLds2 {
  float dec[2][16][64], kd[2][16][64], nk[2][16][64], bb[2][16][64], rr[2][16][64];
  float vv[2][16][32];
  float yy[2][16][32];
  float bp[2][4][16];
};
DI float dpp_sum8(float v) {
  v += dpp_mov<0xB1>(v);
  v += dpp_mov<0x4E>(v);
  v += dpp_mov<0x141>(v);
  return v;
}
template <int DIR, bool EMIT>
DI void scan_steps2(const ScanLds2& L, int bsel, int c0, int myrow, int l7, f32x2 (&S)[4], float& ykA, float& ykB) {
  f32x4 d4[2][2], k4[2][2], n4[2][2], b4[2][2], r4[2][2];
  float vv[2];
  auto ld = [&](int slot, int s) {
#pragma unroll
    for (int hf = 0; hf < 2; ++hf) {
      d4[slot][hf] = *(const f32x4*)&L.dec[bsel][s][c0 + 4 * hf];
      k4[slot][hf] = *(const f32x4*)&L.kd[bsel][s][c0 + 4 * hf];
      n4[slot][hf] = *(const f32x4*)&L.nk[bsel][s][c0 + 4 * hf];
      b4[slot][hf] = *(const f32x4*)&L.bb[bsel][s][c0 + 4 * hf];
      if (EMIT) r4[slot][hf] = *(const f32x4*)&L.rr[bsel][s][c0 + 4 * hf];
    }
    vv[slot] = L.vv[bsel][s][myrow];
  };
  ld(0, DIR ? 15 : 0);
#pragma unroll
  for (int ss = 0; ss < 16; ++ss) {
    const int s = DIR ? 15 - ss : ss;
    const int cur = ss & 1;
    if (ss + 1 < 16) ld(cur ^ 1, DIR ? 14 - ss : ss + 1);
    f32x2 t = {0.f, 0.f};
#pragma unroll
    for (int i = 0; i < 4; ++i) { const f32x2 nn = {n4[cur][i >> 1][(i & 1) * 2], n4[cur][i >> 1][(i & 1) * 2 + 1]}; t += S[i] * nn; }
    const float sa = dpp_sum8(t[0] + t[1]);
    const f32x2 sa2 = {sa, sa}, v2 = {vv[cur], vv[cur]};
#pragma unroll
    for (int i = 0; i < 4; ++i) {
      const f32x2 dd = {d4[cur][i >> 1][(i & 1) * 2], d4[cur][i >> 1][(i & 1) * 2 + 1]};
      const f32x2 kk = {k4[cur][i >> 1][(i & 1) * 2], k4[cur][i >> 1][(i & 1) * 2 + 1]};
      const f32x2 bb = {b4[cur][i >> 1][(i & 1) * 2], b4[cur][i >> 1][(i & 1) * 2 + 1]};
      S[i] = S[i] * dd + (sa2 * bb + v2 * kk);
    }
    if (EMIT) {
      f32x2 u = {0.f, 0.f};
#pragma unroll
      for (int i = 0; i < 4; ++i) { const f32x2 rr = {r4[cur][i >> 1][(i & 1) * 2], r4[cur][i >> 1][(i & 1) * 2 + 1]}; u += S[i] * rr; }
      const float y = dpp_sum8(u[0] + u[1]);
      if (s < 8) ykA = (l7 == s) ? y : ykA; else ykB = (l7 == s - 8) ? y : ykB;
    }
  }
}
template <int DIR>
DI void scan_item2(const Params& p, ScanLds2& L, int b, int h, int hf) {
  constexpr int dir = DIR;
  const int tid = threadIdx.x, lane = tid & 63, wave = tid >> 6;
  const int l15 = lane & 15, l4 = lane >> 4;
  const int colw = h * 64 + wave * 16 + l15;
  const int chd = wave * 16 + l15;
  bf16x8 w2f[2], a2f[2];
#pragma unroll
  for (int ks = 0; ks < 2; ++ks) {
    w2f[ks] = *(const bf16x8*)(p.w2_t + ((size_t)(dir * 1024 + colw) * 64 + ks * 32 + l4 * 8));
    a2f[ks] = *(const bf16x8*)(p.a2_t + ((size_t)(dir * 1024 + colw) * 64 + ks * 32 + l4 * 8));
  }
  const float w0c = p.dw0[dir * 1024 + colw], a0c = p.a0[dir * 1024 + colw], kac = p.k_a[colw], rkc = p.r_k[colw];
  f32x2 S[4];
#pragma unroll
  for (int i = 0; i < 4; ++i) { S[i][0] = 0.f; S[i][1] = 0.f; }
  const int l7 = lane & 7;
  const int myrow = wave * 8 + (lane >> 3);
  const int c0 = l7 * 8;
  bf16x8 lwf[2], laf[2];
  f16 kv[4], kkv[4], rv[4];
  f16 vvr[2];
  auto chunk_rowbase = [&](int c, bool& isctx) -> int {
    if (c < 16) { isctx = true; const int cc = dir ? 15 - c : c; return TL + b * 256 + cc * 16; }
    isctx = false; const int cc = dir ? 511 - (c - 16) : (c - 16); return b * 8192 + cc * 16;
  };
  auto stage_load = [&](int c) {
    bool isctx; const int rb = chunk_rowbase(c, isctx);
#pragma unroll
    for (int ks = 0; ks < 2; ++ks) {
      lwf[ks] = *(const bf16x8*)(p.LW + ((size_t)(rb + l15) * 128 + dir * 64 + ks * 32 + l4 * 8));
      laf[ks] = *(const bf16x8*)(p.LA + ((size_t)(rb + l15) * 128 + dir * 64 + ks * 32 + l4 * 8));
    }
#pragma unroll
    for (int i = 0; i < 4; ++i) {
      const size_t off = (size_t)(rb + l4 * 4 + i) * DM + colw;
      kv[i] = p.K16[off]; kkv[i] = p.KK16[off];
      rv[i] = isctx ? (f16)0.f : p.R16[off];
    }
#pragma unroll
    for (int j = 0; j < 2; ++j) { const int e = tid + 256 * j; vvr[j] = p.V16[(size_t)(rb + (e >> 5)) * DM + h * 64 + hf * 32 + (e & 31)]; }
  };
  auto stage_compute = [&](int c) {
    const int bsel = c & 1;
    f32x4 wacc = {0.f, 0.f, 0.f, 0.f}, aacc = {0.f, 0.f, 0.f, 0.f};
    wacc = __builtin_amdgcn_mfma_f32_16x16x32_bf16(lwf[0], w2f[0], wacc, 0, 0, 0);
    wacc = __builtin_amdgcn_mfma_f32_16x16x32_bf16(lwf[1], w2f[1], wacc, 0, 0, 0);
    aacc = __builtin_amdgcn_mfma_f32_16x16x32_bf16(laf[0], a2f[0], aacc, 0, 0, 0);
    aacc = __builtin_amdgcn_mfma_f32_16x16x32_bf16(laf[1], a2f[1], aacc, 0, 0, 0);
    float bpart[4];
#pragma unroll
    for (int i = 0; i < 4; ++i) {
      const int s = l4 * 4 + i;
      const float sg = sigmoid_fast(w0c + wacc[i]);
      const float dec = __expf(-0.6065306597126334f * sg);
      const float a = sigmoid_fast(a0c + aacc[i]);
      const float k = (float)kv[i], kk = (float)kkv[i], r = (float)rv[i];
      const float kd = k * (1.f + (a - 1.f) * kac);
      L.dec[bsel][s][chd] = dec;
      L.kd[bsel][s][chd] = kd;
      L.nk[bsel][s][chd] = -kk;
      L.bb[bsel][s][chd] = kk * a;
      L.rr[bsel][s][chd] = r;
      if (hf == 0) bpart[i] = dpp_sum16(r * kd * rkc);
    }
    if (hf == 0 && l15 == 0) {
#pragma unroll
      for (int i = 0; i < 4; ++i) L.bp[bsel][wave][l4 * 4 + i] = bpart[i];
    }
#pragma unroll
    for (int j = 0; j < 2; ++j) { const int e = tid + 256 * j; L.vv[bsel][e >> 5][e & 31] = (float)vvr[j]; }
  };
  auto write_bonus = [&](int c) {
    if (hf == 0 && tid < 16) {
      bool isctx; const int rb = chunk_rowbase(c, isctx);
      const int b2 = c & 1;
      p.bonus[((size_t)dir * MR + rb + tid) * 16 + h] = L.bp[b2][0][tid] + L.bp[b2][1][tid] + L.bp[b2][2][tid] + L.bp[b2][3][tid];
    }
  };
  __syncthreads();
  stage_load(0);
  stage_compute(0);
  __syncthreads();
  write_bonus(0);
  const int NCH = 528;
  float ykA = 0.f, ykB = 0.f;
#pragma unroll 1
  for (int c = 0; c < 16; ++c) {
    stage_load(c + 1);
    scan_steps2<DIR, false>(L, c & 1, c0, myrow, l7, S, ykA, ykB);
    stage_compute(c + 1);
    __syncthreads();
    write_bonus(c + 1);
  }
#pragma unroll 1
  for (int c = 16; c < NCH; ++c) {
    const int bsel = c & 1;
    if (c + 1 < NCH) stage_load(c + 1);
    scan_steps2<DIR, true>(L, bsel, c0, myrow, l7, S, ykA, ykB);
    L.yy[bsel][l7][myrow] = ykA;
    L.yy[bsel][8 + l7][myrow] = ykB;
    if (c + 1 < NCH) stage_compute(c + 1);
    __syncthreads();
    {
      bool isctx; const int rb = chunk_rowbase(c, isctx);
      f16* Y = dir ? p.Y1 : p.Y0;
#pragma unroll
      for (int j = 0; j < 2; ++j) {
        const int e = tid + 256 * j;
        Y[(size_t)(rb + (e >> 5)) * DM + h * 64 + hf * 32 + (e & 31)] = (f16)(L.yy[bsel][e >> 5][e & 31] * 0.0625f);
      }
    }
    if (c + 1 < NCH) write_bonus(c + 1);
  }
}
DI void phase_scan2(const Params& p, char* smem) {
  ScanLds2& L = *(ScanLds2*)smem;
  const unsigned info = p.blkinfo[blockIdx.x];
  const unsigned rank = info >> 16, ticket = info & 0xffffu;
  const unsigned n0 = xb_ld(&p.bar[XB_N0]);
  const unsigned item = rank == 0u ? ticket : n0 + ticket;
  if (item < 256u) {
    const int sc = item >> 1, hf = item & 1;
    const int dir = sc & 1, bh = sc >> 1, b = bh >> 4, h = bh & 15;
    if (dir) scan_item2<1>(p, L, b, h, hf); else scan_item2<0>(p, L, b, h, hf);
  }
}

DI void phase_scan(const Params& p, char* smem) {
  ScanLds& L = *(ScanLds*)smem;
  for (int item = blockIdx.x; item < 512; item += gridDim.x) {
    int sc, q;
    if (gridDim.x == 512) { const int xcd = item & 7, slot = item >> 3; sc = xcd * 16 + (slot >> 2); q = slot & 3; }
    else { sc = item >> 2; q = item & 3; }
    const int dir = sc & 1, bh = sc >> 1, b = bh >> 4, h = bh & 15;
    if (dir) scan_item<1>(p, L, b, h, q); else scan_item<0>(p, L, b, h, q);
  }
}

DI void phase_readout(const Params& p, char* smem) {
  float* Cs = (float*)smem;
  const int tid = threadIdx.x;
  int g0, gend, gstep; work_range(256 * 8, g0, gend, gstep);
  for (int tile = g0; tile < gend; tile += gstep) {
    int mt, nt; band_decode(tile, 256, 8, mt, nt);
    const int m0 = mt * 128;
    f32x4 acc[4][4];
    gemm_mainloop(smem, 1, 192,
                  [&](int r, int) { return (const u16*)(p.LG + (size_t)(m0 + r) * 192); },
                  [&](int c) { return (const u16*)(p.g2_t + (size_t)(nt * 128 + c) * 192); }, acc);
    acc_to_lds(Cs, acc);
    const int lane = tid & 63, wave = tid >> 6;
    const int head = nt * 2 + (lane >> 5);
    const int col = nt * 128 + 2 * lane;
    const float gw0 = p.gn_w[col], gw1 = p.gn_w[col + 1], gb0 = p.gn_b[col], gb1 = p.gn_b[col + 1];
#pragma unroll 1
    for (int rb = 0; rb < 32; rb += 8) {
      unsigned ua[8], ub[8], uv[8];
      float bn[8];
#pragma unroll
      for (int j = 0; j < 8; ++j) {
        const int row = m0 + wave * 32 + rb + j;
        ua[j] = *(const unsigned*)(p.Y0 + (size_t)row * DM + col);
        ub[j] = *(const unsigned*)(p.Y1 + (size_t)row * DM + col);
        uv[j] = *(const unsigned*)(p.V16 + (size_t)row * DM + col);
        bn[j] = p.bonus[((size_t)0 * MR + row) * 16 + head] + p.bonus[((size_t)1 * MR + row) * 16 + head];
      }
#pragma unroll
      for (int j = 0; j < 8; ++j) {
        const int r = wave * 32 + rb + j;
        const int row = m0 + r;
        const f16* fa = (const f16*)&ua[j]; const f16* fb = (const f16*)&ub[j]; const f16* fv = (const f16*)&uv[j];
        const float y0 = ((float)fa[0] + (float)fb[0]) * 16.f, y1 = ((float)fa[1] + (float)fb[1]) * 16.f;
        float sm = y0 + y1;
        sm = sum32(sm);
        const float mean = sm * (1.f / 64.f);
        const float d0 = y0 - mean, d1 = y1 - mean;
        float vs = d0 * d0 + d1 * d1;
        vs = sum32(vs);
        const float rstd = rsqrtf(vs * (1.f / 64.f) + 64e-5f);
        const float2 g = *(const float2*)&CS(r, 2 * lane);
        const float z0 = (d0 * rstd * gw0 + gb0 + bn[j] * (float)fv[0]) * g.x;
        const float z1 = (d1 * rstd * gw1 + gb1 + bn[j] * (float)fv[1]) * g.y;
        *(unsigned*)(p.Z + (size_t)row * DM + col) = pack2(z0, z1);
      }
    }
  }
}

DI void phase_final(const Params& p) {
  const int lane = threadIdx.x & 63;
  const int gw = blockIdx.x * 4 + (threadIdx.x >> 6), nw = gridDim.x * 4;
  float4 g[4];
#pragma unroll
  for (int i = 0; i < 4; ++i) g[i] = *(const float4*)(p.final_gain + i * 256 + lane * 4);
  float4 v[4], vn[4];
  int row = gw;
  if (row < TL) {
#pragma unroll
    for (int i = 0; i < 4; ++i) v[i] = *(const float4*)(p.out + (size_t)row * DM + i * 256 + lane * 4);
  }
  for (; row < TL; row += nw) {
    const int nxt = row + nw;
    if (nxt < TL) {
#pragma unroll
      for (int i = 0; i < 4; ++i) vn[i] = *(const float4*)(p.out + (size_t)nxt * DM + i * 256 + lane * 4);
    }
    float* src = p.out + (size_t)row * DM;
    float ss = 0.f;
#pragma unroll
    for (int i = 0; i < 4; ++i) ss += v[i].x * v[i].x + v[i].y * v[i].y + v[i].z * v[i].z + v[i].w * v[i].w;
    ss = wave_sum(ss);
    const float rinv = rsqrtf(ss * (1.f / 1024.f) + 1e-6f);
#pragma unroll
    for (int i = 0; i < 4; ++i) {
      float4 o;
      o.x = v[i].x * rinv * g[i].x; o.y = v[i].y * rinv * g[i].y; o.z = v[i].z * rinv * g[i].z; o.w = v[i].w * rinv * g[i].w;
      *(float4*)(src + i * 256 + lane * 4) = o;
    }
#pragma unroll
    for (int i = 0; i < 4; ++i) v[i] = vn[i];
  }
}

__global__ void __launch_bounds__(256, 2) mega(Params p) {
  __shared__ __attribute__((aligned(16))) char smem[65536];
  cg::grid_group grid = cg::this_grid();
  XbState xst; xst.x = xb_xcc_id(); xst.nloc = 0u; xst.nx = 0u;
  if (threadIdx.x == 0) {
    (void)xb_add(&p.bar[XB_XCNT(xst.x)], 1u);
    const unsigned hwid = (unsigned)__builtin_amdgcn_s_getreg((7 << 11) | (8 << 6) | 4) & 0xffu;
    const unsigned rank = xb_add(&p.bar[XB_CU((xst.x << 8) | hwid)], 1u);
    const unsigned ticket = xb_add(&p.bar[rank == 0u ? XB_N0 : XB_N1], 1u);
    p.blkinfo[blockIdx.x] = ((rank > 0u ? 1u : 0u) << 16) | (ticket & 0xffffu);
  }
  if (gridDim.x == 0x7fffffffu) grid.sync();
  phase_prep(p, smem); grid_barrier(p.bar, xst);
  phase_modreduce(p); grid_barrier(p.bar, xst);
  phase_modulate<true>(p, 0, 0, MR); grid_barrier(p.bar, xst);
  phase_qkv(p, smem); grid_barrier(p.bar, xst);
  phase_attn(p, smem); grid_barrier(p.bar, xst);
  phase_proj_res<true>(p, smem, p.H, 1024, 1024, p.wo_t, 0, 2, 264); grid_barrier(p.bar, xst);
  phase_modulate<false>(p, 0, 1, MR); grid_barrier(p.bar, xst);
  phase_ffn_up(p, smem, 0, true, p.ACT0); grid_barrier(p.bar, xst);
  phase_proj_res<false>(p, smem, p.ACT0, DFF, DFF, p.down_t, 0, 5, 264); grid_barrier(p.bar, xst);
  phase_rwkv_shift(p); grid_barrier(p.bar, xst);
  phase_rwkv_gemms(p, smem); grid_barrier(p.bar, xst);
  phase_scan2(p, smem); grid_barrier(p.bar, xst);
  phase_readout(p, smem); grid_barrier(p.bar, xst);
  phase_proj_res<false>(p, smem, p.Z, 1024, 1024, p.ro_t, 1, 2, 256); grid_barrier(p.bar, xst);
  phase_modulate<false>(p, 1, 1, TL); grid_barrier(p.bar, xst);
  phase_ffn_up(p, smem, 1, false, p.ACT1); grid_barrier(p.bar, xst);
  phase_proj_res<false>(p, smem, p.ACT1, DFF, DFF, p.down_t + (size_t)1024 * 2816, 1, 5, 256); grid_barrier(p.bar, xst);
  phase_final(p);
}

extern "C" void kernel_launch(void* const* d_in, const int* in_sizes, int n_in, void* d_out, int out_size, void* d_ws, size_t ws_size,
                              hipStream_t stream) {
  static int grid_blocks = 0;
  if (!grid_blocks) {
    int dev = 0, cus = 0, per_cu = 0;
    hipGetDevice(&dev);
    hipDeviceGetAttribute(&cus, hipDeviceAttributeMultiprocessorCount, dev);
    hipOccupancyMaxActiveBlocksPerMultiprocessor(&per_cu, mega, 256, 0);
    if (per_cu > 2) per_cu = 2;
    if (per_cu < 1) per_cu = 1;
    grid_blocks = cus * per_cu;
  }
  Params p{};
  const float* const* in = (const float* const*)d_in;
  p.x = in[0]; p.c = in[1]; p.ctx = in[2]; p.c_ctx = in[3]; p.ada_w = in[4]; p.ada_b = in[5]; p.w_qkv = in[6]; p.q_gain = in[7];
  p.k_gain = in[8]; p.w_o = in[9]; p.mu = in[10]; p.rw_r = in[11]; p.rw_k = in[12]; p.rw_v = in[13]; p.rw_o = in[14]; p.dw0 = in[15];
  p.dw1 = in[16]; p.dw2 = in[17]; p.a0 = in[18]; p.a1 = in[19]; p.a2 = in[20]; p.g1 = in[21]; p.g2 = in[22]; p.k_k = in[23];
  p.k_a = in[24]; p.r_k = in[25]; p.gn_w = in[26]; p.gn_b = in[27]; p.f_up = in[28]; p.f_cw = in[29]; p.f_cb = in[30];
  p.f_down = in[31]; p.final_gain = in[32];
  p.out = (float*)d_out;
  char* w = (char*)d_ws;
  size_t off = 0;
  auto take = [&](size_t bytes) { char* r = w + off; off += (bytes + 255) & ~(size_t)255; return r; };
  p.qkv_t = (u16*)take((size_t)1536 * 1024 * 2);
  p.wo_t = (u16*)take((size_t)1024 * 1024 * 2);
  p.up_t = (u16*)take((size_t)2 * 5632 * 1024 * 2);
  p.down_t = (u16*)take((size_t)2 * 1024 * 2816 * 2);
  p.rr_t = (u16*)take((size_t)1024 * 2048 * 2);
  p.rk_t = (u16*)take((size_t)1024 * 2048 * 2);
  p.rv_t = (u16*)take((size_t)1024 * 2048 * 2);
  p.ro_t = (u16*)take((size_t)1024 * 1024 * 2);
  p.w1_t = (u16*)take((size_t)128 * 2048 * 2);
  p.a1_t = (u16*)take((size_t)128 * 2048 * 2);
  p.g1_t = (u16*)take((size_t)256 * 2048 * 2);
  p.w2_t = (u16*)take((size_t)2 * 1024 * 64 * 2);
  p.a2_t = (u16*)take((size_t)2 * 1024 * 64 * 2);
  p.g2_t = (u16*)take((size_t)1024 * 192 * 2);
  p.modpart = (float*)take((size_t)2 * 8 * 5 * 6144 * 4);
  p.modv = (float*)take((size_t)2 * 5 * 6144 * 4);
  p.rope = (float*)take((size_t)8192 * 32 * 2 * 4);
  p.XC = (float*)take((size_t)TCX * DM * 4);
  p.bonus = (float*)take((size_t)2 * MR * 16 * 4);
  p.zero = (u16*)take(8192);
  p.bar = (unsigned*)take(65536);
  p.blkinfo = (unsigned*)take(4096 * 4);
  const size_t pb = off;
  p.H = (u16*)take((size_t)MR * DM * 2);
  const size_t after_h = off;
  p.Q = (u16*)take((size_t)TL * DM * 2);
  p.QC = (u16*)take((size_t)TCX * DM * 2);
  p.Kb = (u16*)take((size_t)16 * NKEY * 64 * 2);
  p.Vt = (u16*)take((size_t)16 * NKEY * 64 * 2);
  p.ACT0 = (u16*)take((size_t)MR * DFF * 2);
  const size_t end0 = off;
  off = after_h;
  p.XX = (u16*)take((size_t)MR * DM * 2);
  p.R16 = (f16*)take((size_t)TL * DM * 2);
  p.K16 = (f16*)take((size_t)MR * DM * 2);
  p.V16 = (f16*)take((size_t)MR * DM * 2);
  p.KK16 = (f16*)take((size_t)MR * DM * 2);
  p.LW = (u16*)take((size_t)MR * 128 * 2);
  p.LA = (u16*)take((size_t)MR * 128 * 2);
  p.LG = (u16*)take((size_t)TL * 192 * 2);
  const size_t end1 = off;
  p.Y0 = (f16*)p.H;
  p.Y1 = (f16*)p.XX;
  p.Z = (u16*)p.R16;
  p.ACT1 = (u16*)p.K16;
  (void)pb;
  const size_t need = end0 > end1 ? end0 : end1;
  if (need > ws_size) { fprintf(stderr, "workspace too small: need %zu have %zu\n", need, ws_size); return; }
  hipMemsetAsync(p.bar, 0, 65536, stream);
  void* args[] = {&p};
  hipError_t e = hipLaunchCooperativeKernel((void*)mega, dim3(grid_blocks), dim3(256), args, 0, stream);
  if (e != hipSuccess) fprintf(stderr, "cooperative launch failed: %s (grid %d)\n", hipGetErrorString(e), grid_blocks);
}
```

```cpp
#include <hip/hip_runtime.h>
#include <hip/hip_cooperative_groups.h>
#include <cstdio>
#include <cstdint>
namespace cg = cooperative_groups;

typedef unsigned short u16;
typedef _Float16 f16;
using bf16x8 = __attribute__((ext_vector_type(8))) short;
using f32x16 = __attribute__((ext_vector_type(16))) float;
using f32x4 = __attribute__((ext_vector_type(4))) float;
using u32x4 = __attribute__((ext_vector_type(4))) unsigned;
#define DI __device__ __forceinline__
DI u32x4 mk4(unsigned a, unsigned b, unsigned c, unsigned d) { u32x4 r; r[0] = a; r[1] = b; r[2] = c; r[3] = d; return r; }

constexpr int TL = 32768;
constexpr int TCX = 1024;
constexpr int MR = 33792;
constexpr int DM = 1024;
constexpr int DFF = 2816;
constexpr int NKEY = 8448;
constexpr int NPHASE = 18;
#define XB_CU(j)    (4096 + (j))
#define XB_N0       8192
#define XB_N1       8256

struct Params {
  const float *x, *c, *ctx, *c_ctx, *ada_w, *ada_b, *w_qkv, *q_gain, *k_gain, *w_o;
  const float *mu, *rw_r, *rw_k, *rw_v, *rw_o, *dw0, *dw1, *dw2, *a0, *a1, *a2, *g1, *g2, *k_k, *k_a, *r_k, *gn_w, *gn_b;
  const float *f_up, *f_cw, *f_cb, *f_down, *final_gain;
  float* out;
  u16 *qkv_t, *wo_t, *up_t, *down_t, *rr_t, *rk_t, *rv_t, *ro_t, *w1_t, *a1_t, *g1_t, *w2_t, *a2_t, *g2_t;
  float *modpart, *modv, *rope, *XC, *bonus;
  u16* zero;
  unsigned* bar;
  unsigned* blkinfo;
  u16 *H, *XX, *Q, *QC, *Kb, *Vt, *ACT0, *ACT1;
  f16 *R16, *K16, *V16, *KK16, *Y0, *Y1;
  u16 *LW, *LA, *LG, *Z;
  int phase_lo, phase_hi;
};

typedef __bf16 bf16x2_t __attribute__((ext_vector_type(2)));
typedef float f32x2 __attribute__((ext_vector_type(2)));
DI unsigned pack2(float a, float b) { f32x2 f = {a, b}; return __builtin_bit_cast(unsigned, __builtin_convertvector(f, bf16x2_t)); }
DI u16 f2bf(float x) { return (u16)(pack2(x, 0.f) & 0xffffu); }
DI float bf2f(u16 h) { return __uint_as_float(((unsigned)h) << 16); }
DI float wave_sum(float v) {
#pragma unroll
  for (int o = 32; o > 0; o >>= 1) v += __shfl_xor(v, o, 64);
  return v;
}
template <int CTRL> DI float dpp_mov(float v) { return __builtin_bit_cast(float, __builtin_amdgcn_update_dpp(0, __builtin_bit_cast(int, v), CTRL, 0xF, 0xF, true)); }
DI float dpp_sum16(float v) {
  v += dpp_mov<0x128>(v);
  v += dpp_mov<0x124>(v);
  v += dpp_mov<0x122>(v);
  v += dpp_mov<0x121>(v);
  return v;
}
DI float sum32(float v) { v = dpp_sum16(v); v += __shfl_xor(v, 16, 64); return v; }
DI float sigmoidf_(float x) { return 1.f / (1.f + __expf(-x)); }
DI float sigmoid_fast(float x) { return __builtin_amdgcn_rcpf(1.f + __expf(-x)); }
DI int midx_of(int row) { return row < TL ? (row >> 13) : 4; }
DI float* resid_ptr(const Params& p, int row) { return row < TL ? p.out + (size_t)row * DM : p.XC + (size_t)(row - TL) * DM; }
DI const float* xin_ptr(const Params& p, int row) { return row < TL ? p.x + (size_t)row * DM : p.ctx + (size_t)(row - TL) * DM; }

DI void work_range(int total, int& g0, int& gend, int& step) {
  if ((gridDim.x & 7) == 0) {
    const int x = blockIdx.x & 7, li = blockIdx.x >> 3, nl = gridDim.x >> 3;
    const int lo = (int)(((long long)total * x) >> 3), hi = (int)(((long long)total * (x + 1)) >> 3);
    g0 = lo + li; gend = hi; step = nl;
  } else { g0 = blockIdx.x; gend = total; step = gridDim.x; }
}
DI void band_decode(int g, int MT, int NT, int& mt, int& nt) {
  const int per = 8 * NT;
  const int band = g / per, r = g - band * per;
  int hb = MT - band * 8; if (hb > 8) hb = 8;
  nt = r / hb; mt = band * 8 + (r - nt * hb);
}

using GAcc = f32x4[4][4];
template <class AF, class BF>
DI void gemm_mainloop(char* smem, int nparts, int kpart, AF arow, BF brow, f32x4 (&acc)[4][4]) {
  const int tid = threadIdx.x, lane = tid & 63, wave = tid >> 6;
  const int wm = wave >> 1, wn = wave & 1;
  const int lr = tid >> 3, lc = tid & 7;
#pragma unroll
  for (int i = 0; i < 4; ++i)
#pragma unroll
    for (int j = 0; j < 4; ++j)
#pragma unroll
      for (int e = 0; e < 4; ++e) acc[i][j][e] = 0.f;
  const int csrc = (lc ^ ((lr >> 1) & 7)) * 8;
  const u16* bp[4];
  const u16* ap[4];
#pragma unroll
  for (int q = 0; q < 4; ++q) { bp[q] = brow(lr + 32 * q) + csrc; ap[q] = arow(lr + 32 * q, 0) + csrc; }
  const int nk = kpart >> 6;
  const int total = nparts * nk;
  const int sw = (lane >> 1) & 7;
  const int kq = lane >> 4;
  char* const wbase = smem + wave * 1024;
  auto stage = [&](int buf, int kk, int boff) {
#pragma unroll
    for (int q = 0; q < 4; ++q) {
      __builtin_amdgcn_global_load_lds((const unsigned*)(ap[q] + kk), (unsigned*)(wbase + buf * 32768 + q * 4096), 16, 0, 0);
      __builtin_amdgcn_global_load_lds((const unsigned*)(bp[q] + boff), (unsigned*)(wbase + buf * 32768 + 16384 + q * 4096), 16, 0, 0);
    }
  };
  __syncthreads();
  stage(0, 0, 0);
  asm volatile("s_waitcnt vmcnt(0)" ::: "memory");
  __syncthreads();
  int part = 0, kk = 0, buf = 0;
#pragma unroll 1
  for (int it = 0; it < total; ++it) {
    kk += 64;
    if (kk == kpart) {
      kk = 0; ++part;
      if (part < nparts) {
#pragma unroll
        for (int q = 0; q < 4; ++q) ap[q] = arow(lr + 32 * q, part) + csrc;
      }
    }
    if (it + 1 < total) stage(buf ^ 1, kk, part * kpart + kk);
    const u16* As = (const u16*)(smem + buf * 32768);
    const u16* Bs = As + 128 * 64;
    const u16* Ar = As + (wm * 64 + (lane & 15)) * 64;
    const u16* Br = Bs + (wn * 64 + (lane & 15)) * 64;
    bf16x8 af[2][4], bf[2][4];
    {
      const int pc = (kq ^ sw) * 8;
#pragma unroll
      for (int i = 0; i < 4; ++i) { af[0][i] = *(const bf16x8*)(Ar + i * 1024 + pc); bf[0][i] = *(const bf16x8*)(Br + i * 1024 + pc); }
    }
#pragma unroll
    for (int ks = 0; ks < 2; ++ks) {
      const int cur = ks & 1;
      if (ks + 1 < 2) {
        const int pc = ((4 + kq) ^ sw) * 8;
#pragma unroll
        for (int i = 0; i < 4; ++i) { af[1][i] = *(const bf16x8*)(Ar + i * 1024 + pc); bf[1][i] = *(const bf16x8*)(Br + i * 1024 + pc); }
      }
#pragma unroll
      for (int i = 0; i < 4; ++i)
#pragma unroll
        for (int j = 0; j < 4; ++j) acc[i][j] = __builtin_amdgcn_mfma_f32_16x16x32_bf16(af[cur][i], bf[cur][j], acc[i][j], 0, 0, 0);
      __builtin_amdgcn_sched_barrier(0);
    }
    asm volatile("s_waitcnt vmcnt(0)" ::: "memory");
    __syncthreads();
    buf ^= 1;
  }
}

template <class F>
DI void epi_direct(const f32x4 (&acc)[4][4], F f) {
  const int lane = threadIdx.x & 63, wave = threadIdx.x >> 6;
  const int wm = wave >> 1, wn = wave & 1, g = lane >> 4;
#pragma unroll
  for (int i = 0; i < 4; ++i)
#pragma unroll
    for (int j = 0; j < 4; ++j)
#pragma unroll
      for (int e = 0; e < 4; ++e) {
        const int row = wm * 64 + i * 16 + g * 4 + e;
        const int col = wn * 64 + j * 16 + (lane & 15);
        f(row, col, acc[i][j][e]);
      }
}
#define CS(r, c) Cs[(r) * 128 + (c)]
DI void acc_to_lds(float* Cs, const f32x4 (&acc)[4][4]) {
  __syncthreads();
  epi_direct(acc, [&](int r, int c, float v) { CS(r, c) = v; });
  __syncthreads();
}

struct TJob { const float* src; int srcK, srcN; u16* dst; int ld, koff; const float* mu; int Kpad, Npad; };
DI TJob get_job(const Params& p, int j) {
  TJob t; t.mu = nullptr; t.koff = 0;
  auto set = [&](const float* s, int K, int N, u16* d, int ld) { t.src = s; t.srcK = K; t.srcN = N; t.dst = d; t.ld = ld; t.Kpad = K; t.Npad = N; };
  switch (j) {
    case 4: set(p.w_qkv, 1024, 1536, p.qkv_t, 1024); break;
    case 5: set(p.w_o, 1024, 1024, p.wo_t, 1024); break;
    case 0: set(p.f_up, 1024, 5632, p.up_t, 1024); break;
    case 1: set(p.f_up + (size_t)1024 * 5632, 1024, 5632, p.up_t + (size_t)5632 * 1024, 1024); break;
    case 2: set(p.f_down, 2816, 1024, p.down_t, 2816); break;
    case 3: set(p.f_down + (size_t)2816 * 1024, 2816, 1024, p.down_t + (size_t)1024 * 2816, 2816); break;
    case 6: set(p.rw_r, 1024, 1024, p.rr_t, 2048); break;
    case 7: set(p.rw_r, 1024, 1024, p.rr_t, 2048); t.mu = p.mu + 0 * 1024; t.koff = 1024; break;
    case 8: set(p.rw_k, 1024, 1024, p.rk_t, 2048); break;
    case 9: set(p.rw_k, 1024, 1024, p.rk_t, 2048); t.mu = p.mu + 2 * 1024; t.koff = 1024; break;
    case 10: set(p.rw_v, 1024, 1024, p.rv_t, 2048); break;
    case 11: set(p.rw_v, 1024, 1024, p.rv_t, 2048); t.mu = p.mu + 3 * 1024; t.koff = 1024; break;
    case 12: set(p.rw_o, 1024, 1024, p.ro_t, 1024); break;
    case 13: set(p.dw1, 1024, 64, p.w1_t, 2048); break;
    case 14: set(p.dw1, 1024, 64, p.w1_t, 2048); t.mu = p.mu + 1 * 1024; t.koff = 1024; break;
    case 15: set(p.dw1 + 1024 * 64, 1024, 64, p.w1_t + 64 * 2048, 2048); break;
    case 16: set(p.dw1 + 1024 * 64, 1024, 64, p.w1_t + 64 * 2048, 2048); t.mu = p.mu + 1 * 1024; t.koff = 1024; break;
    case 17: set(p.a1, 1024, 64, p.a1_t, 2048); break;
    case 18: set(p.a1, 1024, 64, p.a1_t, 2048); t.mu = p.mu + 4 * 1024; t.koff = 1024; break;
    case 19: set(p.a1 + 1024 * 64, 1024, 64, p.a1_t + 64 * 2048, 2048); break;
    case 20: set(p.a1 + 1024 * 64, 1024, 64, p.a1_t + 64 * 2048, 2048); t.mu = p.mu + 4 * 1024; t.koff = 1024; break;
    case 21: set(p.g1, 1024, 160, p.g1_t, 2048); t.Npad = 256; break;
    case 22: set(p.g1, 1024, 160, p.g1_t, 2048); t.Npad = 256; t.mu = p.mu + 5 * 1024; t.koff = 1024; break;
    case 23: set(p.dw2, 64, 1024, p.w2_t, 64); break;
    case 24: set(p.dw2 + 64 * 1024, 64, 1024, p.w2_t + 1024 * 64, 64); break;
    case 25: set(p.a2, 64, 1024, p.a2_t, 64); break;
    case 26: set(p.a2 + 64 * 1024, 64, 1024, p.a2_t + 1024 * 64, 64); break;
    default: set(p.g2, 160, 1024, p.g2_t, 192); t.Kpad = 192; break;
  }
  return t;
}
constexpr int NJOBS = 28;
DI int job_tiles(const TJob& t) { return ((t.Kpad + 63) >> 6) * ((t.Npad + 63) >> 6); }

DI void phase_prep(const Params& p, char* smem) {
  const int tid = threadIdx.x;
  const int ttiles = 7024;
  const int n_mod = 2 * 24 * 8;
  const int n_rope = 1024;
  const int total = ttiles + n_mod + n_rope;
  float* tile = (float*)smem;
  if (blockIdx.x == 0) for (int e = tid; e < 4096; e += 256) p.zero[e] = 0;
  {
    auto decode = [&](int item, TJob& t, int& kt, int& nt) {
      int rem = item, j = 0;
      t = get_job(p, 0);
      while (true) { int n = job_tiles(t); if (rem < n) break; rem -= n; ++j; t = get_job(p, j); }
      const int ntn = (t.Npad + 63) >> 6;
      kt = rem / ntn; nt = rem % ntn;
    };
    auto load_tile = [&](const TJob& t, int kt, int nt, float (&v)[16]) {
#pragma unroll
      for (int i = 0; i < 16; ++i) {
        const int kl = i * 4 + (tid >> 6), nl = tid & 63;
        const int k = kt * 64 + kl, n = nt * 64 + nl;
        float x = 0.f;
        if (k < t.srcK && n < t.srcN) { x = t.src[(size_t)k * t.srcN + n]; if (t.mu) x *= t.mu[k]; }
        v[i] = x;
      }
    };
    TJob tc, tn; int ktc = 0, ntc = 0, ktn = 0, ntn_ = 0;
    float vc[16], vn[16];
    int item = blockIdx.x;
    if (item < ttiles) { decode(item, tc, ktc, ntc); load_tile(tc, ktc, ntc, vc); }
    for (; item < ttiles; item += gridDim.x) {
      const int nxt = item + gridDim.x;
      if (nxt < ttiles) { decode(nxt, tn, ktn, ntn_); load_tile(tn, ktn, ntn_, vn); }
      __syncthreads();
#pragma unroll
      for (int i = 0; i < 16; ++i) tile[(i * 4 + (tid >> 6)) * 65 + (tid & 63)] = vc[i];
      __syncthreads();
#pragma unroll
      for (int i = 0; i < 16; ++i) {
        const int nl = i * 4 + (tid >> 6), kl = tid & 63;
        const int k = ktc * 64 + kl, n = ntc * 64 + nl;
        if (k < tc.Kpad && n < tc.Npad) tc.dst[(size_t)n * tc.ld + tc.koff + k] = f2bf(tile[kl * 65 + nl]);
      }
      if (nxt < ttiles) {
        tc = tn; ktc = ktn; ntc = ntn_;
#pragma unroll
        for (int i = 0; i < 16; ++i) vc[i] = vn[i];
      }
    }
  }
  int first_other = ttiles + (int)blockIdx.x;
  for (int item = first_other; item < total; item += gridDim.x) {
    if (false) {
    } else if (item < ttiles + n_mod) {
      const int it = item - ttiles;
      const int layer = it / 192, cc = (it % 192) / 8, kc = it % 8;
      float* sil = (float*)smem;
      __syncthreads();
      for (int e = tid; e < 640; e += 256) {
        const int j = e >> 7, k = kc * 128 + (e & 127);
        const float v = j < 4 ? p.c[j * 1024 + k] : p.c_ctx[k];
        sil[e] = v / (1.f + __expf(-v));
      }
      __syncthreads();
      const int col = cc * 256 + tid;
      float a0 = 0, a1 = 0, a2 = 0, a3 = 0, a4 = 0;
      const float* w = p.ada_w + ((size_t)layer * 1024 + kc * 128) * 6144 + col;
#pragma unroll 16
      for (int k = 0; k < 128; ++k) {
        const float wv = w[(size_t)k * 6144];
        a0 += sil[k] * wv; a1 += sil[128 + k] * wv; a2 += sil[256 + k] * wv; a3 += sil[384 + k] * wv; a4 += sil[512 + k] * wv;
      }
      float* mp = p.modpart + ((size_t)(layer * 8 + kc) * 5) * 6144 + col;
      mp[0] = a0; mp[6144] = a1; mp[2 * 6144] = a2; mp[3 * 6144] = a3; mp[4 * 6144] = a4;
    } else {
      const int e = (item - ttiles - n_mod) * 256 + tid;
      const int s = e >> 5, pr = e & 31;
      const int f = pr & 15;
      const float inv_freq = powf(10000.f, -(float)f / 16.f);
      const float pos = (pr < 16) ? (float)(s >> 6) : (float)(s & 63);
      const float ang = pos * inv_freq;
      float sn, cs;
      sincosf(ang, &sn, &cs);
      p.rope[e * 2] = cs; p.rope[e * 2 + 1] = sn;
    }
  }
}

DI void phase_modreduce(const Params& p) {
  const int n = 2 * 5 * 6144;
  for (int e = blockIdx.x * 256 + threadIdx.x; e < n; e += gridDim.x * 256) {
    const int layer = e / (5 * 6144), r = e % (5 * 6144), col = r % 6144;
    float s = p.ada_b[layer * 6144 + col];
    for (int kc = 0; kc < 8; ++kc) s += p.modpart[(size_t)(layer * 8 + kc) * 5 * 6144 + r];
    p.modv[e] = s;
  }
}

template <bool FROM_INPUT>
DI void phase_modulate(const Params& p, int layer, int which, int nrows) {
  const int lane = threadIdx.x & 63;
  const int gw = blockIdx.x * 4 + (threadIdx.x >> 6), nw = gridDim.x * 4;
  auto load_row = [&](int row, float4 (&v)[4]) {
    const float* src = FROM_INPUT ? xin_ptr(p, row) : resid_ptr(p, row);
#pragma unroll
    for (int i = 0; i < 4; ++i) v[i] = *(const float4*)(src + i * 256 + lane * 4);
  };
  float4 v[4], vn[4];
  int row = gw;
  if (row < nrows) load_row(row, v);
  for (; row < nrows; row += nw) {
    const int nxt = row + nw;
    if (nxt < nrows) load_row(nxt, vn);
    const float* mv = p.modv + ((size_t)layer * 5 + midx_of(row)) * 6144 + which * 3072;
    float ss = 0.f;
#pragma unroll
    for (int i = 0; i < 4; ++i) ss += v[i].x * v[i].x + v[i].y * v[i].y + v[i].z * v[i].z + v[i].w * v[i].w;
    ss = wave_sum(ss);
    const float rinv = rsqrtf(ss * (1.f / 1024.f) + 1e-6f);
#pragma unroll
    for (int i = 0; i < 4; ++i) {
      const int col = i * 256 + lane * 4;
      const float4 sh = *(const float4*)(mv + col);
      const float4 sc = *(const float4*)(mv + 1024 + col);
      uint2 o;
      o.x = pack2(v[i].x * rinv * (1.f + sc.x) + sh.x, v[i].y * rinv * (1.f + sc.y) + sh.y);
      o.y = pack2(v[i].z * rinv * (1.f + sc.z) + sh.z, v[i].w * rinv * (1.f + sc.w) + sh.w);
      *(uint2*)(p.H + (size_t)row * DM + col) = o;
    }
#pragma unroll
    for (int i = 0; i < 4; ++i) v[i] = vn[i];
  }
}

DI void shift_load(const Params& p, int row, bool valid, int lane, f32x4 (&raw)[4]) {
  if (valid) {
    const float* src = resid_ptr(p, row);
#pragma unroll
    for (int i = 0; i < 4; ++i) raw[i] = *(const f32x4*)(src + i * 256 + lane * 4);
  }
}
DI void shift_finish(const Params& p, int row, bool valid, int lane, const f32x4 (&raw)[4], float (&h)[16]) {
  if (!valid) {
#pragma unroll
    for (int i = 0; i < 16; ++i) h[i] = 0.f;
    return;
  }
  const float* mv = p.modv + ((size_t)1 * 5 + midx_of(row)) * 6144;
  float ss = 0.f;
#pragma unroll
  for (int i = 0; i < 4; ++i) ss += raw[i][0] * raw[i][0] + raw[i][1] * raw[i][1] + raw[i][2] * raw[i][2] + raw[i][3] * raw[i][3];
  ss = wave_sum(ss);
  const float rinv = rsqrtf(ss * (1.f / 1024.f) + 1e-6f);
#pragma unroll
  for (int i = 0; i < 4; ++i) {
    const int col = i * 256 + lane * 4;
    const float4 sh = *(const float4*)(mv + col);
    const float4 sc = *(const float4*)(mv + 1024 + col);
    h[i * 4 + 0] = raw[i][0] * rinv * (1.f + sc.x) + sh.x;
    h[i * 4 + 1] = raw[i][1] * rinv * (1.f + sc.y) + sh.y;
    h[i * 4 + 2] = raw[i][2] * rinv * (1.f + sc.z) + sh.z;
    h[i * 4 + 3] = raw[i][3] * rinv * (1.f + sc.w) + sh.w;
  }
}
DI void phase_rwkv_shift(const Params& p) {
  const int lane = threadIdx.x & 63;
  const int gw = blockIdx.x * 4 + (threadIdx.x >> 6), nw = gridDim.x * 4;
  const int nitems = MR / 8;
  for (int item = gw; item < nitems; item += nw) {
    const int r0 = item * 8;
    int sb, T;
    if (r0 < TL) { sb = r0 & ~8191; T = 8192; } else { sb = TL + ((r0 - TL) & ~255); T = 256; }
    const int send = sb + T;
    float hm[16], hc[16], hn[16];
    f32x4 raw[2][4];
    shift_load(p, r0 - 1, r0 - 1 >= sb, lane, raw[0]);
    shift_load(p, r0, true, lane, raw[1]);
    shift_finish(p, r0 - 1, r0 - 1 >= sb, lane, raw[0], hm);
    shift_load(p, r0 + 1, r0 + 1 < send, lane, raw[0]);
    shift_finish(p, r0, true, lane, raw[1], hc);
#pragma unroll
    for (int j = 0; j < 8; ++j) {
      const int row = r0 + j;
      if (j < 7) shift_load(p, row + 2, row + 2 < send, lane, raw[(j & 1) ^ 1]);
      shift_finish(p, row + 1, row + 1 < send, lane, raw[j & 1], hn);
#pragma unroll
      for (int i = 0; i < 4; ++i) {
        const int col = i * 256 + lane * 4;
        float xx[4];
#pragma unroll
        for (int e = 0; e < 4; ++e) xx[e] = 0.5f * (hm[i * 4 + e] + hn[i * 4 + e]) - hc[i * 4 + e];
        uint2 o, o2;
        o.x = pack2(hc[i * 4 + 0], hc[i * 4 + 1]); o.y = pack2(hc[i * 4 + 2], hc[i * 4 + 3]);
        o2.x = pack2(xx[0], xx[1]); o2.y = pack2(xx[2], xx[3]);
        *(uint2*)(p.H + (size_t)row * DM + col) = o;
        *(uint2*)(p.XX + (size_t)row * DM + col) = o2;
      }
#pragma unroll
      for (int i = 0; i < 16; ++i) { hm[i] = hc[i]; hc[i] = hn[i]; }
    }
  }
}

DI void phase_qkv(const Params& p, char* smem) {
  float* Cs = (float*)smem;
  const int tid = threadIdx.x;
  int g0, gend, gstep; work_range(264 * 12, g0, gend, gstep);
  for (int tile = g0; tile < gend; tile += gstep) {
    int mt, nt; band_decode(tile, 264, 12, mt, nt);
    const int m0 = mt * 128;
    f32x4 acc[4][4];
    gemm_mainloop(smem, 1, 1024,
                  [&](int r, int) { return (const u16*)(p.H + (size_t)(m0 + r) * DM); },
                  [&](int c) { return (const u16*)(p.qkv_t + (size_t)(nt * 128 + c) * 1024); }, acc);
    acc_to_lds(Cs, acc);
    const bool isctx = m0 >= TL;
    const int b = isctx ? (m0 - TL) >> 8 : m0 >> 13;
    const int t0 = isctx ? (m0 - TL) & 255 : m0 & 8191;
    if (nt < 10) {
      const int lane = tid & 63, wave = tid >> 6;
      const int hh = lane >> 5, pr = lane & 31;
      const bool isq = nt < 8;
      const float* gain = isq ? p.q_gain : p.k_gain;
      const float qs = isq ? 0.125f * 1.4426950408889634f : 1.f;
      const float g0 = gain[2 * pr] * qs, g1 = gain[2 * pr + 1] * qs;
      u16* dstb;
      size_t tstride = 64;
      if (isq) {
        const int head = nt * 2 + hh;
        dstb = isctx ? p.QC + ((size_t)(b * 16 + head) * 256 + t0) * 64 : p.Q + ((size_t)(b * 16 + head) * 8192 + t0) * 64;
      } else {
        const int kh = (nt - 8) * 2 + hh;
        dstb = p.Kb + ((size_t)(b * 4 + kh) * NKEY + (isctx ? t0 : 256 + t0)) * 64;
      }
#pragma unroll 1
      for (int rb = 0; rb < 32; rb += 8) {
        float2 cssn[8];
#pragma unroll
        for (int j = 0; j < 8; ++j) cssn[j] = isctx ? make_float2(1.f, 0.f) : *(const float2*)(p.rope + ((size_t)(t0 + wave * 32 + rb + j) * 32 + pr) * 2);
#pragma unroll
        for (int j = 0; j < 8; ++j) {
          const int r = wave * 32 + rb + j;
          const float2 v = *(const float2*)&CS(r, 2 * lane);
          float ss = v.x * v.x + v.y * v.y;
          ss = sum32(ss);
          const float rinv = rsqrtf(ss * (1.f / 64.f) + 1e-6f);
          const float x0 = v.x * rinv * g0, x1 = v.y * rinv * g1;
          const float y0 = x0 * cssn[j].x - x1 * cssn[j].y, y1 = x0 * cssn[j].y + x1 * cssn[j].x;
          *(unsigned*)(dstb + (size_t)r * tstride + 2 * pr) = pack2(y0, y1);
        }
      }
    } else {
      const int keybase = (isctx ? t0 : 256 + t0);
      for (int j = 0; j < 4; ++j) {
        const int item = tid + 256 * j;
        const int d = item & 63, hh = (item >> 6) & 1, rg = item >> 7;
        const int kh = (nt - 10) * 2 + hh;
        float v[16];
#pragma unroll
        for (int i = 0; i < 16; ++i) v[i] = CS(rg * 16 + i, hh * 64 + d);
        u16* dst = p.Vt + ((size_t)(b * 4 + kh) * 64 + d) * NKEY + keybase + rg * 16;
        *(u32x4*)(dst) = mk4(pack2(v[0], v[1]), pack2(v[2], v[3]), pack2(v[8], v[9]), pack2(v[10], v[11]));
        *(u32x4*)(dst + 8) = mk4(pack2(v[4], v[5]), pack2(v[6], v[7]), pack2(v[12], v[13]), pack2(v[14], v[15]));
      }
    }
  }
}

DI void phase_attn(const Params& p, char* smem) {
  const int tid = threadIdx.x, lane = tid & 63, wave = tid >> 6;
  const int sw = (lane >> 1) & 7, hsel = lane >> 5;
  float mq = 0.f, mk = 0.f;
  for (int d = 0; d < 64; ++d) { mq = fmaxf(mq, fabsf(p.q_gain[d])); mk = fmaxf(mk, fabsf(p.k_gain[d])); }
  const float c0 = 0.125f * 1.4426950408889634f * 64.f * mq * mk * 1.02f + 0.5f;
  f32x16 negc;
#pragma unroll
  for (int i = 0; i < 16; ++i) negc[i] = -c0;
  int ga, gae, gs, gc, gce, gs2;
  work_range(2048, ga, gae, gs);
  work_range(64, gc, gce, gs2);
  const int n_lat = ga < gae ? (gae - ga + gs - 1) / gs : 0;
  const int n_ctx = gc < gce ? (gce - gc + gs2 - 1) / gs2 : 0;
  for (int wi = 0; wi < n_lat + n_ctx; ++wi) {
    const int item = wi < n_lat ? ga + wi * gs : 2048 + gc + (wi - n_lat) * gs2;
    int b, kvh, qb, nkt;
    const u16* qbase;
    size_t orow;
    const int head_g = wave;
    if (item < 2048) {
      b = item >> 9; kvh = (item >> 7) & 3; qb = item & 127; nkt = NKEY / 64;
      qbase = p.Q + ((size_t)(b * 16 + kvh * 4 + head_g) * 8192 + qb * 64) * 64;
      orow = (size_t)b * 8192 + qb * 64;
    } else {
      const int j = item - 2048;
      b = j >> 4; kvh = (j >> 2) & 3; qb = j & 3; nkt = 4;
      qbase = p.QC + ((size_t)(b * 16 + kvh * 4 + head_g) * 256 + qb * 64) * 64;
      orow = (size_t)TL + b * 256 + qb * 64;
    }
    const int head = kvh * 4 + head_g;
    bf16x8 qf[2][4];
#pragma unroll
    for (int qi = 0; qi < 2; ++qi)
#pragma unroll
      for (int ks = 0; ks < 4; ++ks) qf[qi][ks] = *(const bf16x8*)(qbase + (qi * 32 + (lane & 31)) * 64 + ks * 16 + hsel * 8);
    const u16* kg = p.Kb + (size_t)(b * 4 + kvh) * NKEY * 64;
    const u16* vg = p.Vt + (size_t)(b * 4 + kvh) * 64 * NKEY;
    f32x16 oacc[2][2];
#pragma unroll
    for (int i = 0; i < 16; ++i) { oacc[0][0][i] = 0.f; oacc[0][1][i] = 0.f; oacc[1][0][i] = 0.f; oacc[1][1][i] = 0.f; }
    f32x2 ls2[2] = {{0.f, 0.f}, {0.f, 0.f}};
    const int grow = wave * 8 + (lane >> 3);
    const int gsrc = ((lane & 7) ^ ((grow >> 1) & 7)) * 8;
    const u16* kgl = kg + (size_t)grow * 64 + gsrc;
    const u16* vgl = vg + (size_t)grow * NKEY + gsrc;
    char* const wb = smem + wave * 1024;
    auto stage_kv = [&](int kt, int buf) {
#pragma unroll
      for (int q = 0; q < 2; ++q) {
        __builtin_amdgcn_global_load_lds((const unsigned*)(kgl + (size_t)kt * 4096 + q * 32 * 64), (unsigned*)(wb + buf * 16384 + q * 4096), 16, 0, 0);
        __builtin_amdgcn_global_load_lds((const unsigned*)(vgl + (size_t)q * 32 * NKEY + kt * 64), (unsigned*)(wb + buf * 16384 + 8192 + q * 4096), 16, 0, 0);
      }
    };
    __syncthreads();
    stage_kv(0, 0);
    asm volatile("s_waitcnt vmcnt(0)" ::: "memory");
    __syncthreads();
    for (int kt = 0; kt < nkt; ++kt) {
      const int buf = kt & 1;
      if (kt + 1 < nkt) stage_kv(kt + 1, buf ^ 1);
      const u16* Ks = (const u16*)(smem + buf * 16384);
      const u16* Vs = Ks + 64 * 64;
      f32x16 sacc[2][2];
#pragma unroll
      for (int kb = 0; kb < 2; ++kb) {
        bf16x8 kf[4];
#pragma unroll
        for (int ks = 0; ks < 4; ++ks) kf[ks] = *(const bf16x8*)(Ks + (kb * 32 + (lane & 31)) * 64 + (((ks * 2 + hsel) ^ sw) * 8));
#pragma unroll
        for (int ks = 0; ks < 4; ++ks) {
          sacc[0][kb] = __builtin_amdgcn_mfma_f32_32x32x16_bf16(kf[ks], qf[0][ks], ks == 0 ? negc : sacc[0][kb], 0, 0, 0);
          sacc[1][kb] = __builtin_amdgcn_mfma_f32_32x32x16_bf16(kf[ks], qf[1][ks], ks == 0 ? negc : sacc[1][kb], 0, 0, 0);
        }
      }
#pragma unroll
      for (int qi = 0; qi < 2; ++qi)
#pragma unroll
        for (int kb = 0; kb < 2; ++kb)
#pragma unroll
          for (int i = 0; i < 16; i += 2) {
            const float e0 = __builtin_amdgcn_exp2f(sacc[qi][kb][i]), e1 = __builtin_amdgcn_exp2f(sacc[qi][kb][i + 1]);
            sacc[qi][kb][i] = e0; sacc[qi][kb][i + 1] = e1;
            const f32x2 e2 = {e0, e1};
            ls2[qi] += e2;
          }
#pragma unroll
      for (int kb = 0; kb < 2; ++kb)
#pragma unroll
        for (int s2 = 0; s2 < 2; ++s2) {
          bf16x8 vfr[2];
#pragma unroll
          for (int db = 0; db < 2; ++db) vfr[db] = *(const bf16x8*)(Vs + (db * 32 + (lane & 31)) * 64 + (((2 * (2 * kb + s2) + hsel) ^ sw) * 8));
#pragma unroll
          for (int qi = 0; qi < 2; ++qi) {
            unsigned w[4];
#pragma unroll
            for (int e = 0; e < 4; ++e) w[e] = pack2(sacc[qi][kb][8 * s2 + 2 * e], sacc[qi][kb][8 * s2 + 2 * e + 1]);
            u32x4 pw = mk4(w[0], w[1], w[2], w[3]);
            const bf16x8 pf = __builtin_bit_cast(bf16x8, pw);
#pragma unroll
            for (int db = 0; db < 2; ++db) oacc[qi][db] = __builtin_amdgcn_mfma_f32_32x32x16_bf16(vfr[db], pf, oacc[qi][db], 0, 0, 0);
          }
        }
      asm volatile("s_waitcnt vmcnt(0)" ::: "memory");
      __syncthreads();
    }
#pragma unroll
    for (int qi = 0; qi < 2; ++qi) {
      const float lsum = ls2[qi][0] + ls2[qi][1];
      const float l = lsum + __shfl_xor(lsum, 32, 64);
      const float inv = 1.f / l;
      u16* od = p.H + (orow + qi * 32 + (lane & 31)) * DM + head * 64;
#pragma unroll
      for (int db = 0; db < 2; ++db)
#pragma unroll
        for (int g = 0; g < 4; ++g) {
          uint2 o;
          o.x = pack2(oacc[qi][db][g * 4 + 0] * inv, oacc[qi][db][g * 4 + 1] * inv);
          o.y = pack2(oacc[qi][db][g * 4 + 2] * inv, oacc[qi][db][g * 4 + 3] * inv);
          *(uint2*)(od + db * 32 + 8 * g + 4 * hsel) = o;
        }
    }
  }
}

template <bool FROM_INPUT>
DI void phase_proj_res(const Params& p, char* smem, const u16* A, int lda, int K, const u16* Bt, int layer, int gate_idx, int mtiles) {
  int g0, gend, gstep; work_range(mtiles * 8, g0, gend, gstep);
  for (int tile = g0; tile < gend; tile += gstep) {
    int mt, nt; band_decode(tile, mtiles, 8, mt, nt);
    const int m0 = mt * 128;
    f32x4 acc[4][4];
    gemm_mainloop(smem, 1, K,
                  [&](int r, int) { return A + (size_t)(m0 + r) * lda; },
                  [&](int c) { return Bt + (size_t)(nt * 128 + c) * K; }, acc);
    const float* gate = p.modv + ((size_t)layer * 5 + midx_of(m0)) * 6144 + gate_idx * 1024 + nt * 128;
    const float* sb = (FROM_INPUT ? xin_ptr(p, m0) : (const float*)resid_ptr(p, m0)) + nt * 128;
    float* db = resid_ptr(p, m0) + nt * 128;
    {
      const int lane = threadIdx.x & 63, wave = threadIdx.x >> 6;
      const int wm = wave >> 1, wn = wave & 1, g4 = lane >> 4;
      float gt[4];
#pragma unroll
      for (int j = 0; j < 4; ++j) gt[j] = gate[wn * 64 + j * 16 + (lane & 15)];
#pragma unroll
      for (int i = 0; i < 4; ++i) {
        float res[4][4];
#pragma unroll
        for (int j = 0; j < 4; ++j)
#pragma unroll
          for (int e = 0; e < 4; ++e) res[j][e] = sb[(wm * 64 + i * 16 + g4 * 4 + e) * DM + wn * 64 + j * 16 + (lane & 15)];
#pragma unroll
        for (int j = 0; j < 4; ++j)
#pragma unroll
          for (int e = 0; e < 4; ++e) db[(wm * 64 + i * 16 + g4 * 4 + e) * DM + wn * 64 + j * 16 + (lane & 15)] = res[j][e] + gt[j] * acc[i][j][e];
      }
    }
  }
}

DI void phase_ffn_up(const Params& p, char* smem, int layer, bool with_ctx, u16* ACT) {
  float* Cs = (float*)smem;
  const int tid = threadIdx.x;
  const int mtiles = with_ctx ? 276 : 264;
  int g0, gend, gstep; work_range(mtiles * 44, g0, gend, gstep);
  const u16* up = p.up_t + (size_t)layer * 5632 * 1024;
  const float* cw = p.f_cw + (size_t)layer * 3 * 5632;
  const float* cb = p.f_cb + (size_t)layer * 5632;
  for (int tile = g0; tile < gend; tile += gstep) {
    int mt, nt; band_decode(tile, mtiles, 44, mt, nt);
    int rowbase, T, j;
    if (mt < 264) { rowbase = (mt / 66) * 8192; T = 8192; j = mt % 66; }
    else { const int m2 = mt - 264; rowbase = TL + (m2 / 3) * 256; T = 256; j = m2 % 3; }
    const int tb = j * 126 - 1;
    f32x4 acc[4][4];
    gemm_mainloop(smem, 1, 1024,
                  [&](int r, int) { const int t = tb + r; return (t >= 0 && t < T) ? (const u16*)(p.H + (size_t)(rowbase + t) * DM) : (const u16*)p.zero; },
                  [&](int c) { return up + (size_t)(c < 64 ? nt * 64 + c : 2816 + nt * 64 + (c - 64)) * 1024; }, acc);
    acc_to_lds(Cs, acc);
    const int c = tid & 63, rq = tid >> 6;
    const int n = nt * 64 + c;
    const float g0 = cw[n], g1 = cw[5632 + n], g2 = cw[2 * 5632 + n], gb = cb[n];
    const float v0 = cw[2816 + n], v1 = cw[5632 + 2816 + n], v2 = cw[2 * 5632 + 2816 + n], vb = cb[2816 + n];
    const int rs = 1 + rq * 32;
    int re = rs + 32; if (re > 127) re = 127;
    float gp = CS(rs - 1, c), gc = CS(rs, c), vp = CS(rs - 1, c + 64), vc = CS(rs, c + 64);
    for (int r = rs; r < re; ++r) {
      const float gn = CS(r + 1, c), vn = CS(r + 1, c + 64);
      const int t = tb + r;
      if (t < T) {
        const float g = g0 * gp + g1 * gc + g2 * gn + gb;
        const float v = v0 * vp + v1 * vc + v2 * vn + vb;
        const float a = g * __builtin_amdgcn_rcpf(1.f + __expf(-g)) * v;
        ACT[(size_t)(rowbase + t) * DFF + n] = f2bf(a);
      }
      gp = gc; gc = gn; vp = vc; vc = vn;
    }
  }
}

DI void phase_rwkv_gemms(const Params& p, char* smem) {
  float* Cs = (float*)smem;
  const int tid = threadIdx.x;
  int g0, gend, gstep; work_range(7312, g0, gend, gstep);
  for (int tile = g0; tile < gend; tile += gstep) {
    int job, mt, nt;
    const u16* Bt;
    if (tile < 2048) { job = 0; band_decode(tile, 256, 8, mt, nt); Bt = p.rr_t; }
    else if (tile < 4160) { job = 1; band_decode(tile - 2048, 264, 8, mt, nt); Bt = p.rk_t; }
    else if (tile < 6272) { job = 2; band_decode(tile - 4160, 264, 8, mt, nt); Bt = p.rv_t; }
    else if (tile < 6536) { job = 3; mt = tile - 6272; nt = 0; Bt = p.w1_t; }
    else if (tile < 6800) { job = 4; mt = tile - 6536; nt = 0; Bt = p.a1_t; }
    else { job = 5; band_decode(tile - 6800, 256, 2, mt, nt); Bt = p.g1_t; }
    const int m0 = mt * 128;
    f32x4 acc[4][4];
    gemm_mainloop(smem, 2, 1024,
                  [&](int r, int part) { return (const u16*)((part ? p.XX : p.H) + (size_t)(m0 + r) * DM); },
                  [&](int c) { return Bt + (size_t)(nt * 128 + c) * 2048; }, acc);
    if (job == 0) {
      epi_direct(acc, [&](int r, int c, float v) { p.R16[(size_t)(m0 + r) * DM + nt * 128 + c] = (f16)v; });
    } else if (job == 2) {
      epi_direct(acc, [&](int r, int c, float v) { p.V16[(size_t)(m0 + r) * DM + nt * 128 + c] = (f16)v; });
    } else if (job == 3) {
      epi_direct(acc, [&](int r, int c, float v) { p.LW[(size_t)(m0 + r) * 128 + c] = f2bf(tanhf(v)); });
    } else if (job == 4) {
      epi_direct(acc, [&](int r, int c, float v) { p.LA[(size_t)(m0 + r) * 128 + c] = f2bf(v); });
    } else if (job == 5) {
      epi_direct(acc, [&](int r, int c, float v) {
        const int col = nt * 128 + c;
        if (col < 192) p.LG[(size_t)(m0 + r) * 192 + col] = col < 160 ? f2bf(sigmoid_fast(v)) : (u16)0;
      });
    } else {
      acc_to_lds(Cs, acc);
      const int lane = tid & 63, wave = tid >> 6;
      const int col = nt * 128 + 2 * lane;
      const float kk0 = p.k_k[col], kk1 = p.k_k[col + 1];
#pragma unroll 4
      for (int rr = 0; rr < 32; ++rr) {
        const int r = wave * 32 + rr;
        const float2 v = *(const float2*)&CS(r, 2 * lane);
        const float a0 = v.x * kk0, a1 = v.y * kk1;
        float ss = a0 * a0 + a1 * a1;
        ss = sum32(ss);
        const float inv = 1.f / fmaxf(sqrtf(ss), 1e-12f);
        f16 k2[2], n2[2];
        k2[0] = (f16)v.x; k2[1] = (f16)v.y; n2[0] = (f16)(a0 * inv); n2[1] = (f16)(a1 * inv);
        *(unsigned*)(p.K16 + (size_t)(m0 + r) * DM + col) = *(const unsigned*)k2;
        *(unsigned*)(p.KK16 + (size_t)(m0 + r) * DM + col) = *(const unsigned*)n2;
      }
    }
  }
}

#define XB_TMO      128
#define XB_XCNT(j)  (256  + 64 * (j))
#define XB_XSUB(j)  (1280 + 64 * (j))
#define XB_XGEN(j)  (2304 + 64 * (j))
#define XB_TOP      3328
#define XB_TOPGEN   3392
#define XB_SPIN_CAP (1u << 20)
DI unsigned xb_ld(unsigned* p) { return __hip_atomic_load(p, __ATOMIC_RELAXED, __HIP_MEMORY_SCOPE_AGENT); }
DI unsigned xb_add(unsigned* p, unsigned v) { return __hip_atomic_fetch_add(p, v, __ATOMIC_RELAXED, __HIP_MEMORY_SCOPE_AGENT); }
DI unsigned xb_xcc_id() { return (unsigned)__builtin_amdgcn_s_getreg((3 << 11) | 20) & 0xFu; }
#define XB_SPIN(cond, bar) do { unsigned _sp = 0; while (cond) { __builtin_amdgcn_s_sleep(1); \
    if ((++_sp & 255u) == 0u) { if (xb_ld(&(bar)[XB_TMO])) break; if (_sp > XB_SPIN_CAP) { atomicAdd(&(bar)[XB_TMO], 1u); break; } } } } while (0)
struct XbState { unsigned x, nloc, nx; };
DI void xb_census(unsigned* bar, unsigned x, unsigned& nloc, unsigned& nx) {
  const unsigned G = gridDim.x;
  unsigned sum, cnt, mine, sp = 0u;
  for (;;) {
    sum = 0u; cnt = 0u; mine = 0u;
#pragma unroll
    for (unsigned j = 0; j < 16; ++j) { const unsigned c = xb_ld(&bar[XB_XCNT(j)]); sum += c; cnt += (c > 0u) ? 1u : 0u; mine = (j == x) ? c : mine; }
    if (sum == G) break;
    __builtin_amdgcn_s_sleep(1);
    if ((++sp & 255u) == 0u) { if (xb_ld(&bar[XB_TMO])) break; if (sp > XB_SPIN_CAP) { atomicAdd(&bar[XB_TMO], 1u); break; } }
  }
  nloc = mine > 0u ? mine : 1u; nx = cnt > 0u ? cnt : 1u;
}
DI void grid_barrier(unsigned* bar, XbState& st) {
  asm volatile("s_waitcnt vmcnt(0)" ::: "memory");
  __syncthreads();
  if (threadIdx.x == 0) {
    __builtin_amdgcn_s_waitcnt(0);
    if (st.nloc == 0u) xb_census(bar, st.x, st.nloc, st.nx);
    const unsigned nloc = st.nloc, nx = st.nx;
    const unsigned old = xb_add(&bar[XB_XSUB(st.x)], 1u);
    const unsigned gen = old / nloc;
    if (old + 1u == (gen + 1u) * nloc) {
      __builtin_amdgcn_fence(__ATOMIC_RELEASE, "agent");
      asm volatile("s_waitcnt vmcnt(0)" ::: "memory");
      const unsigned og = xb_add(&bar[XB_TOP], 1u);
      const unsigned tg = og / nx;
      if (og + 1u == (tg + 1u) * nx) xb_add(&bar[XB_TOPGEN], 1u);
      else XB_SPIN(xb_ld(&bar[XB_TOPGEN]) == tg, bar);
      __builtin_amdgcn_fence(__ATOMIC_ACQUIRE, "agent");
      xb_add(&bar[XB_XGEN(st.x)], 1u);
      asm volatile("s_waitcnt vmcnt(0)" ::: "memory");
    } else {
      XB_SPIN(xb_ld(&bar[XB_XGEN(st.x)]) == gen, bar);
      __builtin_amdgcn_fence(__ATOMIC_ACQUIRE, "agent");
      asm volatile("s_waitcnt vmcnt(0)" ::: "memory");
    }
  }
  __syncthreads();
}

struct ScanLds {
  float dec[2][16][64], kd[2][16][64], nk[2][16][64], bb[2][16][64], rr[2][16][64];
  float vv[2][16][16];
  float yy[2][16][16];
  float bp[2][4][16];
};

template <int DIR, bool EMIT>
DI void scan_steps(const ScanLds& L, int bsel, int c0, int myrow, int l15, f32x2& Sa, f32x2& Sb, float& ykeep) {
  f32x4 d4[2], k4[2], n4[2], b4[2], r4[2];
  float vv[2];
  auto ld = [&](int slot, int s) {
    d4[slot] = *(const f32x4*)&L.dec[bsel][s][c0];
    k4[slot] = *(const f32x4*)&L.kd[bsel][s][c0];
    n4[slot] = *(const f32x4*)&L.nk[bsel][s][c0];
    b4[slot] = *(const f32x4*)&L.bb[bsel][s][c0];
    if (EMIT) r4[slot] = *(const f32x4*)&L.rr[bsel][s][c0];
    vv[slot] = L.vv[bsel][s][myrow];
  };
  ld(0, DIR ? 15 : 0);
#pragma unroll
  for (int ss = 0; ss < 16; ++ss) {
    const int s = DIR ? 15 - ss : ss;
    const int cur = ss & 1;
    if (ss + 1 < 16) ld(cur ^ 1, DIR ? 14 - ss : ss + 1);
    const f32x2 nlo = {n4[cur][0], n4[cur][1]}, nhi = {n4[cur][2], n4[cur][3]};
    const f32x2 dlo = {d4[cur][0], d4[cur][1]}, dhi = {d4[cur][2], d4[cur][3]};
    const f32x2 klo = {k4[cur][0], k4[cur][1]}, khi = {k4[cur][2], k4[cur][3]};
    const f32x2 blo = {b4[cur][0], b4[cur][1]}, bhi = {b4[cur][2], b4[cur][3]};
    f32x2 t = Sa * nlo + Sb * nhi;
    float sa = dpp_sum16(t[0] + t[1]);
    const f32x2 sa2 = {sa, sa}, v2 = {vv[cur], vv[cur]};
    Sa = Sa * dlo + (sa2 * blo + v2 * klo);
    Sb = Sb * dhi + (sa2 * bhi + v2 * khi);
    if (EMIT) {
      const f32x2 rlo = {r4[cur][0], r4[cur][1]}, rhi = {r4[cur][2], r4[cur][3]};
      const f32x2 u = Sa * rlo + Sb * rhi;
      const float y = dpp_sum16(u[0] + u[1]);
      ykeep = (l15 == s) ? y : ykeep;
    }
  }
}

template <int DIR>
DI void scan_item(const Params& p, ScanLds& L, int b, int h, int q) {
  constexpr int dir = DIR;
  const int tid = threadIdx.x, lane = tid & 63, wave = tid >> 6;
  const int l15 = lane & 15, l4 = lane >> 4;
  const int colw = h * 64 + wave * 16 + l15;
  const int chd = wave * 16 + l15;
  bf16x8 w2f[2], a2f[2];
#pragma unroll
  for (int ks = 0; ks < 2; ++ks) {
    w2f[ks] = *(const bf16x8*)(p.w2_t + ((size_t)(dir * 1024 + colw) * 64 + ks * 32 + l4 * 8));
    a2f[ks] = *(const bf16x8*)(p.a2_t + ((size_t)(dir * 1024 + colw) * 64 + ks * 32 + l4 * 8));
  }
  const float w0c = p.dw0[dir * 1024 + colw], a0c = p.a0[dir * 1024 + colw], kac = p.k_a[colw], rkc = p.r_k[colw];
  f32x2 Sa = {0.f, 0.f}, Sb = {0.f, 0.f};
  const int myrow = wave * 4 + l4;
  const int c0 = l15 * 4;
  bf16x8 lwf[2], laf[2];
  f16 kv[4], kkv[4], rv[4];
  f16 vvr;
  auto chunk_rowbase = [&](int c, bool& isctx) -> int {
    if (c < 16) { isctx = true; const int cc = dir ? 15 - c : c; return TL + b * 256 + cc * 16; }
    isctx = false; const int cc = dir ? 511 - (c - 16) : (c - 16); return b * 8192 + cc * 16;
  };
  auto stage_load = [&](int c) {
    bool isctx; const int rb = chunk_rowbase(c, isctx);
#pragma unroll
    for (int ks = 0; ks < 2; ++ks) {
      lwf[ks] = *(const bf16x8*)(p.LW + ((size_t)(rb + l15) * 128 + dir * 64 + ks * 32 + l4 * 8));
      laf[ks] = *(const bf16x8*)(p.LA + ((size_t)(rb + l15) * 128 + dir * 64 + ks * 32 + l4 * 8));
    }
#pragma unroll
    for (int i = 0; i < 4; ++i) {
      const size_t off = (size_t)(rb + l4 * 4 + i) * DM + colw;
      kv[i] = p.K16[off]; kkv[i] = p.KK16[off];
      rv[i] = isctx ? (f16)0.f : p.R16[off];
    }
    vvr = p.V16[(size_t)(rb + (tid >> 4)) * DM + h * 64 + q * 16 + (tid & 15)];
  };
  auto stage_compute = [&](int c) {
    const int bsel = c & 1;
    f32x4 wacc = {0.f, 0.f, 0.f, 0.f}, aacc = {0.f, 0.f, 0.f, 0.f};
    wacc = __builtin_amdgcn_mfma_f32_16x16x32_bf16(lwf[0], w2f[0], wacc, 0, 0, 0);
    wacc = __builtin_amdgcn_mfma_f32_16x16x32_bf16(lwf[1], w2f[1], wacc, 0, 0, 0);
    aacc = __builtin_amdgcn_mfma_f32_16x16x32_bf16(laf[0], a2f[0], aacc, 0, 0, 0);
    aacc = __builtin_amdgcn_mfma_f32_16x16x32_bf16(laf[1], a2f[1], aacc, 0, 0, 0);
    float bpart[4];
#pragma unroll
    for (int i = 0; i < 4; ++i) {
      const int s = l4 * 4 + i;
      const float sg = sigmoid_fast(w0c + wacc[i]);
      const float dec = __expf(-0.6065306597126334f * sg);
      const float a = sigmoid_fast(a0c + aacc[i]);
      const float k = (float)kv[i], kk = (float)kkv[i], r = (float)rv[i];
      const float kd = k * (1.f + (a - 1.f) * kac);
      L.dec[bsel][s][chd] = dec;
      L.kd[bsel][s][chd] = kd;
      L.nk[bsel][s][chd] = -kk;
      L.bb[bsel][s][chd] = kk * a;
      L.rr[bsel][s][chd] = r;
      if (q == 0) bpart[i] = dpp_sum16(r * kd * rkc);
    }
    if (q == 0 && l15 == 0) {
#pragma unroll
      for (int i = 0; i < 4; ++i) L.bp[bsel][wave][l4 * 4 + i] = bpart[i];
    }
    L.vv[bsel][tid >> 4][tid & 15] = (float)vvr;
  };
  auto write_bonus = [&](int c) {
    if (q == 0 && tid < 16) {
      bool isctx; const int rb = chunk_rowbase(c, isctx);
      const int b2 = c & 1;
      p.bonus[((size_t)dir * MR + rb + tid) * 16 + h] = L.bp[b2][0][tid] + L.bp[b2][1][tid] + L.bp[b2][2][tid] + L.bp[b2][3][tid];
    }
  };
  __syncthreads();
  stage_load(0);
  stage_compute(0);
  __syncthreads();
  write_bonus(0);
  const int NCH = 528;
  float ykeep = 0.f;
#pragma unroll 1
  for (int c = 0; c < 16; ++c) {
    stage_load(c + 1);
    scan_steps<DIR, false>(L, c & 1, c0, myrow, l15, Sa, Sb, ykeep);
    stage_compute(c + 1);
    __syncthreads();
    write_bonus(c + 1);
  }
#pragma unroll 1
  for (int c = 16; c < NCH; ++c) {
    const int bsel = c & 1;
    if (c + 1 < NCH) stage_load(c + 1);
    scan_steps<DIR, true>(L, bsel, c0, myrow, l15, Sa, Sb, ykeep);
    L.yy[bsel][l15][myrow] = ykeep;
    if (c + 1 < NCH) stage_compute(c + 1);
    __syncthreads();
    {
      bool isctx; const int rb = chunk_rowbase(c, isctx);
      f16* Y = dir ? p.Y1 : p.Y0;
      Y[(size_t)(rb + (tid >> 4)) * DM + h * 64 + q * 16 + (tid & 15)] = (f16)(L.yy[bsel][tid >> 4][tid & 15] * 0.0625f);
    }
    if (c + 1 < NCH) write_bonus(c + 1);
  }
}

struct ScanLds2 {
  float dec[2][16][64], kd[2][16][64], nk[2][16][64], bb[2][16][64], rr[2][16][64];
  float vv[2][16][32];
  float yy[2][16][32];
  float bp[2][4][16];
};
DI float dpp_sum8(float v) {
  v += dpp_mov<0xB1>(v);
  v += dpp_mov<0x4E>(v);
  v += dpp_mov<0x141>(v);
  return v;
}
template <int DIR, bool EMIT>
DI void scan_steps2(const ScanLds2& L, int bsel, int c0, int myrow, int l7, f32x2 (&S)[4], float& ykA, float& ykB) {
  f32x4 d4[2][2], k4[2][2], n4[2][2], b4[2][2], r4[2][2];
  float vv[2];
  auto ld = [&](int slot, int s) {
#pragma unroll
    for (int hf = 0; hf < 2; ++hf) {
      d4[slot][hf] = *(const f32x4*)&L.dec[bsel][s][c0 + 4 * hf];
      k4[slot][hf] = *(const f32x4*)&L.kd[bsel][s][c0 + 4 * hf];
      n4[slot][hf] = *(const f32x4*)&L.nk[bsel][s][c0 + 4 * hf];
      b4[slot][hf] = *(const f32x4*)&L.bb[bsel][s][c0 + 4 * hf];
      if (EMIT) r4[slot][hf] = *(const f32x4*)&L.rr[bsel][s][c0 + 4 * hf];
    }
    vv[slot] = L.vv[bsel][s][myrow];
  };
  ld(0, DIR ? 15 : 0);
#pragma unroll
  for (int ss = 0; ss < 16; ++ss) {
    const int s = DIR ? 15 - ss : ss;
    const int cur = ss & 1;
    if (ss + 1 < 16) ld(cur ^ 1, DIR ? 14 - ss : ss + 1);
    f32x2 t = {0.f, 0.f};
#pragma unroll
    for (int i = 0; i < 4; ++i) { const f32x2 nn = {n4[cur][i >> 1][(i & 1) * 2], n4[cur][i >> 1][(i & 1) * 2 + 1]}; t += S[i] * nn; }
    const float sa = dpp_sum8(t[0] + t[1]);
    const f32x2 sa2 = {sa, sa}, v2 = {vv[cur], vv[cur]};
#pragma unroll
    for (int i = 0; i < 4; ++i) {
      const f32x2 dd = {d4[cur][i >> 1][(i & 1) * 2], d4[cur][i >> 1][(i & 1) * 2 + 1]};
      const f32x2 kk = {k4[cur][i >> 1][(i & 1) * 2], k4[cur][i >> 1][(i & 1) * 2 + 1]};
      const f32x2 bb = {b4[cur][i >> 1][(i & 1) * 2], b4[cur][i >> 1][(i & 1) * 2 + 1]};
      S[i] = S[i] * dd + (sa2 * bb + v2 * kk);
    }
    if (EMIT) {
      f32x2 u = {0.f, 0.f};
#pragma unroll
      for (int i = 0; i < 4; ++i) { const f32x2 rr = {r4[cur][i >> 1][(i & 1) * 2], r4[cur][i >> 1][(i & 1) * 2 + 1]}; u += S[i] * rr; }
      const float y = dpp_sum8(u[0] + u[1]);
      if (s < 8) ykA = (l7 == s) ? y : ykA; else ykB = (l7 == s - 8) ? y : ykB;
    }
  }
}
template <int DIR>
DI void scan_item2(const Params& p, ScanLds2& L, int b, int h, int hf) {
  constexpr int dir = DIR;
  const int tid = threadIdx.x, lane = tid & 63, wave = tid >> 6;
  const int l15 = lane & 15, l4 = lane >> 4;
  const int colw = h * 64 + wave * 16 + l15;
  const int chd = wave * 16 + l15;
  bf16x8 w2f[2], a2f[2];
#pragma unroll
  for (int ks = 0; ks < 2; ++ks) {
    w2f[ks] = *(const bf16x8*)(p.w2_t + ((size_t)(dir * 1024 + colw) * 64 + ks * 32 + l4 * 8));
    a2f[ks] = *(const bf16x8*)(p.a2_t + ((size_t)(dir * 1024 + colw) * 64 + ks * 32 + l4 * 8));
  }
  const float w0c = p.dw0[dir * 1024 + colw], a0c = p.a0[dir * 1024 + colw], kac = p.k_a[colw], rkc = p.r_k[colw];
  f32x2 S[4];
#pragma unroll
  for (int i = 0; i < 4; ++i) { S[i][0] = 0.f; S[i][1] = 0.f; }
  const int l7 = lane & 7;
  const int myrow = wave * 8 + (lane >> 3);
  const int c0 = l7 * 8;
  bf16x8 lwf[2], laf[2];
  f16 kv[4], kkv[4], rv[4];
  f16 vvr[2];
  auto chunk_rowbase = [&](int c, bool& isctx) -> int {
    if (c < 16) { isctx = true; const int cc = dir ? 15 - c : c; return TL + b * 256 + cc * 16; }
    isctx = false; const int cc = dir ? 511 - (c - 16) : (c - 16); return b * 8192 + cc * 16;
  };
  auto stage_load = [&](int c) {
    bool isctx; const int rb = chunk_rowbase(c, isctx);
#pragma unroll
    for (int ks = 0; ks < 2; ++ks) {
      lwf[ks] = *(const bf16x8*)(p.LW + ((size_t)(rb + l15) * 128 + dir * 64 + ks * 32 + l4 * 8));
      laf[ks] = *(const bf16x8*)(p.LA + ((size_t)(rb + l15) * 128 + dir * 64 + ks * 32 + l4 * 8));
    }
#pragma unroll
    for (int i = 0; i < 4; ++i) {
      const size_t off = (size_t)(rb + l4 * 4 + i) * DM + colw;
      kv[i] = p.K16[off]; kkv[i] = p.KK16[off];
      rv[i] = isctx ? (f16)0.f : p.R16[off];
    }
#pragma unroll
    for (int j = 0; j < 2; ++j) { const int e = tid + 256 * j; vvr[j] = p.V16[(size_t)(rb + (e >> 5)) * DM + h * 64 + hf * 32 + (e & 31)]; }
  };
  auto stage_compute = [&](int c) {
    const int bsel = c & 1;
    f32x4 wacc = {0.f, 0.f, 0.f, 0.f}, aacc = {0.f, 0.f, 0.f, 0.f};
    wacc = __builtin_amdgcn_mfma_f32_16x16x32_bf16(lwf[0], w2f[0], wacc, 0, 0, 0);
    wacc = __builtin_amdgcn_mfma_f32_16x16x32_bf16(lwf[1], w2f[1], wacc, 0, 0, 0);
    aacc = __builtin_amdgcn_mfma_f32_16x16x32_bf16(laf[0], a2f[0], aacc, 0, 0, 0);
    aacc = __builtin_amdgcn_mfma_f32_16x16x32_bf16(laf[1], a2f[1], aacc, 0, 0, 0);
    float bpart[4];
#pragma unroll
    for (int i = 0; i < 4; ++i) {
      const int s = l4 * 4 + i;
      const float sg = sigmoid_fast(w0c + wacc[i]);
      const float dec = __expf(-0.6065306597126334f * sg);
      const float a = sigmoid_fast(a0c + aacc[i]);
      const float k = (float)kv[i], kk = (float)kkv[i], r = (float)rv[i];
      const float kd = k * (1.f + (a - 1.f) * kac);
      L.dec[bsel][s][chd] = dec;
      L.kd[bsel][s][chd] = kd;
      L.nk[bsel][s][chd] = -kk;
      L.bb[bsel][s][chd] = kk * a;
      L.rr[bsel][s][chd] = r;
      if (hf == 0) bpart[i] = dpp_sum16(r * kd * rkc);
    }
    if (hf == 0 && l15 == 0) {
#pragma unroll
      for (int i = 0; i < 4; ++i) L.bp[bsel][wave][l4 * 4 + i] = bpart[i];
    }
#pragma unroll
    for (int j = 0; j < 2; ++j) { const int e = tid + 256 * j; L.vv[bsel][e >> 5][e & 31] = (float)vvr[j]; }
  };
  auto write_bonus = [&](int c) {
    if (hf == 0 && tid < 16) {
      bool isctx; const int rb = chunk_rowbase(c, isctx);
      const int b2 = c & 1;
      p.bonus[((size_t)dir * MR + rb + tid) * 16 + h] = L.bp[b2][0][tid] + L.bp[b2][1][tid] + L.bp[b2][2][tid] + L.bp[b2][3][tid];
    }
  };
  __syncthreads();
  stage_load(0);
  stage_compute(0);
  __syncthreads();
  write_bonus(0);
  const int NCH = 528;
  float ykA = 0.f, ykB = 0.f;
#pragma unroll 1
  for (int c = 0; c < 16; ++c) {
    stage_load(c + 1);
    scan_steps2<DIR, false>(L, c & 1, c0, myrow, l7, S, ykA, ykB);
    stage_compute(c + 1);
    __syncthreads();
    write_bonus(c + 1);
  }
#pragma unroll 1
  for (int c = 16; c < NCH; ++c) {
    const int bsel = c & 1;
    if (c + 1 < NCH) stage_load(c + 1);
    scan_steps2<DIR, true>(L, bsel, c0, myrow, l7, S, ykA, ykB);
    L.yy[bsel][l7][myrow] = ykA;
    L.yy[bsel][8 + l7][myrow] = ykB;
    if (c + 1 < NCH) stage_compute(c + 1);
    __syncthreads();
    {
      bool isctx; const int rb = chunk_rowbase(c, isctx);
      f16* Y = dir ? p.Y1 : p.Y0;
#pragma unroll
      for (int j = 0; j < 2; ++j) {
        const int e = tid + 256 * j;
        Y[(size_t)(rb + (e >> 5)) * DM + h * 64 + hf * 32 + (e & 31)] = (f16)(L.yy[bsel][e >> 5][e & 31] * 0.0625f);
      }
    }
    if (c + 1 < NCH) write_bonus(c + 1);
  }
}
DI void phase_scan2(const Params& p, char* smem) {
  ScanLds2& L = *(ScanLds2*)smem;
  const unsigned info = p.blkinfo[blockIdx.x];
  const unsigned rank = info >> 16, ticket = info & 0xffffu;
  const unsigned n0 = xb_ld(&p.bar[XB_N0]);
  const unsigned item = rank == 0u ? ticket : n0 + ticket;
  if (item < 256u) {
    const int sc = item >> 1, hf = item & 1;
    const int dir = sc & 1, bh = sc >> 1, b = bh >> 4, h = bh & 15;
    if (dir) scan_item2<1>(p, L, b, h, hf); else scan_item2<0>(p, L, b, h, hf);
  }
}

DI void phase_scan(const Params& p, char* smem) {
  ScanLds& L = *(ScanLds*)smem;
  for (int item = blockIdx.x; item < 512; item += gridDim.x) {
    int sc, q;
    if (gridDim.x == 512) { const int xcd = item & 7, slot = item >> 3; sc = xcd * 16 + (slot >> 2); q = slot & 3; }
    else { sc = item >> 2; q = item & 3; }
    const int dir = sc & 1, bh = sc >> 1, b = bh >> 4, h = bh & 15;
    if (dir) scan_item<1>(p, L, b, h, q); else scan_item<0>(p, L, b, h, q);
  }
}

DI void phase_readout(const Params& p, char* smem) {
  float* Cs = (float*)smem;
  const int tid = threadIdx.x;
  int g0, gend, gstep; work_range(256 * 8, g0, gend, gstep);
  for (int tile = g0; tile < gend; tile += gstep) {
    int mt, nt; band_decode(tile, 256, 8, mt, nt);
    const int m0 = mt * 128;
    f32x4 acc[4][4];
    gemm_mainloop(smem, 1, 192,
                  [&](int r, int) { return (const u16*)(p.LG + (size_t)(m0 + r) * 192); },
                  [&](int c) { return (const u16*)(p.g2_t + (size_t)(nt * 128 + c) * 192); }, acc);
    acc_to_lds(Cs, acc);
    const int lane = tid & 63, wave = tid >> 6;
    const int head = nt * 2 + (lane >> 5);
    const int col = nt * 128 + 2 * lane;
    const float gw0 = p.gn_w[col], gw1 = p.gn_w[col + 1], gb0 = p.gn_b[col], gb1 = p.gn_b[col + 1];
#pragma unroll 1
    for (int rb = 0; rb < 32; rb += 8) {
      unsigned ua[8], ub[8], uv[8];
      float bn[8];
#pragma unroll
      for (int j = 0; j < 8; ++j) {
        const int row = m0 + wave * 32 + rb + j;
        ua[j] = *(const unsigned*)(p.Y0 + (size_t)row * DM + col);
        ub[j] = *(const unsigned*)(p.Y1 + (size_t)row * DM + col);
        uv[j] = *(const unsigned*)(p.V16 + (size_t)row * DM + col);
        bn[j] = p.bonus[((size_t)0 * MR + row) * 16 + head] + p.bonus[((size_t)1 * MR + row) * 16 + head];
      }
#pragma unroll
      for (int j = 0; j < 8; ++j) {
        const int r = wave * 32 + rb + j;
        const int row = m0 + r;
        const f16* fa = (const f16*)&ua[j]; const f16* fb = (const f16*)&ub[j]; const f16* fv = (const f16*)&uv[j];
        const float y0 = ((float)fa[0] + (float)fb[0]) * 16.f, y1 = ((float)fa[1] + (float)fb[1]) * 16.f;
        float sm = y0 + y1;
        sm = sum32(sm);
        const float mean = sm * (1.f / 64.f);
        const float d0 = y0 - mean, d1 = y1 - mean;
        float vs = d0 * d0 + d1 * d1;
        vs = sum32(vs);
        const float rstd = rsqrtf(vs * (1.f / 64.f) + 64e-5f);
        const float2 g = *(const float2*)&CS(r, 2 * lane);
        const float z0 = (d0 * rstd * gw0 + gb0 + bn[j] * (float)fv[0]) * g.x;
        const float z1 = (d1 * rstd * gw1 + gb1 + bn[j] * (float)fv[1]) * g.y;
        *(unsigned*)(p.Z + (size_t)row * DM + col) = pack2(z0, z1);
      }
    }
  }
}

DI void phase_final(const Params& p) {
  const int lane = threadIdx.x & 63;
  const int gw = blockIdx.x * 4 + (threadIdx.x >> 6), nw = gridDim.x * 4;
  float4 g[4];
#pragma unroll
  for (int i = 0; i < 4; ++i) g[i] = *(const float4*)(p.final_gain + i * 256 + lane * 4);
  float4 v[4], vn[4];
  int row = gw;
  if (row < TL) {
#pragma unroll
    for (int i = 0; i < 4; ++i) v[i] = *(const float4*)(p.out + (size_t)row * DM + i * 256 + lane * 4);
  }
  for (; row < TL; row += nw) {
    const int nxt = row + nw;
    if (nxt < TL) {
#pragma unroll
      for (int i = 0; i < 4; ++i) vn[i] = *(const float4*)(p.out + (size_t)nxt * DM + i * 256 + lane * 4);
    }
    float* src = p.out + (size_t)row * DM;
    float ss = 0.f;
#pragma unroll
    for (int i = 0; i < 4; ++i) ss += v[i].x * v[i].x + v[i].y * v[i].y + v[i].z * v[i].z + v[i].w * v[i].w;
    ss = wave_sum(ss);
    const float rinv = rsqrtf(ss * (1.f / 1024.f) + 1e-6f);
#pragma unroll
    for (int i = 0; i < 4; ++i) {
      float4 o;
      o.x = v[i].x * rinv * g[i].x; o.y = v[i].y * rinv * g[i].y; o.z = v[i].z * rinv * g[i].z; o.w = v[i].w * rinv * g[i].w;
      *(float4*)(src + i * 256 + lane * 4) = o;
    }
#pragma unroll
    for (int i = 0; i < 4; ++i) v[i] = vn[i];
  }
}

__global__ void __launch_bounds__(256, 2) mega(Params p) {
  __shared__ __attribute__((aligned(16))) char smem[65536];
  cg::grid_group grid = cg::this_grid();
  XbState xst; xst.x = xb_xcc_id(); xst.nloc = 0u; xst.nx = 0u;
  if (threadIdx.x == 0) {
    (void)xb_add(&p.bar[XB_XCNT(xst.x)], 1u);
    const unsigned hwid = (unsigned)__builtin_amdgcn_s_getreg((7 << 11) | (8 << 6) | 4) & 0xffu;
    const unsigned rank = xb_add(&p.bar[XB_CU((xst.x << 8) | hwid)], 1u);
    const unsigned ticket = xb_add(&p.bar[rank == 0u ? XB_N0 : XB_N1], 1u);
    p.blkinfo[blockIdx.x] = ((rank > 0u ? 1u : 0u) << 16) | (ticket & 0xffffu);
  }
  if (gridDim.x == 0x7fffffffu) grid.sync();
  phase_prep(p, smem); grid_barrier(p.bar, xst);
  phase_modreduce(p); grid_barrier(p.bar, xst);
  phase_modulate<true>(p, 0, 0, MR); grid_barrier(p.bar, xst);
  phase_qkv(p, smem); grid_barrier(p.bar, xst);
  phase_attn(p, smem); grid_barrier(p.bar, xst);
  phase_proj_res<true>(p, smem, p.H, 1024, 1024, p.wo_t, 0, 2, 264); grid_barrier(p.bar, xst);
  phase_modulate<false>(p, 0, 1, MR); grid_barrier(p.bar, xst);
  phase_ffn_up(p, smem, 0, true, p.ACT0); grid_barrier(p.bar, xst);
  phase_proj_res<false>(p, smem, p.ACT0, DFF, DFF, p.down_t, 0, 5, 264); grid_barrier(p.bar, xst);
  phase_rwkv_shift(p); grid_barrier(p.bar, xst);
  phase_rwkv_gemms(p, smem); grid_barrier(p.bar, xst);
  phase_scan2(p, smem); grid_barrier(p.bar, xst);
  phase_readout(p, smem); grid_barrier(p.bar, xst);
  phase_proj_res<false>(p, smem, p.Z, 1024, 1024, p.ro_t, 1, 2, 256); grid_barrier(p.bar, xst);
  phase_modulate<false>(p, 1, 1, TL); grid_barrier(p.bar, xst);
  phase_ffn_up(p, smem, 1, false, p.ACT1); grid_barrier(p.bar, xst);
  phase_proj_res<false>(p, smem, p.ACT1, DFF, DFF, p.down_t + (size_t)1024 * 2816, 1, 5, 256); grid_barrier(p.bar, xst);
  phase_final(p);
}

extern "C" void kernel_launch(void* const* d_in, const int* in_sizes, int n_in, void* d_out, int out_size, void* d_ws, size_t ws_size,
                              hipStream_t stream) {
  static int grid_blocks = 0;
  if (!grid_blocks) {
    int dev = 0, cus = 0, per_cu = 0;
    hipGetDevice(&dev);
    hipDeviceGetAttribute(&cus, hipDeviceAttributeMultiprocessorCount, dev);
    hipOccupancyMaxActiveBlocksPerMultiprocessor(&per_cu, mega, 256, 0);
    if (per_cu > 2) per_cu = 2;
    if (per_cu < 1) per_cu = 1;
    grid_blocks = cus * per_cu;
  }
  Params p{};
  const float* const* in = (const float* const*)d_in;
  p.x = in[0]; p.c = in[1]; p.ctx = in[2]; p.c_ctx = in[3]; p.ada_w = in[4]; p.ada_b = in[5]; p.w_qkv = in[6]; p.q_gain = in[7];
  p.k_gain = in[8]; p.w_o = in[9]; p.mu = in[10]; p.rw_r = in[11]; p.rw_k = in[12]; p.rw_v = in[13]; p.rw_o = in[14]; p.dw0 = in[15];
  p.dw1 = in[16]; p.dw2 = in[17]; p.a0 = in[18]; p.a1 = in[19]; p.a2 = in[20]; p.g1 = in[21]; p.g2 = in[22]; p.k_k = in[23];
  p.k_a = in[24]; p.r_k = in[25]; p.gn_w = in[26]; p.gn_b = in[27]; p.f_up = in[28]; p.f_cw = in[29]; p.f_cb = in[30];
  p.f_down = in[31]; p.final_gain = in[32];
  p.out = (float*)d_out;
  char* w = (char*)d_ws;
  size_t off = 0;
  auto take = [&](size_t bytes) { char* r = w + off; off += (bytes + 255) & ~(size_t)255; return r; };
  p.qkv_t = (u16*)take((size_t)1536 * 1024 * 2);
  p.wo_t = (u16*)take((size_t)1024 * 1024 * 2);
  p.up_t = (u16*)take((size_t)2 * 5632 * 1024 * 2);
  p.down_t = (u16*)take((size_t)2 * 1024 * 2816 * 2);
  p.rr_t = (u16*)take((size_t)1024 * 2048 * 2);
  p.rk_t = (u16*)take((size_t)1024 * 2048 * 2);
  p.rv_t = (u16*)take((size_t)1024 * 2048 * 2);
  p.ro_t = (u16*)take((size_t)1024 * 1024 * 2);
  p.w1_t = (u16*)take((size_t)128 * 2048 * 2);
  p.a1_t = (u16*)take((size_t)128 * 2048 * 2);
  p.g1_t = (u16*)take((size_t)256 * 2048 * 2);
  p.w2_t = (u16*)take((size_t)2 * 1024 * 64 * 2);
  p.a2_t = (u16*)take((size_t)2 * 1024 * 64 * 2);
  p.g2_t = (u16*)take((size_t)1024 * 192 * 2);
  p.modpart = (float*)take((size_t)2 * 8 * 5 * 6144 * 4);
  p.modv = (float*)take((size_t)2 * 5 * 6144 * 4);
  p.rope = (float*)take((size_t)8192 * 32 * 2 * 4);
  p.XC = (float*)take((size_t)TCX * DM * 4);
  p.bonus = (float*)take((size_t)2 * MR * 16 * 4);
  p.zero = (u16*)take(8192);
  p.bar = (unsigned*)take(65536);
  p.blkinfo = (unsigned*)take(4096 * 4);
  const size_t pb = off;
  p.H = (u16*)take((size_t)MR * DM * 2);
  const size_t after_h = off;
  p.Q = (u16*)take((size_t)TL * DM * 2);
  p.QC = (u16*)take((size_t)TCX * DM * 2);
  p.Kb = (u16*)take((size_t)16 * NKEY * 64 * 2);
  p.Vt = (u16*)take((size_t)16 * NKEY * 64 * 2);
  p.ACT0 = (u16*)take((size_t)MR * DFF * 2);
  const size_t end0 = off;
  off = after_h;
  p.XX = (u16*)take((size_t)MR * DM * 2);
  p.R16 = (f16*)take((size_t)TL * DM * 2);
  p.K16 = (f16*)take((size_t)MR * DM * 2);
  p.V16 = (f16*)take((size_t)MR * DM * 2);
  p.KK16 = (f16*)take((size_t)MR * DM * 2);
  p.LW = (u16*)take((size_t)MR * 128 * 2);
  p.LA = (u16*)take((size_t)MR * 128 * 2);
  p.LG = (u16*)take((size_t)TL * 192 * 2);
  const size_t end1 = off;
  p.Y0 = (f16*)p.H;
  p.Y1 = (f16*)p.XX;
  p.Z = (u16*)p.R16;
  p.ACT1 = (u16*)p.K16;
  (void)pb;
  const size_t need = end0 > end1 ? end0 : end1;
  if (need > ws_size) { fprintf(stderr, "workspace too small: need %zu have %zu\n", need, ws_size); return; }
  hipMemsetAsync(p.bar, 0, 65536, stream);
  void* args[] = {&p};
  hipError_t e = hipLaunchCooperativeKernel((void*)mega, dim3(grid_blocks), dim3(256), args, 0, stream);
  if (e != hipSuccess) fprintf(stderr, "cooperative launch failed: %s (grid %d)\n", hipGetErrorString(e), grid_blocks);
}
```

```cpp
#include <hip/hip_runtime.h>
#include <hip/hip_cooperative_groups.h>
#include <cstdio>
#include <cstdint>
namespace cg = cooperative_groups;

typedef unsigned short u16;
typedef _Float16 f16;
using bf16x8 = __attribute__((ext_vector_type(8))) short;
using f32x16 = __attribute__((ext_vector_type(16))) float;
using f32x4 = __attribute__((ext_vector_type(4))) float;
using u32x4 = __attribute__((ext_vector_type(4))) unsigned;
#define DI __device__ __forceinline__
DI u32x4 mk4(unsigned a, unsigned b, unsigned c, unsigned d) { u32x4 r; r[0] = a; r[1] = b; r[2] = c; r[3] = d; return r; }

constexpr int TL = 32768;
constexpr int TCX = 1024;
constexpr int MR = 33792;
constexpr int DM = 1024;
constexpr int DFF = 2816;
constexpr int NKEY = 8448;
constexpr int NPHASE = 18;
#define XB_CU(j)    (4096 + (j))
#define XB_N0       8192
#define XB_N1       8256

struct Params {
  const float *x, *c, *ctx, *c_ctx, *ada_w, *ada_b, *w_qkv, *q_gain, *k_gain, *w_o;
  const float *mu, *rw_r, *rw_k, *rw_v, *rw_o, *dw0, *dw1, *dw2, *a0, *a1, *a2, *g1, *g2, *k_k, *k_a, *r_k, *gn_w, *gn_b;
  const float *f_up, *f_cw, *f_cb, *f_down, *final_gain;
  float* out;
  u16 *qkv_t, *wo_t, *up_t, *down_t, *rr_t, *rk_t, *rv_t, *ro_t, *w1_t, *a1_t, *g1_t, *w2_t, *a2_t, *g2_t;
  float *modpart, *modv, *rope, *XC, *bonus;
  u16* zero;
  unsigned* bar;
  unsigned* blkinfo;
  u16 *H, *XX, *Q, *QC, *Kb, *Vt, *ACT0, *ACT1;
  f16 *R16, *K16, *V16, *KK16, *Y0, *Y1;
  u16 *LW, *LA, *LG, *Z;
  int phase_lo, phase_hi;
};

typedef __bf16 bf16x2_t __attribute__((ext_vector_type(2)));
typedef float f32x2 __attribute__((ext_vector_type(2)));
DI unsigned pack2(float a, float b) { f32x2 f = {a, b}; return __builtin_bit_cast(unsigned, __builtin_convertvector(f, bf16x2_t)); }
DI u16 f2bf(float x) { return (u16)(pack2(x, 0.f) & 0xffffu); }
DI float bf2f(u16 h) { return __uint_as_float(((unsigned)h) << 16); }
DI float wave_sum(float v) {
#pragma unroll
  for (int o = 32; o > 0; o >>= 1) v += __shfl_xor(v, o, 64);
  return v;
}
template <int CTRL> DI float dpp_mov(float v) { return __builtin_bit_cast(float, __builtin_amdgcn_update_dpp(0, __builtin_bit_cast(int, v), CTRL, 0xF, 0xF, true)); }
DI float dpp_sum16(float v) {
  v += dpp_mov<0x128>(v);
  v += dpp_mov<0x124>(v);
  v += dpp_mov<0x122>(v);
  v += dpp_mov<0x121>(v);
  return v;
}
DI float sum32(float v) { v = dpp_sum16(v); v += __shfl_xor(v, 16, 64); return v; }
DI float sigmoidf_(float x) { return 1.f / (1.f + __expf(-x)); }
DI float sigmoid_fast(float x) { return __builtin_amdgcn_rcpf(1.f + __expf(-x)); }
DI int midx_of(int row) { return row < TL ? (row >> 13) : 4; }
DI float* resid_ptr(const Params& p, int row) { return row < TL ? p.out + (size_t)row * DM : p.XC + (size_t)(row - TL) * DM; }
DI const float* xin_ptr(const Params& p, int row) { return row < TL ? p.x + (size_t)row * DM : p.ctx + (size_t)(row - TL) * DM; }

DI void work_range(int total, int& g0, int& gend, int& step) {
  if ((gridDim.x & 7) == 0) {
    const int x = blockIdx.x & 7, li = blockIdx.x >> 3, nl = gridDim.x >> 3;
    const int lo = (int)(((long long)total * x) >> 3), hi = (int)(((long long)total * (x + 1)) >> 3);
    g0 = lo + li; gend = hi; step = nl;
  } else { g0 = blockIdx.x; gend = total; step = gridDim.x; }
}
DI void band_decode(int g, int MT, int NT, int& mt, int& nt) {
  const int per = 8 * NT;
  const int band = g / per, r = g - band * per;
  int hb = MT - band * 8; if (hb > 8) hb = 8;
  nt = r / hb; mt = band * 8 + (r - nt * hb);
}

using GAcc = f32x4[4][4];
template <class AF, class BF>
DI void gemm_mainloop(char* smem, int nparts, int kpart, AF arow, BF brow, f32x4 (&acc)[4][4]) {
  const int tid = threadIdx.x, lane = tid & 63, wave = tid >> 6;
  const int wm = wave >> 1, wn = wave & 1;
  const int lr = tid >> 3, lc = tid & 7;
#pragma unroll
  for (int i = 0; i < 4; ++i)
#pragma unroll
    for (int j = 0; j < 4; ++j)
#pragma unroll
      for (int e = 0; e < 4; ++e) acc[i][j][e] = 0.f;
  const int csrc = (lc ^ ((lr >> 1) & 7)) * 8;
  const u16* bp[4];
  const u16* ap[4];
#pragma unroll
  for (int q = 0; q < 4; ++q) { bp[q] = brow(lr + 32 * q) + csrc; ap[q] = arow(lr + 32 * q, 0) + csrc; }
  const int nk = kpart >> 6;
  const int total = nparts * nk;
  const int sw = (lane >> 1) & 7;
  const int kq = lane >> 4;
  char* const wbase = smem + wave * 1024;
  auto stage = [&](int buf, int kk, int boff) {
#pragma unroll
    for (int q = 0; q < 4; ++q) {
      __builtin_amdgcn_global_load_lds((const unsigned*)(ap[q] + kk), (unsigned*)(wbase + buf * 32768 + q * 4096), 16, 0, 0);
      __builtin_amdgcn_global_load_lds((const unsigned*)(bp[q] + boff), (unsigned*)(wbase + buf * 32768 + 16384 + q * 4096), 16, 0, 0);
    }
  };
  __syncthreads();
  stage(0, 0, 0);
  asm volatile("s_waitcnt vmcnt(0)" ::: "memory");
  __syncthreads();
  int part = 0, kk = 0, buf = 0;
#pragma unroll 1
  for (int it = 0; it < total; ++it) {
    kk += 64;
    if (kk == kpart) {
      kk = 0; ++part;
      if (part < nparts) {
#pragma unroll
        for (int q = 0; q < 4; ++q) ap[q] = arow(lr + 32 * q, part) + csrc;
      }
    }
    if (it + 1 < total) stage(buf ^ 1, kk, part * kpart + kk);
    const u16* As = (const u16*)(smem + buf * 32768);
    const u16* Bs = As + 128 * 64;
    const u16* Ar = As + (wm * 64 + (lane & 15)) * 64;
    const u16* Br = Bs + (wn * 64 + (lane & 15)) * 64;
    bf16x8 af[2][4], bf[2][4];
    {
      const int pc = (kq ^ sw) * 8;
#pragma unroll
      for (int i = 0; i < 4; ++i) { af[0][i] = *(const bf16x8*)(Ar + i * 1024 + pc); bf[0][i] = *(const bf16x8*)(Br + i * 1024 + pc); }
    }
#pragma unroll
    for (int ks = 0; ks < 2; ++ks) {
      const int cur = ks & 1;
      if (ks + 1 < 2) {
        const int pc = ((4 + kq) ^ sw) * 8;
#pragma unroll
        for (int i = 0; i < 4; ++i) { af[1][i] = *(const bf16x8*)(Ar + i * 1024 + pc); bf[1][i] = *(const bf16x8*)(Br + i * 1024 + pc); }
      }
#pragma unroll
      for (int i = 0; i < 4; ++i)
#pragma unroll
        for (int j = 0; j < 4; ++j) acc[i][j] = __builtin_amdgcn_mfma_f32_16x16x32_bf16(af[cur][i], bf[cur][j], acc[i][j], 0, 0, 0);
      __builtin_amdgcn_sched_barrier(0);
    }
    asm volatile("s_waitcnt vmcnt(0)" ::: "memory");
    __syncthreads();
    buf ^= 1;
  }
}

template <class F>
DI void epi_direct(const f32x4 (&acc)[4][4], F f) {
  const int lane = threadIdx.x & 63, wave = threadIdx.x >> 6;
  const int wm = wave >> 1, wn = wave & 1, g = lane >> 4;
#pragma unroll
  for (int i = 0; i < 4; ++i)
#pragma unroll
    for (int j = 0; j < 4; ++j)
#pragma unroll
      for (int e = 0; e < 4; ++e) {
        const int row = wm * 64 + i * 16 + g * 4 + e;
        const int col = wn * 64 + j * 16 + (lane & 15);
        f(row, col, acc[i][j][e]);
      }
}
#define CS(r, c) Cs[(r) * 128 + (c)]
DI void acc_to_lds(float* Cs, const f32x4 (&acc)[4][4]) {
  __syncthreads();
  epi_direct(acc, [&](int r, int c, float v) { CS(r, c) = v; });
  __syncthreads();
}

struct TJob { const float* src; int srcK, srcN; u16* dst; int ld, koff; const float* mu; int Kpad, Npad; };
DI TJob get_job(const Params& p, int j) {
  TJob t; t.mu = nullptr; t.koff = 0;
  auto set = [&](const float* s, int K, int N, u16* d, int ld) { t.src = s; t.srcK = K; t.srcN = N; t.dst = d; t.ld = ld; t.Kpad = K; t.Npad = N; };
  switch (j) {
    case 4: set(p.w_qkv, 1024, 1536, p.qkv_t, 1024); break;
    case 5: set(p.w_o, 1024, 1024, p.wo_t, 1024); break;
    case 0: set(p.f_up, 1024, 5632, p.up_t, 1024); break;
    case 1: set(p.f_up + (size_t)1024 * 5632, 1024, 5632, p.up_t + (size_t)5632 * 1024, 1024); break;
    case 2: set(p.f_down, 2816, 1024, p.down_t, 2816); break;
    case 3: set(p.f_down + (size_t)2816 * 1024, 2816, 1024, p.down_t + (size_t)1024 * 2816, 2816); break;
    case 6: set(p.rw_r, 1024, 1024, p.rr_t, 2048); break;
    case 7: set(p.rw_r, 1024, 1024, p.rr_t, 2048); t.mu = p.mu + 0 * 1024; t.koff = 1024; break;
    case 8: set(p.rw_k, 1024, 1024, p.rk_t, 2048); break;
    case 9: set(p.rw_k, 1024, 1024, p.rk_t, 2048); t.mu = p.mu + 2 * 1024; t.koff = 1024; break;
    case 10: set(p.rw_v, 1024, 1024, p.rv_t, 2048); break;
    case 11: set(p.rw_v, 1024, 1024, p.rv_t, 2048); t.mu = p.mu + 3 * 1024; t.koff = 1024; break;
    case 12: set(p.rw_o, 1024, 1024, p.ro_t, 1024); break;
    case 13: set(p.dw1, 1024, 64, p.w1_t, 2048); break;
    case 14: set(p.dw1, 1024, 64, p.w1_t, 2048); t.mu = p.mu + 1 * 1024; t.koff = 1024; break;
    case 15: set(p.dw1 + 1024 * 64, 1024, 64, p.w1_t + 64 * 2048, 2048); break;
    case 16: set(p.dw1 + 1024 * 64, 1024, 64, p.w1_t + 64 * 2048, 2048); t.mu = p.mu + 1 * 1024; t.koff = 1024; break;
    case 17: set(p.a1, 1024, 64, p.a1_t, 2048); break;
    case 18: set(p.a1, 1024, 64, p.a1_t, 2048); t.mu = p.mu + 4 * 1024; t.koff = 1024; break;
    case 19: set(p.a1 + 1024 * 64, 1024, 64, p.a1_t + 64 * 2048, 2048); break;
    case 20: set(p.a1 + 1024 * 64, 1024, 64, p.a1_t + 64 * 2048, 2048); t.mu = p.mu + 4 * 1024; t.koff = 1024; break;
    case 21: set(p.g1, 1024, 160, p.g1_t, 2048); t.Npad = 256; break;
    case 22: set(p.g1, 1024, 160, p.g1_t, 2048); t.Npad = 256; t.mu = p.mu + 5 * 1024; t.koff = 1024; break;
    case 23: set(p.dw2, 64, 1024, p.w2_t, 64); break;
    case 24: set(p.dw2 + 64 * 1024, 64, 1024, p.w2_t + 1024 * 64, 64); break;
    case 25: set(p.a2, 64, 1024, p.a2_t, 64); break;
    case 26: set(p.a2 + 64 * 1024, 64, 1024, p.a2_t + 1024 * 64, 64); break;
    default: set(p.g2, 160, 1024, p.g2_t, 192); t.Kpad = 192; break;
  }
  return t;
}
constexpr int NJOBS = 28;
DI int job_tiles(const TJob& t) { return ((t.Kpad + 63) >> 6) * ((t.Npad + 63) >> 6); }

DI void phase_prep(const Params& p, char* smem) {
  const int tid = threadIdx.x;
  const int ttiles = 7024;
  const int n_mod = 2 * 24 * 8;
  const int n_rope = 1024;
  const int total = ttiles + n_mod + n_rope;
  float* tile = (float*)smem;
  if (blockIdx.x == 0) for (int e = tid; e < 4096; e += 256) p.zero[e] = 0;
  {
    auto decode = [&](int item, TJob& t, int& kt, int& nt) {
      int rem = item, j = 0;
      t = get_job(p, 0);
      while (true) { int n = job_tiles(t); if (rem < n) break; rem -= n; ++j; t = get_job(p, j); }
      const int ntn = (t.Npad + 63) >> 6;
      kt = rem / ntn; nt = rem % ntn;
    };
    auto load_tile = [&](const TJob& t, int kt, int nt, float (&v)[16]) {
#pragma unroll
      for (int i = 0; i < 16; ++i) {
        const int kl = i * 4 + (tid >> 6), nl = tid & 63;
        const int k = kt * 64 + kl, n = nt * 64 + nl;
        float x = 0.f;
        if (k < t.srcK && n < t.srcN) { x = t.src[(size_t)k * t.srcN + n]; if (t.mu) x *= t.mu[k]; }
        v[i] = x;
      }
    };
    TJob tc, tn; int ktc = 0, ntc = 0, ktn = 0, ntn_ = 0;
    float vc[16], vn[16];
    int item = blockIdx.x;
    if (item < ttiles) { decode(item, tc, ktc, ntc); load_tile(tc, ktc, ntc, vc); }
    for (; item < ttiles; item += gridDim.x) {
      const int nxt = item + gridDim.x;
      if (nxt < ttiles) { decode(nxt, tn, ktn, ntn_); load_tile(tn, ktn, ntn_, vn); }
      __syncthreads();
#pragma unroll
      for (int i = 0; i < 16; ++i) tile[(i * 4 + (tid >> 6)) * 65 + (tid & 63)] = vc[i];
      __syncthreads();
#pragma unroll
      for (int i = 0; i < 16; ++i) {
        const int nl = i * 4 + (tid >> 6), kl = tid & 63;
        const int k = ktc * 64 + kl, n = ntc * 64 + nl;
        if (k < tc.Kpad && n < tc.Npad) tc.dst[(size_t)n * tc.ld + tc.koff + k] = f2bf(tile[kl * 65 + nl]);
      }
      if (nxt < ttiles) {
        tc = tn; ktc = ktn; ntc = ntn_;
#pragma unroll
        for (int i = 0; i < 16; ++i) vc[i] = vn[i];
      }
    }
  }
  int first_other = ttiles + (int)blockIdx.x;
  for (int item = first_other; item < total; item += gridDim.x) {
    if (false) {
    } else if (item < ttiles + n_mod) {
      const int it = item - ttiles;
      const int layer = it / 192, cc = (it % 192) / 8, kc = it % 8;
      float* sil = (float*)smem;
      __syncthreads();
      for (int e = tid; e < 640; e += 256) {
        const int j = e >> 7, k = kc * 128 + (e & 127);
        const float v = j < 4 ? p.c[j * 1024 + k] : p.c_ctx[k];
        sil[e] = v / (1.f + __expf(-v));
      }
      __syncthreads();
      const int col = cc * 256 + tid;
      float a0 = 0, a1 = 0, a2 = 0, a3 = 0, a4 = 0;
      const float* w = p.ada_w + ((size_t)layer * 1024 + kc * 128) * 6144 + col;
#pragma unroll 16
      for (int k = 0; k < 128; ++k) {
        const float wv = w[(size_t)k * 6144];
        a0 += sil[k] * wv; a1 += sil[128 + k] * wv; a2 += sil[256 + k] * wv; a3 += sil[384 + k] * wv; a4 += sil[512 + k] * wv;
      }
      float* mp = p.modpart + ((size_t)(layer * 8 + kc) * 5) * 6144 + col;
      mp[0] = a0; mp[6144] = a1; mp[2 * 6144] = a2; mp[3 * 6144] = a3; mp[4 * 6144] = a4;
    } else {
      const int e = (item - ttiles - n_mod) * 256 + tid;
      const int s = e >> 5, pr = e & 31;
      const int f = pr & 15;
      const float inv_freq = powf(10000.f, -(float)f / 16.f);
      const float pos = (pr < 16) ? (float)(s >> 6) : (float)(s & 63);
      const float ang = pos * inv_freq;
      float sn, cs;
      sincosf(ang, &sn, &cs);
      p.rope[e * 2] = cs; p.rope[e * 2 + 1] = sn;
    }
  }
}

DI void phase_modreduce(const Params& p) {
  const int n = 2 * 5 * 6144;
  for (int e = blockIdx.x * 256 + threadIdx.x; e < n; e += gridDim.x * 256) {
    const int layer = e / (5 * 6144), r = e % (5 * 6144), col = r % 6144;
    float s = p.ada_b[layer * 6144 + col];
    for (int kc = 0; kc < 8; ++kc) s += p.modpart[(size_t)(layer * 8 + kc) * 5 * 6144 + r];
    p.modv[e] = s;
  }
}

template <bool FROM_INPUT>
DI void phase_modulate(const Params& p, int layer, int which, int nrows) {
  const int lane = threadIdx.x & 63;
  const int gw = blockIdx.x * 4 + (threadIdx.x >> 6), nw = gridDim.x * 4;
  auto load_row = [&](int row, f32x4 (&v)[4], f32x4 (&sh)[4], f32x4 (&sc)[4]) {
    const float* src = FROM_INPUT ? xin_ptr(p, row) : resid_ptr(p, row);
    const float* mv = p.modv + ((size_t)layer * 5 + midx_of(row)) * 6144 + which * 3072;
#pragma unroll
    for (int i = 0; i < 4; ++i) {
      v[i] = *(const f32x4*)(src + i * 256 + lane * 4);
      sh[i] = *(const f32x4*)(mv + i * 256 + lane * 4);
      sc[i] = *(const f32x4*)(mv + 1024 + i * 256 + lane * 4);
    }
  };
  f32x4 v[4], sh[4], sc[4], vn[4], shn[4], scn[4];
  int row = gw;
  if (row < nrows) load_row(row, v, sh, sc);
  for (; row < nrows; row += nw) {
    const int nxt = row + nw;
    if (nxt < nrows) load_row(nxt, vn, shn, scn);
    float ss = 0.f;
#pragma unroll
    for (int i = 0; i < 4; ++i) ss += v[i][0] * v[i][0] + v[i][1] * v[i][1] + v[i][2] * v[i][2] + v[i][3] * v[i][3];
    ss = wave_sum(ss);
    const float rinv = rsqrtf(ss * (1.f / 1024.f) + 1e-6f);
#pragma unroll
    for (int i = 0; i < 4; ++i) {
      const int col = i * 256 + lane * 4;
      uint2 o;
      o.x = pack2(v[i][0] * rinv * (1.f + sc[i][0]) + sh[i][0], v[i][1] * rinv * (1.f + sc[i][1]) + sh[i][1]);
      o.y = pack2(v[i][2] * rinv * (1.f + sc[i][2]) + sh[i][2], v[i][3] * rinv * (1.f + sc[i][3]) + sh[i][3]);
      *(uint2*)(p.H + (size_t)row * DM + col) = o;
    }
#pragma unroll
    for (int i = 0; i < 4; ++i) { v[i] = vn[i]; sh[i] = shn[i]; sc[i] = scn[i]; }
  }
}

DI void shift_load(const Params& p, int row, bool valid, int lane, f32x4 (&raw)[4]) {
  if (valid) {
    const float* src = resid_ptr(p, row);
#pragma unroll
    for (int i = 0; i < 4; ++i) raw[i] = *(const f32x4*)(src + i * 256 + lane * 4);
  }
}
DI void shift_finish(const Params& p, int row, bool valid, int lane, const f32x4 (&raw)[4], float (&h)[16]) {
  if (!valid) {
#pragma unroll
    for (int i = 0; i < 16; ++i) h[i] = 0.f;
    return;
  }
  const float* mv = p.modv + ((size_t)1 * 5 + midx_of(row)) * 6144;
  float ss = 0.f;
#pragma unroll
  for (int i = 0; i < 4; ++i) ss += raw[i][0] * raw[i][0] + raw[i][1] * raw[i][1] + raw[i][2] * raw[i][2] + raw[i][3] * raw[i][3];
  ss = wave_sum(ss);
  const float rinv = rsqrtf(ss * (1.f / 1024.f) + 1e-6f);
#pragma unroll
  for (int i = 0; i < 4; ++i) {
    const int col = i * 256 + lane * 4;
    const float4 sh = *(const float4*)(mv + col);
    const float4 sc = *(const float4*)(mv + 1024 + col);
    h[i * 4 + 0] = raw[i][0] * rinv * (1.f + sc.x) + sh.x;
    h[i * 4 + 1] = raw[i][1] * rinv * (1.f + sc.y) + sh.y;
    h[i * 4 + 2] = raw[i][2] * rinv * (1.f + sc.z) + sh.z;
    h[i * 4 + 3] = raw[i][3] * rinv * (1.f + sc.w) + sh.w;
  }
}
DI void phase_rwkv_shift(const Params& p) {
  const int lane = threadIdx.x & 63;
  const int gw = blockIdx.x * 4 + (threadIdx.x >> 6), nw = gridDim.x * 4;
  const int nitems = MR / 8;
  for (int item = gw; item < nitems; item += nw) {
    const int r0 = item * 8;
    int sb, T;
    if (r0 < TL) { sb = r0 & ~8191; T = 8192; } else { sb = TL + ((r0 - TL) & ~255); T = 256; }
    const int send = sb + T;
    float hm[16], hc[16], hn[16];
    f32x4 raw[2][4];
    shift_load(p, r0 - 1, r0 - 1 >= sb, lane, raw[0]);
    shift_load(p, r0, true, lane, raw[1]);
    shift_finish(p, r0 - 1, r0 - 1 >= sb, lane, raw[0], hm);
    shift_load(p, r0 + 1, r0 + 1 < send, lane, raw[0]);
    shift_finish(p, r0, true, lane, raw[1], hc);
#pragma unroll
    for (int j = 0; j < 8; ++j) {
      const int row = r0 + j;
      if (j < 7) shift_load(p, row + 2, row + 2 < send, lane, raw[(j & 1) ^ 1]);
      shift_finish(p, row + 1, row + 1 < send, lane, raw[j & 1], hn);
#pragma unroll
      for (int i = 0; i < 4; ++i) {
        const int col = i * 256 + lane * 4;
        float xx[4];
#pragma unroll
        for (int e = 0; e < 4; ++e) xx[e] = 0.5f * (hm[i * 4 + e] + hn[i * 4 + e]) - hc[i * 4 + e];
        uint2 o, o2;
        o.x = pack2(hc[i * 4 + 0], hc[i * 4 + 1]); o.y = pack2(hc[i * 4 + 2], hc[i * 4 + 3]);
        o2.x = pack2(xx[0], xx[1]); o2.y = pack2(xx[2], xx[3]);
        *(uint2*)(p.H + (size_t)row * DM + col) = o;
        *(uint2*)(p.XX + (size_t)row * DM + col) = o2;
      }
#pragma unroll
      for (int i = 0; i < 16; ++i) { hm[i] = hc[i]; hc[i] = hn[i]; }
    }
  }
}

DI void phase_qkv(const Params& p, char* smem) {
  float* Cs = (float*)smem;
  const int tid = threadIdx.x;
  int g0, gend, gstep; work_range(264 * 12, g0, gend, gstep);
  for (int tile = g0; tile < gend; tile += gstep) {
    int mt, nt; band_decode(tile, 264, 12, mt, nt);
    const int m0 = mt * 128;
    f32x4 acc[4][4];
    gemm_mainloop(smem, 1, 1024,
                  [&](int r, int) { return (const u16*)(p.H + (size_t)(m0 + r) * DM); },
                  [&](int c) { return (const u16*)(p.qkv_t + (size_t)(nt * 128 + c) * 1024); }, acc);
    acc_to_lds(Cs, acc);
    const bool isctx = m0 >= TL;
    const int b = isctx ? (m0 - TL) >> 8 : m0 >> 13;
    const int t0 = isctx ? (m0 - TL) & 255 : m0 & 8191;
    if (nt < 10) {
      const int lane = tid & 63, wave = tid >> 6;
      const int hh = lane >> 5, pr = lane & 31;
      const bool isq = nt < 8;
      const float* gain = isq ? p.q_gain : p.k_gain;
      const float qs = isq ? 0.125f * 1.4426950408889634f : 1.f;
      const float g0 = gain[2 * pr] * qs, g1 = gain[2 * pr + 1] * qs;
      u16* dstb;
      size_t tstride = 64;
      if (isq) {
        const int head = nt * 2 + hh;
        dstb = isctx ? p.QC + ((size_t)(b * 16 + head) * 256 + t0) * 64 : p.Q + ((size_t)(b * 16 + head) * 8192 + t0) * 64;
      } else {
        const int kh = (nt - 8) * 2 + hh;
        dstb = p.Kb + ((size_t)(b * 4 + kh) * NKEY + (isctx ? t0 : 256 + t0)) * 64;
      }
#pragma unroll 1
      for (int rb = 0; rb < 32; rb += 8) {
        float2 cssn[8];
#pragma unroll
        for (int j = 0; j < 8; ++j) cssn[j] = isctx ? make_float2(1.f, 0.f) : *(const float2*)(p.rope + ((size_t)(t0 + wave * 32 + rb + j) * 32 + pr) * 2);
#pragma unroll
        for (int j = 0; j < 8; ++j) {
          const int r = wave * 32 + rb + j;
          const float2 v = *(const float2*)&CS(r, 2 * lane);
          float ss = v.x * v.x + v.y * v.y;
          ss = sum32(ss);
          const float rinv = rsqrtf(ss * (1.f / 64.f) + 1e-6f);
          const float x0 = v.x * rinv * g0, x1 = v.y * rinv * g1;
          const float y0 = x0 * cssn[j].x - x1 * cssn[j].y, y1 = x0 * cssn[j].y + x1 * cssn[j].x;
          *(unsigned*)(dstb + (size_t)r * tstride + 2 * pr) = pack2(y0, y1);
        }
      }
    } else {
      const int keybase = (isctx ? t0 : 256 + t0);
      for (int j = 0; j < 4; ++j) {
        const int item = tid + 256 * j;
        const int d = item & 63, hh = (item >> 6) & 1, rg = item >> 7;
        const int kh = (nt - 10) * 2 + hh;
        float v[16];
#pragma unroll
        for (int i = 0; i < 16; ++i) v[i] = CS(rg * 16 + i, hh * 64 + d);
        u16* dst = p.Vt + ((size_t)(b * 4 + kh) * 64 + d) * NKEY + keybase + rg * 16;
        *(u32x4*)(dst) = mk4(pack2(v[0], v[1]), pack2(v[2], v[3]), pack2(v[8], v[9]), pack2(v[10], v[11]));
        *(u32x4*)(dst + 8) = mk4(pack2(v[4], v[5]), pack2(v[6], v[7]), pack2(v[12], v[13]), pack2(v[14], v[15]));
      }
    }
  }
}

DI void phase_attn(const Params& p, char* smem) {
  const int tid = threadIdx.x, lane = tid & 63, wave = tid >> 6;
  const int sw = (lane >> 1) & 7, hsel = lane >> 5;
  float mq = 0.f, mk = 0.f;
  for (int d = 0; d < 64; ++d) { mq = fmaxf(mq, fabsf(p.q_gain[d])); mk = fmaxf(mk, fabsf(p.k_gain[d])); }
  const float c0 = 0.125f * 1.4426950408889634f * 64.f * mq * mk * 1.02f + 0.5f;
  f32x16 negc;
#pragma unroll
  for (int i = 0; i < 16; ++i) negc[i] = -c0;
  int ga, gae, gs, gc, gce, gs2;
  work_range(2048, ga, gae, gs);
  work_range(64, gc, gce, gs2);
  const int n_lat = ga < gae ? (gae - ga + gs - 1) / gs : 0;
  const int n_ctx = gc < gce ? (gce - gc + gs2 - 1) / gs2 : 0;
  for (int wi = 0; wi < n_lat + n_ctx; ++wi) {
    const int item = wi < n_lat ? ga + wi * gs : 2048 + gc + (wi - n_lat) * gs2;
    int b, kvh, qb, nkt;
    const u16* qbase;
    size_t orow;
    const int head_g = wave;
    if (item < 2048) {
      b = item >> 9; kvh = (item >> 7) & 3; qb = item & 127; nkt = NKEY / 64;
      qbase = p.Q + ((size_t)(b * 16 + kvh * 4 + head_g) * 8192 + qb * 64) * 64;
      orow = (size_t)b * 8192 + qb * 64;
    } else {
      const int j = item - 2048;
      b = j >> 4; kvh = (j >> 2) & 3; qb = j & 3; nkt = 4;
      qbase = p.QC + ((size_t)(b * 16 + kvh * 4 + head_g) * 256 + qb * 64) * 64;
      orow = (size_t)TL + b * 256 + qb * 64;
    }
    const int head = kvh * 4 + head_g;
    bf16x8 qf[2][4];
#pragma unroll
    for (int qi = 0; qi < 2; ++qi)
#pragma unroll
      for (int ks = 0; ks < 4; ++ks) qf[qi][ks] = *(const bf16x8*)(qbase + (qi * 32 + (lane & 31)) * 64 + ks * 16 + hsel * 8);
    const u16* kg = p.Kb + (size_t)(b * 4 + kvh) * NKEY * 64;
    const u16* vg = p.Vt + (size_t)(b * 4 + kvh) * 64 * NKEY;
    f32x16 oacc[2][2];
#pragma unroll
    for (int i = 0; i < 16; ++i) { oacc[0][0][i] = 0.f; oacc[0][1][i] = 0.f; oacc[1][0][i] = 0.f; oacc[1][1][i] = 0.f; }
    f32x2 ls2[2] = {{0.f, 0.f}, {0.f, 0.f}};
    const int grow = wave * 8 + (lane >> 3);
    const int gsrc = ((lane & 7) ^ ((grow >> 1) & 7)) * 8;
    const u16* kgl = kg + (size_t)grow * 64 + gsrc;
    const u16* vgl = vg + (size_t)grow * NKEY + gsrc;
    char* const wb = smem + wave * 1024;
    auto stage_kv = [&](int kt, int buf) {
#pragma unroll
      for (int q = 0; q < 2; ++q) {
        __builtin_amdgcn_global_load_lds((const unsigned*)(kgl + (size_t)kt * 4096 + q * 32 * 64), (unsigned*)(wb + buf * 16384 + q * 4096), 16, 0, 0);
        __builtin_amdgcn_global_load_lds((const unsigned*)(vgl + (size_t)q * 32 * NKEY + kt * 64), (unsigned*)(wb + buf * 16384 + 8192 + q * 4096), 16, 0, 0);
      }
    };
    __syncthreads();
    stage_kv(0, 0);
    asm volatile("s_waitcnt vmcnt(0)" ::: "memory");
    __syncthreads();
    for (int kt = 0; kt < nkt; ++kt) {
      const int buf = kt & 1;
      if (kt + 1 < nkt) stage_kv(kt + 1, buf ^ 1);
      const u16* Ks = (const u16*)(smem + buf * 16384);
      const u16* Vs = Ks + 64 * 64;
      f32x16 sacc[2][2];
#pragma unroll
      for (int kb = 0; kb < 2; ++kb) {
        bf16x8 kf[4];
#pragma unroll
        for (int ks = 0; ks < 4; ++ks) kf[ks] = *(const bf16x8*)(Ks + (kb * 32 + (lane & 31)) * 64 + (((ks * 2 + hsel) ^ sw) * 8));
#pragma unroll
        for (int ks = 0; ks < 4; ++ks) {
          sacc[0][kb] = __builtin_amdgcn_mfma_f32_32x32x16_bf16(kf[ks], qf[0][ks], ks == 0 ? negc : sacc[0][kb], 0, 0, 0);
          sacc[1][kb] = __builtin_amdgcn_mfma_f32_32x32x16_bf16(kf[ks], qf[1][ks], ks == 0 ? negc : sacc[1][kb], 0, 0, 0);
        }
      }
#pragma unroll
      for (int qi = 0; qi < 2; ++qi)
#pragma unroll
        for (int kb = 0; kb < 2; ++kb)
#pragma unroll
          for (int i = 0; i < 16; i += 2) {
            const float e0 = __builtin_amdgcn_exp2f(sacc[qi][kb][i]), e1 = __builtin_amdgcn_exp2f(sacc[qi][kb][i + 1]);
            sacc[qi][kb][i] = e0; sacc[qi][kb][i + 1] = e1;
            const f32x2 e2 = {e0, e1};
            ls2[qi] += e2;
          }
#pragma unroll
      for (int kb = 0; kb < 2; ++kb)
#pragma unroll
        for (int s2 = 0; s2 < 2; ++s2) {
          bf16x8 vfr[2];
#pragma unroll
          for (int db = 0; db < 2; ++db) vfr[db] = *(const bf16x8*)(Vs + (db * 32 + (lane & 31)) * 64 + (((2 * (2 * kb + s2) + hsel) ^ sw) * 8));
#pragma unroll
          for (int qi = 0; qi < 2; ++qi) {
            unsigned w[4];
#pragma unroll
            for (int e = 0; e < 4; ++e) w[e] = pack2(sacc[qi][kb][8 * s2 + 2 * e], sacc[qi][kb][8 * s2 + 2 * e + 1]);
            u32x4 pw = mk4(w[0], w[1], w[2], w[3]);
            const bf16x8 pf = __builtin_bit_cast(bf16x8, pw);
#pragma unroll
            for (int db = 0; db < 2; ++db) oacc[qi][db] = __builtin_amdgcn_mfma_f32_32x32x16_bf16(vfr[db], pf, oacc[qi][db], 0, 0, 0);
          }
        }
      asm volatile("s_waitcnt vmcnt(0)" ::: "memory");
      __syncthreads();
    }
#pragma unroll
    for (int qi = 0; qi < 2; ++qi) {
      const float lsum = ls2[qi][0] + ls2[qi][1];
      const float l = lsum + __shfl_xor(lsum, 32, 64);
      const float inv = 1.f / l;
      u16* od = p.H + (orow + qi * 32 + (lane & 31)) * DM + head * 64;
#pragma unroll
      for (int db = 0; db < 2; ++db)
#pragma unroll
        for (int g = 0; g < 4; ++g) {
          uint2 o;
          o.x = pack2(oacc[qi][db][g * 4 + 0] * inv, oacc[qi][db][g * 4 + 1] * inv);
          o.y = pack2(oacc[qi][db][g * 4 + 2] * inv, oacc[qi][db][g * 4 + 3] * inv);
          *(uint2*)(od + db * 32 + 8 * g + 4 * hsel) = o;
        }
    }
  }
}

template <bool FROM_INPUT>
DI void phase_proj_res(const Params& p, char* smem, const u16* A, int lda, int K, const u16* Bt, int layer, int gate_idx, int mtiles) {
  int g0, gend, gstep; work_range(mtiles * 8, g0, gend, gstep);
  for (int tile = g0; tile < gend; tile += gstep) {
    int mt, nt; band_decode(tile, mtiles, 8, mt, nt);
    const int m0 = mt * 128;
    f32x4 acc[4][4];
    gemm_mainloop(smem, 1, K,
                  [&](int r, int) { return A + (size_t)(m0 + r) * lda; },
                  [&](int c) { return Bt + (size_t)(nt * 128 + c) * K; }, acc);
    const float* gate = p.modv + ((size_t)layer * 5 + midx_of(m0)) * 6144 + gate_idx * 1024 + nt * 128;
    const float* sb = (FROM_INPUT ? xin_ptr(p, m0) : (const float*)resid_ptr(p, m0)) + nt * 128;
    float* db = resid_ptr(p, m0) + nt * 128;
    {
      const int lane = threadIdx.x & 63, wave = threadIdx.x >> 6;
      const int wm = wave >> 1, wn = wave & 1, g4 = lane >> 4;
      float gt[4];
#pragma unroll
      for (int j = 0; j < 4; ++j) gt[j] = gate[wn * 64 + j * 16 + (lane & 15)];
#pragma unroll
      for (int i = 0; i < 4; ++i) {
        float res[4][4];
#pragma unroll
        for (int j = 0; j < 4; ++j)
#pragma unroll
          for (int e = 0; e < 4; ++e) res[j][e] = sb[(wm * 64 + i * 16 + g4 * 4 + e) * DM + wn * 64 + j * 16 + (lane & 15)];
#pragma unroll
        for (int j = 0; j < 4; ++j)
#pragma unroll
          for (int e = 0; e < 4; ++e) db[(wm * 64 + i * 16 + g4 * 4 + e) * DM + wn * 64 + j * 16 + (lane & 15)] = res[j][e] + gt[j] * acc[i][j][e];
      }
    }
  }
}

DI void phase_ffn_up(const Params& p, char* smem, int layer, bool with_ctx, u16* ACT) {
  float* Cs = (float*)smem;
  const int tid = threadIdx.x;
  const int mtiles = with_ctx ? 276 : 264;
  int g0, gend, gstep; work_range(mtiles * 44, g0, gend, gstep);
  const u16* up = p.up_t + (size_t)layer * 5632 * 1024;
  const float* cw = p.f_cw + (size_t)layer * 3 * 5632;
  const float* cb = p.f_cb + (size_t)layer * 5632;
  for (int tile = g0; tile < gend; tile += gstep) {
    int mt, nt; band_decode(tile, mtiles, 44, mt, nt);
    int rowbase, T, j;
    if (mt < 264) { rowbase = (mt / 66) * 8192; T = 8192; j = mt % 66; }
    else { const int m2 = mt - 264; rowbase = TL + (m2 / 3) * 256; T = 256; j = m2 % 3; }
    const int tb = j * 126 - 1;
    f32x4 acc[4][4];
    gemm_mainloop(smem, 1, 1024,
                  [&](int r, int) { const int t = tb + r; return (t >= 0 && t < T) ? (const u16*)(p.H + (size_t)(rowbase + t) * DM) : (const u16*)p.zero; },
                  [&](int c) { return up + (size_t)(c < 64 ? nt * 64 + c : 2816 + nt * 64 + (c - 64)) * 1024; }, acc);
    acc_to_lds(Cs, acc);
    const int c = tid & 63, rq = tid >> 6;
    const int n = nt * 64 + c;
    const float g0 = cw[n], g1 = cw[5632 + n], g2 = cw[2 * 5632 + n], gb = cb[n];
    const float v0 = cw[2816 + n], v1 = cw[5632 + 2816 + n], v2 = cw[2 * 5632 + 2816 + n], vb = cb[2816 + n];
    const int rs = 1 + rq * 32;
    int re = rs + 32; if (re > 127) re = 127;
    float gp = CS(rs - 1, c), gc = CS(rs, c), vp = CS(rs - 1, c + 64), vc = CS(rs, c + 64);
    for (int r = rs; r < re; ++r) {
      const float gn = CS(r + 1, c), vn = CS(r + 1, c + 64);
      const int t = tb + r;
      if (t < T) {
        const float g = g0 * gp + g1 * gc + g2 * gn + gb;
        const float v = v0 * vp + v1 * vc + v2 * vn + vb;
        const float a = g * __builtin_amdgcn_rcpf(1.f + __expf(-g)) * v;
        ACT[(size_t)(rowbase + t) * DFF + n] = f2bf(a);
      }
      gp = gc; gc = gn; vp = vc; vc = vn;
    }
  }
}

DI void phase_rwkv_gemms(const Params& p, char* smem) {
  float* Cs = (float*)smem;
  const int tid = threadIdx.x;
  int g0, gend, gstep; work_range(7312, g0, gend, gstep);
  for (int tile = g0; tile < gend; tile += gstep) {
    int job, mt, nt;
    const u16* Bt;
    if (tile < 2048) { job = 0; band_decode(tile, 256, 8, mt, nt); Bt = p.rr_t; }
    else if (tile < 4160) { job = 1; band_decode(tile - 2048, 264, 8, mt, nt); Bt = p.rk_t; }
    else if (tile < 6272) { job = 2; band_decode(tile - 4160, 264, 8, mt, nt); Bt = p.rv_t; }
    else if (tile < 6536) { job = 3; mt = tile - 6272; nt = 0; Bt = p.w1_t; }
    else if (tile < 6800) { job = 4; mt = tile - 6536; nt = 0; Bt = p.a1_t; }
    else { job = 5; band_decode(tile - 6800, 256, 2, mt, nt); Bt = p.g1_t; }
    const int m0 = mt * 128;
    f32x4 acc[4][4];
    gemm_mainloop(smem, 2, 1024,
                  [&](int r, int part) { return (const u16*)((part ? p.XX : p.H) + (size_t)(m0 + r) * DM); },
                  [&](int c) { return Bt + (size_t)(nt * 128 + c) * 2048; }, acc);
    if (job == 0) {
      epi_direct(acc, [&](int r, int c, float v) { p.R16[(size_t)(m0 + r) * DM + nt * 128 + c] = (f16)v; });
    } else if (job == 2) {
      epi_direct(acc, [&](int r, int c, float v) { p.V16[(size_t)(m0 + r) * DM + nt * 128 + c] = (f16)v; });
    } else if (job == 3) {
      epi_direct(acc, [&](int r, int c, float v) { p.LW[(size_t)(m0 + r) * 128 + c] = f2bf(tanhf(v)); });
    } else if (job == 4) {
      epi_direct(acc, [&](int r, int c, float v) { p.LA[(size_t)(m0 + r) * 128 + c] = f2bf(v); });
    } else if (job == 5) {
      epi_direct(acc, [&](int r, int c, float v) {
        const int col = nt * 128 + c;
        if (col < 192) p.LG[(size_t)(m0 + r) * 192 + col] = col < 160 ? f2bf(sigmoid_fast(v)) : (u16)0;
      });
    } else {
      acc_to_lds(Cs, acc);
      const int lane = tid & 63, wave = tid >> 6;
      const int col = nt * 128 + 2 * lane;
      const float kk0 = p.k_k[col], kk1 = p.k_k[col + 1];
#pragma unroll 4
      for (int rr = 0; rr < 32; ++rr) {
        const int r = wave * 32 + rr;
        const float2 v = *(const float2*)&CS(r, 2 * lane);
        const float a0 = v.x * kk0, a1 = v.y * kk1;
        float ss = a0 * a0 + a1 * a1;
        ss = sum32(ss);
        const float inv = 1.f / fmaxf(sqrtf(ss), 1e-12f);
        f16 k2[2], n2[2];
        k2[0] = (f16)v.x; k2[1] = (f16)v.y; n2[0] = (f16)(a0 * inv); n2[1] = (f16)(a1 * inv);
        *(unsigned*)(p.K16 + (size_t)(m0 + r) * DM + col) = *(const unsigned*)k2;
        *(unsigned*)(p.KK16 + (size_t)(m0 + r) * DM + col) = *(const unsigned*)n2;
      }
    }
  }
}

#define XB_TMO      128
#define XB_XCNT(j)  (256  + 64 * (j))
#define XB_XSUB(j)  (1280 + 64 * (j))
#define XB_XGEN(j)  (2304 + 64 * (j))
#define XB_TOP      3328
#define XB_TOPGEN   3392
#define XB_SPIN_CAP (1u << 20)
DI unsigned xb_ld(unsigned* p) { return __hip_atomic_load(p, __ATOMIC_RELAXED, __HIP_MEMORY_SCOPE_AGENT); }
DI unsigned xb_add(unsigned* p, unsigned v) { return __hip_atomic_fetch_add(p, v, __ATOMIC_RELAXED, __HIP_MEMORY_SCOPE_AGENT); }
DI unsigned xb_xcc_id() { return (unsigned)__builtin_amdgcn_s_getreg((3 << 11) | 20) & 0xFu; }
#define XB_SPIN(cond, bar) do { unsigned _sp = 0; while (cond) { __builtin_amdgcn_s_sleep(1); \
    if ((++_sp & 255u) == 0u) { if (xb_ld(&(bar)[XB_TMO])) break; if (_sp > XB_SPIN_CAP) { atomicAdd(&(bar)[XB_TMO], 1u); break; } } } } while (0)
struct XbState { unsigned x, nloc, nx; };
DI void xb_census(unsigned* bar, unsigned x, unsigned& nloc, unsigned& nx) {
  const unsigned G = gridDim.x;
  unsigned sum, cnt, mine, sp = 0u;
  for (;;) {
    sum = 0u; cnt = 0u; mine = 0u;
#pragma unroll
    for (unsigned j = 0; j < 16; ++j) { const unsigned c = xb_ld(&bar[XB_XCNT(j)]); sum += c; cnt += (c > 0u) ? 1u : 0u; mine = (j == x) ? c : mine; }
    if (sum == G) break;
    __builtin_amdgcn_s_sleep(1);
    if ((++sp & 255u) == 0u) { if (xb_ld(&bar[XB_TMO])) break; if (sp > XB_SPIN_CAP) { atomicAdd(&bar[XB_TMO], 1u); break; } }
  }
  nloc = mine > 0u ? mine : 1u; nx = cnt > 0u ? cnt : 1u;
}
DI void grid_barrier(unsigned* bar, XbState& st) {
  asm volatile("s_waitcnt vmcnt(0)" ::: "memory");
  __syncthreads();
  if (threadIdx.x == 0) {
    __builtin_amdgcn_s_waitcnt(0);
    if (st.nloc == 0u) xb_census(bar, st.x, st.nloc, st.nx);
    const unsigned nloc = st.nloc, nx = st.nx;
    const unsigned old = xb_add(&bar[XB_XSUB(st.x)], 1u);
    const unsigned gen = old / nloc;
    if (old + 1u == (gen + 1u) * nloc) {
      __builtin_amdgcn_fence(__ATOMIC_RELEASE, "agent");
      asm volatile("s_waitcnt vmcnt(0)" ::: "memory");
      const unsigned og = xb_add(&bar[XB_TOP], 1u);
      const unsigned tg = og / nx;
      if (og + 1u == (tg + 1u) * nx) xb_add(&bar[XB_TOPGEN], 1u);
      else XB_SPIN(xb_ld(&bar[XB_TOPGEN]) == tg, bar);
      __builtin_amdgcn_fence(__ATOMIC_ACQUIRE, "agent");
      xb_add(&bar[XB_XGEN(st.x)], 1u);
      asm volatile("s_waitcnt vmcnt(0)" ::: "memory");
    } else {
      XB_SPIN(xb_ld(&bar[XB_XGEN(st.x)]) == gen, bar);
      __builtin_amdgcn_fence(__ATOMIC_ACQUIRE, "agent");
      asm volatile("s_waitcnt vmcnt(0)" ::: "memory");
    }
  }
  __syncthreads();
}

struct ScanLds {
  float dec[2][16][64], kd[2][16][64], nk[2][16][64], bb[2][16][64], rr[2][16][64];
  float vv[2][16][16];
  float yy[2][16][16];
  float bp[2][4][16];
};

template <int DIR, bool EMIT>
DI void scan_steps(const ScanLds& L, int bsel, int c0, int myrow, int l15, f32x2& Sa, f32x2& Sb, float& ykeep) {
  f32x4 d4[2], k4[2], n4[2], b4[2], r4[2];
  float vv[2];
  auto ld = [&](int slot, int s) {
    d4[slot] = *(const f32x4*)&L.dec[bsel][s][c0];
    k4[slot] = *(const f32x4*)&L.kd[bsel][s][c0];
    n4[slot] = *(const f32x4*)&L.nk[bsel][s][c0];
    b4[slot] = *(const f32x4*)&L.bb[bsel][s][c0];
    if (EMIT) r4[slot] = *(const f32x4*)&L.rr[bsel][s][c0];
    vv[slot] = L.vv[bsel][s][myrow];
  };
  ld(0, DIR ? 15 : 0);
#pragma unroll
  for (int ss = 0; ss < 16; ++ss) {
    const int s = DIR ? 15 - ss : ss;
    const int cur = ss & 1;
    if (ss + 1 < 16) ld(cur ^ 1, DIR ? 14 - ss : ss + 1);
    const f32x2 nlo = {n4[cur][0], n4[cur][1]}, nhi = {n4[cur][2], n4[cur][3]};
    const f32x2 dlo = {d4[cur][0], d4[cur][1]}, dhi = {d4[cur][2], d4[cur][3]};
    const f32x2 klo = {k4[cur][0], k4[cur][1]}, khi = {k4[cur][2], k4[cur][3]};
    const f32x2 blo = {b4[cur][0], b4[cur][1]}, bhi = {b4[cur][2], b4[cur][3]};
    f32x2 t = Sa * nlo + Sb * nhi;
    float sa = dpp_sum16(t[0] + t[1]);
    const f32x2 sa2 = {sa, sa}, v2 = {vv[cur], vv[cur]};
    Sa = Sa * dlo + (sa2 * blo + v2 * klo);
    Sb = Sb * dhi + (sa2 * bhi + v2 * khi);
    if (EMIT) {
      const f32x2 rlo = {r4[cur][0], r4[cur][1]}, rhi = {r4[cur][2], r4[cur][3]};
      const f32x2 u = Sa * rlo + Sb * rhi;
      const float y = dpp_sum16(u[0] + u[1]);
      ykeep = (l15 == s) ? y : ykeep;
    }
  }
}

template <int DIR>
DI void scan_item(const Params& p, ScanLds& L, int b, int h, int q) {
  constexpr int dir = DIR;
  const int tid = threadIdx.x, lane = tid & 63, wave = tid >> 6;
  const int l15 = lane & 15, l4 = lane >> 4;
  const int colw = h * 64 + wave * 16 + l15;
  const int chd = wave * 16 + l15;
  bf16x8 w2f[2], a2f[2];
#pragma unroll
  for (int ks = 0; ks < 2; ++ks) {
    w2f[ks] = *(const bf16x8*)(p.w2_t + ((size_t)(dir * 1024 + colw) * 64 + ks * 32 + l4 * 8));
    a2f[ks] = *(const bf16x8*)(p.a2_t + ((size_t)(dir * 1024 + colw) * 64 + ks * 32 + l4 * 8));
  }
  const float w0c = p.dw0[dir * 1024 + colw], a0c = p.a0[dir * 1024 + colw], kac = p.k_a[colw], rkc = p.r_k[colw];
  f32x2 Sa = {0.f, 0.f}, Sb = {0.f, 0.f};
  const int myrow = wave * 4 + l4;
  const int c0 = l15 * 4;
  bf16x8 lwf[2], laf[2];
  f16 kv[4], kkv[4], rv[4];
  f16 vvr;
  auto chunk_rowbase = [&](int c, bool& isctx) -> int {
    if (c < 16) { isctx = true; const int cc = dir ? 15 - c : c; return TL + b * 256 + cc * 16; }
    isctx = false; const int cc = dir ? 511 - (c - 16) : (c - 16); return b * 8192 + cc * 16;
  };
  auto stage_load = [&](int c) {
    bool isctx; const int rb = chunk_rowbase(c, isctx);
#pragma unroll
    for (int ks = 0; ks < 2; ++ks) {
      lwf[ks] = *(const bf16x8*)(p.LW + ((size_t)(rb + l15) * 128 + dir * 64 + ks * 32 + l4 * 8));
      laf[ks] = *(const bf16x8*)(p.LA + ((size_t)(rb + l15) * 128 + dir * 64 + ks * 32 + l4 * 8));
    }
#pragma unroll
    for (int i = 0; i < 4; ++i) {
      const size_t off = (size_t)(rb + l4 * 4 + i) * DM + colw;
      kv[i] = p.K16[off]; kkv[i] = p.KK16[off];
      rv[i] = isctx ? (f16)0.f : p.R16[off];
    }
    vvr = p.V16[(size_t)(rb + (tid >> 4)) * DM + h * 64 + q * 16 + (tid & 15)];
  };
  auto stage_compute = [&](int c) {
    const int bsel = c & 1;
    f32x4 wacc = {0.f, 0.f, 0.f, 0.f}, aacc = {0.f, 0.f, 0.f, 0.f};
    wacc = __builtin_amdgcn_mfma_f32_16x16x32_bf16(lwf[0], w2f[0], wacc, 0, 0, 0);
    wacc = __builtin_amdgcn_mfma_f32_16x16x32_bf16(lwf[1], w2f[1], wacc, 0, 0, 0);
    aacc = __builtin_amdgcn_mfma_f32_16x16x32_bf16(laf[0], a2f[0], aacc, 0, 0, 0);
    aacc = __builtin_amdgcn_mfma_f32_16x16x32_bf16(laf[1], a2f[1], aacc, 0, 0, 0);
    float bpart[4];
#pragma unroll
    for (int i = 0; i < 4; ++i) {
      const int s = l4 * 4 + i;
      const float sg = sigmoid_fast(w0c + wacc[i]);
      const float dec = __expf(-0.6065306597126334f * sg);
      const float a = sigmoid_fast(a0c + aacc[i]);
      const float k = (float)kv[i], kk = (float)kkv[i], r = (float)rv[i];
      const float kd = k * (1.f + (a - 1.f) * kac);
      L.dec[bsel][s][chd] = dec;
      L.kd[bsel][s][chd] = kd;
      L.nk[bsel][s][chd] = -kk;
      L.bb[bsel][s][chd] = kk * a;
      L.rr[bsel][s][chd] = r;
      if (q == 0) bpart[i] = dpp_sum16(r * kd * rkc);
    }
    if (q == 0 && l15 == 0) {
#pragma unroll
      for (int i = 0; i < 4; ++i) L.bp[bsel][wave][l4 * 4 + i] = bpart[i];
    }
    L.vv[bsel][tid >> 4][tid & 15] = (float)vvr;
  };
  auto write_bonus = [&](int c) {
    if (q == 0 && tid < 16) {
      bool isctx; const int rb = chunk_rowbase(c, isctx);
      const int b2 = c & 1;
      p.bonus[((size_t)dir * MR + rb + tid) * 16 + h] = L.bp[b2][0][tid] + L.bp[b2][1][tid] + L.bp[b2][2][tid] + L.bp[b2][3][tid];
    }
  };
  __syncthreads();
  stage_load(0);
  stage_compute(0);
  __syncthreads();
  write_bonus(0);
  const int NCH = 528;
  float ykeep = 0.f;
#pragma unroll 1
  for (int c = 0; c < 16; ++c) {
    stage_load(c + 1);
    scan_steps<DIR, false>(L, c & 1, c0, myrow, l15, Sa, Sb, ykeep);
    stage_compute(c + 1);
    __syncthreads();
    write_bonus(c + 1);
  }
#pragma unroll 1
  for (int c = 16; c < NCH; ++c) {
    const int bsel = c & 1;
    if (c + 1 < NCH) stage_load(c + 1);
    scan_steps<DIR, true>(L, bsel, c0, myrow, l15, Sa, Sb, ykeep);
    L.yy[bsel][l15][myrow] = ykeep;
    if (c + 1 < NCH) stage_compute(c + 1);
    __syncthreads();
    {
      bool isctx; const int rb = chunk_rowbase(c, isctx);
      f16* Y = dir ? p.Y1 : p.Y0;
      Y[(size_t)(rb + (tid >> 4)) * DM + h * 64 + q * 16 + (tid & 15)] = (f16)(L.yy[bsel][tid >> 4][tid & 15] * 0.0625f);
    }
    if (c + 1 < NCH) write_bonus(c + 1);
  }
}

struct ScanLds2 {
  float dec[2][16][64], kd[2][16][64], nk[2][16][64], bb[2][16][64], rr[2][16][64];
  float vv[2][16][32];
  float yy[2][16][32];
  float bp[2][4][16];
};
DI float dpp_sum8(float v) {
  v += dpp_mov<0xB1>(v);
  v += dpp_mov<0x4E>(v);
  v += dpp_mov<0x141>(v);
  return v;
}
template <int DIR, bool EMIT>
DI void scan_steps2(const ScanLds2& L, int bsel, int c0, int myrow, int l7, f32x2 (&S)[4], float& ykA, float& ykB) {
  f32x4 d4[2][2], k4[2][2], n4[2][2], b4[2][2], r4[2][2];
  float vv[2];
  auto ld = [&](int slot, int s) {
#pragma unroll
    for (int hf = 0; hf < 2; ++hf) {
      d4[slot][hf] = *(const f32x4*)&L.dec[bsel][s][c0 + 4 * hf];
      k4[slot][hf] = *(const f32x4*)&L.kd[bsel][s][c0 + 4 * hf];
      n4[slot][hf] = *(const f32x4*)&L.nk[bsel][s][c0 + 4 * hf];
      b4[slot][hf] = *(const f32x4*)&L.bb[bsel][s][c0 + 4 * hf];
      if (EMIT) r4[slot][hf] = *(const f32x4*)&L.rr[bsel][s][c0 + 4 * hf];
    }
    vv[slot] = L.vv[bsel][s][myrow];
  };
  ld(0, DIR ? 15 : 0);
#pragma unroll
  for (int ss = 0; ss < 16; ++ss) {
    const int s = DIR ? 15 - ss : ss;
    const int cur = ss & 1;
    if (ss + 1 < 16) ld(cur ^ 1, DIR ? 14 - ss : ss + 1);
    f32x2 t = {0.f, 0.f};
#pragma unroll
    for (int i = 0; i < 4; ++i) { const f32x2 nn = {n4[cur][i >> 1][(i & 1) * 2], n4[cur][i >> 1][(i & 1) * 2 + 1]}; t += S[i] * nn; }
    const float sa = dpp_sum8(t[0] + t[1]);
    const f32x2 sa2 = {sa, sa}, v2 = {vv[cur], vv[cur]};
#pragma unroll
    for (int i = 0; i < 4; ++i) {
      const f32x2 dd = {d4[cur][i >> 1][(i & 1) * 2], d4[cur][i >> 1][(i & 1) * 2 + 1]};
      const f32x2 kk = {k4[cur][i >> 1][(i & 1) * 2], k4[cur][i >> 1][(i & 1) * 2 + 1]};
      const f32x2 bb = {b4[cur][i >> 1][(i & 1) * 2], b4[cur][i >> 1][(i & 1) * 2 + 1]};
      S[i] = S[i] * dd + (sa2 * bb + v2 * kk);
    }
    if (EMIT) {
      f32x2 u = {0.f, 0.f};
#pragma unroll
      for (int i = 0; i < 4; ++i) { const f32x2 rr = {r4[cur][i >> 1][(i & 1) * 2], r4[cur][i >> 1][(i & 1) * 2 + 1]}; u += S[i] * rr; }
      const float y = dpp_sum8(u[0] + u[1]);
      if (s < 8) ykA = (l7 == s) ? y : ykA; else ykB = (l7 == s - 8) ? y : ykB;
    }
  }
}
template <int DIR>
DI void scan_item2(const Params& p, ScanLds2& L, int b, int h, int hf) {
  constexpr int dir = DIR;
  const int tid = threadIdx.x, lane = tid & 63, wave = tid >> 6;
  const int l15 = lane & 15, l4 = lane >> 4;
  const int colw = h * 64 + wave * 16 + l15;
  const int chd = wave * 16 + l15;
  bf16x8 w2f[2], a2f[2];
#pragma unroll
  for (int ks = 0; ks < 2; ++ks) {
    w2f[ks] = *(const bf16x8*)(p.w2_t + ((size_t)(dir * 1024 + colw) * 64 + ks * 32 + l4 * 8));
    a2f[ks] = *(const bf16x8*)(p.a2_t + ((size_t)(dir * 1024 + colw) * 64 + ks * 32 + l4 * 8));
  }
  const float w0c = p.dw0[dir * 1024 + colw], a0c = p.a0[dir * 1024 + colw], kac = p.k_a[colw], rkc = p.r_k[colw];
  f32x2 S[4];
#pragma unroll
  for (int i = 0; i < 4; ++i) { S[i][0] = 0.f; S[i][1] = 0.f; }
  const int l7 = lane & 7;
  const int myrow = wave * 8 + (lane >> 3);
  const int c0 = l7 * 8;
  bf16x8 lwf[2], laf[2];
  f16 kv[4], kkv[4], rv[4];
  f16 vvr[2];
  auto chunk_rowbase = [&](int c, bool& isctx) -> int {
    if (c < 16) { isctx = true; const int cc = dir ? 15 - c : c; return TL + b * 256 + cc * 16; }
    isctx = false; const int cc = dir ? 511 - (c - 16) : (c - 16); return b * 8192 + cc * 16;
  };
  auto stage_load = [&](int c) {
    bool isctx; const int rb = chunk_rowbase(c, isctx);
#pragma unroll
    for (int ks = 0; ks < 2; ++ks) {
      lwf[ks] = *(const bf16x8*)(p.LW + ((size_t)(rb + l15) * 128 + dir * 64 + ks * 32 + l4 * 8));
      laf[ks] = *(const bf16x8*)(p.LA + ((size_t)(rb + l15) * 128 + dir * 64 + ks * 32 + l4 * 8));
    }
#pragma unroll
    for (int i = 0; i < 4; ++i) {
      const size_t off = (size_t)(rb + l4 * 4 + i) * DM + colw;
      kv[i] = p.K16[off]; kkv[i] = p.KK16[off];
      rv[i] = isctx ? (f16)0.f : p.R16[off];
    }
#pragma unroll
    for (int j = 0; j < 2; ++j) { const int e = tid + 256 * j; vvr[j] = p.V16[(size_t)(rb + (e >> 5)) * DM + h * 64 + hf * 32 + (e & 31)]; }
  };
  auto stage_compute = [&](int c) {
    const int bsel = c & 1;
    f32x4 wacc = {0.f, 0.f, 0.f, 0.f}, aacc = {0.f, 0.f, 0.f, 0.f};
    wacc = __builtin_amdgcn_mfma_f32_16x16x32_bf16(lwf[0], w2f[0], wacc, 0, 0, 0);
    wacc = __builtin_amdgcn_mfma_f32_16x16x32_bf16(lwf[1], w2f[1], wacc, 0, 0, 0);
    aacc = __builtin_amdgcn_mfma_f32_16x16x32_bf16(laf[0], a2f[0], aacc, 0, 0, 0);
    aacc = __builtin_amdgcn_mfma_f32_16x16x32_bf16(laf[1], a2f[1], aacc, 0, 0, 0);
    float bpart[4];
#pragma unroll
    for (int i = 0; i < 4; ++i) {
      const int s = l4 * 4 + i;
      const float sg = sigmoid_fast(w0c + wacc[i]);
      const float dec = __expf(-0.6065306597126334f * sg);
      const float a = sigmoid_fast(a0c + aacc[i]);
      const float k = (float)kv[i], kk = (float)kkv[i], r = (float)rv[i];
      const float kd = k * (1.f + (a - 1.f) * kac);
      L.dec[bsel][s][chd] = dec;
      L.kd[bsel][s][chd] = kd;
      L.nk[bsel][s][chd] = -kk;
      L.bb[bsel][s][chd] = kk * a;
      L.rr[bsel][s][chd] = r;
      if (hf == 0) bpart[i] = dpp_sum16(r * kd * rkc);
    }
    if (hf == 0 && l15 == 0) {
#pragma unroll
      for (int i = 0; i < 4; ++i) L.bp[bsel][wave][l4 * 4 + i] = bpart[i];
    }
#pragma unroll
    for (int j = 0; j < 2; ++j) { const int e = tid + 256 * j; L.vv[bsel][e >> 5][e & 31] = (float)vvr[j]; }
  };
  auto write_bonus = [&](int c) {
    if (hf == 0 && tid < 16) {
      bool isctx; const int rb = chunk_rowbase(c, isctx);
      const int b2 = c & 1;
      p.bonus[((size_t)dir * MR + rb + tid) * 16 + h] = L.bp[b2][0][tid] + L.bp[b2][1][tid] + L.bp[b2][2][tid] + L.bp[b2][3][tid];
    }
  };
  __syncthreads();
  stage_load(0);
  stage_compute(0);
  __syncthreads();
  write_bonus(0);
  const int NCH = 528;
  float ykA = 0.f, ykB = 0.f;
#pragma unroll 1
  for (int c = 0; c < 16; ++c) {
    stage_load(c + 1);
    scan_steps2<DIR, false>(L, c & 1, c0, myrow, l7, S, ykA, ykB);
    stage_compute(c + 1);
    __syncthreads();
    write_bonus(c + 1);
  }
#pragma unroll 1
  for (int c = 16; c < NCH; ++c) {
    const int bsel = c & 1;
    if (c + 1 < NCH) stage_load(c + 1);
    scan_steps2<DIR, true>(L, bsel, c0, myrow, l7, S, ykA, ykB);
    L.yy[bsel][l7][myrow] = ykA;
    L.yy[bsel][8 + l7][myrow] = ykB;
    if (c + 1 < NCH) stage_compute(c + 1);
    __syncthreads();
    {
      bool isctx; const int rb = chunk_rowbase(c, isctx);
      f16* Y = dir ? p.Y1 : p.Y0;
#pragma unroll
      for (int j = 0; j < 2; ++j) {
        const int e = tid + 256 * j;
        Y[(size_t)(rb + (e >> 5)) * DM + h * 64 + hf * 32 + (e & 31)] = (f16)(L.yy[bsel][e >> 5][e & 31] * 0.0625f);
      }
    }
    if (c + 1 < NCH) write_bonus(c + 1);
  }
}
DI void phase_scan2(const Params& p, char* smem) {
  ScanLds2& L = *(ScanLds2*)smem;
  const unsigned info = p.blkinfo[blockIdx.x];
  const unsigned rank = info >> 16, ticket = info & 0xffffu;
  const unsigned n0 = xb_ld(&p.bar[XB_N0]);
  const unsigned item = rank == 0u ? ticket : n0 + ticket;
  if (item < 256u) {
    const int sc = item >> 1, hf = item & 1;
    const int dir = sc & 1, bh = sc >> 1, b = bh >> 4, h = bh & 15;
    if (dir) scan_item2<1>(p, L, b, h, hf); else scan_item2<0>(p, L, b, h, hf);
  }
}

DI void phase_scan(const Params& p, char* smem) {
  ScanLds& L = *(ScanLds*)smem;
  for (int item = blockIdx.x; item < 512; item += gridDim.x) {
    int sc, q;
    if (gridDim.x == 512) { const int xcd = item & 7, slot = item >> 3; sc = xcd * 16 + (slot >> 2); q = slot & 3; }
    else { sc = item >> 2; q = item & 3; }
    const int dir = sc & 1, bh = sc >> 1, b = bh >> 4, h = bh & 15;
    if (dir) scan_item<1>(p, L, b, h, q); else scan_item<0>(p, L, b, h, q);
  }
}

DI void phase_readout(const Params& p, char* smem) {
  float* Cs = (float*)smem;
  const int tid = threadIdx.x;
  int g0, gend, gstep; work_range(256 * 8, g0, gend, gstep);
  for (int tile = g0; tile < gend; tile += gstep) {
    int mt, nt; band_decode(tile, 256, 8, mt, nt);
    const int m0 = mt * 128;
    f32x4 acc[4][4];
    gemm_mainloop(smem, 1, 192,
                  [&](int r, int) { return (const u16*)(p.LG + (size_t)(m0 + r) * 192); },
                  [&](int c) { return (const u16*)(p.g2_t + (size_t)(nt * 128 + c) * 192); }, acc);
    acc_to_lds(Cs, acc);
    const int lane = tid & 63, wave = tid >> 6;
    const int head = nt * 2 + (lane >> 5);
    const int col = nt * 128 + 2 * lane;
    const float gw0 = p.gn_w[col], gw1 = p.gn_w[col + 1], gb0 = p.gn_b[col], gb1 = p.gn_b[col + 1];
#pragma unroll 1
    for (int rb = 0; rb < 32; rb += 8) {
      unsigned ua[8], ub[8], uv[8];
      float bn[8];
#pragma unroll
      for (int j = 0; j < 8; ++j) {
        const int row = m0 + wave * 32 + rb + j;
        ua[j] = *(const unsigned*)(p.Y0 + (size_t)row * DM + col);
        ub[j] = *(const unsigned*)(p.Y1 + (size_t)row * DM + col);
        uv[j] = *(const unsigned*)(p.V16 + (size_t)row * DM + col);
        bn[j] = p.bonus[((size_t)0 * MR + row) * 16 + head] + p.bonus[((size_t)1 * MR + row) * 16 + head];
      }
#pragma unroll
      for (int j = 0; j < 8; ++j) {
        const int r = wave * 32 + rb + j;
        const int row = m0 + r;
        const f16* fa = (const f16*)&ua[j]; const f16* fb = (const f16*)&ub[j]; const f16* fv = (const f16*)&uv[j];
        const float y0 = ((float)fa[0] + (float)fb[0]) * 16.f, y1 = ((float)fa[1] + (float)fb[1]) * 16.f;
        float sm = y0 + y1;
        sm = sum32(sm);
        const float mean = sm * (1.f / 64.f);
        const float d0 = y0 - mean, d1 = y1 - mean;
        float vs = d0 * d0 + d1 * d1;
        vs = sum32(vs);
        const float rstd = rsqrtf(vs * (1.f / 64.f) + 64e-5f);
        const float2 g = *(const float2*)&CS(r, 2 * lane);
        const float z0 = (d0 * rstd * gw0 + gb0 + bn[j] * (float)fv[0]) * g.x;
        const float z1 = (d1 * rstd * gw1 + gb1 + bn[j] * (float)fv[1]) * g.y;
        *(unsigned*)(p.Z + (size_t)row * DM + col) = pack2(z0, z1);
      }
    }
  }
}

DI void phase_final(const Params& p) {
  const int lane = threadIdx.x & 63;
  const int gw = blockIdx.x * 4 + (threadIdx.x >> 6), nw = gridDim.x * 4;
  float4 g[4];
#pragma unroll
  for (int i = 0; i < 4; ++i) g[i] = *(const float4*)(p.final_gain + i * 256 + lane * 4);
  float4 v[4], vn[4];
  int row = gw;
  if (row < TL) {
#pragma unroll
    for (int i = 0; i < 4; ++i) v[i] = *(const float4*)(p.out + (size_t)row * DM + i * 256 + lane * 4);
  }
  for (; row < TL; row += nw) {
    const int nxt = row + nw;
    if (nxt < TL) {
#pragma unroll
      for (int i = 0; i < 4; ++i) vn[i] = *(const float4*)(p.out + (size_t)nxt * DM + i * 256 + lane * 4);
    }
    float* src = p.out + (size_t)row * DM;
    float ss = 0.f;
#pragma unroll
    for (int i = 0; i < 4; ++i) ss += v[i].x * v[i].x + v[i].y * v[i].y + v[i].z * v[i].z + v[i].w * v[i].w;
    ss = wave_sum(ss);
    const float rinv = rsqrtf(ss * (1.f / 1024.f) + 1e-6f);
#pragma unroll
    for (int i = 0; i < 4; ++i) {
      float4 o;
      o.x = v[i].x * rinv * g[i].x; o.y = v[i].y * rinv * g[i].y; o.z = v[i].z * rinv * g[i].z; o.w = v[i].w * rinv * g[i].w;
      *(float4*)(src + i * 256 + lane * 4) = o;
    }
#pragma unroll
    for (int i = 0; i < 4; ++i) v[i] = vn[i];
  }
}

__global__ void __launch_bounds__(256, 2) mega(Params p) {
  __shared__ __attribute__((aligned(16))) char smem[65536];
  cg::grid_group grid = cg::this_grid();
  XbState xst; xst.x = xb_xcc_id(); xst.nloc = 0u; xst.nx = 0u;
  if (threadIdx.x == 0) {
    (void)xb_add(&p.bar[XB_XCNT(xst.x)], 1u);
    const unsigned hwid = (unsigned)__builtin_amdgcn_s_getreg((7 << 11) | (8 << 6) | 4) & 0xffu;
    const unsigned rank = xb_add(&p.bar[XB_CU((xst.x << 8) | hwid)], 1u);
    const unsigned ticket = xb_add(&p.bar[rank == 0u ? XB_N0 : XB_N1], 1u);
    p.blkinfo[blockIdx.x] = ((rank > 0u ? 1u : 0u) << 16) | (ticket & 0xffffu);
  }
  if (gridDim.x == 0x7fffffffu) grid.sync();
  phase_prep(p, smem); grid_barrier(p.bar, xst);
  phase_modreduce(p); grid_barrier(p.bar, xst);
  phase_modulate<true>(p, 0, 0, MR); grid_barrier(p.bar, xst);
  phase_qkv(p, smem); grid_barrier(p.bar, xst);
  phase_attn(p, smem); grid_barrier(p.bar, xst);
  phase_proj_res<true>(p, smem, p.H, 1024, 1024, p.wo_t, 0, 2, 264); grid_barrier(p.bar, xst);
  phase_modulate<false>(p, 0, 1, MR); grid_barrier(p.bar, xst);
  phase_ffn_up(p, smem, 0, true, p.ACT0); grid_barrier(p.bar, xst);
  phase_proj_res<false>(p, smem, p.ACT0, DFF, DFF, p.down_t, 0, 5, 264); grid_barrier(p.bar, xst);
  phase_rwkv_shift(p); grid_barrier(p.bar, xst);
  phase_rwkv_gemms(p, smem); grid_barrier(p.bar, xst);
  phase_scan2(p, smem); grid_barrier(p.bar, xst);
  phase_readout(p, smem); grid_barrier(p.bar, xst);
  phase_proj_res<false>(p, smem, p.Z, 1024, 1024, p.ro_t, 1, 2, 256); grid_barrier(p.bar, xst);
  phase_modulate<false>(p, 1, 1, TL); grid_barrier(p.bar, xst);
  phase_ffn_up(p, smem, 1, false, p.ACT1); grid_barrier(p.bar, xst);
  phase_proj_res<false>(p, smem, p.ACT1, DFF, DFF, p.down_t + (size_t)1024 * 2816, 1, 5, 256); grid_barrier(p.bar, xst);
  phase_final(p);
}

extern "C" void kernel_launch(void* const* d_in, const int* in_sizes, int n_in, void* d_out, int out_size, void* d_ws, size_t ws_size,
                              hipStream_t stream) {
  static int grid_blocks = 0;
  if (!grid_blocks) {
    int dev = 0, cus = 0, per_cu = 0;
    hipGetDevice(&dev);
    hipDeviceGetAttribute(&cus, hipDeviceAttributeMultiprocessorCount, dev);
    hipOccupancyMaxActiveBlocksPerMultiprocessor(&per_cu, mega, 256, 0);
    if (per_cu > 2) per_cu = 2;
    if (per_cu < 1) per_cu = 1;
    grid_blocks = cus * per_cu;
  }
  Params p{};
  const float* const* in = (const float* const*)d_in;
  p.x = in[0]; p.c = in[1]; p.ctx = in[2]; p.c_ctx = in[3]; p.ada_w = in[4]; p.ada_b = in[5]; p.w_qkv = in[6]; p.q_gain = in[7];
  p.k_gain = in[8]; p.w_o = in[9]; p.mu = in[10]; p.rw_r = in[11]; p.rw_k = in[12]; p.rw_v = in[13]; p.rw_o = in[14]; p.dw0 = in[15];
  p.dw1 = in[16]; p.dw2 = in[17]; p.a0 = in[18]; p.a1 = in[19]; p.a2 = in[20]; p.g1 = in[21]; p.g2 = in[22]; p.k_k = in[23];
  p.k_a = in[24]; p.r_k = in[25]; p.gn_w = in[26]; p.gn_b = in[27]; p.f_up = in[28]; p.f_cw = in[29]; p.f_cb = in[30];
  p.f_down = in[31]; p.final_gain = in[32];
  p.out = (float*)d_out;
  char* w = (char*)d_ws;
  size_t off = 0;
  auto take = [&](size_t bytes) { char* r = w + off; off += (bytes + 255) & ~(size_t)255; return r; };
  p.qkv_t = (u16*)take((size_t)1536 * 1024 * 2);
  p.wo_t = (u16*)take((size_t)1024 * 1024 * 2);
  p.up_t = (u16*)take((size_t)2 * 5632 * 1024 * 2);
  p.down_t = (u16*)take((size_t)2 * 1024 * 2816 * 2);
  p.rr_t = (u16*)take((size_t)1024 * 2048 * 2);
  p.rk_t = (u16*)take((size_t)1024 * 2048 * 2);
  p.rv_t = (u16*)take((size_t)1024 * 2048 * 2);
  p.ro_t = (u16*)take((size_t)1024 * 1024 * 2);
  p.w1_t = (u16*)take((size_t)128 * 2048 * 2);
  p.a1_t = (u16*)take((size_t)128 * 2048 * 2);
  p.g1_t = (u16*)take((size_t)256 * 2048 * 2);
  p.w2_t = (u16*)take((size_t)2 * 1024 * 64 * 2);
  p.a2_t = (u16*)take((size_t)2 * 1024 * 64 * 2);
  p.g2_t = (u16*)take((size_t)1024 * 192 * 2);
  p.modpart = (float*)take((size_t)2 * 8 * 5 * 6144 * 4);
  p.modv = (float*)take((size_t)2 * 5 * 6144 * 4);
  p.rope = (float*)take((size_t)8192 * 32 * 2 * 4);
  p.XC = (float*)take((size_t)TCX * DM * 4);
  p.bonus = (float*)take((size_t)2 * MR * 16 * 4);
  p.zero = (u16*)take(8192);
  p.bar = (unsigned*)take(65536);
  p.blkinfo = (unsigned*)take(4096 * 4);
  const size_t pb = off;
  p.H = (u16*)take((size_t)MR * DM * 2);
  const size_t after_h = off;
  p.Q = (u16*)take((size_t)TL * DM * 2);
  p.QC = (u16*)take((size_t)TCX * DM * 2);
  p.Kb = (u16*)take((size_t)16 * NKEY * 64 * 2);
  p.Vt = (u16*)take((size_t)16 * NKEY * 64 * 2);
  p.ACT0 = (u16*)take((size_t)MR * DFF * 2);
  const size_t end0 = off;
  off = after_h;
  p.XX = (u16*)take((size_t)MR * DM * 2);
  p.R16 = (f16*)take((size_t)TL * DM * 2);
  p.K16 = (f16*)take((size_t)MR * DM * 2);
  p.V16 = (f16*)take((size_t)MR * DM * 2);
  p.KK16 = (f16*)take((size_t)MR * DM * 2);
  p.LW = (u16*)take((size_t)MR * 128 * 2);
  p.LA = (u16*)take((size_t)MR * 128 * 2);
  p.LG = (u16*)take((size_t)TL * 192 * 2);
  const size_t end1 = off;
  p.Y0 = (f16*)p.H;
  p.Y1 = (f16*)p.XX;
  p.Z = (u16*)p.R16;
  p.ACT1 = (u16*)p.K16;
  (void)pb;
  const size_t need = end0 > end1 ? end0 : end1;
  if (need > ws_size) { fprintf(stderr, "workspace too small: need %zu have %zu\n", need, ws_size); return; }
  hipMemsetAsync(p.bar, 0, 65536, stream);
  void* args[] = {&p};
  hipError_t e = hipLaunchCooperativeKernel((void*)mega, dim3(grid_blocks), dim3(256), args, 0, stream);
  if (e != hipSuccess) fprintf(stderr, "cooperative launch failed: %s (grid %d)\n", hipGetErrorString(e), grid_blocks);
}
```

```cpp
#include <hip/hip_runtime.h>
#include <hip/hip_cooperative_groups.h>
#include <cstdio>
#include <cstdint>
namespace cg = cooperative_groups;

typedef unsigned short u16;
typedef _Float16 f16;
using bf16x8 = __attribute__((ext_vector_type(8))) short;
using f32x16 = __attribute__((ext_vector_type(16))) float;
using f32x4 = __attribute__((ext_vector_type(4))) float;
using u32x4 = __attribute__((ext_vector_type(4))) unsigned;
#define DI __device__ __forceinline__
DI u32x4 mk4(unsigned a, unsigned b, unsigned c, unsigned d) { u32x4 r; r[0] = a; r[1] = b; r[2] = c; r[3] = d; return r; }

constexpr int TL = 32768;
constexpr int TCX = 1024;
constexpr int MR = 33792;
constexpr int DM = 1024;
constexpr int DFF = 2816;
constexpr int NKEY = 8448;
constexpr int NPHASE = 18;
#define XB_CU(j)    (4096 + (j))
#define XB_N0       8192
#define XB_N1       8256

struct Params {
  const float *x, *c, *ctx, *c_ctx, *ada_w, *ada_b, *w_qkv, *q_gain, *k_gain, *w_o;
  const float *mu, *rw_r, *rw_k, *rw_v, *rw_o, *dw0, *dw1, *dw2, *a0, *a1, *a2, *g1, *g2, *k_k, *k_a, *r_k, *gn_w, *gn_b;
  const float *f_up, *f_cw, *f_cb, *f_down, *final_gain;
  float* out;
  u16 *qkv_t, *wo_t, *up_t, *down_t, *rr_t, *rk_t, *rv_t, *ro_t, *w1_t, *a1_t, *g1_t, *w2_t, *a2_t, *g2_t;
  float *modpart, *modv, *rope, *XC, *bonus;
  u16* zero;
  unsigned* bar;
  unsigned* blkinfo;
  u16 *H, *XX, *Q, *QC, *Kb, *Vt, *ACT0, *ACT1;
  f16 *R16, *K16, *V16, *KK16, *Y0, *Y1;
  u16 *LW, *LA, *LG, *Z;
  int phase_lo, phase_hi;
};

typedef __bf16 bf16x2_t __attribute__((ext_vector_type(2)));
typedef float f32x2 __attribute__((ext_vector_type(2)));
DI unsigned pack2(float a, float b) { f32x2 f = {a, b}; return __builtin_bit_cast(unsigned, __builtin_convertvector(f, bf16x2_t)); }
DI u16 f2bf(float x) { return (u16)(pack2(x, 0.f) & 0xffffu); }
DI float bf2f(u16 h) { return __uint_as_float(((unsigned)h) << 16); }
DI float wave_sum(float v) {
#pragma unroll
  for (int o = 32; o > 0; o >>= 1) v += __shfl_xor(v, o, 64);
  return v;
}
template <int CTRL> DI float dpp_mov(float v) { return __builtin_bit_cast(float, __builtin_amdgcn_update_dpp(0, __builtin_bit_cast(int, v), CTRL, 0xF, 0xF, true)); }
DI float dpp_sum16(float v) {
  v += dpp_mov<0x128>(v);
  v += dpp_mov<0x124>(v);
  v += dpp_mov<0x122>(v);
  v += dpp_mov<0x121>(v);
  return v;
}
DI float sum32(float v) { v = dpp_sum16(v); v += __shfl_xor(v, 16, 64); return v; }
DI float sigmoidf_(float x) { return 1.f / (1.f + __expf(-x)); }
DI float sigmoid_fast(float x) { return __builtin_amdgcn_rcpf(1.f + __expf(-x)); }
DI int midx_of(int row) { return row < TL ? (row >> 13) : 4; }
DI float* resid_ptr(const Params& p, int row) { return row < TL ? p.out + (size_t)row * DM : p.XC + (size_t)(row - TL) * DM; }
DI const float* xin_ptr(const Params& p, int row) { return row < TL ? p.x + (size_t)row * DM : p.ctx + (size_t)(row - TL) * DM; }

DI void work_range(int total, int& g0, int& gend, int& step) {
  if ((gridDim.x & 7) == 0) {
    const int x = blockIdx.x & 7, li = blockIdx.x >> 3, nl = gridDim.x >> 3;
    const int lo = (int)(((long long)total * x) >> 3), hi = (int)(((long long)total * (x + 1)) >> 3);
    g0 = lo + li; gend = hi; step = nl;
  } else { g0 = blockIdx.x; gend = total; step = gridDim.x; }
}
DI void band_decode(int g, int MT, int NT, int& mt, int& nt) {
  const int per = 8 * NT;
  const int band = g / per, r = g - band * per;
  int hb = MT - band * 8; if (hb > 8) hb = 8;
  nt = r / hb; mt = band * 8 + (r - nt * hb);
}

using GAcc = f32x4[4][4];
template <class AF, class BF>
DI void gemm_mainloop(char* smem, int nparts, int kpart, AF arow, BF brow, f32x4 (&acc)[4][4]) {
  const int tid = threadIdx.x, lane = tid & 63, wave = tid >> 6;
  const int wm = wave >> 1, wn = wave & 1;
  const int lr = tid >> 3, lc = tid & 7;
#pragma unroll
  for (int i = 0; i < 4; ++i)
#pragma unroll
    for (int j = 0; j < 4; ++j)
#pragma unroll
      for (int e = 0; e < 4; ++e) acc[i][j][e] = 0.f;
  const int csrc = (lc ^ ((lr >> 1) & 7)) * 8;
  const u16* bp[4];
  const u16* ap[4];
#pragma unroll
  for (int q = 0; q < 4; ++q) { bp[q] = brow(lr + 32 * q) + csrc; ap[q] = arow(lr + 32 * q, 0) + csrc; }
  const int nk = kpart >> 6;
  const int total = nparts * nk;
  const int sw = (lane >> 1) & 7;
  const int kq = lane >> 4;
  char* const wbase = smem + wave * 1024;
  auto stage = [&](int buf, int kk, int boff) {
#pragma unroll
    for (int q = 0; q < 4; ++q) {
      __builtin_amdgcn_global_load_lds((const unsigned*)(ap[q] + kk), (unsigned*)(wbase + buf * 32768 + q * 4096), 16, 0, 0);
      __builtin_amdgcn_global_load_lds((const unsigned*)(bp[q] + boff), (unsigned*)(wbase + buf * 32768 + 16384 + q * 4096), 16, 0, 0);
    }
  };
  __syncthreads();
  stage(0, 0, 0);
  asm volatile("s_waitcnt vmcnt(0)" ::: "memory");
  __syncthreads();
  int part = 0, kk = 0, buf = 0;
#pragma unroll 2
  for (int it = 0; it < total; ++it) {
    kk += 64;
    if (kk == kpart) {
      kk = 0; ++part;
      if (part < nparts) {
#pragma unroll
        for (int q = 0; q < 4; ++q) ap[q] = arow(lr + 32 * q, part) + csrc;
      }
    }
    if (it + 1 < total) stage(buf ^ 1, kk, part * kpart + kk);
    const u16* As = (const u16*)(smem + buf * 32768);
    const u16* Bs = As + 128 * 64;
    const u16* Ar = As + (wm * 64 + (lane & 15)) * 64;
    const u16* Br = Bs + (wn * 64 + (lane & 15)) * 64;
    bf16x8 af[2][4], bf[2][4];
    {
      const int pc = (kq ^ sw) * 8;
#pragma unroll
      for (int i = 0; i < 4; ++i) { af[0][i] = *(const bf16x8*)(Ar + i * 1024 + pc); bf[0][i] = *(const bf16x8*)(Br + i * 1024 + pc); }
    }
#pragma unroll
    for (int ks = 0; ks < 2; ++ks) {
      const int cur = ks & 1;
      if (ks + 1 < 2) {
        const int pc = ((4 + kq) ^ sw) * 8;
#pragma unroll
        for (int i = 0; i < 4; ++i) { af[1][i] = *(const bf16x8*)(Ar + i * 1024 + pc); bf[1][i] = *(const bf16x8*)(Br + i * 1024 + pc); }
      }
#pragma unroll
      for (int i = 0; i < 4; ++i)
#pragma unroll
        for (int j = 0; j < 4; ++j) acc[i][j] = __builtin_amdgcn_mfma_f32_16x16x32_bf16(af[cur][i], bf[cur][j], acc[i][j], 0, 0, 0);
      __builtin_amdgcn_sched_barrier(0);
    }
    asm volatile("s_waitcnt vmcnt(0)" ::: "memory");
    __syncthreads();
    buf ^= 1;
  }
}

template <class F>
DI void epi_direct(const f32x4 (&acc)[4][4], F f) {
  const int lane = threadIdx.x & 63, wave = threadIdx.x >> 6;
  const int wm = wave >> 1, wn = wave & 1, g = lane >> 4;
#pragma unroll
  for (int i = 0; i < 4; ++i)
#pragma unroll
    for (int j = 0; j < 4; ++j)
#pragma unroll
      for (int e = 0; e < 4; ++e) {
        const int row = wm * 64 + i * 16 + g * 4 + e;
        const int col = wn * 64 + j * 16 + (lane & 15);
        f(row, col, acc[i][j][e]);
      }
}
#define CS(r, c) Cs[(r) * 128 + (c)]
DI void acc_to_lds(float* Cs, const f32x4 (&acc)[4][4]) {
  __syncthreads();
  epi_direct(acc, [&](int r, int c, float v) { CS(r, c) = v; });
  __syncthreads();
}

struct TJob { const float* src; int srcK, srcN; u16* dst; int ld, koff; const float* mu; int Kpad, Npad; };
DI TJob get_job(const Params& p, int j) {
  TJob t; t.mu = nullptr; t.koff = 0;
  auto set = [&](const float* s, int K, int N, u16* d, int ld) { t.src = s; t.srcK = K; t.srcN = N; t.dst = d; t.ld = ld; t.Kpad = K; t.Npad = N; };
  switch (j) {
    case 4: set(p.w_qkv, 1024, 1536, p.qkv_t, 1024); break;
    case 5: set(p.w_o, 1024, 1024, p.wo_t, 1024); break;
    case 0: set(p.f_up, 1024, 5632, p.up_t, 1024); break;
    case 1: set(p.f_up + (size_t)1024 * 5632, 1024, 5632, p.up_t + (size_t)5632 * 1024, 1024); break;
    case 2: set(p.f_down, 2816, 1024, p.down_t, 2816); break;
    case 3: set(p.f_down + (size_t)2816 * 1024, 2816, 1024, p.down_t + (size_t)1024 * 2816, 2816); break;
    case 6: set(p.rw_r, 1024, 1024, p.rr_t, 2048); break;
    case 7: set(p.rw_r, 1024, 1024, p.rr_t, 2048); t.mu = p.mu + 0 * 1024; t.koff = 1024; break;
    case 8: set(p.rw_k, 1024, 1024, p.rk_t, 2048); break;
    case 9: set(p.rw_k, 1024, 1024, p.rk_t, 2048); t.mu = p.mu + 2 * 1024; t.koff = 1024; break;
    case 10: set(p.rw_v, 1024, 1024, p.rv_t, 2048); break;
    case 11: set(p.rw_v, 1024, 1024, p.rv_t, 2048); t.mu = p.mu + 3 * 1024; t.koff = 1024; break;
    case 12: set(p.rw_o, 1024, 1024, p.ro_t, 1024); break;
    case 13: set(p.dw1, 1024, 64, p.w1_t, 2048); break;
    case 14: set(p.dw1, 1024, 64, p.w1_t, 2048); t.mu = p.mu + 1 * 1024; t.koff = 1024; break;
    case 15: set(p.dw1 + 1024 * 64, 1024, 64, p.w1_t + 64 * 2048, 2048); break;
    case 16: set(p.dw1 + 1024 * 64, 1024, 64, p.w1_t + 64 * 2048, 2048); t.mu = p.mu + 1 * 1024; t.koff = 1024; break;
    case 17: set(p.a1, 1024, 64, p.a1_t, 2048); break;
    case 18: set(p.a1, 1024, 64, p.a1_t, 2048); t.mu = p.mu + 4 * 1024; t.koff = 1024; break;
    case 19: set(p.a1 + 1024 * 64, 1024, 64, p.a1_t + 64 * 2048, 2048); break;
    case 20: set(p.a1 + 1024 * 64, 1024, 64, p.a1_t + 64 * 2048, 2048); t.mu = p.mu + 4 * 1024; t.koff = 1024; break;
    case 21: set(p.g1, 1024, 160, p.g1_t, 2048); t.Npad = 256; break;
    case 22: set(p.g1, 1024, 160, p.g1_t, 2048); t.Npad = 256; t.mu = p.mu + 5 * 1024; t.koff = 1024; break;
    case 23: set(p.dw2, 64, 1024, p.w2_t, 64); break;
    case 24: set(p.dw2 + 64 * 1024, 64, 1024, p.w2_t + 1024 * 64, 64); break;
    case 25: set(p.a2, 64, 1024, p.a2_t, 64); break;
    case 26: set(p.a2 + 64 * 1024, 64, 1024, p.a2_t + 1024 * 64, 64); break;
    default: set(p.g2, 160, 1024, p.g2_t, 192); t.Kpad = 192; break;
  }
  return t;
}
constexpr int NJOBS = 28;
DI int job_tiles(const TJob& t) { return ((t.Kpad + 63) >> 6) * ((t.Npad + 63) >> 6); }

DI void phase_prep(const Params& p, char* smem) {
  const int tid = threadIdx.x;
  const int ttiles = 7024;
  const int n_mod = 2 * 24 * 8;
  const int n_rope = 1024;
  const int total = ttiles + n_mod + n_rope;
  float* tile = (float*)smem;
  if (blockIdx.x == 0) for (int e = tid; e < 4096; e += 256) p.zero[e] = 0;
  {
    auto decode = [&](int item, TJob& t, int& kt, int& nt) {
      int rem = item, j = 0;
      t = get_job(p, 0);
      while (true) { int n = job_tiles(t); if (rem < n) break; rem -= n; ++j; t = get_job(p, j); }
      const int ntn = (t.Npad + 63) >> 6;
      kt = rem / ntn; nt = rem % ntn;
    };
    auto load_tile = [&](const TJob& t, int kt, int nt, float (&v)[16]) {
#pragma unroll
      for (int i = 0; i < 16; ++i) {
        const int kl = i * 4 + (tid >> 6), nl = tid & 63;
        const int k = kt * 64 + kl, n = nt * 64 + nl;
        float x = 0.f;
        if (k < t.srcK && n < t.srcN) { x = t.src[(size_t)k * t.srcN + n]; if (t.mu) x *= t.mu[k]; }
        v[i] = x;
      }
    };
    TJob tc, tn; int ktc = 0, ntc = 0, ktn = 0, ntn_ = 0;
    float vc[16], vn[16];
    int item = blockIdx.x;
    if (item < ttiles) { decode(item, tc, ktc, ntc); load_tile(tc, ktc, ntc, vc); }
    for (; item < ttiles; item += gridDim.x) {
      const int nxt = item + gridDim.x;
      if (nxt < ttiles) { decode(nxt, tn, ktn, ntn_); load_tile(tn, ktn, ntn_, vn); }
      __syncthreads();
#pragma unroll
      for (int i = 0; i < 16; ++i) tile[(i * 4 + (tid >> 6)) * 65 + (tid & 63)] = vc[i];
      __syncthreads();
#pragma unroll
      for (int i = 0; i < 16; ++i) {
        const int nl = i * 4 + (tid >> 6), kl = tid & 63;
        const int k = ktc * 64 + kl, n = ntc * 64 + nl;
        if (k < tc.Kpad && n < tc.Npad) tc.dst[(size_t)n * tc.ld + tc.koff + k] = f2bf(tile[kl * 65 + nl]);
      }
      if (nxt < ttiles) {
        tc = tn; ktc = ktn; ntc = ntn_;
#pragma unroll
        for (int i = 0; i < 16; ++i) vc[i] = vn[i];
      }
    }
  }
  int first_other = ttiles + (int)blockIdx.x;
  for (int item = first_other; item < total; item += gridDim.x) {
    if (false) {
    } else if (item < ttiles + n_mod) {
      const int it = item - ttiles;
      const int layer = it / 192, cc = (it % 192) / 8, kc = it % 8;
      float* sil = (float*)smem;
      __syncthreads();
      for (int e = tid; e < 640; e += 256) {
        const int j = e >> 7, k = kc * 128 + (e & 127);
        const float v = j < 4 ? p.c[j * 1024 + k] : p.c_ctx[k];
        sil[e] = v / (1.f + __expf(-v));
      }
      __syncthreads();
      const int col = cc * 256 + tid;
      float a0 = 0, a1 = 0, a2 = 0, a3 = 0, a4 = 0;
      const float* w = p.ada_w + ((size_t)layer * 1024 + kc * 128) * 6144 + col;
#pragma unroll 16
      for (int k = 0; k < 128; ++k) {
        const float wv = w[(size_t)k * 6144];
        a0 += sil[k] * wv; a1 += sil[128 + k] * wv; a2 += sil[256 + k] * wv; a3 += sil[384 + k] * wv; a4 += sil[512 + k] * wv;
      }
      float* mp = p.modpart + ((size_t)(layer * 8 + kc) * 5) * 6144 + col;
      mp[0] = a0; mp[6144] = a1; mp[2 * 6144] = a2; mp[3 * 6144] = a3; mp[4 * 6144] = a4;
    } else {
      const int e = (item - ttiles - n_mod) * 256 + tid;
      const int s = e >> 5, pr = e & 31;
      const int f = pr & 15;
      const float inv_freq = powf(10000.f, -(float)f / 16.f);
      const float pos = (pr < 16) ? (float)(s >> 6) : (float)(s & 63);
      const float ang = pos * inv_freq;
      float sn, cs;
      sincosf(ang, &sn, &cs);
      p.rope[e * 2] = cs; p.rope[e * 2 + 1] = sn;
    }
  }
}

DI void phase_modreduce(const Params& p) {
  const int n = 2 * 5 * 6144;
  for (int e = blockIdx.x * 256 + threadIdx.x; e < n; e += gridDim.x * 256) {
    const int layer = e / (5 * 6144), r = e % (5 * 6144), col = r % 6144;
    float s = p.ada_b[layer * 6144 + col];
    for (int kc = 0; kc < 8; ++kc) s += p.modpart[(size_t)(layer * 8 + kc) * 5 * 6144 + r];
    p.modv[e] = s;
  }
}

template <bool FROM_INPUT>
DI void phase_modulate(const Params& p, int layer, int which, int nrows) {
  const int lane = threadIdx.x & 63;
  const int gw = blockIdx.x * 4 + (threadIdx.x >> 6), nw = gridDim.x * 4;
  auto load_row = [&](int row, f32x4 (&v)[4], f32x4 (&sh)[4], f32x4 (&sc)[4]) {
    const float* src = FROM_INPUT ? xin_ptr(p, row) : resid_ptr(p, row);
    const float* mv = p.modv + ((size_t)layer * 5 + midx_of(row)) * 6144 + which * 3072;
#pragma unroll
    for (int i = 0; i < 4; ++i) {
      v[i] = *(const f32x4*)(src + i * 256 + lane * 4);
      sh[i] = *(const f32x4*)(mv + i * 256 + lane * 4);
      sc[i] = *(const f32x4*)(mv + 1024 + i * 256 + lane * 4);
    }
  };
  f32x4 v[4], sh[4], sc[4], vn[4], shn[4], scn[4];
  int row = gw;
  if (row < nrows) load_row(row, v, sh, sc);
  for (; row < nrows; row += nw) {
    const int nxt = row + nw;
    if (nxt < nrows) load_row(nxt, vn, shn, scn);
    float ss = 0.f;
#pragma unroll
    for (int i = 0; i < 4; ++i) ss += v[i][0] * v[i][0] + v[i][1] * v[i][1] + v[i][2] * v[i][2] + v[i][3] * v[i][3];
    ss = wave_sum(ss);
    const float rinv = rsqrtf(ss * (1.f / 1024.f) + 1e-6f);
#pragma unroll
    for (int i = 0; i < 4; ++i) {
      const int col = i * 256 + lane * 4;
      uint2 o;
      o.x = pack2(v[i][0] * rinv * (1.f + sc[i][0]) + sh[i][0], v[i][1] * rinv * (1.f + sc[i][1]) + sh[i][1]);
      o.y = pack2(v[i][2] * rinv * (1.f + sc[i][2]) + sh[i][2], v[i][3] * rinv * (1.f + sc[i][3]) + sh[i][3]);
      *(uint2*)(p.H + (size_t)row * DM + col) = o;
    }
#pragma unroll
    for (int i = 0; i < 4; ++i) { v[i] = vn[i]; sh[i] = shn[i]; sc[i] = scn[i]; }
  }
}

DI void shift_load(const Params& p, int row, bool valid, int lane, f32x4 (&raw)[4]) {
  if (valid) {
    const float* src = resid_ptr(p, row);
#pragma unroll
    for (int i = 0; i < 4; ++i) raw[i] = *(const f32x4*)(src + i * 256 + lane * 4);
  }
}
DI void shift_finish(const Params& p, int row, bool valid, int lane, const f32x4 (&raw)[4], float (&h)[16]) {
  if (!valid) {
#pragma unroll
    for (int i = 0; i < 16; ++i) h[i] = 0.f;
    return;
  }
  const float* mv = p.modv + ((size_t)1 * 5 + midx_of(row)) * 6144;
  float ss = 0.f;
#pragma unroll
  for (int i = 0; i < 4; ++i) ss += raw[i][0] * raw[i][0] + raw[i][1] * raw[i][1] + raw[i][2] * raw[i][2] + raw[i][3] * raw[i][3];
  ss = wave_sum(ss);
  const float rinv = rsqrtf(ss * (1.f / 1024.f) + 1e-6f);
#pragma unroll
  for (int i = 0; i < 4; ++i) {
    const int col = i * 256 + lane * 4;
    const float4 sh = *(const float4*)(mv + col);
    const float4 sc = *(const float4*)(mv + 1024 + col);
    h[i * 4 + 0] = raw[i][0] * rinv * (1.f + sc.x) + sh.x;
    h[i * 4 + 1] = raw[i][1] * rinv * (1.f + sc.y) + sh.y;
    h[i * 4 + 2] = raw[i][2] * rinv * (1.f + sc.z) + sh.z;
    h[i * 4 + 3] = raw[i][3] * rinv * (1.f + sc.w) + sh.w;
  }
}
DI void phase_rwkv_shift(const Params& p) {
  const int lane = threadIdx.x & 63;
  const int gw = blockIdx.x * 4 + (threadIdx.x >> 6), nw = gridDim.x * 4;
  const int nitems = MR / 8;
  for (int item = gw; item < nitems; item += nw) {
    const int r0 = item * 8;
    int sb, T;
    if (r0 < TL) { sb = r0 & ~8191; T = 8192; } else { sb = TL + ((r0 - TL) & ~255); T = 256; }
    const int send = sb + T;
    float hm[16], hc[16], hn[16];
    f32x4 raw[2][4];
    shift_load(p, r0 - 1, r0 - 1 >= sb, lane, raw[0]);
    shift_load(p, r0, true, lane, raw[1]);
    shift_finish(p, r0 - 1, r0 - 1 >= sb, lane, raw[0], hm);
    shift_load(p, r0 + 1, r0 + 1 < send, lane, raw[0]);
    shift_finish(p, r0, true, lane, raw[1], hc);
#pragma unroll
    for (int j = 0; j < 8; ++j) {
      const int row = r0 + j;
      if (j < 7) shift_load(p, row + 2, row + 2 < send, lane, raw[(j & 1) ^ 1]);
      shift_finish(p, row + 1, row + 1 < send, lane, raw[j & 1], hn);
#pragma unroll
      for (int i = 0; i < 4; ++i) {
        const int col = i * 256 + lane * 4;
        float xx[4];
#pragma unroll
        for (int e = 0; e < 4; ++e) xx[e] = 0.5f * (hm[i * 4 + e] + hn[i * 4 + e]) - hc[i * 4 + e];
        uint2 o, o2;
        o.x = pack2(hc[i * 4 + 0], hc[i * 4 + 1]); o.y = pack2(hc[i * 4 + 2], hc[i * 4 + 3]);
        o2.x = pack2(xx[0], xx[1]); o2.y = pack2(xx[2], xx[3]);
        *(uint2*)(p.H + (size_t)row * DM + col) = o;
        *(uint2*)(p.XX + (size_t)row * DM + col) = o2;
      }
#pragma unroll
      for (int i = 0; i < 16; ++i) { hm[i] = hc[i]; hc[i] = hn[i]; }
    }
  }
}

DI void phase_qkv(const Params& p, char* smem) {
  float* Cs = (float*)smem;
  const int tid = threadIdx.x;
  int g0, gend, gstep; work_range(264 * 12, g0, gend, gstep);
  for (int tile = g0; tile < gend; tile += gstep) {
    int mt, nt; band_decode(tile, 264, 12, mt, nt);
    const int m0 = mt * 128;
    f32x4 acc[4][4];
    gemm_mainloop(smem, 1, 1024,
                  [&](int r, int) { return (const u16*)(p.H + (size_t)(m0 + r) * DM); },
                  [&](int c) { return (const u16*)(p.qkv_t + (size_t)(nt * 128 + c) * 1024); }, acc);
    acc_to_lds(Cs, acc);
    const bool isctx = m0 >= TL;
    const int b = isctx ? (m0 - TL) >> 8 : m0 >> 13;
    const int t0 = isctx ? (m0 - TL) & 255 : m0 & 8191;
    if (nt < 10) {
      const int lane = tid & 63, wave = tid >> 6;
      const int hh = lane >> 5, pr = lane & 31;
      const bool isq = nt < 8;
      const float* gain = isq ? p.q_gain : p.k_gain;
      const float qs = isq ? 0.125f * 1.4426950408889634f : 1.f;
      const float g0 = gain[2 * pr] * qs, g1 = gain[2 * pr + 1] * qs;
      u16* dstb;
      size_t tstride = 64;
      if (isq) {
        const int head = nt * 2 + hh;
        dstb = isctx ? p.QC + ((size_t)(b * 16 + head) * 256 + t0) * 64 : p.Q + ((size_t)(b * 16 + head) * 8192 + t0) * 64;
      } else {
        const int kh = (nt - 8) * 2 + hh;
        dstb = p.Kb + ((size_t)(b * 4 + kh) * NKEY + (isctx ? t0 : 256 + t0)) * 64;
      }
#pragma unroll 1
      for (int rb = 0; rb < 32; rb += 8) {
        float2 cssn[8];
#pragma unroll
        for (int j = 0; j < 8; ++j) cssn[j] = isctx ? make_float2(1.f, 0.f) : *(const float2*)(p.rope + ((size_t)(t0 + wave * 32 + rb + j) * 32 + pr) * 2);
#pragma unroll
        for (int j = 0; j < 8; ++j) {
          const int r = wave * 32 + rb + j;
          const float2 v = *(const float2*)&CS(r, 2 * lane);
          float ss = v.x * v.x + v.y * v.y;
          ss = sum32(ss);
          const float rinv = rsqrtf(ss * (1.f / 64.f) + 1e-6f);
          const float x0 = v.x * rinv * g0, x1 = v.y * rinv * g1;
          const float y0 = x0 * cssn[j].x - x1 * cssn[j].y, y1 = x0 * cssn[j].y + x1 * cssn[j].x;
          *(unsigned*)(dstb + (size_t)r * tstride + 2 * pr) = pack2(y0, y1);
        }
      }
    } else {
      const int keybase = (isctx ? t0 : 256 + t0);
      for (int j = 0; j < 4; ++j) {
        const int item = tid + 256 * j;
        const int d = item & 63, hh = (item >> 6) & 1, rg = item >> 7;
        const int kh = (nt - 10) * 2 + hh;
        float v[16];
#pragma unroll
        for (int i = 0; i < 16; ++i) v[i] = CS(rg * 16 + i, hh * 64 + d);
        u16* dst = p.Vt + ((size_t)(b * 4 + kh) * 64 + d) * NKEY + keybase + rg * 16;
        *(u32x4*)(dst) = mk4(pack2(v[0], v[1]), pack2(v[2], v[3]), pack2(v[8], v[9]), pack2(v[10], v[11]));
        *(u32x4*)(dst + 8) = mk4(pack2(v[4], v[5]), pack2(v[6], v[7]), pack2(v[12], v[13]), pack2(v[14], v[15]));
      }
    }
  }
}

DI void phase_attn(const Params& p, char* smem) {
  const int tid = threadIdx.x, lane = tid & 63, wave = tid >> 6;
  const int sw = (lane >> 1) & 7, hsel = lane >> 5;
  float mq = 0.f, mk = 0.f;
  for (int d = 0; d < 64; ++d) { mq = fmaxf(mq, fabsf(p.q_gain[d])); mk = fmaxf(mk, fabsf(p.k_gain[d])); }
  const float c0 = 0.125f * 1.4426950408889634f * 64.f * mq * mk * 1.02f + 0.5f;
  f32x16 negc;
#pragma unroll
  for (int i = 0; i < 16; ++i) negc[i] = -c0;
  int ga, gae, gs, gc, gce, gs2;
  work_range(2048, ga, gae, gs);
  work_range(64, gc, gce, gs2);
  const int n_lat = ga < gae ? (gae - ga + gs - 1) / gs : 0;
  const int n_ctx = gc < gce ? (gce - gc + gs2 - 1) / gs2 : 0;
  for (int wi = 0; wi < n_lat + n_ctx; ++wi) {
    const int item = wi < n_lat ? ga + wi * gs : 2048 + gc + (wi - n_lat) * gs2;
    int b, kvh, qb, nkt;
    const u16* qbase;
    size_t orow;
    const int head_g = wave;
    if (item < 2048) {
      b = item >> 9; kvh = (item >> 7) & 3; qb = item & 127; nkt = NKEY / 64;
      qbase = p.Q + ((size_t)(b * 16 + kvh * 4 + head_g) * 8192 + qb * 64) * 64;
      orow = (size_t)b * 8192 + qb * 64;
    } else {
      const int j = item - 2048;
      b = j >> 4; kvh = (j >> 2) & 3; qb = j & 3; nkt = 4;
      qbase = p.QC + ((size_t)(b * 16 + kvh * 4 + head_g) * 256 + qb * 64) * 64;
      orow = (size_t)TL + b * 256 + qb * 64;
    }
    const int head = kvh * 4 + head_g;
    bf16x8 qf[2][4];
#pragma unroll
    for (int qi = 0; qi < 2; ++qi)
#pragma unroll
      for (int ks = 0; ks < 4; ++ks) qf[qi][ks] = *(const bf16x8*)(qbase + (qi * 32 + (lane & 31)) * 64 + ks * 16 + hsel * 8);
    const u16* kg = p.Kb + (size_t)(b * 4 + kvh) * NKEY * 64;
    const u16* vg = p.Vt + (size_t)(b * 4 + kvh) * 64 * NKEY;
    f32x16 oacc[2][2];
#pragma unroll
    for (int i = 0; i < 16; ++i) { oacc[0][0][i] = 0.f; oacc[0][1][i] = 0.f; oacc[1][0][i] = 0.f; oacc[1][1][i] = 0.f; }
    f32x2 ls2[2] = {{0.f, 0.f}, {0.f, 0.f}};
    const int grow = wave * 8 + (lane >> 3);
    const int gsrc = ((lane & 7) ^ ((grow >> 1) & 7)) * 8;
    const u16* kgl = kg + (size_t)grow * 64 + gsrc;
    const u16* vgl = vg + (size_t)grow * NKEY + gsrc;
    char* const wb = smem + wave * 1024;
    auto stage_kv = [&](int kt, int buf) {
#pragma unroll
      for (int q = 0; q < 2; ++q) {
        __builtin_amdgcn_global_load_lds((const unsigned*)(kgl + (size_t)kt * 4096 + q * 32 * 64), (unsigned*)(wb + buf * 16384 + q * 4096), 16, 0, 0);
        __builtin_amdgcn_global_load_lds((const unsigned*)(vgl + (size_t)q * 32 * NKEY + kt * 64), (unsigned*)(wb + buf * 16384 + 8192 + q * 4096), 16, 0, 0);
      }
    };
    __syncthreads();
    stage_kv(0, 0);
    asm volatile("s_waitcnt vmcnt(0)" ::: "memory");
    __syncthreads();
    for (int kt = 0; kt < nkt; ++kt) {
      const int buf = kt & 1;
      if (kt + 1 < nkt) stage_kv(kt + 1, buf ^ 1);
      const u16* Ks = (const u16*)(smem + buf * 16384);
      const u16* Vs = Ks + 64 * 64;
      f32x16 sacc[2][2];
#pragma unroll
      for (int kb = 0; kb < 2; ++kb) {
        bf16x8 kf[4];
#pragma unroll
        for (int ks = 0; ks < 4; ++ks) kf[ks] = *(const bf16x8*)(Ks + (kb * 32 + (lane & 31)) * 64 + (((ks * 2 + hsel) ^ sw) * 8));
#pragma unroll
        for (int ks = 0; ks < 4; ++ks) {
          sacc[0][kb] = __builtin_amdgcn_mfma_f32_32x32x16_bf16(kf[ks], qf[0][ks], ks == 0 ? negc : sacc[0][kb], 0, 0, 0);
          sacc[1][kb] = __builtin_amdgcn_mfma_f32_32x32x16_bf16(kf[ks], qf[1][ks], ks == 0 ? negc : sacc[1][kb], 0, 0, 0);
        }
      }
#pragma unroll
      for (int qi = 0; qi < 2; ++qi)
#pragma unroll
        for (int kb = 0; kb < 2; ++kb)
#pragma unroll
          for (int i = 0; i < 16; i += 2) {
            const float e0 = __builtin_amdgcn_exp2f(sacc[qi][kb][i]), e1 = __builtin_amdgcn_exp2f(sacc[qi][kb][i + 1]);
            sacc[qi][kb][i] = e0; sacc[qi][kb][i + 1] = e1;
            const f32x2 e2 = {e0, e1};
            ls2[qi] += e2;
          }
#pragma unroll
      for (int kb = 0; kb < 2; ++kb)
#pragma unroll
        for (int s2 = 0; s2 < 2; ++s2) {
          bf16x8 vfr[2];
#pragma unroll
          for (int db = 0; db < 2; ++db) vfr[db] = *(const bf16x8*)(Vs + (db * 32 + (lane & 31)) * 64 + (((2 * (2 * kb + s2) + hsel) ^ sw) * 8));
#pragma unroll
          for (int qi = 0; qi < 2; ++qi) {
            unsigned w[4];
#pragma unroll
            for (int e = 0; e < 4; ++e) w[e] = pack2(sacc[qi][kb][8 * s2 + 2 * e], sacc[qi][kb][8 * s2 + 2 * e + 1]);
            u32x4 pw = mk4(w[0], w[1], w[2], w[3]);
            const bf16x8 pf = __builtin_bit_cast(bf16x8, pw);
#pragma unroll
            for (int db = 0; db < 2; ++db) oacc[qi][db] = __builtin_amdgcn_mfma_f32_32x32x16_bf16(vfr[db], pf, oacc[qi][db], 0, 0, 0);
          }
        }
      asm volatile("s_waitcnt vmcnt(0)" ::: "memory");
      __syncthreads();
    }
#pragma unroll
    for (int qi = 0; qi < 2; ++qi) {
      const float lsum = ls2[qi][0] + ls2[qi][1];
      const float l = lsum + __shfl_xor(lsum, 32, 64);
      const float inv = 1.f / l;
      u16* od = p.H + (orow + qi * 32 + (lane & 31)) * DM + head * 64;
#pragma unroll
      for (int db = 0; db < 2; ++db)
#pragma unroll
        for (int g = 0; g < 4; ++g) {
          uint2 o;
          o.x = pack2(oacc[qi][db][g * 4 + 0] * inv, oacc[qi][db][g * 4 + 1] * inv);
          o.y = pack2(oacc[qi][db][g * 4 + 2] * inv, oacc[qi][db][g * 4 + 3] * inv);
          *(uint2*)(od + db * 32 + 8 * g + 4 * hsel) = o;
        }
    }
  }
}

template <bool FROM_INPUT>
DI void phase_proj_res(const Params& p, char* smem, const u16* A, int lda, int K, const u16* Bt, int layer, int gate_idx, int mtiles) {
  int g0, gend, gstep; work_range(mtiles * 8, g0, gend, gstep);
  for (int tile = g0; tile < gend; tile += gstep) {
    int mt, nt; band_decode(tile, mtiles, 8, mt, nt);
    const int m0 = mt * 128;
    f32x4 acc[4][4];
    gemm_mainloop(smem, 1, K,
                  [&](int r, int) { return A + (size_t)(m0 + r) * lda; },
                  [&](int c) { return Bt + (size_t)(nt * 128 + c) * K; }, acc);
    const float* gate = p.modv + ((size_t)layer * 5 + midx_of(m0)) * 6144 + gate_idx * 1024 + nt * 128;
    const float* sb = (FROM_INPUT ? xin_ptr(p, m0) : (const float*)resid_ptr(p, m0)) + nt * 128;
    float* db = resid_ptr(p, m0) + nt * 128;
    {
      const int lane = threadIdx.x & 63, wave = threadIdx.x >> 6;
      const int wm = wave >> 1, wn = wave & 1, g4 = lane >> 4;
      float gt[4];
#pragma unroll
      for (int j = 0; j < 4; ++j) gt[j] = gate[wn * 64 + j * 16 + (lane & 15)];
#pragma unroll
      for (int i = 0; i < 4; ++i) {
        float res[4][4];
#pragma unroll
        for (int j = 0; j < 4; ++j)
#pragma unroll
          for (int e = 0; e < 4; ++e) res[j][e] = sb[(wm * 64 + i * 16 + g4 * 4 + e) * DM + wn * 64 + j * 16 + (lane & 15)];
#pragma unroll
        for (int j = 0; j < 4; ++j)
#pragma unroll
          for (int e = 0; e < 4; ++e) db[(wm * 64 + i * 16 + g4 * 4 + e) * DM + wn * 64 + j * 16 + (lane & 15)] = res[j][e] + gt[j] * acc[i][j][e];
      }
    }
  }
}

DI void phase_ffn_up(const Params& p, char* smem, int layer, bool with_ctx, u16* ACT) {
  float* Cs = (float*)smem;
  const int tid = threadIdx.x;
  const int mtiles = with_ctx ? 276 : 264;
  int g0, gend, gstep; work_range(mtiles * 44, g0, gend, gstep);
  const u16* up = p.up_t + (size_t)layer * 5632 * 1024;
  const float* cw = p.f_cw + (size_t)layer * 3 * 5632;
  const float* cb = p.f_cb + (size_t)layer * 5632;
  for (int tile = g0; tile < gend; tile += gstep) {
    int mt, nt; band_decode(tile, mtiles, 44, mt, nt);
    int rowbase, T, j;
    if (mt < 264) { rowbase = (mt / 66) * 8192; T = 8192; j = mt % 66; }
    else { const int m2 = mt - 264; rowbase = TL + (m2 / 3) * 256; T = 256; j = m2 % 3; }
    const int tb = j * 126 - 1;
    f32x4 acc[4][4];
    gemm_mainloop(smem, 1, 1024,
                  [&](int r, int) { const int t = tb + r; return (t >= 0 && t < T) ? (const u16*)(p.H + (size_t)(rowbase + t) * DM) : (const u16*)p.zero; },
                  [&](int c) { return up + (size_t)(c < 64 ? nt * 64 + c : 2816 + nt * 64 + (c - 64)) * 1024; }, acc);
    acc_to_lds(Cs, acc);
    const int c = tid & 63, rq = tid >> 6;
    const int n = nt * 64 + c;
    const float g0 = cw[n], g1 = cw[5632 + n], g2 = cw[2 * 5632 + n], gb = cb[n];
    const float v0 = cw[2816 + n], v1 = cw[5632 + 2816 + n], v2 = cw[2 * 5632 + 2816 + n], vb = cb[2816 + n];
    const int rs = 1 + rq * 32;
    int re = rs + 32; if (re > 127) re = 127;
    float gp = CS(rs - 1, c), gc = CS(rs, c), vp = CS(rs - 1, c + 64), vc = CS(rs, c + 64);
    for (int r = rs; r < re; ++r) {
      const float gn = CS(r + 1, c), vn = CS(r + 1, c + 64);
      const int t = tb + r;
      if (t < T) {
        const float g = g0 * gp + g1 * gc + g2 * gn + gb;
        const float v = v0 * vp + v1 * vc + v2 * vn + vb;
        const float a = g * __builtin_amdgcn_rcpf(1.f + __expf(-g)) * v;
        ACT[(size_t)(rowbase + t) * DFF + n] = f2bf(a);
      }
      gp = gc; gc = gn; vp = vc; vc = vn;
    }
  }
}

DI void phase_rwkv_gemms(const Params& p, char* smem) {
  float* Cs = (float*)smem;
  const int tid = threadIdx.x;
  int g0, gend, gstep; work_range(7312, g0, gend, gstep);
  for (int tile = g0; tile < gend; tile += gstep) {
    int job, mt, nt;
    const u16* Bt;
    if (tile < 2048) { job = 0; band_decode(tile, 256, 8, mt, nt); Bt = p.rr_t; }
    else if (tile < 4160) { job = 1; band_decode(tile - 2048, 264, 8, mt, nt); Bt = p.rk_t; }
    else if (tile < 6272) { job = 2; band_decode(tile - 4160, 264, 8, mt, nt); Bt = p.rv_t; }
    else if (tile < 6536) { job = 3; mt = tile - 6272; nt = 0; Bt = p.w1_t; }
    else if (tile < 6800) { job = 4; mt = tile - 6536; nt = 0; Bt = p.a1_t; }
    else { job = 5; band_decode(tile - 6800, 256, 2, mt, nt); Bt = p.g1_t; }
    const int m0 = mt * 128;
    f32x4 acc[4][4];
    gemm_mainloop(smem, 2, 1024,
                  [&](int r, int part) { return (const u16*)((part ? p.XX : p.H) + (size_t)(m0 + r) * DM); },
                  [&](int c) { return Bt + (size_t)(nt * 128 + c) * 2048; }, acc);
    if (job == 0) {
      epi_direct(acc, [&](int r, int c, float v) { p.R16[(size_t)(m0 + r) * DM + nt * 128 + c] = (f16)v; });
    } else if (job == 2) {
      epi_direct(acc, [&](int r, int c, float v) { p.V16[(size_t)(m0 + r) * DM + nt * 128 + c] = (f16)v; });
    } else if (job == 3) {
      epi_direct(acc, [&](int r, int c, float v) { p.LW[(size_t)(m0 + r) * 128 + c] = f2bf(tanhf(v)); });
    } else if (job == 4) {
      epi_direct(acc, [&](int r, int c, float v) { p.LA[(size_t)(m0 + r) * 128 + c] = f2bf(v); });
    } else if (job == 5) {
      epi_direct(acc, [&](int r, int c, float v) {
        const int col = nt * 128 + c;
        if (col < 192) p.LG[(size_t)(m0 + r) * 192 + col] = col < 160 ? f2bf(sigmoid_fast(v)) : (u16)0;
      });
    } else {
      acc_to_lds(Cs, acc);
      const int lane = tid & 63, wave = tid >> 6;
      const int col = nt * 128 + 2 * lane;
      const float kk0 = p.k_k[col], kk1 = p.k_k[col + 1];
#pragma unroll 4
      for (int rr = 0; rr < 32; ++rr) {
        const int r = wave * 32 + rr;
        const float2 v = *(const float2*)&CS(r, 2 * lane);
        const float a0 = v.x * kk0, a1 = v.y * kk1;
        float ss = a0 * a0 + a1 * a1;
        ss = sum32(ss);
        const float inv = 1.f / fmaxf(sqrtf(ss), 1e-12f);
        f16 k2[2], n2[2];
        k2[0] = (f16)v.x; k2[1] = (f16)v.y; n2[0] = (f16)(a0 * inv); n2[1] = (f16)(a1 * inv);
        *(unsigned*)(p.K16 + (size_t)(m0 + r) * DM + col) = *(const unsigned*)k2;
        *(unsigned*)(p.KK16 + (size_t)(m0 + r) * DM + col) = *(const unsigned*)n2;
      }
    }
  }
}

#define XB_TMO      128
#define XB_XCNT(j)  (256  + 64 * (j))
#define XB_XSUB(j)  (1280 + 64 * (j))
#define XB_XGEN(j)  (2304 + 64 * (j))
#define XB_TOP      3328
#define XB_TOPGEN   3392
#define XB_SPIN_CAP (1u << 20)
DI unsigned xb_ld(unsigned* p) { return __hip_atomic_load(p, __ATOMIC_RELAXED, __HIP_MEMORY_SCOPE_AGENT); }
DI unsigned xb_add(unsigned* p, unsigned v) { return __hip_atomic_fetch_add(p, v, __ATOMIC_RELAXED, __HIP_MEMORY_SCOPE_AGENT); }
DI unsigned xb_xcc_id() { return (unsigned)__builtin_amdgcn_s_getreg((3 << 11) | 20) & 0xFu; }
#define XB_SPIN(cond, bar) do { unsigned _sp = 0; while (cond) { __builtin_amdgcn_s_sleep(1); \
    if ((++_sp & 255u) == 0u) { if (xb_ld(&(bar)[XB_TMO])) break; if (_sp > XB_SPIN_CAP) { atomicAdd(&(bar)[XB_TMO], 1u); break; } } } } while (0)
struct XbState { unsigned x, nloc, nx; };
DI void xb_census(unsigned* bar, unsigned x, unsigned& nloc, unsigned& nx) {
  const unsigned G = gridDim.x;
  unsigned sum, cnt, mine, sp = 0u;
  for (;;) {
    sum = 0u; cnt = 0u; mine = 0u;
#pragma unroll
    for (unsigned j = 0; j < 16; ++j) { const unsigned c = xb_ld(&bar[XB_XCNT(j)]); sum += c; cnt += (c > 0u) ? 1u : 0u; mine = (j == x) ? c : mine; }
    if (sum == G) break;
    __builtin_amdgcn_s_sleep(1);
    if ((++sp & 255u) == 0u) { if (xb_ld(&bar[XB_TMO])) break; if (sp > XB_SPIN_CAP) { atomicAdd(&bar[XB_TMO], 1u); break; } }
  }
  nloc = mine > 0u ? mine : 1u; nx = cnt > 0u ? cnt : 1u;
}
DI void grid_barrier(unsigned* bar, XbState& st) {
  asm volatile("s_waitcnt vmcnt(0)" ::: "memory");
  __syncthreads();
  if (threadIdx.x == 0) {
    __builtin_amdgcn_s_waitcnt(0);
    if (st.nloc == 0u) xb_census(bar, st.x, st.nloc, st.nx);
    const unsigned nloc = st.nloc, nx = st.nx;
    const unsigned old = xb_add(&bar[XB_XSUB(st.x)], 1u);
    const unsigned gen = old / nloc;
    if (old + 1u == (gen + 1u) * nloc) {
      __builtin_amdgcn_fence(__ATOMIC_RELEASE, "agent");
      asm volatile("s_waitcnt vmcnt(0)" ::: "memory");
      const unsigned og = xb_add(&bar[XB_TOP], 1u);
      const unsigned tg = og / nx;
      if (og + 1u == (tg + 1u) * nx) xb_add(&bar[XB_TOPGEN], 1u);
      else XB_SPIN(xb_ld(&bar[XB_TOPGEN]) == tg, bar);
      __builtin_amdgcn_fence(__ATOMIC_ACQUIRE, "agent");
      xb_add(&bar[XB_XGEN(st.x)], 1u);
      asm volatile("s_waitcnt vmcnt(0)" ::: "memory");
    } else {
      XB_SPIN(xb_ld(&bar[XB_XGEN(st.x)]) == gen, bar);
      __builtin_amdgcn_fence(__ATOMIC_ACQUIRE, "agent");
      asm volatile("s_waitcnt vmcnt(0)" ::: "memory");
    }
  }
  __syncthreads();
}

struct ScanLds {
  float dec[2][16][64], kd[2][16][64], nk[2][16][64], bb[2][16][64], rr[2][16][64];
  float vv[2][16][16];
  float yy[2][16][16];
  float bp[2][4][16];
};

template <int DIR, bool EMIT>
DI void scan_steps(const ScanLds& L, int bsel, int c0, int myrow, int l15, f32x2& Sa, f32x2& Sb, float& ykeep) {
  f32x4 d4[2], k4[2], n4[2], b4[2], r4[2];
  float vv[2];
  auto ld = [&](int slot, int s) {
    d4[slot] = *(const f32x4*)&L.dec[bsel][s][c0];
    k4[slot] = *(const f32x4*)&L.kd[bsel][s][c0];
    n4[slot] = *(const f32x4*)&L.nk[bsel][s][c0];
    b4[slot] = *(const f32x4*)&L.bb[bsel][s][c0];
    if (EMIT) r4[slot] = *(const f32x4*)&L.rr[bsel][s][c0];
    vv[slot] = L.vv[bsel][s][myrow];
  };
  ld(0, DIR ? 15 : 0);
#pragma unroll
  for (int ss = 0; ss < 16; ++ss) {
    const int s = DIR ? 15 - ss : ss;
    const int cur = ss & 1;
    if (ss + 1 < 16) ld(cur ^ 1, DIR ? 14 - ss : ss + 1);
    const f32x2 nlo = {n4[cur][0], n4[cur][1]}, nhi = {n4[cur][2], n4[cur][3]};
    const f32x2 dlo = {d4[cur][0], d4[cur][1]}, dhi = {d4[cur][2], d4[cur][3]};
    const f32x2 klo = {k4[cur][0], k4[cur][1]}, khi = {k4[cur][2], k4[cur][3]};
    const f32x2 blo = {b4[cur][0], b4[cur][1]}, bhi = {b4[cur][2], b4[cur][3]};
    f32x2 t = Sa * nlo + Sb * nhi;
    float sa = dpp_sum16(t[0] + t[1]);
    const f32x2 sa2 = {sa, sa}, v2 = {vv[cur], vv[cur]};
    Sa = Sa * dlo + (sa2 * blo + v2 * klo);
    Sb = Sb * dhi + (sa2 * bhi + v2 * khi);
    if (EMIT) {
      const f32x2 rlo = {r4[cur][0], r4[cur][1]}, rhi = {r4[cur][2], r4[cur][3]};
      const f32x2 u = Sa * rlo + Sb * rhi;
      const float y = dpp_sum16(u[0] + u[1]);
      ykeep = (l15 == s) ? y : ykeep;
    }
  }
}

template <int DIR>
DI void scan_item(const Params& p, ScanLds& L, int b, int h, int q) {
  constexpr int dir = DIR;
  const int tid = threadIdx.x, lane = tid & 63, wave = tid >> 6;
  const int l15 = lane & 15, l4 = lane >> 4;
  const int colw = h * 64 + wave * 16 + l15;
  const int chd = wave * 16 + l15;
  bf16x8 w2f[2], a2f[2];
#pragma unroll
  for (int ks = 0; ks < 2; ++ks) {
    w2f[ks] = *(const bf16x8*)(p.w2_t + ((size_t)(dir * 1024 + colw) * 64 + ks * 32 + l4 * 8));
    a2f[ks] = *(const bf16x8*)(p.a2_t + ((size_t)(dir * 1024 + colw) * 64 + ks * 32 + l4 * 8));
  }
  const float w0c = p.dw0[dir * 1024 + colw], a0c = p.a0[dir * 1024 + colw], kac = p.k_a[colw], rkc = p.r_k[colw];
  f32x2 Sa = {0.f, 0.f}, Sb = {0.f, 0.f};
  const int myrow = wave * 4 + l4;
  const int c0 = l15 * 4;
  bf16x8 lwf[2], laf[2];
  f16 kv[4], kkv[4], rv[4];
  f16 vvr;
  auto chunk_rowbase = [&](int c, bool& isctx) -> int {
    if (c < 16) { isctx = true; const int cc = dir ? 15 - c : c; return TL + b * 256 + cc * 16; }
    isctx = false; const int cc = dir ? 511 - (c - 16) : (c - 16); return b * 8192 + cc * 16;
  };
  auto stage_load = [&](int c) {
    bool isctx; const int rb = chunk_rowbase(c, isctx);
#pragma unroll
    for (int ks = 0; ks < 2; ++ks) {
      lwf[ks] = *(const bf16x8*)(p.LW + ((size_t)(rb + l15) * 128 + dir * 64 + ks * 32 + l4 * 8));
      laf[ks] = *(const bf16x8*)(p.LA + ((size_t)(rb + l15) * 128 + dir * 64 + ks * 32 + l4 * 8));
    }
#pragma unroll
    for (int i = 0; i < 4; ++i) {
      const size_t off = (size_t)(rb + l4 * 4 + i) * DM + colw;
      kv[i] = p.K16[off]; kkv[i] = p.KK16[off];
      rv[i] = isctx ? (f16)0.f : p.R16[off];
    }
    vvr = p.V16[(size_t)(rb + (tid >> 4)) * DM + h * 64 + q * 16 + (tid & 15)];
  };
  auto stage_compute = [&](int c) {
    const int bsel = c & 1;
    f32x4 wacc = {0.f, 0.f, 0.f, 0.f}, aacc = {0.f, 0.f, 0.f, 0.f};
    wacc = __builtin_amdgcn_mfma_f32_16x16x32_bf16(lwf[0], w2f[0], wacc, 0, 0, 0);
    wacc = __builtin_amdgcn_mfma_f32_16x16x32_bf16(lwf[1], w2f[1], wacc, 0, 0, 0);
    aacc = __builtin_amdgcn_mfma_f32_16x16x32_bf16(laf[0], a2f[0], aacc, 0, 0, 0);
    aacc = __builtin_amdgcn_mfma_f32_16x16x32_bf16(laf[1], a2f[1], aacc, 0, 0, 0);
    float bpart[4];
#pragma unroll
    for (int i = 0; i < 4; ++i) {
      const int s = l4 * 4 + i;
      const float sg = sigmoid_fast(w0c + wacc[i]);
      const float dec = __expf(-0.6065306597126334f * sg);
      const float a = sigmoid_fast(a0c + aacc[i]);
      const float k = (float)kv[i], kk = (float)kkv[i], r = (float)rv[i];
      const float kd = k * (1.f + (a - 1.f) * kac);
      L.dec[bsel][s][chd] = dec;
      L.kd[bsel][s][chd] = kd;
      L.nk[bsel][s][chd] = -kk;
      L.bb[bsel][s][chd] = kk * a;
      L.rr[bsel][s][chd] = r;
      if (q == 0) bpart[i] = dpp_sum16(r * kd * rkc);
    }
    if (q == 0 && l15 == 0) {
#pragma unroll
      for (int i = 0; i < 4; ++i) L.bp[bsel][wave][l4 * 4 + i] = bpart[i];
    }
    L.vv[bsel][tid >> 4][tid & 15] = (float)vvr;
  };
  auto write_bonus = [&](int c) {
    if (q == 0 && tid < 16) {
      bool isctx; const int rb = chunk_rowbase(c, isctx);
      const int b2 = c & 1;
      p.bonus[((size_t)dir * MR + rb + tid) * 16 + h] = L.bp[b2][0][tid] + L.bp[b2][1][tid] + L.bp[b2][2][tid] + L.bp[b2][3][tid];
    }
  };
  __syncthreads();
  stage_load(0);
  stage_compute(0);
  __syncthreads();
  write_bonus(0);
  const int NCH = 528;
  float ykeep = 0.f;
#pragma unroll 1
  for (int c = 0; c < 16; ++c) {
    stage_load(c + 1);
    scan_steps<DIR, false>(L, c & 1, c0, myrow, l15, Sa, Sb, ykeep);
    stage_compute(c + 1);
    __syncthreads();
    write_bonus(c + 1);
  }
#pragma unroll 1
  for (int c = 16; c < NCH; ++c) {
    const int bsel = c & 1;
    if (c + 1 < NCH) stage_load(c + 1);
    scan_steps<DIR, true>(L, bsel, c0, myrow, l15, Sa, Sb, ykeep);
    L.yy[bsel][l15][myrow] = ykeep;
    if (c + 1 < NCH) stage_compute(c + 1);
    __syncthreads();
    {
      bool isctx; const int rb = chunk_rowbase(c, isctx);
      f16* Y = dir ? p.Y1 : p.Y0;
      Y[(size_t)(rb + (tid >> 4)) * DM + h * 64 + q * 16 + (tid & 15)] = (f16)(L.yy[bsel][tid >> 4][tid & 15] * 0.0625f);
    }
    if (c + 1 < NCH) write_bonus(c + 1);
  }
}

struct ScanLds2 {
  float dec[2][16][64], kd[2][16][64], nk[2][16][64], bb[2][16][64], rr[2][16][64];
  float vv[2][16][32];
  float yy[2][16][32];
  float bp[2][4][16];
};
DI float dpp_sum8(float v) {
  v += dpp_mov<0xB1>(v);
  v += dpp_mov<0x4E>(v);
  v += dpp_mov<0x141>(v);
  return v;
}
template <int DIR, bool EMIT>
DI void scan_steps2(const ScanLds2& L, int bsel, int c0, int myrow, int l7, f32x2 (&S)[4], float& ykA, float& ykB) {
  f32x4 d4[2][2], k4[2][2], n4[2][2], b4[2][2], r4[2][2];
  float vv[2];
  auto ld = [&](int slot, int s) {
#pragma unroll
    for (int hf = 0; hf < 2; ++hf) {
      d4[slot][hf] = *(const f32x4*)&L.dec[bsel][s][c0 + 4 * hf];
      k4[slot][hf] = *(const f32x4*)&L.kd[bsel][s][c0 + 4 * hf];
      n4[slot][hf] = *(const f32x4*)&L.nk[bsel][s][c0 + 4 * hf];
      b4[slot][hf] = *(const f32x4*)&L.bb[bsel][s][c0 + 4 * hf];
      if (EMIT) r4[slot][hf] = *(const f32x4*)&L.rr[bsel][s][c0 + 4 * hf];
    }
    vv[slot] = L.vv[bsel][s][myrow];
  };
  ld(0, DIR ? 15 : 0);
#pragma unroll
  for (int ss = 0; ss < 16; ++ss) {
    const int s = DIR ? 15 - ss : ss;
    const int cur = ss & 1;
    if (ss + 1 < 16) ld(cur ^ 1, DIR ? 14 - ss : ss + 1);
    f32x2 t = {0.f, 0.f};
#pragma unroll
    for (int i = 0; i < 4; ++i) { const f32x2 nn = {n4[cur][i >> 1][(i & 1) * 2], n4[cur][i >> 1][(i & 1) * 2 + 1]}; t += S[i] * nn; }
    const float sa = dpp_sum8(t[0] + t[1]);
    const f32x2 sa2 = {sa, sa}, v2 = {vv[cur], vv[cur]};
#pragma unroll
    for (int i = 0; i < 4; ++i) {
      const f32x2 dd = {d4[cur][i >> 1][(i & 1) * 2], d4[cur][i >> 1][(i & 1) * 2 + 1]};
      const f32x2 kk = {k4[cur][i >> 1][(i & 1) * 2], k4[cur][i >> 1][(i & 1) * 2 + 1]};
      const f32x2 bb = {b4[cur][i >> 1][(i & 1) * 2], b4[cur][i >> 1][(i & 1) * 2 + 1]};
      S[i] = S[i] * dd + (sa2 * bb + v2 * kk);
    }
    if (EMIT) {
      f32x2 u = {0.f, 0.f};
#pragma unroll
      for (int i = 0; i < 4; ++i) { const f32x2 rr = {r4[cur][i >> 1][(i & 1) * 2], r4[cur][i >> 1][(i & 1) * 2 + 1]}; u += S[i] * rr; }
      const float y = dpp_sum8(u[0] + u[1]);
      if (s < 8) ykA = (l7 == s) ? y : ykA; else ykB = (l7 == s - 8) ? y : ykB;
    }
  }
}
template <int DIR>
DI void scan_item2(const Params& p, ScanLds2& L, int b, int h, int hf) {
  constexpr int dir = DIR;
  const int tid = threadIdx.x, lane = tid & 63, wave = tid >> 6;
  const int l15 = lane & 15, l4 = lane >> 4;
  const int colw = h * 64 + wave * 16 + l15;
  const int chd = wave * 16 + l15;
  bf16x8 w2f[2], a2f[2];
#pragma unroll
  for (int ks = 0; ks < 2; ++ks) {
    w2f[ks] = *(const bf16x8*)(p.w2_t + ((size_t)(dir * 1024 + colw) * 64 + ks * 32 + l4 * 8));
    a2f[ks] = *(const bf16x8*)(p.a2_t + ((size_t)(dir * 1024 + colw) * 64 + ks * 32 + l4 * 8));
  }
  const float w0c = p.dw0[dir * 1024 + colw], a0c = p.a0[dir * 1024 + colw], kac = p.k_a[colw], rkc = p.r_k[colw];
  f32x2 S[4];
#pragma unroll
  for (int i = 0; i < 4; ++i) { S[i][0] = 0.f; S[i][1] = 0.f; }
  const int l7 = lane & 7;
  const int myrow = wave * 8 + (lane >> 3);
  const int c0 = l7 * 8;
  bf16x8 lwf[2], laf[2];
  f16 kv[4], kkv[4], rv[4];
  f16 vvr[2];
  auto chunk_rowbase = [&](int c, bool& isctx) -> int {
    if (c < 16) { isctx = true; const int cc = dir ? 15 - c : c; return TL + b * 256 + cc * 16; }
    isctx = false; const int cc = dir ? 511 - (c - 16) : (c - 16); return b * 8192 + cc * 16;
  };
  auto stage_load = [&](int c) {
    bool isctx; const int rb = chunk_rowbase(c, isctx);
#pragma unroll
    for (int ks = 0; ks < 2; ++ks) {
      lwf[ks] = *(const bf16x8*)(p.LW + ((size_t)(rb + l15) * 128 + dir * 64 + ks * 32 + l4 * 8));
      laf[ks] = *(const bf16x8*)(p.LA + ((size_t)(rb + l15) * 128 + dir * 64 + ks * 32 + l4 * 8));
    }
#pragma unroll
    for (int i = 0; i < 4; ++i) {
      const size_t off = (size_t)(rb + l4 * 4 + i) * DM + colw;
      kv[i] = p.K16[off]; kkv[i] = p.KK16[off];
      rv[i] = isctx ? (f16)0.f : p.R16[off];
    }
#pragma unroll
    for (int j = 0; j < 2; ++j) { const int e = tid + 256 * j; vvr[j] = p.V16[(size_t)(rb + (e >> 5)) * DM + h * 64 + hf * 32 + (e & 31)]; }
  };
  auto stage_compute = [&](int c) {
    const int bsel = c & 1;
    f32x4 wacc = {0.f, 0.f, 0.f, 0.f}, aacc = {0.f, 0.f, 0.f, 0.f};
    wacc = __builtin_amdgcn_mfma_f32_16x16x32_bf16(lwf[0], w2f[0], wacc, 0, 0, 0);
    wacc = __builtin_amdgcn_mfma_f32_16x16x32_bf16(lwf[1], w2f[1], wacc, 0, 0, 0);
    aacc = __builtin_amdgcn_mfma_f32_16x16x32_bf16(laf[0], a2f[0], aacc, 0, 0, 0);
    aacc = __builtin_amdgcn_mfma_f32_16x16x32_bf16(laf[1], a2f[1], aacc, 0, 0, 0);
    float bpart[4];
#pragma unroll
    for (int i = 0; i < 4; ++i) {
      const int s = l4 * 4 + i;
      const float sg = sigmoid_fast(w0c + wacc[i]);
      const float dec = __expf(-0.6065306597126334f * sg);
      const float a = sigmoid_fast(a0c + aacc[i]);
      const float k = (float)kv[i], kk = (float)kkv[i], r = (float)rv[i];
      const float kd = k * (1.f + (a - 1.f) * kac);
      L.dec[bsel][s][chd] = dec;
      L.kd[bsel][s][chd] = kd;
      L.nk[bsel][s][chd] = -kk;
      L.bb[bsel][s][chd] = kk * a;
      L.rr[bsel][s][chd] = r;
      if (hf == 0) bpart[i] = dpp_sum16(r * kd * rkc);
    }
    if (hf == 0 && l15 == 0) {
#pragma unroll
      for (int i = 0; i < 4; ++i) L.bp[bsel][wave][l4 * 4 + i] = bpart[i];
    }
#pragma unroll
    for (int j = 0; j < 2; ++j) { const int e = tid + 256 * j; L.vv[bsel][e >> 5][e & 31] = (float)vvr[j]; }
  };
  auto write_bonus = [&](int c) {
    if (hf == 0 && tid < 16) {
      bool isctx; const int rb = chunk_rowbase(c, isctx);
      const int b2 = c & 1;
      p.bonus[((size_t)dir * MR + rb + tid) * 16 + h] = L.bp[b2][0][tid] + L.bp[b2][1][tid] + L.bp[b2][2][tid] + L.bp[b2][3][tid];
    }
  };
  __syncthreads();
  stage_load(0);
  stage_compute(0);
  __syncthreads();
  write_bonus(0);
  const int NCH = 528;
  float ykA = 0.f, ykB = 0.f;
#pragma unroll 1
  for (int c = 0; c < 16; ++c) {
    stage_load(c + 1);
    scan_steps2<DIR, false>(L, c & 1, c0, myrow, l7, S, ykA, ykB);
    stage_compute(c + 1);
    __syncthreads();
    write_bonus(c + 1);
  }
#pragma unroll 1
  for (int c = 16; c < NCH; ++c) {
    const int bsel = c & 1;
    if (c + 1 < NCH) stage_load(c + 1);
    scan_steps2<DIR, true>(L, bsel, c0, myrow, l7, S, ykA, ykB);
    L.yy[bsel][l7][myrow] = ykA;
    L.yy[bsel][8 + l7][myrow] = ykB;
    if (c + 1 < NCH) stage_compute(c + 1);
    __syncthreads();
    {
      bool isctx; const int rb = chunk_rowbase(c, isctx);
      f16* Y = dir ? p.Y1 : p.Y0;
#pragma unroll
      for (int j = 0; j < 2; ++j) {
        const int e = tid + 256 * j;
        Y[(size_t)(rb + (e >> 5)) * DM + h * 64 + hf * 32 + (e & 31)] = (f16)(L.yy[bsel][e >> 5][e & 31] * 0.0625f);
      }
    }
    if (c + 1 < NCH) write_bonus(c + 1);
  }
}
DI void phase_scan2(const Params& p, char* smem) {
  ScanLds2& L = *(ScanLds2*)smem;
  const unsigned info = p.blkinfo[blockIdx.x];
  const unsigned rank = info >> 16, ticket = info & 0xffffu;
  const unsigned n0 = xb_ld(&p.bar[XB_N0]);
  const unsigned item = rank == 0u ? ticket : n0 + ticket;
  if (item < 256u) {
    const int sc = item >> 1, hf = item & 1;
    const int dir = sc & 1, bh = sc >> 1, b = bh >> 4, h = bh & 15;
    if (dir) scan_item2<1>(p, L, b, h, hf); else scan_item2<0>(p, L, b, h, hf);
  }
}

DI void phase_scan(const Params& p, char* smem) {
  ScanLds& L = *(ScanLds*)smem;
  for (int item = blockIdx.x; item < 512; item += gridDim.x) {
    int sc, q;
    if (gridDim.x == 512) { const int xcd = item & 7, slot = item >> 3; sc = xcd * 16 + (slot >> 2); q = slot & 3; }
    else { sc = item >> 2; q = item & 3; }
    const int dir = sc & 1, bh = sc >> 1, b = bh >> 4, h = bh & 15;
    if (dir) scan_item<1>(p, L, b, h, q); else scan_item<0>(p, L, b, h, q);
  }
}

DI void phase_readout(const Params& p, char* smem) {
  float* Cs = (float*)smem;
  const int tid = threadIdx.x;
  int g0, gend, gstep; work_range(256 * 8, g0, gend, gstep);
  for (int tile = g0; tile < gend; tile += gstep) {
    int mt, nt; band_decode(tile, 256, 8, mt, nt);
    const int m0 = mt * 128;
    f32x4 acc[4][4];
    gemm_mainloop(smem, 1, 192,
                  [&](int r, int) { return (const u16*)(p.LG + (size_t)(m0 + r) * 192); },
                  [&](int c) { return (const u16*)(p.g2_t + (size_t)(nt * 128 + c) * 192); }, acc);
    acc_to_lds(Cs, acc);
    const int lane = tid & 63, wave = tid >> 6;
    const int head = nt * 2 + (lane >> 5);
    const int col = nt * 128 + 2 * lane;
    const float gw0 = p.gn_w[col], gw1 = p.gn_w[col + 1], gb0 = p.gn_b[col], gb1 = p.gn_b[col + 1];
#pragma unroll 1
    for (int rb = 0; rb < 32; rb += 8) {
      unsigned ua[8], ub[8], uv[8];
      float bn[8];
#pragma unroll
      for (int j = 0; j < 8; ++j) {
        const int row = m0 + wave * 32 + rb + j;
        ua[j] = *(const unsigned*)(p.Y0 + (size_t)row * DM + col);
        ub[j] = *(const unsigned*)(p.Y1 + (size_t)row * DM + col);
        uv[j] = *(const unsigned*)(p.V16 + (size_t)row * DM + col);
        bn[j] = p.bonus[((size_t)0 * MR + row) * 16 + head] + p.bonus[((size_t)1 * MR + row) * 16 + head];
      }
#pragma unroll
      for (int j = 0; j < 8; ++j) {
        const int r = wave * 32 + rb + j;
        const int row = m0 + r;
        const f16* fa = (const f16*)&ua[j]; const f16* fb = (const f16*)&ub[j]; const f16* fv = (const f16*)&uv[j];
        const float y0 = ((float)fa[0] + (float)fb[0]) * 16.f, y1 = ((float)fa[1] + (float)fb[1]) * 16.f;
        float sm = y0 + y1;
        sm = sum32(sm);
        const float mean = sm * (1.f / 64.f);
        const float d0 = y0 - mean, d1 = y1 - mean;
        float vs = d0 * d0 + d1 * d1;
        vs = sum32(vs);
        const float rstd = rsqrtf(vs * (1.f / 64.f) + 64e-5f);
        const float2 g = *(const float2*)&CS(r, 2 * lane);
        const float z0 = (d0 * rstd * gw0 + gb0 + bn[j] * (float)fv[0]) * g.x;
        const float z1 = (d1 * rstd * gw1 + gb1 + bn[j] * (float)fv[1]) * g.y;
        *(unsigned*)(p.Z + (size_t)row * DM + col) = pack2(z0, z1);
      }
    }
  }
}

DI void phase_final(const Params& p) {
  const int lane = threadIdx.x & 63;
  const int gw = blockIdx.x * 4 + (threadIdx.x >> 6), nw = gridDim.x * 4;
  float4 g[4];
#pragma unroll
  for (int i = 0; i < 4; ++i) g[i] = *(const float4*)(p.final_gain + i * 256 + lane * 4);
  float4 v[4], vn[4];
  int row = gw;
  if (row < TL) {
#pragma unroll
    for (int i = 0; i < 4; ++i) v[i] = *(const float4*)(p.out + (size_t)row * DM + i * 256 + lane * 4);
  }
  for (; row < TL; row += nw) {
    const int nxt = row + nw;
    if (nxt < TL) {
#pragma unroll
      for (int i = 0; i < 4; ++i) vn[i] = *(const float4*)(p.out + (size_t)nxt * DM + i * 256 + lane * 4);
    }
    float* src = p.out + (size_t)row * DM;
    float ss = 0.f;
#pragma unroll
    for (int i = 0; i < 4; ++i) ss += v[i].x * v[i].x + v[i].y * v[i].y + v[i].z * v[i].z + v[i].w * v[i].w;
    ss = wave_sum(ss);
    const float rinv = rsqrtf(ss * (1.f / 1024.f) + 1e-6f);
#pragma unroll
    for (int i = 0; i < 4; ++i) {
      float4 o;
      o.x = v[i].x * rinv * g[i].x; o.y = v[i].y * rinv * g[i].y; o.z = v[i].z * rinv * g[i].z; o.w = v[i].w * rinv * g[i].w;
      *(float4*)(src + i * 256 + lane * 4) = o;
    }
#pragma unroll
    for (int i = 0; i < 4; ++i) v[i] = vn[i];
  }
}

__global__ void __launch_bounds__(256, 2) mega(Params p) {
  __shared__ __attribute__((aligned(16))) char smem[65536];
  cg::grid_group grid = cg::this_grid();
  XbState xst; xst.x = xb_xcc_id(); xst.nloc = 0u; xst.nx = 0u;
  if (threadIdx.x == 0) {
    (void)xb_add(&p.bar[XB_XCNT(xst.x)], 1u);
    const unsigned hwid = (unsigned)__builtin_amdgcn_s_getreg((7 << 11) | (8 << 6) | 4) & 0xffu;
    const unsigned rank = xb_add(&p.bar[XB_CU((xst.x << 8) | hwid)], 1u);
    const unsigned ticket = xb_add(&p.bar[rank == 0u ? XB_N0 : XB_N1], 1u);
    p.blkinfo[blockIdx.x] = ((rank > 0u ? 1u : 0u) << 16) | (ticket & 0xffffu);
  }
  if (gridDim.x == 0x7fffffffu) grid.sync();
  phase_prep(p, smem); grid_barrier(p.bar, xst);
  phase_modreduce(p); grid_barrier(p.bar, xst);
  phase_modulate<true>(p, 0, 0, MR); grid_barrier(p.bar, xst);
  phase_qkv(p, smem); grid_barrier(p.bar, xst);
  phase_attn(p, smem); grid_barrier(p.bar, xst);
  phase_proj_res<true>(p, smem, p.H, 1024, 1024, p.wo_t, 0, 2, 264); grid_barrier(p.bar, xst);
  phase_modulate<false>(p, 0, 1, MR); grid_barrier(p.bar, xst);
  phase_ffn_up(p, smem, 0, true, p.ACT0); grid_barrier(p.bar, xst);
  phase_proj_res<false>(p, smem, p.ACT0, DFF, DFF, p.down_t, 0, 5, 264); grid_barrier(p.bar, xst);
  phase_rwkv_shift(p); grid_barrier(p.bar, xst);
  phase_rwkv_gemms(p, smem); grid_barrier(p.bar, xst);
  phase_scan2(p, smem); grid_barrier(p.bar, xst);
  phase_readout(p, smem); grid_barrier(p.bar, xst);
  phase_proj_res<false>(p, smem, p.Z, 1024, 1024, p.ro_t, 1, 2, 256); grid_barrier(p.bar, xst);
  phase_modulate<false>(p, 1, 1, TL); grid_barrier(p.bar, xst);
  phase_ffn_up(p, smem, 1, false, p.ACT1); grid_barrier(p.bar, xst);
  phase_proj_res<false>(p, smem, p.ACT1, DFF, DFF, p.down_t + (size_t)1024 * 2816, 1, 5, 256); grid_barrier(p.bar, xst);
  phase_final(p);
}

extern "C" void kernel_launch(void* const* d_in, const int* in_sizes, int n_in, void* d_out, int out_size, void* d_ws, size_t ws_size,
                              hipStream_t stream) {
  static int grid_blocks = 0;
  if (!grid_blocks) {
    int dev = 0, cus = 0, per_cu = 0;
    hipGetDevice(&dev);
    hipDeviceGetAttribute(&cus, hipDeviceAttributeMultiprocessorCount, dev);
    hipOccupancyMaxActiveBlocksPerMultiprocessor(&per_cu, mega, 256, 0);
    if (per_cu > 2) per_cu = 2;
    if (per_cu < 1) per_cu = 1;
    grid_blocks = cus * per_cu;
  }
  Params p{};
  const float* const* in = (const float* const*)d_in;
  p.x = in[0]; p.c = in[1]; p.ctx = in[2]; p.c_ctx = in[3]; p.ada_w = in[4]; p.ada_b = in[5]; p.w_qkv = in[6]; p.q_gain = in[7];
  p.k_gain = in[8]; p.w_o = in[9]; p.mu = in[10]; p.rw_r = in[11]; p.rw_k = in[12]; p.rw_v = in[13]; p.rw_o = in[14]; p.dw0 = in[15];
  p.dw1 = in[16]; p.dw2 = in[17]; p.a0 = in[18]; p.a1 = in[19]; p.a2 = in[20]; p.g1 = in[21]; p.g2 = in[22]; p.k_k = in[23];
  p.k_a = in[24]; p.r_k = in[25]; p.gn_w = in[26]; p.gn_b = in[27]; p.f_up = in[28]; p.f_cw = in[29]; p.f_cb = in[30];
  p.f_down = in[31]; p.final_gain = in[32];
  p.out = (float*)d_out;
  char* w = (char*)d_ws;
  size_t off = 0;
  auto take = [&](size_t bytes) { char* r = w + off; off += (bytes + 255) & ~(size_t)255; return r; };
  p.qkv_t = (u16*)take((size_t)1536 * 1024 * 2);
  p.wo_t = (u16*)take((size_t)1024 * 1024 * 2);
  p.up_t = (u16*)take((size_t)2 * 5632 * 1024 * 2);
  p.down_t = (u16*)take((size_t)2 * 1024 * 2816 * 2);
  p.rr_t = (u16*)take((size_t)1024 * 2048 * 2);
  p.rk_t = (u16*)take((size_t)1024 * 2048 * 2);
  p.rv_t = (u16*)take((size_t)1024 * 2048 * 2);
  p.ro_t = (u16*)take((size_t)1024 * 1024 * 2);
  p.w1_t = (u16*)take((size_t)128 * 2048 * 2);
  p.a1_t = (u16*)take((size_t)128 * 2048 * 2);
  p.g1_t = (u16*)take((size_t)256 * 2048 * 2);
  p.w2_t = (u16*)take((size_t)2 * 1024 * 64 * 2);
  p.a2_t = (u16*)take((size_t)2 * 1024 * 64 * 2);
  p.g2_t = (u16*)take((size_t)1024 * 192 * 2);
  p.modpart = (float*)take((size_t)2 * 8 * 5 * 6144 * 4);
  p.modv = (float*)take((size_t)2 * 5 * 6144 * 4);
  p.rope = (float*)take((size_t)8192 * 32 * 2 * 4);
  p.XC = (float*)take((size_t)TCX * DM * 4);
  p.bonus = (float*)take((size_t)2 * MR * 16 * 4);
  p.zero = (u16*)take(8192);
  p.bar = (unsigned*)take(65536);
  p.blkinfo = (unsigned*)take(4096 * 4);
  const size_t pb = off;
  p.H = (u16*)take((size_t)MR * DM * 2);
  const size_t after_h = off;
  p.Q = (u16*)take((size_t)TL * DM * 2);
  p.QC = (u16*)take((size_t)TCX * DM * 2);
  p.Kb = (u16*)take((size_t)16 * NKEY * 64 * 2);
  p.Vt = (u16*)take((size_t)16 * NKEY * 64 * 2);
  p.ACT0 = (u16*)take((size_t)MR * DFF * 2);
  const size_t end0 = off;
  off = after_h;
  p.XX = (u16*)take((size_t)MR * DM * 2);
  p.R16 = (f16*)take((size_t)TL * DM * 2);
  p.K16 = (f16*)take((size_t)MR * DM * 2);
  p.V16 = (f16*)take((size_t)MR * DM * 2);
  p.KK16 = (f16*)take((size_t)MR * DM * 2);
  p.LW = (u16*)take((size_t)MR * 128 * 2);
  p.LA = (u16*)take((size_t)MR * 128 * 2);
  p.LG = (u16*)take((size_t)TL * 192 * 2);
  const size_t end1 = off;
  p.Y0 = (f16*)p.H;
  p.Y1 = (f16*)p.XX;
  p.Z = (u16*)p.R16;
  p.ACT1 = (u16*)p.K16;
  (void)pb;
  const size_t need = end0 > end1 ? end0 : end1;
  if (need > ws_size) { fprintf(stderr, "workspace too small: need %zu have %zu\n", need, ws_size); return; }
  hipMemsetAsync(p.bar, 0, 65536, stream);
  void* args[] = {&p};
  hipError_t e = hipLaunchCooperativeKernel((void*)mega, dim3(grid_blocks), dim3(256), args, 0, stream);
  if (e != hipSuccess) fprintf(stderr, "cooperative launch failed: %s (grid %d)\n", hipGetErrorString(e), grid_blocks);
}
```
